# Optimizing an MI355X kernel written in HIP

```python
import jax
import jax.numpy as jnp
from jax import lax
import numpy as np

D_MODEL = 1024
BATCH = 8
SEQ = 4096
DEPTH = 2

EPS = 1e-6
MEM_LEN = 256
GDN_HEADS = 6
GDN_DK = 128
GDN_DV = 128
GDN_WIDTH = GDN_HEADS * GDN_DV
CONV_K = 4
CHUNK = 64
SB_HEADS = 12
SB_DH = 64
SB_WIDTH = SB_HEADS * SB_DH
SB_BLOCK = 128
MEM_HEADS = 4
MEM_DH = 64
MEM_WIDTH = MEM_HEADS * MEM_DH
MIX_WIDTH = GDN_WIDTH + MEM_WIDTH
A_IN = 4 * GDN_WIDTH + 2 * GDN_HEADS + MEM_WIDTH
B_IN = SB_WIDTH + MEM_WIDTH
N_GROUPS = 4
EXPERTS_PER_GROUP = 4
N_EXPERTS = N_GROUPS * EXPERTS_PER_GROUP
TOP_K = 2
EXPERT_FF = 256

kernel_name = 'yoco_gdn_stickbreak_hmoe'


def rmsnorm(x, g):
    xf = x.astype(jnp.float32)
    y = xf * lax.rsqrt(jnp.mean(xf * xf, axis=-1, keepdims=True) + EPS)
    return (y * g.astype(jnp.float32)).astype(x.dtype)


def l2norm(x):
    return x * lax.rsqrt(jnp.sum(x * x, axis=-1, keepdims=True) + EPS)


def causal_dwconv(x, w):
    c = x.shape[-1]
    return lax.conv_general_dilated(
        x, w[:, None, :].astype(x.dtype), window_strides=(1,),
        padding=((CONV_K - 1, 0),), dimension_numbers=('NWC', 'WIO', 'NWC'),
        feature_group_count=c)


def gated_delta_rule(q, k, v, beta, g):
    bsz, s, h, _ = q.shape
    n = s // CHUNK

    def chunks(t):
        return t.reshape(bsz, n, CHUNK, h, -1).transpose(0, 3, 1, 2, 4)

    q, k, v = chunks(q), chunks(k), chunks(v)
    beta = beta.reshape(bsz, n, CHUNK, h).transpose(0, 3, 1, 2)
    gc = jnp.cumsum(g.reshape(bsz, n, CHUNK, h).transpose(0, 3, 1, 2), axis=-1)
    idx = jnp.arange(CHUNK)
    incl = idx[:, None] >= idx[None, :]
    strict = idx[:, None] > idx[None, :]
    decay = jnp.exp(jnp.where(incl, gc[..., :, None] - gc[..., None, :], -jnp.inf))
    kb = k * beta[..., None]
    a_mat = jnp.where(strict, jnp.einsum('bhnid,bhnjd->bhnij', kb, k) * decay, 0.0)
    eye = jnp.eye(CHUNK, dtype=q.dtype)
    rhs = jnp.concatenate([v * beta[..., None], kb * jnp.exp(gc)[..., None]], axis=-1)
    sol = lax.linalg.triangular_solve(eye + a_mat, rhs, left_side=True, lower=True)
    u, w = sol[..., :GDN_DV], sol[..., GDN_DV:]
    qg = q * jnp.exp(gc)[..., None]
    attn_intra = jnp.where(incl, jnp.einsum('bhnid,bhnjd->bhnij', q, k) * decay, 0.0)
    g_last = gc[..., -1]
    k_tail = k * jnp.exp(g_last[..., None] - gc)[..., None]

    def step(state, xs):
        qg_c, w_c, u_c, att_c, kt_c, gl_c = xs
        v_new = u_c - jnp.einsum('bhck,bhkv->bhcv', w_c, state)
        o = jnp.einsum('bhck,bhkv->bhcv', qg_c, state) + jnp.einsum('bhij,bhjv->bhiv', att_c, v_new)
        state = state * jnp.exp(gl_c)[..., None, None] + jnp.einsum('bhck,bhcv->bhkv', kt_c, v_new)
        return state, o

    xs = tuple(jnp.moveaxis(t, 2, 0) for t in (qg, w, u, attn_intra, k_tail, g_last))
    s0 = jnp.zeros((bsz, h, GDN_DK, GDN_DV), q.dtype)
    _, o = lax.scan(step, s0, xs)
    return o.transpose(1, 0, 3, 2, 4).reshape(bsz, s, h, GDN_DV)


def memory_attend(mq, mem_k, mem_v):
    bsz, s, _ = mq.shape
    q = mq.reshape(bsz, s, MEM_HEADS, MEM_DH)
    sc = jnp.einsum('bshd,bmhd->bhsm', q, mem_k).astype(jnp.float32) * (MEM_DH ** -0.5)
    p = jax.nn.softmax(sc, axis=-1).astype(mem_v.dtype)
    return jnp.einsum('bhsm,bmhd->bshd', p, mem_v).reshape(bsz, s, MEM_WIDTH)


def stick_breaking(q, k, v):
    s_len = q.shape[2]
    outs = []
    for i in range(s_len // SB_BLOCK):
        hi = (i + 1) * SB_BLOCK
        qb = q[:, :, i * SB_BLOCK:hi]
        kb = k[:, :, :hi]
        vb = v[:, :, :hi]
        z = jnp.einsum('bhtd,bhsd->bhts', qb, kb).astype(jnp.float32) * (SB_DH ** -0.5)
        t_pos = i * SB_BLOCK + jnp.arange(SB_BLOCK)
        causal = jnp.arange(hi)[None, :] < t_pos[:, None]
        log_1mb = jnp.where(causal, jax.nn.log_sigmoid(-z), 0.0)
        after = lax.cumsum(log_1mb, axis=3, reverse=True) - log_1mb
        a = jnp.where(causal, jnp.exp(jax.nn.log_sigmoid(z) + after), 0.0)
        outs.append(jnp.einsum('bhts,bhsd->bhtd', a.astype(vb.dtype), vb))
    return jnp.concatenate(outs, axis=2)


def mixer_a(h, norm_g, w_in, w_conv, a_log, dt_bias, o_gain, w_out, mem_k, mem_v):
    bsz, s, _ = h.shape
    f32 = jnp.float32
    p = rmsnorm(h, norm_g) @ w_in
    qkv = jax.nn.silu(causal_dwconv(p[..., :3 * GDN_WIDTH], w_conv)).astype(f32)
    gate = p[..., 3 * GDN_WIDTH:4 * GDN_WIDTH].astype(f32).reshape(bsz, s, GDN_HEADS, GDN_DV)
    b_raw = p[..., 4 * GDN_WIDTH:4 * GDN_WIDTH + GDN_HEADS].astype(f32)
    a_raw = p[..., 4 * GDN_WIDTH + GDN_HEADS:4 * GDN_WIDTH + 2 * GDN_HEADS].astype(f32)
    mq = p[..., 4 * GDN_WIDTH + 2 * GDN_HEADS:]
    q = l2norm(qkv[..., :GDN_WIDTH].reshape(bsz, s, GDN_HEADS, GDN_DK)) * (GDN_DK ** -0.5)
    k = l2norm(qkv[..., GDN_WIDTH:2 * GDN_WIDTH].reshape(bsz, s, GDN_HEADS, GDN_DK))
    v = qkv[..., 2 * GDN_WIDTH:].reshape(bsz, s, GDN_HEADS, GDN_DV)
    beta = jax.nn.sigmoid(b_raw)
    g = -jnp.exp(a_log.astype(f32)) * jax.nn.softplus(a_raw + dt_bias.astype(f32))
    o = gated_delta_rule(q, k, v, beta, g)
    o = o * lax.rsqrt(jnp.mean(o * o, axis=-1, keepdims=True) + EPS) * o_gain.astype(f32) * jax.nn.silu(gate)
    o = o.reshape(bsz, s, GDN_WIDTH).astype(h.dtype)
    m = memory_attend(mq, mem_k, mem_v)
    return jnp.concatenate([o, m], axis=-1) @ w_out


def mixer_b(h, norm_g, w_in, w_out, k_sh, v_sh, mem_k, mem_v):
    bsz, s, _ = h.shape
    p = rmsnorm(h, norm_g) @ w_in
    q = p[..., :SB_WIDTH].reshape(bsz, s, SB_HEADS, SB_DH).transpose(0, 2, 1, 3)
    o = stick_breaking(q, k_sh, v_sh).transpose(0, 2, 1, 3).reshape(bsz, s, SB_WIDTH)
    m = memory_attend(p[..., SB_WIDTH:], mem_k, mem_v)
    return jnp.concatenate([o.astype(h.dtype), m], axis=-1) @ w_out


def hier_moe(xn, w_group, b_group, w_router, b_router, w1, w3, w2):
    bsz, s, d = xn.shape
    t = xn.reshape(-1, d)
    n_tok = t.shape[0]
    gl = (t @ w_group).astype(jnp.float32) + b_group.astype(jnp.float32)
    gsel = jnp.argmax(gl, axis=-1)
    p_group = jnp.max(jax.nn.softmax(gl, axis=-1), axis=-1, keepdims=True)
    el = ((t @ w_router).astype(jnp.float32) + b_router.astype(jnp.float32)).reshape(n_tok, N_GROUPS, EXPERTS_PER_GROUP)
    el = el[jnp.arange(n_tok), gsel]
    top_p, top_i = lax.top_k(jax.nn.softmax(el, axis=-1), TOP_K)
    top_p = top_p / jnp.sum(top_p, axis=-1, keepdims=True)
    eid = gsel[:, None] * EXPERTS_PER_GROUP + top_i
    combine = jnp.sum(jax.nn.one_hot(eid, N_EXPERTS, dtype=jnp.float32) * (p_group * top_p)[..., None], axis=1)
    combine = combine.astype(t.dtype)
    y = jnp.zeros_like(t)
    for e in range(N_EXPERTS):
        hid = jax.nn.silu(t @ w1[e]) * (t @ w3[e])
        y = y + combine[:, e:e + 1] * (hid @ w2[e])
    return y.reshape(bsz, s, d)


def setup_inputs(seed: int = 0) -> dict:
    key = jax.random.key(seed)
    ks = iter(jax.random.split(key, 32))
    n_a = DEPTH // 2
    n_b = DEPTH - n_a

    def nrm(shape, scale):
        return jax.random.normal(next(ks), shape, jnp.float32) * scale

    def gain(shape):
        return 1.0 + nrm(shape, 0.02)

    x = nrm((BATCH, SEQ, D_MODEL), 1.0)
    mem = nrm((BATCH, MEM_LEN, D_MODEL), 1.0)
    a_norm = gain((n_a, D_MODEL))
    a_w_in = nrm((n_a, D_MODEL, A_IN), D_MODEL ** -0.5)
    a_conv = nrm((n_a, CONV_K, 3 * GDN_WIDTH), CONV_K ** -0.5)
    a_log = jnp.log(jax.random.uniform(next(ks), (n_a, GDN_HEADS), jnp.float32, 1.0, 16.0))
    dt = jnp.exp(jax.random.uniform(next(ks), (n_a, GDN_HEADS), jnp.float32, np.log(1e-3), np.log(1e-1)))
    a_dt_bias = dt + jnp.log(-jnp.expm1(-dt))
    a_out_gain = gain((n_a, GDN_DV))
    a_w_out = nrm((n_a, MIX_WIDTH, D_MODEL), MIX_WIDTH ** -0.5)
    kv_norm = gain((D_MODEL,))
    w_kv = nrm((D_MODEL, 2 * SB_WIDTH), D_MODEL ** -0.5)
    b_norm = gain((n_b, D_MODEL))
    b_w_in = nrm((n_b, D_MODEL, B_IN), D_MODEL ** -0.5)
    b_w_out = nrm((n_b, MIX_WIDTH, D_MODEL), MIX_WIDTH ** -0.5)
    mem_norm = gain((DEPTH, D_MODEL))
    w_mem_kv = nrm((DEPTH, D_MODEL, 2 * MEM_WIDTH), D_MODEL ** -0.5)
    ffn_norm = gain((DEPTH, D_MODEL))
    w_group = nrm((DEPTH, D_MODEL, N_GROUPS), D_MODEL ** -0.5)
    b_group = nrm((DEPTH, N_GROUPS), 0.01)
    w_router = nrm((DEPTH, D_MODEL, N_EXPERTS), D_MODEL ** -0.5)
    b_router = nrm((DEPTH, N_EXPERTS), 0.01)
    w1 = nrm((DEPTH, N_EXPERTS, D_MODEL, EXPERT_FF), D_MODEL ** -0.5)
    w3 = nrm((DEPTH, N_EXPERTS, D_MODEL, EXPERT_FF), D_MODEL ** -0.5)
    w2 = nrm((DEPTH, N_EXPERTS, EXPERT_FF, D_MODEL), EXPERT_FF ** -0.5)
    final_norm = gain((D_MODEL,))
    return {'x': x, 'mem': mem, 'a_norm': a_norm, 'a_w_in': a_w_in, 'a_conv': a_conv,
            'a_log': a_log, 'a_dt_bias': a_dt_bias, 'a_out_gain': a_out_gain, 'a_w_out': a_w_out,
            'kv_norm': kv_norm, 'w_kv': w_kv, 'b_norm': b_norm, 'b_w_in': b_w_in, 'b_w_out': b_w_out,
            'mem_norm': mem_norm, 'w_mem_kv': w_mem_kv, 'ffn_norm': ffn_norm,
            'w_group': w_group, 'b_group': b_group, 'w_router': w_router, 'b_router': b_router,
            'w1': w1, 'w3': w3, 'w2': w2, 'final_norm': final_norm}


def reference(x, mem, a_norm, a_w_in, a_conv, a_log, a_dt_bias, a_out_gain, a_w_out,
              kv_norm, w_kv, b_norm, b_w_in, b_w_out, mem_norm, w_mem_kv, ffn_norm,
              w_group, b_group, w_router, b_router, w1, w3, w2, final_norm):
    bsz, s, _ = x.shape
    m_len = mem.shape[1]
    n_a = DEPTH // 2
    h = x
    k_sh = None
    v_sh = None
    for l in range(DEPTH):
        mkv = rmsnorm(mem, mem_norm[l]) @ w_mem_kv[l]
        mem_k = mkv[..., :MEM_WIDTH].reshape(bsz, m_len, MEM_HEADS, MEM_DH)
        mem_v = mkv[..., MEM_WIDTH:].reshape(bsz, m_len, MEM_HEADS, MEM_DH)
        if l < n_a:
            h = h + mixer_a(h, a_norm[l], a_w_in[l], a_conv[l], a_log[l], a_dt_bias[l],
                            a_out_gain[l], a_w_out[l], mem_k, mem_v)
        else:
            if l == n_a:
                kv = rmsnorm(h, kv_norm) @ w_kv
                k_sh = kv[..., :SB_WIDTH].reshape(bsz, s, SB_HEADS, SB_DH).transpose(0, 2, 1, 3)
                v_sh = kv[..., SB_WIDTH:].reshape(bsz, s, SB_HEADS, SB_DH).transpose(0, 2, 1, 3)
            lb = l - n_a
            h = h + mixer_b(h, b_norm[lb], b_w_in[lb], b_w_out[lb], k_sh, v_sh, mem_k, mem_v)
        h = h + hier_moe(rmsnorm(h, ffn_norm[l]), w_group[l], b_group[l], w_router[l], b_router[l],
                         w1[l], w3[l], w2[l])
    return rmsnorm(h, final_norm)
```

```cpp
#include <hip/hip_runtime.h>
#include <stdint.h>
#include <stddef.h>

#define LAS __attribute__((address_space(3)))
typedef unsigned short bf16_t;
typedef short bf16x8 __attribute__((ext_vector_type(8)));
typedef float f32x4 __attribute__((ext_vector_type(4)));
typedef float f32x16 __attribute__((ext_vector_type(16)));
typedef unsigned u32x4 __attribute__((ext_vector_type(4)));
typedef unsigned u32x2 __attribute__((ext_vector_type(2)));

constexpr int NTOK = 32768, DM = 1024, SEQ = 4096, NBATCH = 8, MEMLEN = 256, NMEMROW = NBATCH * MEMLEN;
constexpr int LDP = 3344;
constexpr int PC_Q = 0, PC_MQ = 768, PC_K = 1024, PC_V = 1792, PC_GATE = 2560, PC_BA = 3328;
constexpr int NIN_A = 3584;
constexpr int NIN_B = 2560;
constexpr float EPS = 1e-6f;
constexpr float LOG2E = 1.4426950408889634f;
constexpr int NTHR = 512;

constexpr size_t OFF_CTRL  = 0;
constexpr size_t OFF_RSTD  = 65536;
constexpr size_t OFF_MRSTD = OFF_RSTD + (size_t)NTOK * 4;
constexpr size_t OFF_CW    = OFF_MRSTD + 8192;
constexpr size_t OFF_LIST  = OFF_CW + 65536 * 4;
constexpr size_t OFF_MEMKV = OFF_LIST + (size_t)16 * NTOK * 4;
constexpr size_t OFF_WR    = OFF_MEMKV + (size_t)2 * 2048 * 512 * 2;
constexpr size_t OFF_W     = 8u << 20;
constexpr size_t W_AIN  = 0;
constexpr size_t W_AOUT = W_AIN + (size_t)NIN_A * 1024 * 2;
constexpr size_t W_BIN  = W_AOUT + (size_t)1024 * 1024 * 2;
constexpr size_t W_BOUT = W_BIN + (size_t)NIN_B * 1024 * 2;
constexpr size_t W_MEM  = W_BOUT + (size_t)1024 * 1024 * 2;
constexpr size_t W_13   = W_MEM + (size_t)2 * 512 * 1024 * 2;
constexpr size_t W_2    = W_13 + (size_t)32 * 512 * 1024 * 2;
constexpr size_t W_END  = W_2 + (size_t)32 * 1024 * 256 * 2;
constexpr size_t OFF_P  = OFF_W + W_END;
constexpr size_t OFF_G  = OFF_P + (size_t)NTOK * LDP * 2;
constexpr size_t G_MIX  = 0;
constexpr size_t G_HB   = (size_t)128 << 20;
constexpr size_t WS_NEED = OFF_G + ((size_t)216 << 20);
static_assert(OFF_WR + 2 * 20 * 1024 * 4 <= OFF_W, "small region");
static_assert(WS_NEED <= ((size_t)512 << 20), "workspace");
constexpr int CTRL_CNT = 4096;

constexpr int LDS_BYTES = 147456;

struct Params {
  const float *x, *mem, *a_norm, *a_w_in, *a_conv, *a_log, *a_dt_bias, *a_out_gain, *a_w_out, *kv_norm, *w_kv,
      *b_norm, *b_w_in, *b_w_out, *mem_norm, *w_mem_kv, *ffn_norm, *w_group, *b_group, *w_router, *b_router,
      *w1, *w3, *w2, *final_norm;
  float* out; char* ws;
};

__device__ __forceinline__ unsigned cvt_pk_bf16(float lo, float hi) { unsigned r; asm volatile("v_cvt_pk_bf16_f32 %0, %1, %2" : "=v"(r) : "v"(lo), "v"(hi)); return r; }
__device__ __forceinline__ bf16_t f2bf(float f) { return (bf16_t)(cvt_pk_bf16(f, 0.f) & 0xffffu); }
__device__ __forceinline__ float bf2f(bf16_t b) { return __uint_as_float(((unsigned)b) << 16); }
__device__ __forceinline__ float bflo(unsigned u) { return __uint_as_float(u << 16); }
__device__ __forceinline__ float bfhi(unsigned u) { return __uint_as_float(u & 0xffff0000u); }
__device__ __forceinline__ float wave_sum(float v) {
#pragma unroll
  for (int o = 32; o >= 1; o >>= 1) v += __shfl_xor(v, o);
  return v;
}
__device__ __forceinline__ float sigmoidf_(float x) { return 1.f / (1.f + __expf(-x)); }
__device__ __forceinline__ float siluf_(float x) { return x / (1.f + __expf(-x)); }
__device__ __forceinline__ float softplusf_(float x) { return fmaxf(x, 0.f) + log1pf(__expf(-fabsf(x))); }

#define XB_TMO      128
#define XB_XCNT(j)  (256  + 64 * (j))
#define XB_XSUB(j)  (1280 + 64 * (j))
#define XB_XGEN(j)  (2304 + 64 * (j))
#define XB_TOP      3328
#define XB_TOPGEN   3392
#define XCD_BAR_WORDS 3456
#define XB_SPIN_CAP (1u << 22)
__device__ __forceinline__ unsigned xb_ld(unsigned* p)              { return __hip_atomic_load(p, __ATOMIC_RELAXED, __HIP_MEMORY_SCOPE_AGENT); }
__device__ __forceinline__ unsigned xb_add(unsigned* p, unsigned v) { return __hip_atomic_fetch_add(p, v, __ATOMIC_RELAXED, __HIP_MEMORY_SCOPE_AGENT); }
__device__ __forceinline__ unsigned xb_xcc_id() { return (unsigned)__builtin_amdgcn_s_getreg((3 << 11) | 20) & 0xFu; }
#define XB_SPIN(cond, bar) do { unsigned _sp = 0; while (cond) { __builtin_amdgcn_s_sleep(1); \
    if ((++_sp & 255u) == 0u) { if (xb_ld(&(bar)[XB_TMO])) break; if (_sp > XB_SPIN_CAP) { atomicAdd(&(bar)[XB_TMO], 1u); break; } } } } while (0)
struct XcdBarrier { unsigned* bar; unsigned x; volatile LAS unsigned* st; };
__device__ __forceinline__ XcdBarrier xcd_barrier_post(unsigned* bar, volatile LAS unsigned* st) {
    XcdBarrier b; b.bar = bar; b.x = xb_xcc_id(); b.st = st;
    if (threadIdx.x == 0) (void)xb_add(&bar[XB_XCNT(b.x)], 1u);
    return b;
}
__device__ __forceinline__ void xcd_barrier_complete(unsigned* bar, unsigned x, unsigned& nloc, unsigned& nx) {
    const unsigned G = gridDim.x * gridDim.y * gridDim.z;
    unsigned sum, cnt, mine, sp = 0u;
    for (;;) {
        sum = 0u; cnt = 0u; mine = 0u;
#pragma unroll
        for (unsigned j = 0; j < 16; ++j) { const unsigned c = xb_ld(&bar[XB_XCNT(j)]); sum += c; cnt += (c > 0u) ? 1u : 0u; mine = (j == x) ? c : mine; }
        if (sum == G) break;
        __builtin_amdgcn_s_sleep(1);
        if ((++sp & 255u) == 0u) { if (xb_ld(&bar[XB_TMO])) break; if (sp > XB_SPIN_CAP) { atomicAdd(&bar[XB_TMO], 1u); break; } }
    }
    nloc = mine > 0u ? mine : 1u; nx = cnt > 0u ? cnt : 1u;
}
__device__ __forceinline__ void xcd_barrier(const XcdBarrier& b) {
    asm volatile("s_waitcnt vmcnt(0)" ::: "memory");
    __syncthreads();
    if (threadIdx.x == 0) {
        unsigned* bar = b.bar;
        __builtin_amdgcn_s_waitcnt(0);
        unsigned nloc = b.st[0], nx = b.st[1];
        if (nloc == 0u) { xcd_barrier_complete(bar, b.x, nloc, nx); b.st[0] = nloc; b.st[1] = nx; }
        const unsigned old = xb_add(&bar[XB_XSUB(b.x)], 1u);
        const unsigned gen = old / nloc;
        if (old + 1u == (gen + 1u) * nloc) {
            __builtin_amdgcn_fence(__ATOMIC_RELEASE, "agent");
            asm volatile("s_waitcnt vmcnt(0)" ::: "memory");
            const unsigned og = xb_add(&bar[XB_TOP], 1u);
            const unsigned tg = og / nx;
            if (og + 1u == (tg + 1u) * nx) xb_add(&bar[XB_TOPGEN], 1u);
            else XB_SPIN(xb_ld(&bar[XB_TOPGEN]) == tg, bar);
            __builtin_amdgcn_fence(__ATOMIC_ACQUIRE, "agent");
            xb_add(&bar[XB_XGEN(b.x)], 1u);
            asm volatile("s_waitcnt vmcnt(0)" ::: "memory");
        } else {
            XB_SPIN(xb_ld(&bar[XB_XGEN(b.x)]) == gen, bar);
            __builtin_amdgcn_fence(__ATOMIC_ACQUIRE, "agent");
            asm volatile("s_waitcnt vmcnt(0)" ::: "memory");
        }
    }
    __syncthreads();
}

__device__ __forceinline__ void cvt_rows(bf16_t* dst, int nrows_dst, int K, const float* src, int src_ld, int col0, int nrows_src,
                         const float* gain, float scale, int gtid, int gthreads) {
  const int items = nrows_dst * (K >> 3);
  for (int it = gtid; it < items; it += gthreads) {
    const int r = it % nrows_dst, k8 = it / nrows_dst;
    float v[8];
#pragma unroll
    for (int j = 0; j < 8; ++j) {
      const int k = k8 * 8 + j;
      v[j] = (r < nrows_src) ? src[(size_t)k * src_ld + col0 + r] * (gain ? gain[k] : 1.f) * scale : 0.f;
    }
    u32x4 w; w.x = cvt_pk_bf16(v[0], v[1]); w.y = cvt_pk_bf16(v[2], v[3]); w.z = cvt_pk_bf16(v[4], v[5]); w.w = cvt_pk_bf16(v[6], v[7]);
    *(u32x4*)(dst + (size_t)r * K + k8 * 8) = w;
  }
}

__device__ __forceinline__ void rows_to_bf16(const float* src, bf16_t* dst, float* rstd, int nrows, int gwave, int nwaves, int lane) {
  for (int r = gwave; r < nrows; r += nwaves) {
    const float* s = src + (size_t)r * DM; float ss = 0.f;
#pragma unroll
    for (int i = 0; i < 4; ++i) {
      const f32x4 v = *(const f32x4*)(s + i * 256 + lane * 4);
      ss += v[0] * v[0] + v[1] * v[1] + v[2] * v[2] + v[3] * v[3];
      u32x2 w; w.x = cvt_pk_bf16(v[0], v[1]); w.y = cvt_pk_bf16(v[2], v[3]);
      *(u32x2*)(dst + (size_t)r * DM + i * 256 + lane * 4) = w;
    }
    ss = wave_sum(ss);
    if (lane == 0) rstd[r] = rsqrtf(ss * (1.f / DM) + EPS);
  }
}

__device__ __forceinline__ void phase_prep(const Params& p, int bid, int nblk) {
  const int tid = threadIdx.x, gtid = bid * NTHR + tid, gthreads = nblk * NTHR, lane = tid & 63;
  char* ws = p.ws; bf16_t* W = (bf16_t*)(ws + OFF_W);
  bf16_t* wa = (bf16_t*)((char*)W + W_AIN);
  cvt_rows(wa + (size_t)PC_Q * 1024, 768, 1024, p.a_w_in, 3340, 0, 768, p.a_norm, 1.f, gtid, gthreads);
  cvt_rows(wa + (size_t)PC_MQ * 1024, 256, 1024, p.a_w_in, 3340, 3084, 256, p.a_norm, 0.125f * LOG2E, gtid, gthreads);
  cvt_rows(wa + (size_t)PC_K * 1024, 768, 1024, p.a_w_in, 3340, 768, 768, p.a_norm, 1.f, gtid, gthreads);
  cvt_rows(wa + (size_t)PC_V * 1024, 768, 1024, p.a_w_in, 3340, 1536, 768, p.a_norm, 1.f, gtid, gthreads);
  cvt_rows(wa + (size_t)PC_GATE * 1024, 768, 1024, p.a_w_in, 3340, 2304, 768, p.a_norm, 1.f, gtid, gthreads);
  cvt_rows(wa + (size_t)PC_BA * 1024, NIN_A - PC_BA, 1024, p.a_w_in, 3340, 3072, 12, p.a_norm, 1.f, gtid, gthreads);
  cvt_rows((bf16_t*)((char*)W + W_AOUT), 1024, 1024, p.a_w_out, 1024, 0, 1024, nullptr, 1.f, gtid, gthreads);
  bf16_t* wb = (bf16_t*)((char*)W + W_BIN);
  cvt_rows(wb + (size_t)PC_Q * 1024, 768, 1024, p.b_w_in, 1024, 0, 768, p.b_norm, 0.125f * LOG2E, gtid, gthreads);
  cvt_rows(wb + (size_t)PC_MQ * 1024, 256, 1024, p.b_w_in, 1024, 768, 256, p.b_norm, 0.125f * LOG2E, gtid, gthreads);
  cvt_rows(wb + (size_t)PC_K * 1024, 768, 1024, p.w_kv, 1536, 0, 768, p.kv_norm, 1.f, gtid, gthreads);
  cvt_rows(wb + (size_t)PC_V * 1024, 768, 1024, p.w_kv, 1536, 768, 768, p.kv_norm, 1.f, gtid, gthreads);
  cvt_rows((bf16_t*)((char*)W + W_BOUT), 1024, 1024, p.b_w_out, 1024, 0, 1024, nullptr, 1.f, gtid, gthreads);
  for (int l = 0; l < 2; ++l)
    cvt_rows((bf16_t*)((char*)W + W_MEM) + (size_t)l * 512 * 1024, 512, 1024, p.w_mem_kv + (size_t)l * 1024 * 512, 512, 0, 512, p.mem_norm + l * 1024, 1.f, gtid, gthreads);
  {
    bf16_t* w13 = (bf16_t*)((char*)W + W_13);
    const int items = 32 * 512 * 128;
    for (int it = gtid; it < items; it += gthreads) {
      const int le = it >> 16, rem = it & 65535, r = rem & 511, k8 = rem >> 9;
      const int u = r >> 8, which = (r >> 7) & 1, j = r & 127, l = le >> 4;
      const float* src = (which ? p.w3 : p.w1) + (size_t)le * 1024 * 256 + u * 128 + j;
      const float* g = p.ffn_norm + l * 1024;
      float v[8];
#pragma unroll
      for (int q = 0; q < 8; ++q) { const int k = k8 * 8 + q; v[q] = src[(size_t)k * 256] * g[k]; }
      u32x4 w; w.x = cvt_pk_bf16(v[0], v[1]); w.y = cvt_pk_bf16(v[2], v[3]); w.z = cvt_pk_bf16(v[4], v[5]); w.w = cvt_pk_bf16(v[6], v[7]);
      *(u32x4*)(w13 + ((size_t)le * 512 + r) * 1024 + k8 * 8) = w;
    }
    bf16_t* w2t = (bf16_t*)((char*)W + W_2);
    const int items2 = 32 * 1024 * 32;
    for (int it = gtid; it < items2; it += gthreads) {
      const int le = it >> 15, rem = it & 32767, n = rem & 1023, k8 = rem >> 10;
      const float* src = p.w2 + (size_t)le * 256 * 1024 + n;
      float v[8];
#pragma unroll
      for (int q = 0; q < 8; ++q) v[q] = src[(size_t)(k8 * 8 + q) * 1024];
      u32x4 w; w.x = cvt_pk_bf16(v[0], v[1]); w.y = cvt_pk_bf16(v[2], v[3]); w.z = cvt_pk_bf16(v[4], v[5]); w.w = cvt_pk_bf16(v[6], v[7]);
      *(u32x4*)(w2t + ((size_t)le * 1024 + n) * 256 + k8 * 8) = w;
    }
  }
  {
    float* wr = (float*)(ws + OFF_WR);
    for (int it = gtid; it < 2 * 20 * 1024; it += gthreads) {
      const int l = it / 20480, rem = it % 20480, j = rem >> 10, k = rem & 1023;
      const float w = (j < 4) ? p.w_group[((size_t)l * 1024 + k) * 4 + j] : p.w_router[((size_t)l * 1024 + k) * 16 + (j - 4)];
      wr[it] = w * p.ffn_norm[l * 1024 + k];
    }
  }
  const int gwave = gtid >> 6, nwaves = gthreads >> 6;
  rows_to_bf16(p.x, (bf16_t*)p.out, (float*)(ws + OFF_RSTD), NTOK, gwave, nwaves, lane);
  rows_to_bf16(p.mem, (bf16_t*)((char*)p.out + ((size_t)64 << 20)), (float*)(ws + OFF_MRSTD), NMEMROW, gwave, nwaves, lane);
}

struct TileSrc {
  const bf16_t* A; int lda; const int* list; int shift; int row0; int nvalid;
  const bf16_t* Bt; int K;
};
template <class Epi>
__device__ __forceinline__ void gemm_tile(LAS char* lds, const TileSrc& s, const Epi& epi) {
  const int tid = threadIdx.x, lane = tid & 63, w = tid >> 6, r32 = lane & 31, hi = lane >> 5;
  const bf16_t* ap[2]; const bf16_t* bp[2]; int soff[2];
#pragma unroll
  for (int i = 0; i < 2; ++i) {
    const int c = tid + i * NTHR, row = c >> 2, kc = (c & 3) * 8;
    int ar;
    if (s.list) { const int rr = row < s.nvalid ? row : 0; ar = s.list[s.row0 + rr] >> s.shift; } else ar = s.row0 + row;
    ap[i] = s.A + (size_t)ar * s.lda + kc; bp[i] = s.Bt + (size_t)row * s.K + kc; soff[i] = row * 80 + kc * 2;
  }
  f32x16 acc[8];
#pragma unroll
  for (int i = 0; i < 8; ++i) acc[i] = f32x16{};
  const int nk = s.K >> 5;
  u32x4 ra[2], rb[2];
#pragma unroll
  for (int i = 0; i < 2; ++i) { ra[i] = *(const u32x4*)ap[i]; rb[i] = *(const u32x4*)bp[i]; }
  __syncthreads();
#pragma unroll
  for (int i = 0; i < 2; ++i) { *(LAS u32x4*)(lds + soff[i]) = ra[i]; *(LAS u32x4*)(lds + 20480 + soff[i]) = rb[i]; }
  __syncthreads();
  for (int kt = 0; kt < nk; ++kt) {
    const int buf = kt & 1;
    if (kt + 1 < nk) {
#pragma unroll
      for (int i = 0; i < 2; ++i) { ra[i] = *(const u32x4*)(ap[i] + (kt + 1) * 32); rb[i] = *(const u32x4*)(bp[i] + (kt + 1) * 32); }
    }
    LAS const char* Ab = lds + buf * 40960; LAS const char* Bb = Ab + 20480;
#pragma unroll
    for (int ks = 0; ks < 2; ++ks) {
      const bf16x8 af = *(LAS const bf16x8*)(Ab + (32 * w + r32) * 80 + ks * 32 + hi * 16);
#pragma unroll
      for (int nt = 0; nt < 8; ++nt) {
        const bf16x8 bfr = *(LAS const bf16x8*)(Bb + (nt * 32 + r32) * 80 + ks * 32 + hi * 16);
        acc[nt] = __builtin_amdgcn_mfma_f32_32x32x16_bf16(bfr, af, acc[nt], 0, 0, 0);
      }
    }
    if (kt + 1 < nk) {
      LAS char* nb = lds + (buf ^ 1) * 40960;
#pragma unroll
      for (int i = 0; i < 2; ++i) { *(LAS u32x4*)(nb + soff[i]) = ra[i]; *(LAS u32x4*)(nb + 20480 + soff[i]) = rb[i]; }
    }
    __syncthreads();
  }
  epi(acc, 32 * w + r32, hi);
}

struct EpiScaleBf16 {
  bf16_t* C; int ldc; const float* rowscale; int row0, col0, ncol_store;
  __device__ __forceinline__ void operator()(const f32x16 (&acc)[8], int r, int hi) const {
    const int row = row0 + r; const float sc = rowscale[row];
    bf16_t* cp = C + (size_t)row * ldc;
#pragma unroll
    for (int nt = 0; nt < 8; ++nt)
#pragma unroll
      for (int g = 0; g < 4; ++g) {
        const int col = col0 + nt * 32 + 8 * g + 4 * hi;
        if (col < ncol_store) { u32x2 w; w.x = cvt_pk_bf16(acc[nt][4 * g] * sc, acc[nt][4 * g + 1] * sc); w.y = cvt_pk_bf16(acc[nt][4 * g + 2] * sc, acc[nt][4 * g + 3] * sc); *(u32x2*)(cp + col) = w; }
      }
  }
};
struct EpiResidF32 {
  float* out; const float* resid; int row0, col0;
  __device__ __forceinline__ void operator()(const f32x16 (&acc)[8], int r, int hi) const {
    const size_t base = (size_t)(row0 + r) * DM + col0;
#pragma unroll
    for (int nt = 0; nt < 8; ++nt)
#pragma unroll
      for (int g = 0; g < 4; ++g) {
        const size_t o = base + nt * 32 + 8 * g + 4 * hi;
        const f32x4 rv = *(const f32x4*)(resid + o);
        f32x4 v; v[0] = rv[0] + acc[nt][4 * g]; v[1] = rv[1] + acc[nt][4 * g + 1]; v[2] = rv[2] + acc[nt][4 * g + 2]; v[3] = rv[3] + acc[nt][4 * g + 3];
        *(f32x4*)(out + o) = v;
      }
  }
};
struct EpiMoe1 {
  bf16_t* hid; const int* list; const float* rstd; int row0, nvalid, pn;
  __device__ __forceinline__ void operator()(const f32x16 (&acc)[8], int r, int hi) const {
    if (r >= nvalid) return;
    const int slot = list[row0 + r]; const float rs = rstd[slot >> 1];
    bf16_t* hp = hid + (size_t)slot * 256 + pn * 128;
#pragma unroll
    for (int nt = 0; nt < 4; ++nt)
#pragma unroll
      for (int g = 0; g < 4; ++g) {
        float h[4];
#pragma unroll
        for (int j = 0; j < 4; ++j) { const float a = acc[nt][4 * g + j] * rs, b = acc[nt + 4][4 * g + j] * rs; h[j] = siluf_(a) * b; }
        u32x2 w; w.x = cvt_pk_bf16(h[0], h[1]); w.y = cvt_pk_bf16(h[2], h[3]);
        *(u32x2*)(hp + nt * 32 + 8 * g + 4 * hi) = w;
      }
  }
};
struct EpiMoe2 {
  bf16_t* y; const int* list; const float* cw; int row0, nvalid, col0;
  __device__ __forceinline__ void operator()(const f32x16 (&acc)[8], int r, int hi) const {
    if (r >= nvalid) return;
    const int slot = list[row0 + r]; const float c = cw[slot];
    bf16_t* yp = y + (size_t)slot * DM + col0;
#pragma unroll
    for (int nt = 0; nt < 8; ++nt)
#pragma unroll
      for (int g = 0; g < 4; ++g) {
        u32x2 w; w.x = cvt_pk_bf16(acc[nt][4 * g] * c, acc[nt][4 * g + 1] * c); w.y = cvt_pk_bf16(acc[nt][4 * g + 2] * c, acc[nt][4 * g + 3] * c);
        *(u32x2*)(yp + nt * 32 + 8 * g + 4 * hi) = w;
      }
  }
};

__device__ __forceinline__ void phase_gemm_inA(const Params& p, LAS char* lds, int bid, int nblk) {
  char* ws = p.ws;
  const bf16_t* hb = (const bf16_t*)p.out; const bf16_t* memb = (const bf16_t*)((char*)p.out + ((size_t)64 << 20));
  const bf16_t* wa = (const bf16_t*)(ws + OFF_W + W_AIN); const bf16_t* wm = (const bf16_t*)(ws + OFF_W + W_MEM);
  bf16_t* P = (bf16_t*)(ws + OFF_P); bf16_t* memkv = (bf16_t*)(ws + OFF_MEMKV);
  const int nun = 128 * 14 + 32;
  for (int u = bid; u < nun; u += nblk) {
    if (u < 128 * 14) {
      const int pm = u / 14, pn = u % 14;
      TileSrc s{hb, DM, nullptr, 0, pm * 256, 256, wa + (size_t)pn * 256 * 1024, 1024};
      EpiScaleBf16 e{P, LDP, (const float*)(ws + OFF_RSTD), pm * 256, pn * 256, LDP};
      gemm_tile(lds, s, e);
    } else {
      const int v = u - 128 * 14, l = v >> 4, pm = (v >> 1) & 7, pn = v & 1;
      TileSrc s{memb, DM, nullptr, 0, pm * 256, 256, wm + ((size_t)l * 512 + pn * 256) * 1024, 1024};
      EpiScaleBf16 e{memkv + (size_t)l * 2048 * 512, 512, (const float*)(ws + OFF_MRSTD), pm * 256, pn * 256, 512};
      gemm_tile(lds, s, e);
    }
  }
}
__device__ __forceinline__ void phase_gemm_inB(const Params& p, LAS char* lds, int bid, int nblk) {
  char* ws = p.ws;
  const bf16_t* hb = (const bf16_t*)(ws + OFF_G + G_HB); const bf16_t* wb = (const bf16_t*)(ws + OFF_W + W_BIN);
  bf16_t* P = (bf16_t*)(ws + OFF_P);
  for (int u = bid; u < 128 * 10; u += nblk) {
    const int pm = u / 10, pn = u % 10;
    TileSrc s{hb, DM, nullptr, 0, pm * 256, 256, wb + (size_t)pn * 256 * 1024, 1024};
    EpiScaleBf16 e{P, LDP, (const float*)(ws + OFF_RSTD), pm * 256, pn * 256, LDP};
    gemm_tile(lds, s, e);
  }
}
__device__ __forceinline__ void phase_gemm_out(const Params& p, LAS char* lds, int bid, int nblk, int layer) {
  char* ws = p.ws;
  const bf16_t* mix = (const bf16_t*)(ws + OFF_G + G_MIX);
  const bf16_t* wo = (const bf16_t*)(ws + OFF_W + (layer ? W_BOUT : W_AOUT));
  const float* resid = layer ? p.out : p.x;
  for (int u = bid; u < 128 * 4; u += nblk) {
    const int pm = u >> 2, pn = u & 3;
    TileSrc s{mix, DM, nullptr, 0, pm * 256, 256, wo + (size_t)pn * 256 * 1024, 1024};
    EpiResidF32 e{p.out, resid, pm * 256, pn * 256};
    gemm_tile(lds, s, e);
  }
}
__device__ __forceinline__ void phase_moe1(const Params& p, LAS char* lds, int bid, int nblk, int layer) {
  char* ws = p.ws;
  const unsigned* cnt = (const unsigned*)(ws + OFF_CTRL) + CTRL_CNT + layer * 16;
  const int* lists = (const int*)(ws + OFF_LIST);
  const bf16_t* hb = (const bf16_t*)(ws + OFF_G + G_HB); const bf16_t* w13 = (const bf16_t*)(ws + OFF_W + W_13) + (size_t)layer * 16 * 512 * 1024;
  bf16_t* hid = (bf16_t*)(ws + OFF_P);
  int base = 0;
  for (int e = 0; e < 16; ++e) {
    const int n = (int)cnt[e], nt = (n + 255) >> 8, nu = nt * 2;
    int u0 = bid - (base % nblk); if (u0 < 0) u0 += nblk;
    for (int u = u0; u < nu; u += nblk) {
      const int tile = u >> 1, pn = u & 1; const int nv = (n - tile * 256) < 256 ? (n - tile * 256) : 256;
      TileSrc s{hb, DM, lists + (size_t)e * NTOK, 1, tile * 256, nv, w13 + ((size_t)e * 512 + pn * 256) * 1024, 1024};
      EpiMoe1 ep{hid, lists + (size_t)e * NTOK, (const float*)(ws + OFF_RSTD), tile * 256, nv, pn};
      gemm_tile(lds, s, ep);
    }
    base += nu;
  }
}
__device__ __forceinline__ void phase_moe2(const Params& p, LAS char* lds, int bid, int nblk, int layer) {
  char* ws = p.ws;
  const unsigned* cnt = (const unsigned*)(ws + OFF_CTRL) + CTRL_CNT + layer * 16;
  const int* lists = (const int*)(ws + OFF_LIST);
  const bf16_t* hid = (const bf16_t*)(ws + OFF_P); const bf16_t* w2t = (const bf16_t*)(ws + OFF_W + W_2) + (size_t)layer * 16 * 1024 * 256;
  bf16_t* y = (bf16_t*)(ws + OFF_G + G_MIX);
  int base = 0;
  for (int e = 0; e < 16; ++e) {
    const int n = (int)cnt[e], nt = (n + 255) >> 8, nu = nt * 4;
    int u0 = bid - (base % nblk); if (u0 < 0) u0 += nblk;
    for (int u = u0; u < nu; u += nblk) {
      const int tile = u >> 2, pn = u & 3; const int nv = (n - tile * 256) < 256 ? (n - tile * 256) : 256;
      TileSrc s{hid, 256, lists + (size_t)e * NTOK, 0, tile * 256, nv, w2t + ((size_t)e * 1024 + pn * 256) * 256, 256};
      EpiMoe2 ep{y, lists + (size_t)e * NTOK, (const float*)(ws + OFF_CW), tile * 256, nv, pn * 256};
      gemm_tile(lds, s, ep);
    }
    base += nu;
  }
}

__device__ __forceinline__ void phase_norm_route(const Params& p, LAS char* lds, int bid, int nblk, int layer) {
  char* ws = p.ws; const int tid = threadIdx.x, lane = tid & 63, w = tid >> 6;
  LAS float* wl = (LAS float*)lds;
  const float* wr = (const float*)(ws + OFF_WR) + (size_t)layer * 20480;
  __syncthreads();
  for (int i = tid; i < 20480 / 4; i += NTHR) *(LAS f32x4*)(wl + i * 4) = *(const f32x4*)(wr + i * 4);
  __syncthreads();
  bf16_t* hb = (bf16_t*)(ws + OFF_G + G_HB); float* rstd = (float*)(ws + OFF_RSTD); float* cw = (float*)(ws + OFF_CW);
  unsigned* cnt = (unsigned*)(ws + OFF_CTRL) + CTRL_CNT + layer * 16; int* lists = (int*)(ws + OFF_LIST);
  const float* bg = p.b_group + layer * 4; const float* br = p.b_router + layer * 16;
  for (int t = bid * 8 + w; t < NTOK; t += nblk * 8) {
    const float* hrow = p.out + (size_t)t * DM;
    f32x4 v[4]; float ss = 0.f;
#pragma unroll
    for (int i = 0; i < 4; ++i) {
      v[i] = *(const f32x4*)(hrow + i * 256 + lane * 4);
      ss += v[i][0] * v[i][0] + v[i][1] * v[i][1] + v[i][2] * v[i][2] + v[i][3] * v[i][3];
      u32x2 o; o.x = cvt_pk_bf16(v[i][0], v[i][1]); o.y = cvt_pk_bf16(v[i][2], v[i][3]);
      *(u32x2*)(hb + (size_t)t * DM + i * 256 + lane * 4) = o;
    }
    ss = wave_sum(ss);
    const float rs = rsqrtf(ss * (1.f / DM) + EPS);
    float lg[20];
#pragma unroll
    for (int j = 0; j < 20; ++j) {
      float a = 0.f;
#pragma unroll
      for (int i = 0; i < 4; ++i) { const f32x4 wv = *(LAS const f32x4*)(wl + j * 1024 + i * 256 + lane * 4); a += v[i][0] * wv[0] + v[i][1] * wv[1] + v[i][2] * wv[2] + v[i][3] * wv[3]; }
      lg[j] = wave_sum(a) * rs + (j < 4 ? bg[j] : br[j - 4]);
    }
    if (lane == 0) {
      rstd[t] = rs;
      int gs = 0; float gm = lg[0];
#pragma unroll
      for (int j = 1; j < 4; ++j) if (lg[j] > gm) { gm = lg[j]; gs = j; }
      float den = 0.f;
#pragma unroll
      for (int j = 0; j < 4; ++j) den += __expf(lg[j] - gm);
      const float pg = 1.f / den;
      float el[4];
#pragma unroll
      for (int j = 0; j < 4; ++j) el[j] = gs == 0 ? lg[4 + j] : gs == 1 ? lg[8 + j] : gs == 2 ? lg[12 + j] : lg[16 + j];
      int i1 = 0; float m1 = el[0];
#pragma unroll
      for (int j = 1; j < 4; ++j) if (el[j] > m1) { m1 = el[j]; i1 = j; }
      int i2 = -1; float m2 = -INFINITY;
#pragma unroll
      for (int j = 0; j < 4; ++j) if (j != i1 && el[j] > m2) { m2 = el[j]; i2 = j; }
      const float e2 = __expf(m2 - m1), p1 = 1.f / (1.f + e2), p2 = e2 * p1;
      const int ex1 = gs * 4 + i1, ex2 = gs * 4 + i2;
      const unsigned q1 = atomicAdd(&cnt[ex1], 1u), q2 = atomicAdd(&cnt[ex2], 1u);
      lists[(size_t)ex1 * NTOK + q1] = t * 2; lists[(size_t)ex2 * NTOK + q2] = t * 2 + 1;
      cw[t * 2] = pg * p1; cw[t * 2 + 1] = pg * p2;
    }
  }
}

template <bool FINAL>
__device__ __forceinline__ void phase_combine(const Params& p, int bid, int nblk) {
  char* ws = p.ws; const int tid = threadIdx.x, lane = tid & 63, w = tid >> 6;
  const bf16_t* y = (const bf16_t*)(ws + OFF_G + G_MIX); bf16_t* hb = (bf16_t*)(ws + OFF_G + G_HB); float* rstd = (float*)(ws + OFF_RSTD);
  for (int t = bid * 8 + w; t < NTOK; t += nblk * 8) {
    float* hrow = p.out + (size_t)t * DM;
    f32x4 v[4]; float ss = 0.f;
#pragma unroll
    for (int i = 0; i < 4; ++i) {
      const int c = i * 256 + lane * 4;
      v[i] = *(const f32x4*)(hrow + c);
      const u32x2 a = *(const u32x2*)(y + (size_t)(2 * t) * DM + c), b = *(const u32x2*)(y + (size_t)(2 * t + 1) * DM + c);
      v[i][0] += bflo(a.x) + bflo(b.x); v[i][1] += bfhi(a.x) + bfhi(b.x); v[i][2] += bflo(a.y) + bflo(b.y); v[i][3] += bfhi(a.y) + bfhi(b.y);
      ss += v[i][0] * v[i][0] + v[i][1] * v[i][1] + v[i][2] * v[i][2] + v[i][3] * v[i][3];
    }
    ss = wave_sum(ss);
    const float rs = rsqrtf(ss * (1.f / DM) + EPS);
#pragma unroll
    for (int i = 0; i < 4; ++i) {
      const int c = i * 256 + lane * 4;
      if (FINAL) {
        const f32x4 g = *(const f32x4*)(p.final_norm + c);
        f32x4 o; o[0] = v[i][0] * rs * g[0]; o[1] = v[i][1] * rs * g[1]; o[2] = v[i][2] * rs * g[2]; o[3] = v[i][3] * rs * g[3];
        *(f32x4*)(hrow + c) = o;
      } else {
        *(f32x4*)(hrow + c) = v[i];
        u32x2 o; o.x = cvt_pk_bf16(v[i][0], v[i][1]); o.y = cvt_pk_bf16(v[i][2], v[i][3]);
        *(u32x2*)(hb + (size_t)t * DM + c) = o;
      }
    }
    if (!FINAL && lane == 0) rstd[t] = rs;
  }
}

__device__ __forceinline__ void phase_memattn(const Params& p, int bid, int nblk, int layer) {
  char* ws = p.ws; const int tid = threadIdx.x, lane = tid & 63, w = tid >> 6;
  const bf16_t* P = (const bf16_t*)(ws + OFF_P); bf16_t* mix = (bf16_t*)(ws + OFF_G + G_MIX);
  const bf16_t* mkv = (const bf16_t*)(ws + OFF_MEMKV) + (size_t)layer * 2048 * 512;
  for (int u = bid * 8 + w; u < (NTOK / 64) * 4; u += nblk * 8) {
    const int tt = u >> 2, hd = u & 3, t = tt * 64 + lane, b = t / SEQ;
    float q[64];
    const bf16_t* qp = P + (size_t)t * LDP + PC_MQ + hd * 64;
#pragma unroll
    for (int i = 0; i < 8; ++i) { const u32x4 r = *(const u32x4*)(qp + i * 8); q[8 * i] = bflo(r.x); q[8 * i + 1] = bfhi(r.x); q[8 * i + 2] = bflo(r.y); q[8 * i + 3] = bfhi(r.y); q[8 * i + 4] = bflo(r.z); q[8 * i + 5] = bfhi(r.z); q[8 * i + 6] = bflo(r.w); q[8 * i + 7] = bfhi(r.w); }
    float o[64];
#pragma unroll
    for (int i = 0; i < 64; ++i) o[i] = 0.f;
    float mx = -INFINITY, l = 0.f;
    const bf16_t* kb = mkv + (size_t)b * 256 * 512 + hd * 64;
    for (int m = 0; m < 256; ++m) {
      const bf16_t* kp = kb + (size_t)m * 512; const bf16_t* vp = kp + 256;
      float s = 0.f;
#pragma unroll
      for (int i = 0; i < 8; ++i) { const u32x4 r = *(const u32x4*)(kp + i * 8); s += q[8 * i] * bflo(r.x) + q[8 * i + 1] * bfhi(r.x) + q[8 * i + 2] * bflo(r.y) + q[8 * i + 3] * bfhi(r.y) + q[8 * i + 4] * bflo(r.z) + q[8 * i + 5] * bfhi(r.z) + q[8 * i + 6] * bflo(r.w) + q[8 * i + 7] * bfhi(r.w); }
      const float mn = fmaxf(mx, s), sc = exp2f(mx - mn), pr = exp2f(s - mn);
      l = l * sc + pr; mx = mn;
#pragma unroll
      for (int i = 0; i < 8; ++i) { const u32x4 r = *(const u32x4*)(vp + i * 8);
        o[8 * i] = o[8 * i] * sc + pr * bflo(r.x); o[8 * i + 1] = o[8 * i + 1] * sc + pr * bfhi(r.x); o[8 * i + 2] = o[8 * i + 2] * sc + pr * bflo(r.y); o[8 * i + 3] = o[8 * i + 3] * sc + pr * bfhi(r.y);
        o[8 * i + 4] = o[8 * i + 4] * sc + pr * bflo(r.z); o[8 * i + 5] = o[8 * i + 5] * sc + pr * bfhi(r.z); o[8 * i + 6] = o[8 * i + 6] * sc + pr * bflo(r.w); o[8 * i + 7] = o[8 * i + 7] * sc + pr * bfhi(r.w); }
    }
    const float il = 1.f / l;
    bf16_t* op = mix + (size_t)t * DM + 768 + hd * 64;
#pragma unroll
    for (int i = 0; i < 8; ++i) { u32x4 r; r.x = cvt_pk_bf16(o[8 * i] * il, o[8 * i + 1] * il); r.y = cvt_pk_bf16(o[8 * i + 2] * il, o[8 * i + 3] * il); r.z = cvt_pk_bf16(o[8 * i + 4] * il, o[8 * i + 5] * il); r.w = cvt_pk_bf16(o[8 * i + 6] * il, o[8 * i + 7] * il); *(u32x4*)(op + i * 8) = r; }
  }
}

__device__ __forceinline__ void phase_sb_attn(const Params& p, int bid, int nblk) {
  char* ws = p.ws; const int tid = threadIdx.x, lane = tid & 63, w = tid >> 6;
  const bf16_t* P = (const bf16_t*)(ws + OFF_P); bf16_t* mix = (bf16_t*)(ws + OFF_G + G_MIX);
  const int nun = NBATCH * 12 * 64;
  for (int u = bid * 8 + w; u < nun; u += nblk * 8) {
    const int qt = 63 - (u / 96), bh = u % 96, b = bh / 12, h = bh % 12;
    const int tq = qt * 64 + lane; const size_t rowb = (size_t)b * SEQ;
    float q[64];
    const bf16_t* qp = P + (rowb + tq) * LDP + PC_Q + h * 64;
#pragma unroll
    for (int i = 0; i < 8; ++i) { const u32x4 r = *(const u32x4*)(qp + i * 8); q[8 * i] = bflo(r.x); q[8 * i + 1] = bfhi(r.x); q[8 * i + 2] = bflo(r.y); q[8 * i + 3] = bfhi(r.y); q[8 * i + 4] = bflo(r.z); q[8 * i + 5] = bfhi(r.z); q[8 * i + 6] = bflo(r.w); q[8 * i + 7] = bfhi(r.w); }
    float o[64];
#pragma unroll
    for (int i = 0; i < 64; ++i) o[i] = 0.f;
    float c = 1.f;
    for (int s = qt * 64 + 62; s >= 0; --s) {
      const bf16_t* kp = P + (rowb + s) * LDP + PC_K + h * 64; const bf16_t* vp = kp + (PC_V - PC_K);
      float z = 0.f;
#pragma unroll
      for (int i = 0; i < 8; ++i) { const u32x4 r = *(const u32x4*)(kp + i * 8); z += q[8 * i] * bflo(r.x) + q[8 * i + 1] * bfhi(r.x) + q[8 * i + 2] * bflo(r.y) + q[8 * i + 3] * bfhi(r.y) + q[8 * i + 4] * bflo(r.z) + q[8 * i + 5] * bfhi(r.z) + q[8 * i + 6] * bflo(r.w) + q[8 * i + 7] * bfhi(r.w); }
      const float e = exp2f(z), r1 = 1.f / (1.f + e), beta = 1.f - r1;
      const bool valid = s < tq;
      const float a = valid ? beta * c : 0.f;
      c = valid ? c * r1 : c;
#pragma unroll
      for (int i = 0; i < 8; ++i) { const u32x4 r = *(const u32x4*)(vp + i * 8);
        o[8 * i] += a * bflo(r.x); o[8 * i + 1] += a * bfhi(r.x); o[8 * i + 2] += a * bflo(r.y); o[8 * i + 3] += a * bfhi(r.y);
        o[8 * i + 4] += a * bflo(r.z); o[8 * i + 5] += a * bfhi(r.z); o[8 * i + 6] += a * bflo(r.w); o[8 * i + 7] += a * bfhi(r.w); }
    }
    bf16_t* op = mix + (rowb + tq) * DM + h * 64;
#pragma unroll
    for (int i = 0; i < 8; ++i) { u32x4 r; r.x = cvt_pk_bf16(o[8 * i], o[8 * i + 1]); r.y = cvt_pk_bf16(o[8 * i + 2], o[8 * i + 3]); r.z = cvt_pk_bf16(o[8 * i + 4], o[8 * i + 5]); r.w = cvt_pk_bf16(o[8 * i + 6], o[8 * i + 7]); *(u32x4*)(op + i * 8) = r; }
  }
}

__device__ __forceinline__ void phase_gdn_simple(const Params& p, LAS char* lds, int bid, int nblk) {
  char* ws = p.ws; const int tid = threadIdx.x;
  const bf16_t* P = (const bf16_t*)(ws + OFF_P); bf16_t* mix = (bf16_t*)(ws + OFF_G + G_MIX);
  LAS float* raw = (LAS float*)lds;
  LAS float* qs = raw + 19 * 384;
  LAS float* ks = qs + 16 * 128;
  LAS float* vs = ks + 16 * 128;
  LAS float* os = vs + 16 * 128;
  LAS float* bet = os + 16 * 128;
  LAS float* egs = bet + 16;
  const int v = tid >> 2, kq = tid & 3;
  for (int u = bid; u < NBATCH * 6; u += nblk) {
    const int b = u / 6, h = u % 6; const size_t rowb = (size_t)b * SEQ;
    float S[32];
#pragma unroll
    for (int j = 0; j < 32; ++j) S[j] = 0.f;
    const float alog = __expf(p.a_log[h]), dtb = p.a_dt_bias[h];
    for (int t0 = 0; t0 < SEQ; t0 += 16) {
      __syncthreads();
      for (int i = tid; i < 19 * 384; i += NTHR) {
        const int rr = i / 384, c = i % 384, t = t0 - 3 + rr, part = c >> 7, cc = c & 127;
        const int col = (part == 0 ? PC_Q : part == 1 ? PC_K : PC_V) + h * 128 + cc;
        raw[i] = t >= 0 ? bf2f(P[(rowb + t) * LDP + col]) : 0.f;
      }
      __syncthreads();
      for (int i = tid; i < 16 * 384; i += NTHR) {
        const int rr = i / 384, c = i % 384, part = c >> 7, cc = c & 127, ch = part * 768 + h * 128 + cc;
        float a = 0.f;
#pragma unroll
        for (int j = 0; j < 4; ++j) a += p.a_conv[j * 2304 + ch] * raw[(rr + j) * 384 + c];
        a = siluf_(a);
        (part == 0 ? qs : part == 1 ? ks : vs)[rr * 128 + cc] = a;
      }
      if (tid < 16) {
        const int t = t0 + tid;
        const float braw = bf2f(P[(rowb + t) * LDP + PC_BA + h]), araw = bf2f(P[(rowb + t) * LDP + PC_BA + 6 + h]);
        bet[tid] = sigmoidf_(braw);
        egs[tid] = __expf(-alog * softplusf_(araw + dtb));
      }
      __syncthreads();
      {
        const int pr = tid >> 4, sub = tid & 15, rr = pr >> 1, which = pr & 1;
        LAS float* row = (which ? ks : qs) + rr * 128 + sub * 8;
        float ss = 0.f;
#pragma unroll
        for (int j = 0; j < 8; ++j) ss += row[j] * row[j];
#pragma unroll
        for (int o = 8; o >= 1; o >>= 1) ss += __shfl_xor(ss, o);
        const float sc = rsqrtf(ss + EPS) * (which ? 1.f : 0.08838834764831845f);
#pragma unroll
        for (int j = 0; j < 8; ++j) row[j] *= sc;
      }
      __syncthreads();
      for (int i = 0; i < 16; ++i) {
        const float e = egs[i], be = bet[i];
        float kk[32], qq[32];
#pragma unroll
        for (int j = 0; j < 8; ++j) { const f32x4 a = *(LAS const f32x4*)(ks + i * 128 + kq * 32 + j * 4), c = *(LAS const f32x4*)(qs + i * 128 + kq * 32 + j * 4);
          kk[4 * j] = a[0]; kk[4 * j + 1] = a[1]; kk[4 * j + 2] = a[2]; kk[4 * j + 3] = a[3]; qq[4 * j] = c[0]; qq[4 * j + 1] = c[1]; qq[4 * j + 2] = c[2]; qq[4 * j + 3] = c[3]; }
        float dot = 0.f;
#pragma unroll
        for (int j = 0; j < 32; ++j) { S[j] *= e; dot += S[j] * kk[j]; }
        dot += __shfl_xor(dot, 1); dot += __shfl_xor(dot, 2);
        const float vn = be * (vs[i * 128 + v] - dot);
        float od = 0.f;
#pragma unroll
        for (int j = 0; j < 32; ++j) { S[j] += kk[j] * vn; od += S[j] * qq[j]; }
        od += __shfl_xor(od, 1); od += __shfl_xor(od, 2);
        if (kq == 0) os[i * 128 + v] = od;
      }
      __syncthreads();
      {
        const int rr = tid >> 5, sub = tid & 31, t = t0 + rr;
        const f32x4 ov = *(LAS const f32x4*)(os + rr * 128 + sub * 4);
        float ss = ov[0] * ov[0] + ov[1] * ov[1] + ov[2] * ov[2] + ov[3] * ov[3];
#pragma unroll
        for (int o = 16; o >= 1; o >>= 1) ss += __shfl_xor(ss, o);
        const float sc = rsqrtf(ss * (1.f / 128.f) + EPS);
        const bf16_t* gp = P + (rowb + t) * LDP + PC_GATE + h * 128 + sub * 4;
        const u32x2 gr = *(const u32x2*)gp;
        const f32x4 gn = *(const f32x4*)(p.a_out_gain + sub * 4);
        u32x2 o2; o2.x = cvt_pk_bf16(ov[0] * sc * gn[0] * siluf_(bflo(gr.x)), ov[1] * sc * gn[1] * siluf_(bfhi(gr.x)));
        o2.y = cvt_pk_bf16(ov[2] * sc * gn[2] * siluf_(bflo(gr.y)), ov[3] * sc * gn[3] * siluf_(bfhi(gr.y)));
        *(u32x2*)(mix + (rowb + t) * DM + h * 128 + sub * 4) = o2;
      }
    }
  }
}

constexpr int NPHASE = 15;
__global__ void __launch_bounds__(NTHR, 2) yoco_fwd(Params p, int lo, int hi) {
  extern __shared__ __attribute__((aligned(16))) char smem_raw[];
  LAS char* lds = (LAS char*)smem_raw;
  const int bid = blockIdx.x, nblk = gridDim.x;
  LAS unsigned* xbw = (LAS unsigned*)(lds + LDS_BYTES - 16);
  if (threadIdx.x == 0) { xbw[0] = 0u; xbw[1] = 0u; xbw[2] = 0u; xbw[3] = 0u; }
  __syncthreads();
  XcdBarrier bar; bar.bar = (unsigned*)(p.ws + OFF_CTRL); bar.x = 0; bar.st = (volatile LAS unsigned*)xbw;
  if (hi - lo > 1) bar = xcd_barrier_post((unsigned*)(p.ws + OFF_CTRL), (volatile LAS unsigned*)xbw);
#define PH(k) if (lo <= (k) && (k) < hi)
#define SEAM(k) if (lo <= (k) && (k) + 1 < hi) xcd_barrier(bar)
  PH(0) phase_prep(p, bid, nblk);
  SEAM(0);
  PH(1) phase_gemm_inA(p, lds, bid, nblk);
  SEAM(1);
  PH(2) { phase_memattn(p, bid, nblk, 0); phase_gdn_simple(p, lds, bid, nblk); }
  SEAM(2);
  PH(3) phase_gemm_out(p, lds, bid, nblk, 0);
  SEAM(3);
  PH(4) phase_norm_route(p, lds, bid, nblk, 0);
  SEAM(4);
  PH(5) phase_moe1(p, lds, bid, nblk, 0);
  SEAM(5);
  PH(6) phase_moe2(p, lds, bid, nblk, 0);
  SEAM(6);
  PH(7) phase_combine<false>(p, bid, nblk);
  SEAM(7);
  PH(8) phase_gemm_inB(p, lds, bid, nblk);
  SEAM(8);
  PH(9) { phase_sb_attn(p, bid, nblk); phase_memattn(p, bid, nblk, 1); }
  SEAM(9);
  PH(10) phase_gemm_out(p, lds, bid, nblk, 1);
  SEAM(10);
  PH(11) phase_norm_route(p, lds, bid, nblk, 1);
  SEAM(11);
  PH(12) phase_moe1(p, lds, bid, nblk, 1);
  SEAM(12);
  PH(13) phase_moe2(p, lds, bid, nblk, 1);
  SEAM(13);
  PH(14) phase_combine<true>(p, bid, nblk);
#undef PH
#undef SEAM
}

#ifndef N_LAUNCH_SPLIT
#define N_LAUNCH_SPLIT 1
#endif

extern "C" void kernel_launch(void* const* d_in, const int* in_sizes, int n_in, void* d_out, int out_size, void* d_ws, size_t ws_size, hipStream_t stream) {
  (void)in_sizes; (void)n_in; (void)out_size;
  if (ws_size < WS_NEED) return;
  static int grid = 0;
  if (!grid) {
    if (hipFuncSetAttribute((const void*)yoco_fwd, hipFuncAttributeMaxDynamicSharedMemorySize, LDS_BYTES) != hipSuccess) { grid = -1; return; }
    int dev = 0, cus = 0; hipGetDevice(&dev); hipDeviceGetAttribute(&cus, hipDeviceAttributeMultiprocessorCount, dev);
    int per_cu = 0; hipOccupancyMaxActiveBlocksPerMultiprocessor(&per_cu, (const void*)yoco_fwd, NTHR, LDS_BYTES);
    grid = (per_cu >= 1) ? cus : -1;
  }
  if (grid <= 0) return;
  Params p{};
  const float** pf = (const float**)&p;
  for (int i = 0; i < 25; ++i) pf[i] = (const float*)d_in[i];
  p.out = (float*)d_out; p.ws = (char*)d_ws;
  hipMemsetAsync(d_ws, 0, 65536, stream);
#if N_LAUNCH_SPLIT
  for (int k = 0; k < NPHASE; ++k) hipLaunchKernelGGL(yoco_fwd, dim3(grid), dim3(NTHR), LDS_BYTES, stream, p, k, k + 1);
#else
  hipLaunchKernelGGL(yoco_fwd, dim3(grid), dim3(NTHR), LDS_BYTES, stream, p, 0, NPHASE);
#endif
}
```

```cpp
#include <hip/hip_runtime.h>
#include <stdint.h>
#include <stddef.h>

#define LAS __attribute__((address_space(3)))
typedef unsigned short bf16_t;
typedef short bf16x8 __attribute__((ext_vector_type(8)));
typedef float f32x4 __attribute__((ext_vector_type(4)));
typedef float f32x16 __attribute__((ext_vector_type(16)));
typedef unsigned u32x4 __attribute__((ext_vector_type(4)));
typedef unsigned u32x2 __attribute__((ext_vector_type(2)));

constexpr int NTOK = 32768, DM = 1024, SEQ = 4096, NBATCH = 8, MEMLEN = 256, NMEMROW = NBATCH * MEMLEN;
constexpr int LDP = 3344;
constexpr int PC_Q = 0, PC_MQ = 768, PC_K = 1024, PC_V = 1792, PC_GATE = 2560, PC_BA = 3328;
constexpr int NIN_A = 3584;
constexpr int NIN_B = 2560;
constexpr float EPS = 1e-6f;
constexpr float LOG2E = 1.4426950408889634f;
constexpr int NTHR = 512;

constexpr size_t OFF_CTRL  = 0;
constexpr size_t OFF_RSTD  = 65536;
constexpr size_t OFF_MRSTD = OFF_RSTD + (size_t)NTOK * 4;
constexpr size_t OFF_CW    = OFF_MRSTD + 8192;
constexpr size_t OFF_LIST  = OFF_CW + 65536 * 4;
constexpr size_t OFF_MEMKV = OFF_LIST + (size_t)16 * NTOK * 4;
constexpr size_t OFF_WR    = OFF_MEMKV + (size_t)2 * 2048 * 512 * 2;
constexpr size_t OFF_W     = 8u << 20;
constexpr size_t W_AIN  = 0;
constexpr size_t W_AOUT = W_AIN + (size_t)NIN_A * 1024 * 2;
constexpr size_t W_BIN  = W_AOUT + (size_t)1024 * 1024 * 2;
constexpr size_t W_BOUT = W_BIN + (size_t)NIN_B * 1024 * 2;
constexpr size_t W_MEM  = W_BOUT + (size_t)1024 * 1024 * 2;
constexpr size_t W_13   = W_MEM + (size_t)2 * 512 * 1024 * 2;
constexpr size_t W_2    = W_13 + (size_t)32 * 512 * 1024 * 2;
constexpr size_t W_END  = W_2 + (size_t)32 * 1024 * 256 * 2;
constexpr size_t OFF_P  = OFF_W + W_END;
constexpr size_t OFF_G  = OFF_P + (size_t)NTOK * LDP * 2;
constexpr size_t G_MIX  = 0;
constexpr size_t G_HB   = (size_t)128 << 20;
constexpr size_t WS_NEED = OFF_G + ((size_t)216 << 20);
static_assert(OFF_WR + 2 * 20 * 1024 * 4 <= OFF_W, "small region");
static_assert(WS_NEED <= ((size_t)512 << 20), "workspace");
constexpr int CTRL_CNT = 4096;

constexpr int LDS_BYTES = 147456;

struct Params {
  const float *x, *mem, *a_norm, *a_w_in, *a_conv, *a_log, *a_dt_bias, *a_out_gain, *a_w_out, *kv_norm, *w_kv,
      *b_norm, *b_w_in, *b_w_out, *mem_norm, *w_mem_kv, *ffn_norm, *w_group, *b_group, *w_router, *b_router,
      *w1, *w3, *w2, *final_norm;
  float* out; char* ws;
};

__device__ __forceinline__ unsigned cvt_pk_bf16(float lo, float hi) { unsigned r; asm volatile("v_cvt_pk_bf16_f32 %0, %1, %2" : "=v"(r) : "v"(lo), "v"(hi)); return r; }
__device__ __forceinline__ bf16_t f2bf(float f) { return (bf16_t)(cvt_pk_bf16(f, 0.f) & 0xffffu); }
__device__ __forceinline__ float bf2f(bf16_t b) { return __uint_as_float(((unsigned)b) << 16); }
__device__ __forceinline__ float bflo(unsigned u) { return __uint_as_float(u << 16); }
__device__ __forceinline__ float bfhi(unsigned u) { return __uint_as_float(u & 0xffff0000u); }
__device__ __forceinline__ float wave_sum(float v) {
#pragma unroll
  for (int o = 32; o >= 1; o >>= 1) v += __shfl_xor(v, o);
  return v;
}
__device__ __forceinline__ float sigmoidf_(float x) { return 1.f / (1.f + __expf(-x)); }
__device__ __forceinline__ float siluf_(float x) { return x / (1.f + __expf(-x)); }
__device__ __forceinline__ float softplusf_(float x) { return fmaxf(x, 0.f) + log1pf(__expf(-fabsf(x))); }

#define XB_TMO      128
#define XB_XCNT(j)  (256  + 64 * (j))
#define XB_XSUB(j)  (1280 + 64 * (j))
#define XB_XGEN(j)  (2304 + 64 * (j))
#define XB_TOP      3328
#define XB_TOPGEN   3392
#define XCD_BAR_WORDS 3456
#define XB_SPIN_CAP (1u << 22)
__device__ __forceinline__ unsigned xb_ld(unsigned* p)              { return __hip_atomic_load(p, __ATOMIC_RELAXED, __HIP_MEMORY_SCOPE_AGENT); }
__device__ __forceinline__ unsigned xb_add(unsigned* p, unsigned v) { return __hip_atomic_fetch_add(p, v, __ATOMIC_RELAXED, __HIP_MEMORY_SCOPE_AGENT); }
__device__ __forceinline__ unsigned xb_xcc_id() { return (unsigned)__builtin_amdgcn_s_getreg((3 << 11) | 20) & 0xFu; }
#define XB_SPIN(cond, bar) do { unsigned _sp = 0; while (cond) { __builtin_amdgcn_s_sleep(1); \
    if ((++_sp & 255u) == 0u) { if (xb_ld(&(bar)[XB_TMO])) break; if (_sp > XB_SPIN_CAP) { atomicAdd(&(bar)[XB_TMO], 1u); break; } } } } while (0)
struct XcdBarrier { unsigned* bar; unsigned x; volatile LAS unsigned* st; };
__device__ __forceinline__ XcdBarrier xcd_barrier_post(unsigned* bar, volatile LAS unsigned* st) {
    XcdBarrier b; b.bar = bar; b.x = xb_xcc_id(); b.st = st;
    if (threadIdx.x == 0) (void)xb_add(&bar[XB_XCNT(b.x)], 1u);
    return b;
}
__device__ __forceinline__ void xcd_barrier_complete(unsigned* bar, unsigned x, unsigned& nloc, unsigned& nx) {
    const unsigned G = gridDim.x * gridDim.y * gridDim.z;
    unsigned sum, cnt, mine, sp = 0u;
    for (;;) {
        sum = 0u; cnt = 0u; mine = 0u;
#pragma unroll
        for (unsigned j = 0; j < 16; ++j) { const unsigned c = xb_ld(&bar[XB_XCNT(j)]); sum += c; cnt += (c > 0u) ? 1u : 0u; mine = (j == x) ? c : mine; }
        if (sum == G) break;
        __builtin_amdgcn_s_sleep(1);
        if ((++sp & 255u) == 0u) { if (xb_ld(&bar[XB_TMO])) break; if (sp > XB_SPIN_CAP) { atomicAdd(&bar[XB_TMO], 1u); break; } }
    }
    nloc = mine > 0u ? mine : 1u; nx = cnt > 0u ? cnt : 1u;
}
__device__ __forceinline__ void xcd_barrier(const XcdBarrier& b) {
    asm volatile("s_waitcnt vmcnt(0)" ::: "memory");
    __syncthreads();
    if (threadIdx.x == 0) {
        unsigned* bar = b.bar;
        __builtin_amdgcn_s_waitcnt(0);
        unsigned nloc = b.st[0], nx = b.st[1];
        if (nloc == 0u) { xcd_barrier_complete(bar, b.x, nloc, nx); b.st[0] = nloc; b.st[1] = nx; }
        const unsigned old = xb_add(&bar[XB_XSUB(b.x)], 1u);
        const unsigned gen = old / nloc;
        if (old + 1u == (gen + 1u) * nloc) {
            __builtin_amdgcn_fence(__ATOMIC_RELEASE, "agent");
            asm volatile("s_waitcnt vmcnt(0)" ::: "memory");
            const unsigned og = xb_add(&bar[XB_TOP], 1u);
            const unsigned tg = og / nx;
            if (og + 1u == (tg + 1u) * nx) xb_add(&bar[XB_TOPGEN], 1u);
            else XB_SPIN(xb_ld(&bar[XB_TOPGEN]) == tg, bar);
            __builtin_amdgcn_fence(__ATOMIC_ACQUIRE, "agent");
            xb_add(&bar[XB_XGEN(b.x)], 1u);
            asm volatile("s_waitcnt vmcnt(0)" ::: "memory");
        } else {
            XB_SPIN(xb_ld(&bar[XB_XGEN(b.x)]) == gen, bar);
            __builtin_amdgcn_fence(__ATOMIC_ACQUIRE, "agent");
            asm volatile("s_waitcnt vmcnt(0)" ::: "memory");
        }
    }
    __syncthreads();
}

__device__ __forceinline__ void cvt_rows(bf16_t* dst, int nrows_dst, int K, const float* src, int src_ld, int col0, int nrows_src,
                         const float* gain, float scale, int gtid, int gthreads) {
  const int items = nrows_dst * (K >> 3);
  for (int it = gtid; it < items; it += gthreads) {
    const int r = it % nrows_dst, k8 = it / nrows_dst;
    float v[8];
#pragma unroll
    for (int j = 0; j < 8; ++j) {
      const int k = k8 * 8 + j;
      v[j] = (r < nrows_src) ? src[(size_t)k * src_ld + col0 + r] * (gain ? gain[k] : 1.f) * scale : 0.f;
    }
    u32x4 w; w.x = cvt_pk_bf16(v[0], v[1]); w.y = cvt_pk_bf16(v[2], v[3]); w.z = cvt_pk_bf16(v[4], v[5]); w.w = cvt_pk_bf16(v[6], v[7]);
    *(u32x4*)(dst + (size_t)r * K + k8 * 8) = w;
  }
}

__device__ __forceinline__ void rows_to_bf16(const float* src, bf16_t* dst, float* rstd, int nrows, int gwave, int nwaves, int lane) {
  for (int r = gwave; r < nrows; r += nwaves) {
    const float* s = src + (size_t)r * DM; float ss = 0.f;
#pragma unroll
    for (int i = 0; i < 4; ++i) {
      const f32x4 v = *(const f32x4*)(s + i * 256 + lane * 4);
      ss += v[0] * v[0] + v[1] * v[1] + v[2] * v[2] + v[3] * v[3];
      u32x2 w; w.x = cvt_pk_bf16(v[0], v[1]); w.y = cvt_pk_bf16(v[2], v[3]);
      *(u32x2*)(dst + (size_t)r * DM + i * 256 + lane * 4) = w;
    }
    ss = wave_sum(ss);
    if (lane == 0) rstd[r] = rsqrtf(ss * (1.f / DM) + EPS);
  }
}

__device__ __forceinline__ void phase_prep(const Params& p, int bid, int nblk) {
  const int tid = threadIdx.x, gtid = bid * NTHR + tid, gthreads = nblk * NTHR, lane = tid & 63;
  char* ws = p.ws; bf16_t* W = (bf16_t*)(ws + OFF_W);
  bf16_t* wa = (bf16_t*)((char*)W + W_AIN);
  cvt_rows(wa + (size_t)PC_Q * 1024, 768, 1024, p.a_w_in, 3340, 0, 768, p.a_norm, 1.f, gtid, gthreads);
  cvt_rows(wa + (size_t)PC_MQ * 1024, 256, 1024, p.a_w_in, 3340, 3084, 256, p.a_norm, 0.125f * LOG2E, gtid, gthreads);
  cvt_rows(wa + (size_t)PC_K * 1024, 768, 1024, p.a_w_in, 3340, 768, 768, p.a_norm, 1.f, gtid, gthreads);
  cvt_rows(wa + (size_t)PC_V * 1024, 768, 1024, p.a_w_in, 3340, 1536, 768, p.a_norm, 1.f, gtid, gthreads);
  cvt_rows(wa + (size_t)PC_GATE * 1024, 768, 1024, p.a_w_in, 3340, 2304, 768, p.a_norm, 1.f, gtid, gthreads);
  cvt_rows(wa + (size_t)PC_BA * 1024, NIN_A - PC_BA, 1024, p.a_w_in, 3340, 3072, 12, p.a_norm, 1.f, gtid, gthreads);
  cvt_rows((bf16_t*)((char*)W + W_AOUT), 1024, 1024, p.a_w_out, 1024, 0, 1024, nullptr, 1.f, gtid, gthreads);
  bf16_t* wb = (bf16_t*)((char*)W + W_BIN);
  cvt_rows(wb + (size_t)PC_Q * 1024, 768, 1024, p.b_w_in, 1024, 0, 768, p.b_norm, 0.125f * LOG2E, gtid, gthreads);
  cvt_rows(wb + (size_t)PC_MQ * 1024, 256, 1024, p.b_w_in, 1024, 768, 256, p.b_norm, 0.125f * LOG2E, gtid, gthreads);
  cvt_rows(wb + (size_t)PC_K * 1024, 768, 1024, p.w_kv, 1536, 0, 768, p.kv_norm, 1.f, gtid, gthreads);
  cvt_rows(wb + (size_t)PC_V * 1024, 768, 1024, p.w_kv, 1536, 768, 768, p.kv_norm, 1.f, gtid, gthreads);
  cvt_rows((bf16_t*)((char*)W + W_BOUT), 1024, 1024, p.b_w_out, 1024, 0, 1024, nullptr, 1.f, gtid, gthreads);
  for (int l = 0; l < 2; ++l)
    cvt_rows((bf16_t*)((char*)W + W_MEM) + (size_t)l * 512 * 1024, 512, 1024, p.w_mem_kv + (size_t)l * 1024 * 512, 512, 0, 512, p.mem_norm + l * 1024, 1.f, gtid, gthreads);
  {
    bf16_t* w13 = (bf16_t*)((char*)W + W_13);
    const int items = 32 * 512 * 128;
    for (int it = gtid; it < items; it += gthreads) {
      const int le = it >> 16, rem = it & 65535, r = rem & 511, k8 = rem >> 9;
      const int u = r >> 8, which = (r >> 7) & 1, j = r & 127, l = le >> 4;
      const float* src = (which ? p.w3 : p.w1) + (size_t)le * 1024 * 256 + u * 128 + j;
      const float* g = p.ffn_norm + l * 1024;
      float v[8];
#pragma unroll
      for (int q = 0; q < 8; ++q) { const int k = k8 * 8 + q; v[q] = src[(size_t)k * 256] * g[k]; }
      u32x4 w; w.x = cvt_pk_bf16(v[0], v[1]); w.y = cvt_pk_bf16(v[2], v[3]); w.z = cvt_pk_bf16(v[4], v[5]); w.w = cvt_pk_bf16(v[6], v[7]);
      *(u32x4*)(w13 + ((size_t)le * 512 + r) * 1024 + k8 * 8) = w;
    }
    bf16_t* w2t = (bf16_t*)((char*)W + W_2);
    const int items2 = 32 * 1024 * 32;
    for (int it = gtid; it < items2; it += gthreads) {
      const int le = it >> 15, rem = it & 32767, n = rem & 1023, k8 = rem >> 10;
      const float* src = p.w2 + (size_t)le * 256 * 1024 + n;
      float v[8];
#pragma unroll
      for (int q = 0; q < 8; ++q) v[q] = src[(size_t)(k8 * 8 + q) * 1024];
      u32x4 w; w.x = cvt_pk_bf16(v[0], v[1]); w.y = cvt_pk_bf16(v[2], v[3]); w.z = cvt_pk_bf16(v[4], v[5]); w.w = cvt_pk_bf16(v[6], v[7]);
      *(u32x4*)(w2t + ((size_t)le * 1024 + n) * 256 + k8 * 8) = w;
    }
  }
  {
    float* wr = (float*)(ws + OFF_WR);
    for (int it = gtid; it < 2 * 20 * 1024; it += gthreads) {
      const int l = it / 20480, rem = it % 20480, j = rem >> 10, k = rem & 1023;
      const float w = (j < 4) ? p.w_group[((size_t)l * 1024 + k) * 4 + j] : p.w_router[((size_t)l * 1024 + k) * 16 + (j - 4)];
      wr[it] = w * p.ffn_norm[l * 1024 + k];
    }
  }
  const int gwave = gtid >> 6, nwaves = gthreads >> 6;
  rows_to_bf16(p.x, (bf16_t*)p.out, (float*)(ws + OFF_RSTD), NTOK, gwave, nwaves, lane);
  rows_to_bf16(p.mem, (bf16_t*)((char*)p.out + ((size_t)64 << 20)), (float*)(ws + OFF_MRSTD), NMEMROW, gwave, nwaves, lane);
}

namespace g8 {
constexpr int BM = 256, BK = 64, HALF = 128, HTB = HALF * BK * 2, STAGE_BYTES = 8 * HTB, NXCD = 8, WGM = 8;
__host__ __device__ __forceinline__ int lds_byte(int r, int c) { const int st = (r >> 4) * 2 + (c >> 5), rr = r & 15, cc = c & 31, ob = rr * 64 + cc * 2; return st * 1024 + (ob ^ (((ob >> 9) & 1) << 5)); }
__host__ __device__ __forceinline__ void stage_rc(int b, int& R, int& C) { const int st = b / 1024, sb = b % 1024, swz = sb ^ (((sb >> 9) & 1) << 5); R = (st >> 1) * 16 + swz / 64; C = (st & 1) * 32 + (swz % 64) / 2; }
__host__ __device__ __forceinline__ int perm32(int rho) { const int n = rho >> 4, i = rho & 15; return 8 * (i >> 2) + 4 * n + (i & 3); }

struct Unit { const char* A; const char* B; const int* list; int row0, nvalid, pm, pn, aux; };

struct DenseOrder {
  const char* A; const char* Bt; int K; int nM, nN, nwg, G, c;
  __device__ __forceinline__ void init(const void* A_, const void* Bt_, int K_, int M, int N, int G_, int c_) { A = (const char*)A_; Bt = (const char*)Bt_; K = K_; nM = M / BM; nN = N / BM; nwg = nM * nN; G = G_; c = c_; }
  __device__ __forceinline__ bool next(int i, Unit& u) const {
    const long L = (long)i * G + c; if (L >= nwg) return false;
    int wgid = (int)L; { const int q = nwg / NXCD, r = nwg % NXCD, xcd = wgid % NXCD, off = wgid / NXCD; wgid = (xcd < r ? xcd * (q + 1) : r * (q + 1) + (xcd - r) * q) + off; }
    const int nig = WGM * nN, gid = wgid / nig, fm = gid * WGM, gsz = (nM - fm) < WGM ? (nM - fm) : WGM;
    u.pm = fm + ((wgid % nig) % gsz); u.pn = (wgid % nig) / gsz;
    u.A = A; u.B = Bt + (size_t)u.pn * BM * K * 2; u.list = nullptr; u.row0 = u.pm * BM; u.nvalid = BM; u.aux = 0; return true;
  }
};

template <class Epi, class Sched, int SHIFT>
__device__ __forceinline__ void gemm_phase(LAS unsigned char* lds, const int K, const int lda, const Sched& S, const Epi& E) {
    const int tid = threadIdx.x, wid = __builtin_amdgcn_readfirstlane(tid >> 6), lane = tid & 63, wr = wid >> 2, wc = wid & 3, fr = lane & 15, fq = lane >> 4;
    const int nt = K / BK;
    int RA[2], CA[2]; unsigned voffB[2];
#pragma unroll
    for (int i = 0; i < 2; ++i) { int R, C; stage_rc(tid * 16 + i * 8192, R, C); const int Rb = Epi::PERM ? ((R & ~31) + perm32(R & 31)) : R;
        RA[i] = R; CA[i] = C; voffB[i] = (unsigned)(Rb * K + C) * 2u; }
    const size_t kstep = (size_t)(BK * 2);
    const size_t hstepB = (size_t)HALF * K * 2;
    const unsigned ldsw = (unsigned)wid * 1024u;
    const int aoff = lds_byte(wr * 64 + fr, fq * 8), boff = lds_byte(wc * 32 + fr, fq * 8);
#define G8_AOFF(dst, u) do { _Pragma("unroll") for (int _h = 0; _h < 2; ++_h) _Pragma("unroll") for (int _i = 0; _i < 2; ++_i) { const int _r = _h * HALF + RA[_i]; int _ar; \
        if ((u).list) { const int _rr = _r < (u).nvalid ? _r : 0; _ar = (u).list[(u).row0 + _rr] >> SHIFT; } else _ar = (u).row0 + _r; \
        dst[_h][_i] = (unsigned)(_ar * lda + CA[_i]) * 2u; } } while (0)
#define G8_SA(b, h) (((b) * 2 + (h)) * HTB)
#define G8_SB(b, h) ((4 + (b) * 2 + (h)) * HTB)
#define G8_STAGEA(bufoff, gbase, vo, kb) do { _Pragma("unroll") for (int _i = 0; _i < 2; ++_i) \
        __builtin_amdgcn_global_load_lds((const unsigned*)((gbase) + (size_t)((vo)[_i] + (unsigned)(kb))), (LAS unsigned*)(lds + (bufoff) + ldsw + _i * 8192), 16, 0, 0); } while (0)
#define G8_STAGEB(bufoff, gbase) do { _Pragma("unroll") for (int _i = 0; _i < 2; ++_i) \
        __builtin_amdgcn_global_load_lds((const unsigned*)((const char*)(gbase) + voffB[_i]), (LAS unsigned*)(lds + (bufoff) + ldsw + _i * 8192), 16, 0, 0); } while (0)
#define G8_LDA(dst, b, h) do { _Pragma("unroll") for (int m = 0; m < 4; ++m) _Pragma("unroll") for (int k = 0; k < 2; ++k) dst[m][k] = *(const LAS bf16x8*)(lds + G8_SA(b, h) + aoff + m * 2048 + k * 1024); } while (0)
#define G8_LDB(dst, b, h) do { _Pragma("unroll") for (int n = 0; n < 2; ++n) _Pragma("unroll") for (int k = 0; k < 2; ++k) dst[n][k] = *(const LAS bf16x8*)(lds + G8_SB(b, h) + boff + n * 2048 + k * 1024); } while (0)
#define G8_MMA(ai, bj, At, Bt) do { __builtin_amdgcn_s_setprio(1); _Pragma("unroll") for (int m = 0; m < 4; ++m) _Pragma("unroll") for (int n = 0; n < 2; ++n) _Pragma("unroll") for (int k = 0; k < 2; ++k) \
        acc[ai][bj][m][n] = __builtin_amdgcn_mfma_f32_16x16x32_bf16(Bt[n][k], At[m][k], acc[ai][bj][m][n], 0, 0, 0); __builtin_amdgcn_s_setprio(0); } while (0)
#define G8_WAIT_V(n) asm volatile("s_waitcnt vmcnt(" #n ")" ::: "memory")
#define G8_WAIT_L(n) asm volatile("s_waitcnt lgkmcnt(" #n ")" ::: "memory")
#define G8_BAR __builtin_amdgcn_s_barrier()
#define G8_SCHED __builtin_amdgcn_sched_barrier(0)
    Unit cur, nxt; int ui = 0;
    if (!S.next(0, cur)) return;
    f32x4 acc[2][2][4][2];
#pragma unroll
    for (int a = 0; a < 2; ++a)
#pragma unroll
        for (int b = 0; b < 2; ++b)
#pragma unroll
            for (int m = 0; m < 4; ++m)
#pragma unroll
                for (int n = 0; n < 2; ++n) acc[a][b][m][n] = (f32x4){0.f, 0.f, 0.f, 0.f};
    bf16x8 At[4][2], B0[2][2], B1[2][2];
    unsigned aoC[2][2], aoN[2][2];
    G8_AOFF(aoC, cur);
    const char* cA = cur.A; const char* cB = cur.B;
    G8_STAGEB(G8_SB(0, 0), cB); G8_STAGEB(G8_SB(0, 1), cB + hstepB); G8_STAGEA(G8_SA(0, 0), cA, aoC[0], 0); G8_STAGEA(G8_SA(0, 1), cA, aoC[1], 0);
    if (wr == 1) G8_BAR;
    G8_WAIT_V(2); G8_BAR;
    G8_STAGEB(G8_SB(1, 0), cB + kstep); G8_STAGEA(G8_SA(1, 0), cA, aoC[0], kstep); G8_STAGEB(G8_SB(1, 1), cB + hstepB + kstep);
    G8_WAIT_V(6); G8_BAR;
    for (;;) {
        const bool has_next = S.next(ui + 1, nxt);
        const char* nA = has_next ? nxt.A : cA; const char* nB = has_next ? nxt.B : cB;
        if (has_next) { G8_AOFF(aoN, nxt); } else {
#pragma unroll
            for (int h = 0; h < 2; ++h)
#pragma unroll
                for (int i = 0; i < 2; ++i) aoN[h][i] = aoC[h][i]; }
        for (int t = 0; t < nt; t += 2) {
            const bool last = (t == nt - 2);
            const unsigned k1 = (unsigned)((t + 1) * kstep);
            const char* a2b = last ? nA : cA; const unsigned k2 = last ? 0u : (unsigned)((t + 2) * kstep), k3 = k2 + (unsigned)kstep;
            const char* b2 = last ? nB : cB + (size_t)(t + 2) * kstep; const char* b3 = b2 + kstep;
            unsigned ao2[2][2];
#pragma unroll
            for (int h = 0; h < 2; ++h)
#pragma unroll
                for (int i = 0; i < 2; ++i) ao2[h][i] = last ? aoN[h][i] : aoC[h][i];
            G8_LDB(B0, 0, 0); G8_LDB(B1, 0, 1); G8_SCHED; G8_LDA(At, 0, 0); G8_STAGEA(G8_SA(1, 1), cA, aoC[1], k1);
            G8_WAIT_V(8); G8_WAIT_L(0); G8_BAR; G8_MMA(0, 0, At, B0); G8_MMA(0, 1, At, B1); G8_BAR; G8_SCHED;
            G8_LDA(At, 0, 1); G8_STAGEB(G8_SB(0, 0), b2); G8_STAGEB(G8_SB(0, 1), b2 + hstepB); G8_STAGEA(G8_SA(0, 0), a2b, ao2[0], k2);
            G8_WAIT_V(8); G8_WAIT_L(0); G8_BAR; G8_MMA(1, 0, At, B0); G8_MMA(1, 1, At, B1); G8_BAR; G8_SCHED;
            G8_LDB(B0, 1, 0); G8_LDB(B1, 1, 1); G8_SCHED; G8_LDA(At, 1, 0); G8_STAGEA(G8_SA(0, 1), a2b, ao2[1], k2);
            G8_WAIT_V(8); G8_WAIT_L(0); G8_BAR; G8_MMA(0, 0, At, B0); G8_MMA(0, 1, At, B1); G8_BAR; G8_SCHED;
            G8_LDA(At, 1, 1); G8_STAGEB(G8_SB(1, 0), b3); G8_STAGEB(G8_SB(1, 1), b3 + hstepB); G8_STAGEA(G8_SA(1, 0), a2b, ao2[0], k3);
            G8_WAIT_V(8); G8_WAIT_L(0); G8_BAR; G8_MMA(1, 0, At, B0); G8_MMA(1, 1, At, B1); G8_BAR; G8_SCHED;
        }
        if (wr == 0) G8_BAR;
        E(acc, cur, wr, wc, fr, fq);
        if (!has_next) break;
#pragma unroll
        for (int a = 0; a < 2; ++a)
#pragma unroll
            for (int b = 0; b < 2; ++b)
#pragma unroll
                for (int m = 0; m < 4; ++m)
#pragma unroll
                    for (int n = 0; n < 2; ++n) acc[a][b][m][n] = (f32x4){0.f, 0.f, 0.f, 0.f};
        cur = nxt; cA = nA; cB = nB; ++ui;
#pragma unroll
        for (int h = 0; h < 2; ++h)
#pragma unroll
            for (int i = 0; i < 2; ++i) aoC[h][i] = aoN[h][i];
        if (wr == 1) G8_BAR;
    }
    G8_WAIT_V(0);
    G8_BAR;
#undef G8_AOFF
#undef G8_SA
#undef G8_SB
#undef G8_STAGEA
#undef G8_STAGEB
#undef G8_LDA
#undef G8_LDB
#undef G8_MMA
#undef G8_WAIT_V
#undef G8_WAIT_L
#undef G8_BAR
#undef G8_SCHED
}

struct EpiScaleBf16 {
  static constexpr bool PERM = true;
  bf16_t* C; int ldc; const float* rowscale; int ncol_store;
  __device__ __forceinline__ void operator()(const f32x4 (&acc)[2][2][4][2], const Unit& u, int wr, int wc, int fr, int fq) const {
    const int row0 = u.pm * BM + wr * 64 + fr, col0 = u.pn * BM + wc * 32 + 8 * fq;
#pragma unroll
    for (int ai = 0; ai < 2; ++ai)
#pragma unroll
      for (int m = 0; m < 4; ++m) { const int row = row0 + ai * HALF + m * 16; const float sc = rowscale[row]; bf16_t* rowp = C + (size_t)row * ldc + col0;
#pragma unroll
        for (int bj = 0; bj < 2; ++bj) { const f32x4 v0 = acc[ai][bj][m][0] * sc, v1 = acc[ai][bj][m][1] * sc;
          u32x4 w; w.x = cvt_pk_bf16(v0[0], v0[1]); w.y = cvt_pk_bf16(v0[2], v0[3]); w.z = cvt_pk_bf16(v1[0], v1[1]); w.w = cvt_pk_bf16(v1[2], v1[3]);
          if (col0 + bj * HALF < ncol_store) *(u32x4*)(rowp + bj * HALF) = w; } }
  }
};
struct EpiMem {
  static constexpr bool PERM = true; bf16_t* C; const float* rs;
  __device__ __forceinline__ void operator()(const f32x4 (&acc)[2][2][4][2], const Unit& u, int wr, int wc, int fr, int fq) const {
    const int l = u.pn >> 1; Unit v = u; v.pn = u.pn & 1;
    EpiScaleBf16 e{C + (size_t)l * 2048 * 512, 512, rs, 512}; e(acc, v, wr, wc, fr, fq); }
};
struct EpiResidF32 {
  static constexpr bool PERM = false;
  float* out; const float* resid;
  __device__ __forceinline__ void operator()(const f32x4 (&acc)[2][2][4][2], const Unit& u, int wr, int wc, int fr, int fq) const {
    const int row0 = u.pm * BM + wr * 64 + fr, col0 = u.pn * BM + wc * 32 + 4 * fq;
#pragma unroll
    for (int ai = 0; ai < 2; ++ai)
#pragma unroll
      for (int m = 0; m < 4; ++m) { const size_t base = (size_t)(row0 + ai * HALF + m * 16) * DM + col0;
#pragma unroll
        for (int bj = 0; bj < 2; ++bj)
#pragma unroll
          for (int n = 0; n < 2; ++n) { const size_t o = base + bj * HALF + n * 16; const f32x4 rv = *(const f32x4*)(resid + o); *(f32x4*)(out + o) = rv + acc[ai][bj][m][n]; } }
  }
};
struct EpiMoe1 {
  static constexpr bool PERM = true;
  bf16_t* hid; const float* rstd;
  __device__ __forceinline__ void operator()(const f32x4 (&acc)[2][2][4][2], const Unit& u, int wr, int wc, int fr, int fq) const {
#pragma unroll
    for (int ai = 0; ai < 2; ++ai)
#pragma unroll
      for (int m = 0; m < 4; ++m) { const int r = ai * HALF + wr * 64 + m * 16 + fr;
        if (r < u.nvalid) { const int slot = u.list[u.row0 + r]; const float rs = rstd[slot >> 1];
          float h[8];
#pragma unroll
          for (int n = 0; n < 2; ++n)
#pragma unroll
            for (int j = 0; j < 4; ++j) { const float a = acc[ai][0][m][n][j] * rs, b = acc[ai][1][m][n][j] * rs; h[4 * n + j] = siluf_(a) * b; }
          u32x4 w; w.x = cvt_pk_bf16(h[0], h[1]); w.y = cvt_pk_bf16(h[2], h[3]); w.z = cvt_pk_bf16(h[4], h[5]); w.w = cvt_pk_bf16(h[6], h[7]);
          *(u32x4*)(hid + (size_t)slot * 256 + u.pn * 128 + wc * 32 + 8 * fq) = w; } }
  }
};
struct EpiMoe2 {
  static constexpr bool PERM = true;
  bf16_t* y; const float* cw;
  __device__ __forceinline__ void operator()(const f32x4 (&acc)[2][2][4][2], const Unit& u, int wr, int wc, int fr, int fq) const {
#pragma unroll
    for (int ai = 0; ai < 2; ++ai)
#pragma unroll
      for (int m = 0; m < 4; ++m) { const int r = ai * HALF + wr * 64 + m * 16 + fr;
        if (r < u.nvalid) { const int slot = u.list[u.row0 + r]; const float c = cw[slot];
          bf16_t* yp = y + (size_t)slot * DM + u.pn * BM + wc * 32 + 8 * fq;
#pragma unroll
          for (int bj = 0; bj < 2; ++bj) { const f32x4 v0 = acc[ai][bj][m][0] * c, v1 = acc[ai][bj][m][1] * c;
            u32x4 w; w.x = cvt_pk_bf16(v0[0], v0[1]); w.y = cvt_pk_bf16(v0[2], v0[3]); w.z = cvt_pk_bf16(v1[0], v1[1]); w.w = cvt_pk_bf16(v1[2], v1[3]);
            *(u32x4*)(yp + bj * HALF) = w; } } }
  }
};

template <int NPN>
struct MoeOrder {
  const char* A; const char* Wt; const int* lists; int cn[16]; int G, c; size_t wstride_e, wstride_pn;
  __device__ __forceinline__ bool next(int i, Unit& u) const {
    int L = i * G + c; bool found = false;
#pragma unroll
    for (int e = 0; e < 16; ++e) { const int nu = ((cn[e] + 255) >> 8) * NPN;
      if (!found) { if (L < nu) { found = true; const int tile = L / NPN, pn = L % NPN; u.pm = tile; u.pn = pn; u.aux = e; u.A = A; u.B = Wt + (size_t)e * wstride_e + (size_t)pn * wstride_pn;
          u.list = lists + (size_t)e * NTOK; u.row0 = tile * 256; u.nvalid = (cn[e] - tile * 256) < 256 ? (cn[e] - tile * 256) : 256; } else L -= nu; } }
    return found;
  }
};
}

__device__ __forceinline__ void phase_gemm_inA(const Params& p, LAS char* lds, int bid, int nblk) {
  char* ws = p.ws;
  const bf16_t* hb = (const bf16_t*)p.out; const bf16_t* memb = (const bf16_t*)((char*)p.out + ((size_t)64 << 20));
  const bf16_t* wa = (const bf16_t*)(ws + OFF_W + W_AIN); const bf16_t* wm = (const bf16_t*)(ws + OFF_W + W_MEM);
  { g8::DenseOrder S; S.init(hb, wa, 1024, NTOK, NIN_A, nblk, bid);
    g8::EpiScaleBf16 E{(bf16_t*)(ws + OFF_P), LDP, (const float*)(ws + OFF_RSTD), LDP};
    g8::gemm_phase<g8::EpiScaleBf16, g8::DenseOrder, 0>((LAS unsigned char*)lds, 1024, DM, S, E); }
  { g8::DenseOrder S; S.init(memb, wm, 1024, NMEMROW, 1024, nblk, bid);
    g8::EpiMem E{(bf16_t*)(ws + OFF_MEMKV), (const float*)(ws + OFF_MRSTD)};
    g8::gemm_phase<g8::EpiMem, g8::DenseOrder, 0>((LAS unsigned char*)lds, 1024, DM, S, E); }
}
__device__ __forceinline__ void phase_gemm_inB(const Params& p, LAS char* lds, int bid, int nblk) {
  char* ws = p.ws;
  g8::DenseOrder S; S.init(ws + OFF_G + G_HB, ws + OFF_W + W_BIN, 1024, NTOK, NIN_B, nblk, bid);
  g8::EpiScaleBf16 E{(bf16_t*)(ws + OFF_P), LDP, (const float*)(ws + OFF_RSTD), LDP};
  g8::gemm_phase<g8::EpiScaleBf16, g8::DenseOrder, 0>((LAS unsigned char*)lds, 1024, DM, S, E);
}
__device__ __forceinline__ void phase_gemm_out(const Params& p, LAS char* lds, int bid, int nblk, int layer) {
  char* ws = p.ws;
  g8::DenseOrder S; S.init(ws + OFF_G + G_MIX, ws + OFF_W + (layer ? W_BOUT : W_AOUT), 1024, NTOK, 1024, nblk, bid);
  g8::EpiResidF32 E{p.out, layer ? (const float*)p.out : p.x};
  g8::gemm_phase<g8::EpiResidF32, g8::DenseOrder, 0>((LAS unsigned char*)lds, 1024, DM, S, E);
}
__device__ __forceinline__ void phase_moe1(const Params& p, LAS char* lds, int bid, int nblk, int layer) {
  char* ws = p.ws;
  const unsigned* cnt = (const unsigned*)(ws + OFF_CTRL) + CTRL_CNT + layer * 16;
  g8::MoeOrder<2> S; S.A = ws + OFF_G + G_HB; S.Wt = ws + OFF_W + W_13 + (size_t)layer * 16 * 512 * 1024 * 2; S.lists = (const int*)(ws + OFF_LIST);
#pragma unroll
  for (int e = 0; e < 16; ++e) S.cn[e] = (int)cnt[e];
  S.G = nblk; S.c = bid; S.wstride_e = (size_t)512 * 1024 * 2; S.wstride_pn = (size_t)256 * 1024 * 2;
  g8::EpiMoe1 E{(bf16_t*)(ws + OFF_P), (const float*)(ws + OFF_RSTD)};
  g8::gemm_phase<g8::EpiMoe1, g8::MoeOrder<2>, 1>((LAS unsigned char*)lds, 1024, DM, S, E);
}
__device__ __forceinline__ void phase_moe2(const Params& p, LAS char* lds, int bid, int nblk, int layer) {
  char* ws = p.ws;
  const unsigned* cnt = (const unsigned*)(ws + OFF_CTRL) + CTRL_CNT + layer * 16;
  g8::MoeOrder<4> S; S.A = ws + OFF_P; S.Wt = ws + OFF_W + W_2 + (size_t)layer * 16 * 1024 * 256 * 2; S.lists = (const int*)(ws + OFF_LIST);
#pragma unroll
  for (int e = 0; e < 16; ++e) S.cn[e] = (int)cnt[e];
  S.G = nblk; S.c = bid; S.wstride_e = (size_t)1024 * 256 * 2; S.wstride_pn = (size_t)256 * 256 * 2;
  g8::EpiMoe2 E{(bf16_t*)(ws + OFF_G + G_MIX), (const float*)(ws + OFF_CW)};
  g8::gemm_phase<g8::EpiMoe2, g8::MoeOrder<4>, 0>((LAS unsigned char*)lds, 256, 256, S, E);
}


__device__ __forceinline__ void phase_norm_route(const Params& p, LAS char* lds, int bid, int nblk, int layer) {
  char* ws = p.ws; const int tid = threadIdx.x, lane = tid & 63, w = tid >> 6;
  LAS float* wl = (LAS float*)lds;
  const float* wr = (const float*)(ws + OFF_WR) + (size_t)layer * 20480;
  __syncthreads();
  for (int i = tid; i < 20480 / 4; i += NTHR) *(LAS f32x4*)(wl + i * 4) = *(const f32x4*)(wr + i * 4);
  __syncthreads();
  bf16_t* hb = (bf16_t*)(ws + OFF_G + G_HB); float* rstd = (float*)(ws + OFF_RSTD); float* cw = (float*)(ws + OFF_CW);
  unsigned* cnt = (unsigned*)(ws + OFF_CTRL) + CTRL_CNT + layer * 16; int* lists = (int*)(ws + OFF_LIST);
  const float* bg = p.b_group + layer * 4; const float* br = p.b_router + layer * 16;
  for (int t = bid * 8 + w; t < NTOK; t += nblk * 8) {
    const float* hrow = p.out + (size_t)t * DM;
    f32x4 v[4]; float ss = 0.f;
#pragma unroll
    for (int i = 0; i < 4; ++i) {
      v[i] = *(const f32x4*)(hrow + i * 256 + lane * 4);
      ss += v[i][0] * v[i][0] + v[i][1] * v[i][1] + v[i][2] * v[i][2] + v[i][3] * v[i][3];
      u32x2 o; o.x = cvt_pk_bf16(v[i][0], v[i][1]); o.y = cvt_pk_bf16(v[i][2], v[i][3]);
      *(u32x2*)(hb + (size_t)t * DM + i * 256 + lane * 4) = o;
    }
    ss = wave_sum(ss);
    const float rs = rsqrtf(ss * (1.f / DM) + EPS);
    float lg[20];
#pragma unroll
    for (int j = 0; j < 20; ++j) {
      float a = 0.f;
#pragma unroll
      for (int i = 0; i < 4; ++i) { const f32x4 wv = *(LAS const f32x4*)(wl + j * 1024 + i * 256 + lane * 4); a += v[i][0] * wv[0] + v[i][1] * wv[1] + v[i][2] * wv[2] + v[i][3] * wv[3]; }
      lg[j] = wave_sum(a) * rs + (j < 4 ? bg[j] : br[j - 4]);
    }
    if (lane == 0) {
      rstd[t] = rs;
      int gs = 0; float gm = lg[0];
#pragma unroll
      for (int j = 1; j < 4; ++j) if (lg[j] > gm) { gm = lg[j]; gs = j; }
      float den = 0.f;
#pragma unroll
      for (int j = 0; j < 4; ++j) den += __expf(lg[j] - gm);
      const float pg = 1.f / den;
      float el[4];
#pragma unroll
      for (int j = 0; j < 4; ++j) el[j] = gs == 0 ? lg[4 + j] : gs == 1 ? lg[8 + j] : gs == 2 ? lg[12 + j] : lg[16 + j];
      int i1 = 0; float m1 = el[0];
#pragma unroll
      for (int j = 1; j < 4; ++j) if (el[j] > m1) { m1 = el[j]; i1 = j; }
      int i2 = -1; float m2 = -INFINITY;
#pragma unroll
      for (int j = 0; j < 4; ++j) if (j != i1 && el[j] > m2) { m2 = el[j]; i2 = j; }
      const float e2 = __expf(m2 - m1), p1 = 1.f / (1.f + e2), p2 = e2 * p1;
      const int ex1 = gs * 4 + i1, ex2 = gs * 4 + i2;
      const unsigned q1 = atomicAdd(&cnt[ex1], 1u), q2 = atomicAdd(&cnt[ex2], 1u);
      lists[(size_t)ex1 * NTOK + q1] = t * 2; lists[(size_t)ex2 * NTOK + q2] = t * 2 + 1;
      cw[t * 2] = pg * p1; cw[t * 2 + 1] = pg * p2;
    }
  }
}

template <bool FINAL>
__device__ __forceinline__ void phase_combine(const Params& p, int bid, int nblk) {
  char* ws = p.ws; const int tid = threadIdx.x, lane = tid & 63, w = tid >> 6;
  const bf16_t* y = (const bf16_t*)(ws + OFF_G + G_MIX); bf16_t* hb = (bf16_t*)(ws + OFF_G + G_HB); float* rstd = (float*)(ws + OFF_RSTD);
  for (int t = bid * 8 + w; t < NTOK; t += nblk * 8) {
    float* hrow = p.out + (size_t)t * DM;
    f32x4 v[4]; float ss = 0.f;
#pragma unroll
    for (int i = 0; i < 4; ++i) {
      const int c = i * 256 + lane * 4;
      v[i] = *(const f32x4*)(hrow + c);
      const u32x2 a = *(const u32x2*)(y + (size_t)(2 * t) * DM + c), b = *(const u32x2*)(y + (size_t)(2 * t + 1) * DM + c);
      v[i][0] += bflo(a.x) + bflo(b.x); v[i][1] += bfhi(a.x) + bfhi(b.x); v[i][2] += bflo(a.y) + bflo(b.y); v[i][3] += bfhi(a.y) + bfhi(b.y);
      ss += v[i][0] * v[i][0] + v[i][1] * v[i][1] + v[i][2] * v[i][2] + v[i][3] * v[i][3];
    }
    ss = wave_sum(ss);
    const float rs = rsqrtf(ss * (1.f / DM) + EPS);
#pragma unroll
    for (int i = 0; i < 4; ++i) {
      const int c = i * 256 + lane * 4;
      if (FINAL) {
        const f32x4 g = *(const f32x4*)(p.final_norm + c);
        f32x4 o; o[0] = v[i][0] * rs * g[0]; o[1] = v[i][1] * rs * g[1]; o[2] = v[i][2] * rs * g[2]; o[3] = v[i][3] * rs * g[3];
        *(f32x4*)(hrow + c) = o;
      } else {
        *(f32x4*)(hrow + c) = v[i];
        u32x2 o; o.x = cvt_pk_bf16(v[i][0], v[i][1]); o.y = cvt_pk_bf16(v[i][2], v[i][3]);
        *(u32x2*)(hb + (size_t)t * DM + c) = o;
      }
    }
    if (!FINAL && lane == 0) rstd[t] = rs;
  }
}

__device__ __forceinline__ void phase_memattn(const Params& p, int bid, int nblk, int layer) {
  char* ws = p.ws; const int tid = threadIdx.x, lane = tid & 63, w = tid >> 6;
  const bf16_t* P = (const bf16_t*)(ws + OFF_P); bf16_t* mix = (bf16_t*)(ws + OFF_G + G_MIX);
  const bf16_t* mkv = (const bf16_t*)(ws + OFF_MEMKV) + (size_t)layer * 2048 * 512;
  for (int u = bid * 8 + w; u < (NTOK / 64) * 4; u += nblk * 8) {
    const int tt = u >> 2, hd = u & 3, t = tt * 64 + lane, b = t / SEQ;
    float q[64];
    const bf16_t* qp = P + (size_t)t * LDP + PC_MQ + hd * 64;
#pragma unroll
    for (int i = 0; i < 8; ++i) { const u32x4 r = *(const u32x4*)(qp + i * 8); q[8 * i] = bflo(r.x); q[8 * i + 1] = bfhi(r.x); q[8 * i + 2] = bflo(r.y); q[8 * i + 3] = bfhi(r.y); q[8 * i + 4] = bflo(r.z); q[8 * i + 5] = bfhi(r.z); q[8 * i + 6] = bflo(r.w); q[8 * i + 7] = bfhi(r.w); }
    float o[64];
#pragma unroll
    for (int i = 0; i < 64; ++i) o[i] = 0.f;
    float mx = -INFINITY, l = 0.f;
    const bf16_t* kb = mkv + (size_t)b * 256 * 512 + hd * 64;
    for (int m = 0; m < 256; ++m) {
      const bf16_t* kp = kb + (size_t)m * 512; const bf16_t* vp = kp + 256;
      float s = 0.f;
#pragma unroll
      for (int i = 0; i < 8; ++i) { const u32x4 r = *(const u32x4*)(kp + i * 8); s += q[8 * i] * bflo(r.x) + q[8 * i + 1] * bfhi(r.x) + q[8 * i + 2] * bflo(r.y) + q[8 * i + 3] * bfhi(r.y) + q[8 * i + 4] * bflo(r.z) + q[8 * i + 5] * bfhi(r.z) + q[8 * i + 6] * bflo(r.w) + q[8 * i + 7] * bfhi(r.w); }
      const float mn = fmaxf(mx, s), sc = exp2f(mx - mn), pr = exp2f(s - mn);
      l = l * sc + pr; mx = mn;
#pragma unroll
      for (int i = 0; i < 8; ++i) { const u32x4 r = *(const u32x4*)(vp + i * 8);
        o[8 * i] = o[8 * i] * sc + pr * bflo(r.x); o[8 * i + 1] = o[8 * i + 1] * sc + pr * bfhi(r.x); o[8 * i + 2] = o[8 * i + 2] * sc + pr * bflo(r.y); o[8 * i + 3] = o[8 * i + 3] * sc + pr * bfhi(r.y);
        o[8 * i + 4] = o[8 * i + 4] * sc + pr * bflo(r.z); o[8 * i + 5] = o[8 * i + 5] * sc + pr * bfhi(r.z); o[8 * i + 6] = o[8 * i + 6] * sc + pr * bflo(r.w); o[8 * i + 7] = o[8 * i + 7] * sc + pr * bfhi(r.w); }
    }
    const float il = 1.f / l;
    bf16_t* op = mix + (size_t)t * DM + 768 + hd * 64;
#pragma unroll
    for (int i = 0; i < 8; ++i) { u32x4 r; r.x = cvt_pk_bf16(o[8 * i] * il, o[8 * i + 1] * il); r.y = cvt_pk_bf16(o[8 * i + 2] * il, o[8 * i + 3] * il); r.z = cvt_pk_bf16(o[8 * i + 4] * il, o[8 * i + 5] * il); r.w = cvt_pk_bf16(o[8 * i + 6] * il, o[8 * i + 7] * il); *(u32x4*)(op + i * 8) = r; }
  }
}

namespace sb {
typedef short s16x4 __attribute__((ext_vector_type(4)));
constexpr int SLOTB = 8192, LDS_K = 0, LDS_V = 3 * SLOTB, LDS_OST = 6 * SLOTB, LDS_BYTES_SB = LDS_OST + 8 * 4096;
__device__ __forceinline__ s16x4 vtr(LAS const char* p) { return __builtin_bit_cast(s16x4, __builtin_amdgcn_ds_read_tr16_b64_v4i16((LAS s16x4*)p)); }

__device__ __forceinline__ void unit(const bf16_t* __restrict__ P, bf16_t* __restrict__ O, int ldo, int b, int h, int qb, LAS char* lds) {
  const int tid = threadIdx.x, lane = tid & 63, r32 = lane & 31, hi = lane >> 5; const int wid = __builtin_amdgcn_readfirstlane(tid >> 6);
  const size_t rowbase = (size_t)b * SEQ; const int q0 = qb * 256;
  const bf16_t* Kh = P + rowbase * LDP + PC_K + h * 64; const bf16_t* Vh = P + rowbase * LDP + PC_V + h * 64;
  const bf16_t* Qw = P + (rowbase + q0 + wid * 32) * LDP + PC_Q + h * 64;
  const bf16_t* ksrc = Kh + (size_t)lane * LDP + wid * 8;
  const bf16_t* vsrc = Vh + (size_t)(16 * (wid & 3) + (lane >> 2)) * LDP + (wid >> 2) * 32 + (lane & 3) * 8;
  LAS char* kdst = lds + LDS_K + wid * 1024; LAS char* vdst = lds + LDS_V + wid * 1024;
#define SB_DMA(t, slot) do { __builtin_amdgcn_global_load_lds((const unsigned*)(ksrc + (size_t)(t) * 64 * LDP), (LAS unsigned*)(kdst + (slot)), 16, 0, 0); \
                             __builtin_amdgcn_global_load_lds((const unsigned*)(vsrc + (size_t)(t) * 64 * LDP), (LAS unsigned*)(vdst + (slot)), 16, 0, 0); } while (0)
  const int NT = 4 * qb + 4;
  SB_DMA(NT - 1, 0);
  bf16x8 qr[4];
#pragma unroll
  for (int d0 = 0; d0 < 4; ++d0) qr[d0] = *(const bf16x8*)(Qw + (size_t)r32 * LDP + d0 * 16 + hi * 8);
  f32x16 o[2]; o[0] = f32x16{}; o[1] = f32x16{};
  float c = 1.f;
  const int qrel = wid * 32 + r32;
  LAS const char* kp0 = lds + LDS_K + hi * 1024 + r32 * 16;
  LAS const char* vp0 = lds + LDS_V + ((lane >> 4) & 1) * 32 + (lane & 3) * 8 + (4 * hi + ((lane & 15) >> 2)) * 64;
  int slot = 0;
  for (int i = 0; i < NT; ++i) {
    const int t = NT - 1 - i;
    const int nslot = (slot == 2 * SLOTB) ? 0 : slot + SLOTB;
    if (t > 0) { SB_DMA(t - 1, nslot); asm volatile("s_waitcnt vmcnt(2) lgkmcnt(0)\n\ts_barrier" ::: "memory"); }
    else { asm volatile("s_waitcnt vmcnt(0) lgkmcnt(0)\n\ts_barrier" ::: "memory"); }
    const int jb = t - (NT - 4);
    if (!(jb >= 0 && 64 * jb > 32 * wid + 30)) {
      f32x16 p0 = f32x16{}, p1 = f32x16{};
#pragma unroll
      for (int d0 = 0; d0 < 4; ++d0) {
        const bf16x8 k0 = *(LAS const bf16x8*)(kp0 + slot + d0 * 2048), k1 = *(LAS const bf16x8*)(kp0 + slot + d0 * 2048 + 512);
        p0 = __builtin_amdgcn_mfma_f32_32x32x16_bf16(k0, qr[d0], p0, 0, 0, 0);
        p1 = __builtin_amdgcn_mfma_f32_32x32x16_bf16(k1, qr[d0], p1, 0, 0, 0);
      }
      if (jb >= 0) {
        const int kb = 64 * jb + 4 * hi;
#pragma unroll
        for (int r = 0; r < 16; ++r) { const int kv = kb + (r & 3) + 8 * (r >> 2); if (kv >= qrel) p0[r] = -INFINITY; if (kv + 32 >= qrel) p1[r] = -INFINITY; }
      }
      float rr[32], be[32];
#pragma unroll
      for (int r = 0; r < 16; ++r) {
        const float e0 = __builtin_amdgcn_exp2f(p0[r]), e1 = __builtin_amdgcn_exp2f(p1[r]);
        rr[r] = __builtin_amdgcn_rcpf(1.f + e0); rr[16 + r] = __builtin_amdgcn_rcpf(1.f + e1);
        be[r] = 1.f - rr[r]; be[16 + r] = 1.f - rr[16 + r];
      }
      float OS[9]; OS[8] = 1.f;
#pragma unroll
      for (int G = 7; G >= 0; --G) { const float gp = (rr[4 * G] * rr[4 * G + 1]) * (rr[4 * G + 2] * rr[4 * G + 3]); OS[G] = OS[G + 1] * gp; }
      float cE[8];
#pragma unroll
      for (int G = 0; G < 8; ++G) {
        const float X = hi ? OS[G] : OS[G + 1], Y = OS[G + 1];
        auto sw = __builtin_amdgcn_permlane32_swap(__float_as_uint(X), __float_as_uint(Y), false, false);
        cE[G] = c * (__uint_as_float(sw[0]) * __uint_as_float(sw[1]));
      }
      { auto sw = __builtin_amdgcn_permlane32_swap(__float_as_uint(OS[0]), __float_as_uint(OS[0]), false, false); c *= __uint_as_float(sw[0]) * __uint_as_float(sw[1]); }
      float a[32];
#pragma unroll
      for (int G = 0; G < 8; ++G) {
        const float t3 = cE[G], t2 = t3 * rr[4 * G + 3], t1 = t2 * rr[4 * G + 2], t0 = t1 * rr[4 * G + 1];
        a[4 * G + 3] = be[4 * G + 3] * t3; a[4 * G + 2] = be[4 * G + 2] * t2; a[4 * G + 1] = be[4 * G + 1] * t1; a[4 * G] = be[4 * G] * t0;
      }
      u32x4 pw[4];
#pragma unroll
      for (int ks = 0; ks < 4; ++ks) { pw[ks].x = cvt_pk_bf16(a[8 * ks], a[8 * ks + 1]); pw[ks].y = cvt_pk_bf16(a[8 * ks + 2], a[8 * ks + 3]); pw[ks].z = cvt_pk_bf16(a[8 * ks + 4], a[8 * ks + 5]); pw[ks].w = cvt_pk_bf16(a[8 * ks + 6], a[8 * ks + 7]); }
      LAS const char* vp = vp0 + slot;
#pragma unroll
      for (int d0 = 0; d0 < 2; ++d0)
#pragma unroll
        for (int ks = 0; ks < 4; ++ks) {
          const s16x4 lo = vtr(vp + d0 * 4096 + ks * 1024), hh = vtr(vp + d0 * 4096 + ks * 1024 + 512);
          const bf16x8 vf = (bf16x8){lo[0], lo[1], lo[2], lo[3], hh[0], hh[1], hh[2], hh[3]};
          o[d0] = __builtin_amdgcn_mfma_f32_32x32x16_bf16(__builtin_bit_cast(bf16x8, pw[ks]), vf, o[d0], 0, 0, 0);
        }
    }
    slot = nslot;
  }
  bf16_t* Ow = O + (rowbase + q0 + wid * 32) * ldo + h * 64;
  LAS bf16_t* stg = (LAS bf16_t*)(lds + LDS_OST) + wid * 2048;
#pragma unroll
  for (int r = 0; r < 16; ++r) { const int orow = (r & 3) + 8 * (r >> 2) + 4 * hi;
#pragma unroll
    for (int d0 = 0; d0 < 2; ++d0) stg[orow * 64 + d0 * 32 + r32] = f2bf(o[d0][r]); }
  asm volatile("s_waitcnt lgkmcnt(0)" ::: "memory");
#pragma unroll
  for (int i = 0; i < 4; ++i) { const int row = i * 8 + (lane >> 3), ch = lane & 7; const u32x4 v = *(LAS const u32x4*)(stg + row * 64 + ch * 8); *(u32x4*)(Ow + (size_t)row * ldo + ch * 8) = v; }
  asm volatile("s_waitcnt vmcnt(0) lgkmcnt(0)\n\ts_barrier" ::: "memory");
#undef SB_DMA
}
}
__device__ __forceinline__ void phase_sb_attn(const Params& p, LAS char* lds, int bid, int nblk) {
  char* ws = p.ws;
  const bf16_t* P = (const bf16_t*)(ws + OFF_P); bf16_t* mix = (bf16_t*)(ws + OFF_G + G_MIX);
  const int vcu = (nblk % 8 == 0) ? (bid % 8) * (nblk / 8) + bid / 8 : bid;
  for (int pi = vcu; pi < 96 * 8; pi += nblk) {
    const int bh = pi >> 3, s = pi & 7, b = bh / 12, h = bh % 12;
    sb::unit(P, mix, DM, b, h, 15 - s, lds);
    sb::unit(P, mix, DM, b, h, s, lds);
  }
}

__device__ __forceinline__ void phase_gdn_simple(const Params& p, LAS char* lds, int bid, int nblk) {
  char* ws = p.ws; const int tid = threadIdx.x;
  const bf16_t* P = (const bf16_t*)(ws + OFF_P); bf16_t* mix = (bf16_t*)(ws + OFF_G + G_MIX);
  LAS float* raw = (LAS float*)lds;
  LAS float* qs = raw + 19 * 384;
  LAS float* ks = qs + 16 * 128;
  LAS float* vs = ks + 16 * 128;
  LAS float* os = vs + 16 * 128;
  LAS float* bet = os + 16 * 128;
  LAS float* egs = bet + 16;
  const int v = tid >> 2, kq = tid & 3;
  for (int u = bid; u < NBATCH * 6; u += nblk) {
    const int b = u / 6, h = u % 6; const size_t rowb = (size_t)b * SEQ;
    float S[32];
#pragma unroll
    for (int j = 0; j < 32; ++j) S[j] = 0.f;
    const float alog = __expf(p.a_log[h]), dtb = p.a_dt_bias[h];
    for (int t0 = 0; t0 < SEQ; t0 += 16) {
      __syncthreads();
      for (int i = tid; i < 19 * 384; i += NTHR) {
        const int rr = i / 384, c = i % 384, t = t0 - 3 + rr, part = c >> 7, cc = c & 127;
        const int col = (part == 0 ? PC_Q : part == 1 ? PC_K : PC_V) + h * 128 + cc;
        raw[i] = t >= 0 ? bf2f(P[(rowb + t) * LDP + col]) : 0.f;
      }
      __syncthreads();
      for (int i = tid; i < 16 * 384; i += NTHR) {
        const int rr = i / 384, c = i % 384, part = c >> 7, cc = c & 127, ch = part * 768 + h * 128 + cc;
        float a = 0.f;
#pragma unroll
        for (int j = 0; j < 4; ++j) a += p.a_conv[j * 2304 + ch] * raw[(rr + j) * 384 + c];
        a = siluf_(a);
        (part == 0 ? qs : part == 1 ? ks : vs)[rr * 128 + cc] = a;
      }
      if (tid < 16) {
        const int t = t0 + tid;
        const float braw = bf2f(P[(rowb + t) * LDP + PC_BA + h]), araw = bf2f(P[(rowb + t) * LDP + PC_BA + 6 + h]);
        bet[tid] = sigmoidf_(braw);
        egs[tid] = __expf(-alog * softplusf_(araw + dtb));
      }
      __syncthreads();
      {
        const int pr = tid >> 4, sub = tid & 15, rr = pr >> 1, which = pr & 1;
        LAS float* row = (which ? ks : qs) + rr * 128 + sub * 8;
        float ss = 0.f;
#pragma unroll
        for (int j = 0; j < 8; ++j) ss += row[j] * row[j];
#pragma unroll
        for (int o = 8; o >= 1; o >>= 1) ss += __shfl_xor(ss, o);
        const float sc = rsqrtf(ss + EPS) * (which ? 1.f : 0.08838834764831845f);
#pragma unroll
        for (int j = 0; j < 8; ++j) row[j] *= sc;
      }
      __syncthreads();
      for (int i = 0; i < 16; ++i) {
        const float e = egs[i], be = bet[i];
        float kk[32], qq[32];
#pragma unroll
        for (int j = 0; j < 8; ++j) { const f32x4 a = *(LAS const f32x4*)(ks + i * 128 + kq * 32 + j * 4), c = *(LAS const f32x4*)(qs + i * 128 + kq * 32 + j * 4);
          kk[4 * j] = a[0]; kk[4 * j + 1] = a[1]; kk[4 * j + 2] = a[2]; kk[4 * j + 3] = a[3]; qq[4 * j] = c[0]; qq[4 * j + 1] = c[1]; qq[4 * j + 2] = c[2]; qq[4 * j + 3] = c[3]; }
        float dot = 0.f;
#pragma unroll
        for (int j = 0; j < 32; ++j) { S[j] *= e; dot += S[j] * kk[j]; }
        dot += __shfl_xor(dot, 1); dot += __shfl_xor(dot, 2);
        const float vn = be * (vs[i * 128 + v] - dot);
        float od = 0.f;
#pragma unroll
        for (int j = 0; j < 32; ++j) { S[j] += kk[j] * vn; od += S[j] * qq[j]; }
        od += __shfl_xor(od, 1); od += __shfl_xor(od, 2);
        if (kq == 0) os[i * 128 + v] = od;
      }
      __syncthreads();
      {
        const int rr = tid >> 5, sub = tid & 31, t = t0 + rr;
        const f32x4 ov = *(LAS const f32x4*)(os + rr * 128 + sub * 4);
        float ss = ov[0] * ov[0] + ov[1] * ov[1] + ov[2] * ov[2] + ov[3] * ov[3];
#pragma unroll
        for (int o = 16; o >= 1; o >>= 1) ss += __shfl_xor(ss, o);
        const float sc = rsqrtf(ss * (1.f / 128.f) + EPS);
        const bf16_t* gp = P + (rowb + t) * LDP + PC_GATE + h * 128 + sub * 4;
        const u32x2 gr = *(const u32x2*)gp;
        const f32x4 gn = *(const f32x4*)(p.a_out_gain + sub * 4);
        u32x2 o2; o2.x = cvt_pk_bf16(ov[0] * sc * gn[0] * siluf_(bflo(gr.x)), ov[1] * sc * gn[1] * siluf_(bfhi(gr.x)));
        o2.y = cvt_pk_bf16(ov[2] * sc * gn[2] * siluf_(bflo(gr.y)), ov[3] * sc * gn[3] * siluf_(bfhi(gr.y)));
        *(u32x2*)(mix + (rowb + t) * DM + h * 128 + sub * 4) = o2;
      }
    }
  }
}

constexpr int NPHASE = 15;
__global__ void __launch_bounds__(NTHR, 2) yoco_fwd(Params p, int lo, int hi) {
  extern __shared__ __attribute__((aligned(16))) char smem_raw[];
  LAS char* lds = (LAS char*)smem_raw;
  const int bid = blockIdx.x, nblk = gridDim.x;
  LAS unsigned* xbw = (LAS unsigned*)(lds + LDS_BYTES - 16);
  if (threadIdx.x == 0) { xbw[0] = 0u; xbw[1] = 0u; xbw[2] = 0u; xbw[3] = 0u; }
  __syncthreads();
  XcdBarrier bar; bar.bar = (unsigned*)(p.ws + OFF_CTRL); bar.x = 0; bar.st = (volatile LAS unsigned*)xbw;
  if (hi - lo > 1) bar = xcd_barrier_post((unsigned*)(p.ws + OFF_CTRL), (volatile LAS unsigned*)xbw);
#ifndef PROBE_DOUBLE
#define PROBE_DOUBLE -1
#endif
#define PH(k) if (lo <= (k) && (k) < hi)
#define SEAM(k) if (lo <= (k) && (k) + 1 < hi) xcd_barrier(bar)
  PH(0) phase_prep(p, bid, nblk);
#if PROBE_DOUBLE == 0
  PH(0) { __syncthreads(); phase_prep(p, bid, nblk); }
#endif
  SEAM(0);
  PH(1) phase_gemm_inA(p, lds, bid, nblk);
  SEAM(1);
  PH(2) { phase_memattn(p, bid, nblk, 0); phase_gdn_simple(p, lds, bid, nblk); }
#if PROBE_DOUBLE == 2
  PH(2) { phase_gdn_simple(p, lds, bid, nblk); }
#endif
#if PROBE_DOUBLE == 22
  PH(2) { phase_memattn(p, bid, nblk, 0); }
#endif
  SEAM(2);
  PH(3) phase_gemm_out(p, lds, bid, nblk, 0);
  SEAM(3);
  PH(4) phase_norm_route(p, lds, bid, nblk, 0);
  SEAM(4);
  PH(5) phase_moe1(p, lds, bid, nblk, 0);
  SEAM(5);
  PH(6) phase_moe2(p, lds, bid, nblk, 0);
  SEAM(6);
  PH(7) phase_combine<false>(p, bid, nblk);
  SEAM(7);
  PH(8) phase_gemm_inB(p, lds, bid, nblk);
  SEAM(8);
  PH(9) { phase_sb_attn(p, lds, bid, nblk); phase_memattn(p, bid, nblk, 1); }
#if PROBE_DOUBLE == 9
  PH(9) { phase_sb_attn(p, lds, bid, nblk); }
#endif
  SEAM(9);
  PH(10) phase_gemm_out(p, lds, bid, nblk, 1);
  SEAM(10);
  PH(11) phase_norm_route(p, lds, bid, nblk, 1);
  SEAM(11);
  PH(12) phase_moe1(p, lds, bid, nblk, 1);
  SEAM(12);
  PH(13) phase_moe2(p, lds, bid, nblk, 1);
  SEAM(13);
  PH(14) phase_combine<true>(p, bid, nblk);
#undef PH
#undef SEAM
}

#ifndef N_LAUNCH_SPLIT
#define N_LAUNCH_SPLIT 0
#endif

extern "C" void kernel_launch(void* const* d_in, const int* in_sizes, int n_in, void* d_out, int out_size, void* d_ws, size_t ws_size, hipStream_t stream) {
  (void)in_sizes; (void)n_in; (void)out_size;
  if (ws_size < WS_NEED) return;
  static int grid = 0;
  if (!grid) {
    if (hipFuncSetAttribute((const void*)yoco_fwd, hipFuncAttributeMaxDynamicSharedMemorySize, LDS_BYTES) != hipSuccess) { grid = -1; return; }
    int dev = 0, cus = 0; hipGetDevice(&dev); hipDeviceGetAttribute(&cus, hipDeviceAttributeMultiprocessorCount, dev);
    int per_cu = 0; hipOccupancyMaxActiveBlocksPerMultiprocessor(&per_cu, (const void*)yoco_fwd, NTHR, LDS_BYTES);
    grid = (per_cu >= 1) ? cus : -1;
  }
  if (grid <= 0) return;
  Params p{};
  const float** pf = (const float**)&p;
  for (int i = 0; i < 25; ++i) pf[i] = (const float*)d_in[i];
  p.out = (float*)d_out; p.ws = (char*)d_ws;
  hipMemsetAsync(d_ws, 0, 65536, stream);
#if N_LAUNCH_SPLIT
  for (int k = 0; k < NPHASE; ++k) hipLaunchKernelGGL(yoco_fwd, dim3(grid), dim3(NTHR), LDS_BYTES, stream, p, k, k + 1);
#else
  hipLaunchKernelGGL(yoco_fwd, dim3(grid), dim3(NTHR), LDS_BYTES, stream, p, 0, NPHASE);
#endif
}
```

```cpp
#include <hip/hip_runtime.h>
#include <stdint.h>
#include <stddef.h>

#define LAS __attribute__((address_space(3)))
typedef unsigned short bf16_t;
typedef short bf16x8 __attribute__((ext_vector_type(8)));
typedef float f32x4 __attribute__((ext_vector_type(4)));
typedef float f32x16 __attribute__((ext_vector_type(16)));
typedef unsigned u32x4 __attribute__((ext_vector_type(4)));
typedef unsigned u32x2 __attribute__((ext_vector_type(2)));

constexpr int NTOK = 32768, DM = 1024, SEQ = 4096, NBATCH = 8, MEMLEN = 256, NMEMROW = NBATCH * MEMLEN;
constexpr int LDP = 3392;
constexpr int PC_Q = 0, PC_MQ = 768, PC_K = 1024, PC_V = 1792, PC_GATE = 2560, PC_BA = 3328;
constexpr int NIN_A = 3584;
constexpr int NIN_B = 2560;
constexpr float EPS = 1e-6f;
constexpr float LOG2E = 1.4426950408889634f;
constexpr int NTHR = 512;

constexpr size_t OFF_CTRL  = 0;
constexpr size_t OFF_RSTD  = 65536;
constexpr size_t OFF_MRSTD = OFF_RSTD + (size_t)NTOK * 4;
constexpr size_t OFF_CW    = OFF_MRSTD + 8192;
constexpr size_t OFF_LIST  = OFF_CW + 65536 * 4;
constexpr size_t OFF_MEMKV = OFF_LIST + (size_t)16 * NTOK * 4;
constexpr size_t OFF_WR    = OFF_MEMKV + (size_t)2 * 2048 * 512 * 2;
constexpr size_t OFF_EGL   = OFF_WR + (size_t)2 * 20 * 1024 * 4;
constexpr size_t OFF_W     = 8u << 20;
constexpr size_t W_AIN  = 0;
constexpr size_t W_AOUT = W_AIN + (size_t)NIN_A * 1024 * 2;
constexpr size_t W_BIN  = W_AOUT + (size_t)1024 * 1024 * 2;
constexpr size_t W_BOUT = W_BIN + (size_t)NIN_B * 1024 * 2;
constexpr size_t W_MEM  = W_BOUT + (size_t)1024 * 1024 * 2;
constexpr size_t W_13   = W_MEM + (size_t)2 * 512 * 1024 * 2;
constexpr size_t W_2    = W_13 + (size_t)32 * 512 * 1024 * 2;
constexpr size_t W_END  = W_2 + (size_t)32 * 1024 * 256 * 2;
constexpr size_t OFF_P  = OFF_W + W_END;
constexpr size_t OFF_G  = OFF_P + (size_t)NTOK * LDP * 2;
constexpr size_t G_MIX  = 0;
constexpr size_t G_HB   = (size_t)128 << 20;
constexpr size_t WS_NEED = OFF_G + ((size_t)216 << 20);
static_assert(OFF_EGL + 3072 * 4 <= OFF_W, "small region");
static_assert(WS_NEED <= ((size_t)512 << 20), "workspace");
constexpr int CTRL_CNT = 4096;

constexpr int LDS_BYTES = 147456;

struct Params {
  const float *x, *mem, *a_norm, *a_w_in, *a_conv, *a_log, *a_dt_bias, *a_out_gain, *a_w_out, *kv_norm, *w_kv,
      *b_norm, *b_w_in, *b_w_out, *mem_norm, *w_mem_kv, *ffn_norm, *w_group, *b_group, *w_router, *b_router,
      *w1, *w3, *w2, *final_norm;
  float* out; char* ws;
};

typedef float f32x2_t __attribute__((ext_vector_type(2))); typedef __bf16 bf16x2_t __attribute__((ext_vector_type(2)));
__device__ __forceinline__ unsigned cvt_pk_bf16(float lo, float hi) { const f32x2_t v = {lo, hi}; const bf16x2_t b = __builtin_convertvector(v, bf16x2_t); return __builtin_bit_cast(unsigned, b); }
__device__ __forceinline__ bf16_t f2bf(float f) { return (bf16_t)(cvt_pk_bf16(f, 0.f) & 0xffffu); }
__device__ __forceinline__ float bf2f(bf16_t b) { return __uint_as_float(((unsigned)b) << 16); }
__device__ __forceinline__ float bflo(unsigned u) { return __uint_as_float(u << 16); }
__device__ __forceinline__ float bfhi(unsigned u) { return __uint_as_float(u & 0xffff0000u); }
__device__ __forceinline__ float wave_sum(float v) {
#pragma unroll
  for (int o = 32; o >= 1; o >>= 1) v += __shfl_xor(v, o);
  return v;
}
__device__ __forceinline__ float sigmoidf_(float x) { return __builtin_amdgcn_rcpf(1.f + __expf(-x)); }
__device__ __forceinline__ float siluf_(float x) { return x * __builtin_amdgcn_rcpf(1.f + __expf(-x)); }
__device__ __forceinline__ float softplusf_(float x) { return fmaxf(x, 0.f) + log1pf(__expf(-fabsf(x))); }

#define XB_TMO      128
#define XB_XCNT(j)  (256  + 64 * (j))
#define XB_XSUB(j)  (1280 + 64 * (j))
#define XB_XGEN(j)  (2304 + 64 * (j))
#define XB_TOP      3328
#define XB_TOPGEN   3392
#define XCD_BAR_WORDS 3456
#define XB_SPIN_CAP (1u << 22)
__device__ __forceinline__ unsigned xb_ld(unsigned* p)              { return __hip_atomic_load(p, __ATOMIC_RELAXED, __HIP_MEMORY_SCOPE_AGENT); }
__device__ __forceinline__ unsigned xb_add(unsigned* p, unsigned v) { return __hip_atomic_fetch_add(p, v, __ATOMIC_RELAXED, __HIP_MEMORY_SCOPE_AGENT); }
__device__ __forceinline__ unsigned xb_xcc_id() { return (unsigned)__builtin_amdgcn_s_getreg((3 << 11) | 20) & 0xFu; }
#define XB_SPIN(cond, bar) do { unsigned _sp = 0; while (cond) { __builtin_amdgcn_s_sleep(1); \
    if ((++_sp & 255u) == 0u) { if (xb_ld(&(bar)[XB_TMO])) break; if (_sp > XB_SPIN_CAP) { atomicAdd(&(bar)[XB_TMO], 1u); break; } } } } while (0)
struct XcdBarrier { unsigned* bar; unsigned x; volatile LAS unsigned* st; };
__device__ __forceinline__ XcdBarrier xcd_barrier_post(unsigned* bar, volatile LAS unsigned* st) {
    XcdBarrier b; b.bar = bar; b.x = xb_xcc_id(); b.st = st;
    if (threadIdx.x == 0) (void)xb_add(&bar[XB_XCNT(b.x)], 1u);
    return b;
}
__device__ __forceinline__ void xcd_barrier_complete(unsigned* bar, unsigned x, unsigned& nloc, unsigned& nx) {
    const unsigned G = gridDim.x * gridDim.y * gridDim.z;
    unsigned sum, cnt, mine, sp = 0u;
    for (;;) {
        sum = 0u; cnt = 0u; mine = 0u;
#pragma unroll
        for (unsigned j = 0; j < 16; ++j) { const unsigned c = xb_ld(&bar[XB_XCNT(j)]); sum += c; cnt += (c > 0u) ? 1u : 0u; mine = (j == x) ? c : mine; }
        if (sum == G) break;
        __builtin_amdgcn_s_sleep(1);
        if ((++sp & 255u) == 0u) { if (xb_ld(&bar[XB_TMO])) break; if (sp > XB_SPIN_CAP) { atomicAdd(&bar[XB_TMO], 1u); break; } }
    }
    nloc = mine > 0u ? mine : 1u; nx = cnt > 0u ? cnt : 1u;
}
__device__ __forceinline__ void xcd_barrier(const XcdBarrier& b) {
    asm volatile("s_waitcnt vmcnt(0)" ::: "memory");
    __syncthreads();
    if (threadIdx.x == 0) {
        unsigned* bar = b.bar;
        __builtin_amdgcn_s_waitcnt(0);
        unsigned nloc = b.st[0], nx = b.st[1];
        if (nloc == 0u) { xcd_barrier_complete(bar, b.x, nloc, nx); b.st[0] = nloc; b.st[1] = nx; }
        const unsigned old = xb_add(&bar[XB_XSUB(b.x)], 1u);
        const unsigned gen = old / nloc;
        if (old + 1u == (gen + 1u) * nloc) {
            __builtin_amdgcn_fence(__ATOMIC_RELEASE, "agent");
            asm volatile("s_waitcnt vmcnt(0)" ::: "memory");
            const unsigned og = xb_add(&bar[XB_TOP], 1u);
            const unsigned tg = og / nx;
            if (og + 1u == (tg + 1u) * nx) xb_add(&bar[XB_TOPGEN], 1u);
            else XB_SPIN(xb_ld(&bar[XB_TOPGEN]) == tg, bar);
            __builtin_amdgcn_fence(__ATOMIC_ACQUIRE, "agent");
            xb_add(&bar[XB_XGEN(b.x)], 1u);
            asm volatile("s_waitcnt vmcnt(0)" ::: "memory");
        } else {
            XB_SPIN(xb_ld(&bar[XB_XGEN(b.x)]) == gen, bar);
            __builtin_amdgcn_fence(__ATOMIC_ACQUIRE, "agent");
            asm volatile("s_waitcnt vmcnt(0)" ::: "memory");
        }
    }
    __syncthreads();
}

__device__ __forceinline__ void cvt_rows(bf16_t* dst, int nrows_dst, int K, const float* src, int src_ld, int col0, int nrows_src,
                         const float* gain, float scale, int gtid, int gthreads) {
  const int items = nrows_dst * (K >> 3);
  for (int it = gtid; it < items; it += gthreads) {
    const int r = it % nrows_dst, k8 = it / nrows_dst;
    float v[8];
#pragma unroll
    for (int j = 0; j < 8; ++j) {
      const int k = k8 * 8 + j;
      v[j] = (r < nrows_src) ? src[(size_t)k * src_ld + col0 + r] * (gain ? gain[k] : 1.f) * scale : 0.f;
    }
    u32x4 w; w.x = cvt_pk_bf16(v[0], v[1]); w.y = cvt_pk_bf16(v[2], v[3]); w.z = cvt_pk_bf16(v[4], v[5]); w.w = cvt_pk_bf16(v[6], v[7]);
    *(u32x4*)(dst + (size_t)r * K + k8 * 8) = w;
  }
}

__device__ __forceinline__ void rows_to_bf16(const float* src, bf16_t* dst, float* rstd, int nrows, int gwave, int nwaves, int lane) {
  for (int r = gwave; r < nrows; r += nwaves) {
    const float* s = src + (size_t)r * DM; float ss = 0.f;
#pragma unroll
    for (int i = 0; i < 4; ++i) {
      const f32x4 v = *(const f32x4*)(s + i * 256 + lane * 4);
      ss += v[0] * v[0] + v[1] * v[1] + v[2] * v[2] + v[3] * v[3];
      u32x2 w; w.x = cvt_pk_bf16(v[0], v[1]); w.y = cvt_pk_bf16(v[2], v[3]);
      *(u32x2*)(dst + (size_t)r * DM + i * 256 + lane * 4) = w;
    }
    ss = wave_sum(ss);
    if (lane == 0) rstd[r] = rsqrtf(ss * (1.f / DM) + EPS);
  }
}

__device__ __forceinline__ void phase_prep(const Params& p, int bid, int nblk) {
  const int tid = threadIdx.x, gtid = bid * NTHR + tid, gthreads = nblk * NTHR, lane = tid & 63;
  char* ws = p.ws; bf16_t* W = (bf16_t*)(ws + OFF_W);
  bf16_t* wa = (bf16_t*)((char*)W + W_AIN);
  cvt_rows(wa + (size_t)PC_Q * 1024, 768, 1024, p.a_w_in, 3340, 0, 768, p.a_norm, 1.f, gtid, gthreads);
  cvt_rows(wa + (size_t)PC_MQ * 1024, 256, 1024, p.a_w_in, 3340, 3084, 256, p.a_norm, 0.125f * LOG2E, gtid, gthreads);
  cvt_rows(wa + (size_t)PC_K * 1024, 768, 1024, p.a_w_in, 3340, 768, 768, p.a_norm, 1.f, gtid, gthreads);
  cvt_rows(wa + (size_t)PC_V * 1024, 768, 1024, p.a_w_in, 3340, 1536, 768, p.a_norm, 1.f, gtid, gthreads);
  cvt_rows(wa + (size_t)PC_GATE * 1024, 768, 1024, p.a_w_in, 3340, 2304, 768, p.a_norm, 1.f, gtid, gthreads);
  cvt_rows(wa + (size_t)PC_BA * 1024, NIN_A - PC_BA, 1024, p.a_w_in, 3340, 3072, 12, p.a_norm, 1.f, gtid, gthreads);
  cvt_rows((bf16_t*)((char*)W + W_AOUT), 1024, 1024, p.a_w_out, 1024, 0, 1024, nullptr, 1.f, gtid, gthreads);
  bf16_t* wb = (bf16_t*)((char*)W + W_BIN);
  cvt_rows(wb + (size_t)PC_Q * 1024, 768, 1024, p.b_w_in, 1024, 0, 768, p.b_norm, 0.125f * LOG2E, gtid, gthreads);
  cvt_rows(wb + (size_t)PC_MQ * 1024, 256, 1024, p.b_w_in, 1024, 768, 256, p.b_norm, 0.125f * LOG2E, gtid, gthreads);
  cvt_rows(wb + (size_t)PC_K * 1024, 768, 1024, p.w_kv, 1536, 0, 768, p.kv_norm, 1.f, gtid, gthreads);
  cvt_rows(wb + (size_t)PC_V * 1024, 768, 1024, p.w_kv, 1536, 768, 768, p.kv_norm, 1.f, gtid, gthreads);
  cvt_rows((bf16_t*)((char*)W + W_BOUT), 1024, 1024, p.b_w_out, 1024, 0, 1024, nullptr, 1.f, gtid, gthreads);
  for (int l = 0; l < 2; ++l)
    cvt_rows((bf16_t*)((char*)W + W_MEM) + (size_t)l * 512 * 1024, 512, 1024, p.w_mem_kv + (size_t)l * 1024 * 512, 512, 0, 512, p.mem_norm + l * 1024, 1.f, gtid, gthreads);
  {
    bf16_t* w13 = (bf16_t*)((char*)W + W_13);
    const int items = 32 * 512 * 128;
    for (int it = gtid; it < items; it += gthreads) {
      const int le = it >> 16, rem = it & 65535, r = rem & 511, k8 = rem >> 9;
      const int u = r >> 8, which = (r >> 7) & 1, j = r & 127, l = le >> 4;
      const float* src = (which ? p.w3 : p.w1) + (size_t)le * 1024 * 256 + u * 128 + j;
      const float* g = p.ffn_norm + l * 1024;
      float v[8];
#pragma unroll
      for (int q = 0; q < 8; ++q) { const int k = k8 * 8 + q; v[q] = src[(size_t)k * 256] * g[k]; }
      u32x4 w; w.x = cvt_pk_bf16(v[0], v[1]); w.y = cvt_pk_bf16(v[2], v[3]); w.z = cvt_pk_bf16(v[4], v[5]); w.w = cvt_pk_bf16(v[6], v[7]);
      *(u32x4*)(w13 + ((size_t)le * 512 + r) * 1024 + k8 * 8) = w;
    }
    bf16_t* w2t = (bf16_t*)((char*)W + W_2);
    const int items2 = 32 * 1024 * 32;
    for (int it = gtid; it < items2; it += gthreads) {
      const int le = it >> 15, rem = it & 32767, n = rem & 1023, k8 = rem >> 10;
      const float* src = p.w2 + (size_t)le * 256 * 1024 + n;
      float v[8];
#pragma unroll
      for (int q = 0; q < 8; ++q) v[q] = src[(size_t)(k8 * 8 + q) * 1024];
      u32x4 w; w.x = cvt_pk_bf16(v[0], v[1]); w.y = cvt_pk_bf16(v[2], v[3]); w.z = cvt_pk_bf16(v[4], v[5]); w.w = cvt_pk_bf16(v[6], v[7]);
      *(u32x4*)(w2t + ((size_t)le * 1024 + n) * 256 + k8 * 8) = w;
    }
  }
  {
    float* wr = (float*)(ws + OFF_WR);
    for (int it = gtid; it < 2 * 20 * 1024; it += gthreads) {
      const int l = it / 20480, rem = it % 20480, j = rem >> 10, k = rem & 1023;
      const float w = (j < 4) ? p.w_group[((size_t)l * 1024 + k) * 4 + j] : p.w_router[((size_t)l * 1024 + k) * 16 + (j - 4)];
      wr[it] = w * p.ffn_norm[l * 1024 + k];
    }
  }
  const int gwave = gtid >> 6, nwaves = gthreads >> 6;
  rows_to_bf16(p.x, (bf16_t*)p.out, (float*)(ws + OFF_RSTD), NTOK, gwave, nwaves, lane);
  rows_to_bf16(p.mem, (bf16_t*)((char*)p.out + ((size_t)64 << 20)), (float*)(ws + OFF_MRSTD), NMEMROW, gwave, nwaves, lane);
}

namespace g8 {
constexpr int BM = 256, BK = 64, HALF = 128, HTB = HALF * BK * 2, STAGE_BYTES = 8 * HTB, NXCD = 8, WGM = 8;
__host__ __device__ __forceinline__ int lds_byte(int r, int c) { const int st = (r >> 4) * 2 + (c >> 5), rr = r & 15, cc = c & 31, ob = rr * 64 + cc * 2; return st * 1024 + (ob ^ (((ob >> 9) & 1) << 5)); }
__host__ __device__ __forceinline__ void stage_rc(int b, int& R, int& C) { const int st = b / 1024, sb = b % 1024, swz = sb ^ (((sb >> 9) & 1) << 5); R = (st >> 1) * 16 + swz / 64; C = (st & 1) * 32 + (swz % 64) / 2; }
__host__ __device__ __forceinline__ int perm32(int rho) { const int n = rho >> 4, i = rho & 15; return 8 * (i >> 2) + 4 * n + (i & 3); }

struct Unit { const char* A; const char* B; const int* list; int row0, nvalid, pm, pn, aux; };

struct DenseOrder {
  const char* A; const char* Bt; int K; int nM, nN, nwg, G, c;
  __device__ __forceinline__ void init(const void* A_, const void* Bt_, int K_, int M, int N, int G_, int c_) { A = (const char*)A_; Bt = (const char*)Bt_; K = K_; nM = M / BM; nN = N / BM; nwg = nM * nN; G = G_; c = c_; }
  __device__ __forceinline__ bool next(int i, Unit& u) const {
    const long L = (long)i * G + c; if (L >= nwg) return false;
    int wgid = (int)L; { const int q = nwg / NXCD, r = nwg % NXCD, xcd = wgid % NXCD, off = wgid / NXCD; wgid = (xcd < r ? xcd * (q + 1) : r * (q + 1) + (xcd - r) * q) + off; }
    const int nig = WGM * nN, gid = wgid / nig, fm = gid * WGM, gsz = (nM - fm) < WGM ? (nM - fm) : WGM;
    u.pm = fm + ((wgid % nig) % gsz); u.pn = (wgid % nig) / gsz;
    u.A = A; u.B = Bt + (size_t)u.pn * BM * K * 2; u.list = nullptr; u.row0 = u.pm * BM; u.nvalid = BM; u.aux = 0; return true;
  }
};

template <class Epi, class Sched, int SHIFT>
__device__ __forceinline__ void gemm_phase(LAS unsigned char* lds, const int K, const int lda, const Sched& S, const Epi& E) {
    const int tid = threadIdx.x, wid = __builtin_amdgcn_readfirstlane(tid >> 6), lane = tid & 63, wr = wid >> 2, wc = wid & 3, fr = lane & 15, fq = lane >> 4;
    const int nt = K / BK;
    int RA[2], CA[2]; unsigned voffB[2];
#pragma unroll
    for (int i = 0; i < 2; ++i) { int R, C; stage_rc(tid * 16 + i * 8192, R, C); const int Rb = Epi::PERM ? ((R & ~31) + perm32(R & 31)) : R;
        RA[i] = R; CA[i] = C; voffB[i] = (unsigned)(Rb * K + C) * 2u; }
    const size_t kstep = (size_t)(BK * 2);
    const size_t hstepB = (size_t)HALF * K * 2;
    const unsigned ldsw = (unsigned)wid * 1024u;
    const int aoff = lds_byte(wr * 64 + fr, fq * 8), boff = lds_byte(wc * 32 + fr, fq * 8);
#define G8_AOFF(dst, u) do { _Pragma("unroll") for (int _h = 0; _h < 2; ++_h) _Pragma("unroll") for (int _i = 0; _i < 2; ++_i) { const int _r = _h * HALF + RA[_i]; int _ar; \
        if ((u).list) { const int _rr = _r < (u).nvalid ? _r : 0; _ar = (u).list[(u).row0 + _rr] >> SHIFT; } else _ar = (u).row0 + _r; \
        dst[_h][_i] = (unsigned)(_ar * lda + CA[_i]) * 2u; } } while (0)
#define G8_SA(b, h) (((b) * 2 + (h)) * HTB)
#define G8_SB(b, h) ((4 + (b) * 2 + (h)) * HTB)
#define G8_STAGEA(bufoff, gbase, vo, kb) do { _Pragma("unroll") for (int _i = 0; _i < 2; ++_i) \
        __builtin_amdgcn_global_load_lds((const unsigned*)((gbase) + (size_t)((vo)[_i] + (unsigned)(kb))), (LAS unsigned*)(lds + (bufoff) + ldsw + _i * 8192), 16, 0, 0); } while (0)
#define G8_STAGEB(bufoff, gbase) do { _Pragma("unroll") for (int _i = 0; _i < 2; ++_i) \
        __builtin_amdgcn_global_load_lds((const unsigned*)((const char*)(gbase) + voffB[_i]), (LAS unsigned*)(lds + (bufoff) + ldsw + _i * 8192), 16, 0, 0); } while (0)
#define G8_LDA(dst, b, h) do { _Pragma("unroll") for (int m = 0; m < 4; ++m) _Pragma("unroll") for (int k = 0; k < 2; ++k) dst[m][k] = *(const LAS bf16x8*)(lds + G8_SA(b, h) + aoff + m * 2048 + k * 1024); } while (0)
#define G8_LDB(dst, b, h) do { _Pragma("unroll") for (int n = 0; n < 2; ++n) _Pragma("unroll") for (int k = 0; k < 2; ++k) dst[n][k] = *(const LAS bf16x8*)(lds + G8_SB(b, h) + boff + n * 2048 + k * 1024); } while (0)
#define G8_MMA(ai, bj, At, Bt) do { __builtin_amdgcn_s_setprio(1); _Pragma("unroll") for (int m = 0; m < 4; ++m) _Pragma("unroll") for (int n = 0; n < 2; ++n) _Pragma("unroll") for (int k = 0; k < 2; ++k) \
        acc[ai][bj][m][n] = __builtin_amdgcn_mfma_f32_16x16x32_bf16(Bt[n][k], At[m][k], acc[ai][bj][m][n], 0, 0, 0); __builtin_amdgcn_s_setprio(0); } while (0)
#define G8_WAIT_V(n) asm volatile("s_waitcnt vmcnt(" #n ")" ::: "memory")
#define G8_WAIT_L(n) asm volatile("s_waitcnt lgkmcnt(" #n ")" ::: "memory")
#define G8_BAR __builtin_amdgcn_s_barrier()
#define G8_SCHED __builtin_amdgcn_sched_barrier(0)
    Unit cur, nxt; int ui = 0;
    if (!S.next(0, cur)) return;
    f32x4 acc[2][2][4][2];
#pragma unroll
    for (int a = 0; a < 2; ++a)
#pragma unroll
        for (int b = 0; b < 2; ++b)
#pragma unroll
            for (int m = 0; m < 4; ++m)
#pragma unroll
                for (int n = 0; n < 2; ++n) acc[a][b][m][n] = (f32x4){0.f, 0.f, 0.f, 0.f};
    bf16x8 At[4][2], B0[2][2], B1[2][2];
    unsigned aoC[2][2], aoN[2][2];
    G8_AOFF(aoC, cur);
    const char* cA = cur.A; const char* cB = cur.B;
    G8_STAGEB(G8_SB(0, 0), cB); G8_STAGEB(G8_SB(0, 1), cB + hstepB); G8_STAGEA(G8_SA(0, 0), cA, aoC[0], 0); G8_STAGEA(G8_SA(0, 1), cA, aoC[1], 0);
    if (wr == 1) G8_BAR;
    G8_WAIT_V(2); G8_BAR;
    G8_STAGEB(G8_SB(1, 0), cB + kstep); G8_STAGEA(G8_SA(1, 0), cA, aoC[0], kstep); G8_STAGEB(G8_SB(1, 1), cB + hstepB + kstep);
    G8_WAIT_V(6); G8_BAR;
    for (;;) {
        const bool has_next = S.next(ui + 1, nxt);
        const char* nA = has_next ? nxt.A : cA; const char* nB = has_next ? nxt.B : cB;
        if (has_next) { G8_AOFF(aoN, nxt); } else {
#pragma unroll
            for (int h = 0; h < 2; ++h)
#pragma unroll
                for (int i = 0; i < 2; ++i) aoN[h][i] = aoC[h][i]; }
        for (int t = 0; t < nt; t += 2) {
            const bool last = (t == nt - 2);
            const unsigned k1 = (unsigned)((t + 1) * kstep);
            const char* a2b = last ? nA : cA; const unsigned k2 = last ? 0u : (unsigned)((t + 2) * kstep), k3 = k2 + (unsigned)kstep;
            const char* b2 = last ? nB : cB + (size_t)(t + 2) * kstep; const char* b3 = b2 + kstep;
            unsigned ao2[2][2];
#pragma unroll
            for (int h = 0; h < 2; ++h)
#pragma unroll
                for (int i = 0; i < 2; ++i) ao2[h][i] = last ? aoN[h][i] : aoC[h][i];
            G8_LDB(B0, 0, 0); G8_LDB(B1, 0, 1); G8_SCHED; G8_LDA(At, 0, 0); G8_STAGEA(G8_SA(1, 1), cA, aoC[1], k1);
            G8_WAIT_V(8); G8_WAIT_L(0); G8_BAR; G8_MMA(0, 0, At, B0); G8_MMA(0, 1, At, B1); G8_BAR; G8_SCHED;
            G8_LDA(At, 0, 1); G8_STAGEB(G8_SB(0, 0), b2); G8_STAGEB(G8_SB(0, 1), b2 + hstepB); G8_STAGEA(G8_SA(0, 0), a2b, ao2[0], k2);
            G8_WAIT_V(8); G8_WAIT_L(0); G8_BAR; G8_MMA(1, 0, At, B0); G8_MMA(1, 1, At, B1); G8_BAR; G8_SCHED;
            G8_LDB(B0, 1, 0); G8_LDB(B1, 1, 1); G8_SCHED; G8_LDA(At, 1, 0); G8_STAGEA(G8_SA(0, 1), a2b, ao2[1], k2);
            G8_WAIT_V(8); G8_WAIT_L(0); G8_BAR; G8_MMA(0, 0, At, B0); G8_MMA(0, 1, At, B1); G8_BAR; G8_SCHED;
            G8_LDA(At, 1, 1); G8_STAGEB(G8_SB(1, 0), b3); G8_STAGEB(G8_SB(1, 1), b3 + hstepB); G8_STAGEA(G8_SA(1, 0), a2b, ao2[0], k3);
            G8_WAIT_V(8); G8_WAIT_L(0); G8_BAR; G8_MMA(1, 0, At, B0); G8_MMA(1, 1, At, B1); G8_BAR; G8_SCHED;
        }
        if (wr == 0) G8_BAR;
        E(acc, cur, wr, wc, fr, fq);
        if (!has_next) break;
#pragma unroll
        for (int a = 0; a < 2; ++a)
#pragma unroll
            for (int b = 0; b < 2; ++b)
#pragma unroll
                for (int m = 0; m < 4; ++m)
#pragma unroll
                    for (int n = 0; n < 2; ++n) acc[a][b][m][n] = (f32x4){0.f, 0.f, 0.f, 0.f};
        cur = nxt; cA = nA; cB = nB; ++ui;
#pragma unroll
        for (int h = 0; h < 2; ++h)
#pragma unroll
            for (int i = 0; i < 2; ++i) aoC[h][i] = aoN[h][i];
        if (wr == 1) G8_BAR;
    }
    G8_WAIT_V(0);
    G8_BAR;
#undef G8_AOFF
#undef G8_SA
#undef G8_SB
#undef G8_STAGEA
#undef G8_STAGEB
#undef G8_LDA
#undef G8_LDB
#undef G8_MMA
#undef G8_WAIT_V
#undef G8_WAIT_L
#undef G8_BAR
#undef G8_SCHED
}

struct EpiScaleBf16 {
  static constexpr bool PERM = true;
  bf16_t* C; int ldc; const float* rowscale; int ncol_store;
  __device__ __forceinline__ void operator()(const f32x4 (&acc)[2][2][4][2], const Unit& u, int wr, int wc, int fr, int fq) const {
    const int row0 = u.pm * BM + wr * 64 + fr, col0 = u.pn * BM + wc * 32 + 8 * fq;
#pragma unroll
    for (int ai = 0; ai < 2; ++ai)
#pragma unroll
      for (int m = 0; m < 4; ++m) { const int row = row0 + ai * HALF + m * 16; const float sc = rowscale[row]; bf16_t* rowp = C + (size_t)row * ldc + col0;
#pragma unroll
        for (int bj = 0; bj < 2; ++bj) { const f32x4 v0 = acc[ai][bj][m][0] * sc, v1 = acc[ai][bj][m][1] * sc;
          u32x4 w; w.x = cvt_pk_bf16(v0[0], v0[1]); w.y = cvt_pk_bf16(v0[2], v0[3]); w.z = cvt_pk_bf16(v1[0], v1[1]); w.w = cvt_pk_bf16(v1[2], v1[3]);
          if (col0 + bj * HALF < ncol_store) *(u32x4*)(rowp + bj * HALF) = w; } }
  }
};
struct EpiMem {
  static constexpr bool PERM = true; bf16_t* C; const float* rs;
  __device__ __forceinline__ void operator()(const f32x4 (&acc)[2][2][4][2], const Unit& u, int wr, int wc, int fr, int fq) const {
    const int l = u.pn >> 1; Unit v = u; v.pn = u.pn & 1;
    EpiScaleBf16 e{C + (size_t)l * 2048 * 512, 512, rs, 512}; e(acc, v, wr, wc, fr, fq); }
};
struct EpiResidF32 {
  static constexpr bool PERM = false;
  float* out; const float* resid;
  __device__ __forceinline__ void operator()(const f32x4 (&acc)[2][2][4][2], const Unit& u, int wr, int wc, int fr, int fq) const {
    const int row0 = u.pm * BM + wr * 64 + fr, col0 = u.pn * BM + wc * 32 + 4 * fq;
#pragma unroll
    for (int ai = 0; ai < 2; ++ai)
#pragma unroll
      for (int m = 0; m < 4; ++m) { const size_t base = (size_t)(row0 + ai * HALF + m * 16) * DM + col0;
#pragma unroll
        for (int bj = 0; bj < 2; ++bj)
#pragma unroll
          for (int n = 0; n < 2; ++n) { const size_t o = base + bj * HALF + n * 16; const f32x4 rv = *(const f32x4*)(resid + o); *(f32x4*)(out + o) = rv + acc[ai][bj][m][n]; } }
  }
};
struct EpiMoe1 {
  static constexpr bool PERM = true;
  bf16_t* hid; const float* rstd;
  __device__ __forceinline__ void operator()(const f32x4 (&acc)[2][2][4][2], const Unit& u, int wr, int wc, int fr, int fq) const {
#pragma unroll
    for (int ai = 0; ai < 2; ++ai)
#pragma unroll
      for (int m = 0; m < 4; ++m) { const int r = ai * HALF + wr * 64 + m * 16 + fr;
        if (r < u.nvalid) { const int slot = u.list[u.row0 + r]; const float rs = rstd[slot >> 1];
          float h[8];
#pragma unroll
          for (int n = 0; n < 2; ++n)
#pragma unroll
            for (int j = 0; j < 4; ++j) { const float a = acc[ai][0][m][n][j] * rs, b = acc[ai][1][m][n][j] * rs; h[4 * n + j] = siluf_(a) * b; }
          u32x4 w; w.x = cvt_pk_bf16(h[0], h[1]); w.y = cvt_pk_bf16(h[2], h[3]); w.z = cvt_pk_bf16(h[4], h[5]); w.w = cvt_pk_bf16(h[6], h[7]);
          *(u32x4*)(hid + (size_t)slot * 256 + u.pn * 128 + wc * 32 + 8 * fq) = w; } }
  }
};
struct EpiMoe2 {
  static constexpr bool PERM = true;
  bf16_t* y; const float* cw;
  __device__ __forceinline__ void operator()(const f32x4 (&acc)[2][2][4][2], const Unit& u, int wr, int wc, int fr, int fq) const {
#pragma unroll
    for (int ai = 0; ai < 2; ++ai)
#pragma unroll
      for (int m = 0; m < 4; ++m) { const int r = ai * HALF + wr * 64 + m * 16 + fr;
        if (r < u.nvalid) { const int slot = u.list[u.row0 + r]; const float c = cw[slot];
          bf16_t* yp = y + (size_t)slot * DM + u.pn * BM + wc * 32 + 8 * fq;
#pragma unroll
          for (int bj = 0; bj < 2; ++bj) { const f32x4 v0 = acc[ai][bj][m][0] * c, v1 = acc[ai][bj][m][1] * c;
            u32x4 w; w.x = cvt_pk_bf16(v0[0], v0[1]); w.y = cvt_pk_bf16(v0[2], v0[3]); w.z = cvt_pk_bf16(v1[0], v1[1]); w.w = cvt_pk_bf16(v1[2], v1[3]);
            *(u32x4*)(yp + bj * HALF) = w; } } }
  }
};

template <int NPN>
struct MoeOrder {
  const char* A; const char* Wt; const int* lists; int cn[16]; int G, c; size_t wstride_e, wstride_pn;
  __device__ __forceinline__ bool next(int i, Unit& u) const {
    int L = i * G + c; bool found = false;
#pragma unroll
    for (int e = 0; e < 16; ++e) { const int nu = ((cn[e] + 255) >> 8) * NPN;
      if (!found) { if (L < nu) { found = true; const int tile = L / NPN, pn = L % NPN; u.pm = tile; u.pn = pn; u.aux = e; u.A = A; u.B = Wt + (size_t)e * wstride_e + (size_t)pn * wstride_pn;
          u.list = lists + (size_t)e * NTOK; u.row0 = tile * 256; u.nvalid = (cn[e] - tile * 256) < 256 ? (cn[e] - tile * 256) : 256; } else L -= nu; } }
    return found;
  }
};
}

__device__ __forceinline__ void phase_gemm_inA(const Params& p, LAS char* lds, int bid, int nblk) {
  char* ws = p.ws;
  const bf16_t* hb = (const bf16_t*)p.out; const bf16_t* memb = (const bf16_t*)((char*)p.out + ((size_t)64 << 20));
  const bf16_t* wa = (const bf16_t*)(ws + OFF_W + W_AIN); const bf16_t* wm = (const bf16_t*)(ws + OFF_W + W_MEM);
  { g8::DenseOrder S; S.init(hb, wa, 1024, NTOK, NIN_A, nblk, bid);
    g8::EpiScaleBf16 E{(bf16_t*)(ws + OFF_P), LDP, (const float*)(ws + OFF_RSTD), LDP};
    g8::gemm_phase<g8::EpiScaleBf16, g8::DenseOrder, 0>((LAS unsigned char*)lds, 1024, DM, S, E); }
  { g8::DenseOrder S; S.init(memb, wm, 1024, NMEMROW, 1024, nblk, bid);
    g8::EpiMem E{(bf16_t*)(ws + OFF_MEMKV), (const float*)(ws + OFF_MRSTD)};
    g8::gemm_phase<g8::EpiMem, g8::DenseOrder, 0>((LAS unsigned char*)lds, 1024, DM, S, E); }
}
__device__ __forceinline__ void phase_gemm_inB(const Params& p, LAS char* lds, int bid, int nblk) {
  char* ws = p.ws;
  g8::DenseOrder S; S.init(ws + OFF_G + G_HB, ws + OFF_W + W_BIN, 1024, NTOK, NIN_B, nblk, bid);
  g8::EpiScaleBf16 E{(bf16_t*)(ws + OFF_P), LDP, (const float*)(ws + OFF_RSTD), LDP};
  g8::gemm_phase<g8::EpiScaleBf16, g8::DenseOrder, 0>((LAS unsigned char*)lds, 1024, DM, S, E);
}
__device__ __forceinline__ void phase_gemm_out(const Params& p, LAS char* lds, int bid, int nblk, int layer) {
  char* ws = p.ws;
  g8::DenseOrder S; S.init(ws + OFF_P, ws + OFF_W + (layer ? W_BOUT : W_AOUT), 1024, NTOK, 1024, nblk, bid);
  g8::EpiResidF32 E{p.out, layer ? (const float*)p.out : p.x};
  g8::gemm_phase<g8::EpiResidF32, g8::DenseOrder, 0>((LAS unsigned char*)lds, 1024, LDP, S, E);
}
__device__ __forceinline__ void phase_moe1(const Params& p, LAS char* lds, int bid, int nblk, int layer) {
  char* ws = p.ws;
  const unsigned* cnt = (const unsigned*)(ws + OFF_CTRL) + CTRL_CNT + layer * 16;
  g8::MoeOrder<2> S; S.A = ws + OFF_G + G_HB; S.Wt = ws + OFF_W + W_13 + (size_t)layer * 16 * 512 * 1024 * 2; S.lists = (const int*)(ws + OFF_LIST);
#pragma unroll
  for (int e = 0; e < 16; ++e) S.cn[e] = (int)cnt[e];
  S.G = nblk; S.c = bid; S.wstride_e = (size_t)512 * 1024 * 2; S.wstride_pn = (size_t)256 * 1024 * 2;
  g8::EpiMoe1 E{(bf16_t*)(ws + OFF_P), (const float*)(ws + OFF_RSTD)};
  g8::gemm_phase<g8::EpiMoe1, g8::MoeOrder<2>, 1>((LAS unsigned char*)lds, 1024, DM, S, E);
}
__device__ __forceinline__ void phase_moe2(const Params& p, LAS char* lds, int bid, int nblk, int layer) {
  char* ws = p.ws;
  const unsigned* cnt = (const unsigned*)(ws + OFF_CTRL) + CTRL_CNT + layer * 16;
  g8::MoeOrder<4> S; S.A = ws + OFF_P; S.Wt = ws + OFF_W + W_2 + (size_t)layer * 16 * 1024 * 256 * 2; S.lists = (const int*)(ws + OFF_LIST);
#pragma unroll
  for (int e = 0; e < 16; ++e) S.cn[e] = (int)cnt[e];
  S.G = nblk; S.c = bid; S.wstride_e = (size_t)1024 * 256 * 2; S.wstride_pn = (size_t)256 * 256 * 2;
  g8::EpiMoe2 E{(bf16_t*)(ws + OFF_G + G_MIX), (const float*)(ws + OFF_CW)};
  g8::gemm_phase<g8::EpiMoe2, g8::MoeOrder<4>, 0>((LAS unsigned char*)lds, 256, 256, S, E);
}


__device__ __forceinline__ void phase_norm_route(const Params& p, LAS char* lds, int bid, int nblk, int layer) {
  char* ws = p.ws; const int tid = threadIdx.x, lane = tid & 63, w = tid >> 6;
  LAS float* wl = (LAS float*)lds;
  const float* wr = (const float*)(ws + OFF_WR) + (size_t)layer * 20480;
  __syncthreads();
  for (int i = tid; i < 20480 / 4; i += NTHR) *(LAS f32x4*)(wl + i * 4) = *(const f32x4*)(wr + i * 4);
  __syncthreads();
  bf16_t* hb = (bf16_t*)(ws + OFF_G + G_HB); float* rstd = (float*)(ws + OFF_RSTD); float* cw = (float*)(ws + OFF_CW);
  unsigned* cnt = (unsigned*)(ws + OFF_CTRL) + CTRL_CNT + layer * 16; int* lists = (int*)(ws + OFF_LIST);
  const float* bg = p.b_group + layer * 4; const float* br = p.b_router + layer * 16;
  for (int t = bid * 8 + w; t < NTOK; t += nblk * 8) {
    const float* hrow = p.out + (size_t)t * DM;
    f32x4 v[4]; float ss = 0.f;
#pragma unroll
    for (int i = 0; i < 4; ++i) {
      v[i] = *(const f32x4*)(hrow + i * 256 + lane * 4);
      ss += v[i][0] * v[i][0] + v[i][1] * v[i][1] + v[i][2] * v[i][2] + v[i][3] * v[i][3];
      u32x2 o; o.x = cvt_pk_bf16(v[i][0], v[i][1]); o.y = cvt_pk_bf16(v[i][2], v[i][3]);
      *(u32x2*)(hb + (size_t)t * DM + i * 256 + lane * 4) = o;
    }
    ss = wave_sum(ss);
    const float rs = rsqrtf(ss * (1.f / DM) + EPS);
    float lg[20];
#pragma unroll
    for (int j = 0; j < 20; ++j) {
      float a = 0.f;
#pragma unroll
      for (int i = 0; i < 4; ++i) { const f32x4 wv = *(LAS const f32x4*)(wl + j * 1024 + i * 256 + lane * 4); a += v[i][0] * wv[0] + v[i][1] * wv[1] + v[i][2] * wv[2] + v[i][3] * wv[3]; }
      lg[j] = wave_sum(a) * rs + (j < 4 ? bg[j] : br[j - 4]);
      asm volatile("" ::: "memory");
    }
    if (lane == 0) {
      rstd[t] = rs;
      int gs = 0; float gm = lg[0];
#pragma unroll
      for (int j = 1; j < 4; ++j) if (lg[j] > gm) { gm = lg[j]; gs = j; }
      float den = 0.f;
#pragma unroll
      for (int j = 0; j < 4; ++j) den += __expf(lg[j] - gm);
      const float pg = 1.f / den;
      float el[4];
#pragma unroll
      for (int j = 0; j < 4; ++j) el[j] = gs == 0 ? lg[4 + j] : gs == 1 ? lg[8 + j] : gs == 2 ? lg[12 + j] : lg[16 + j];
      int i1 = 0; float m1 = el[0];
#pragma unroll
      for (int j = 1; j < 4; ++j) if (el[j] > m1) { m1 = el[j]; i1 = j; }
      int i2 = -1; float m2 = -INFINITY;
#pragma unroll
      for (int j = 0; j < 4; ++j) if (j != i1 && el[j] > m2) { m2 = el[j]; i2 = j; }
      const float e2 = __expf(m2 - m1), p1 = 1.f / (1.f + e2), p2 = e2 * p1;
      const int ex1 = gs * 4 + i1, ex2 = gs * 4 + i2;
      const unsigned q1 = atomicAdd(&cnt[ex1], 1u), q2 = atomicAdd(&cnt[ex2], 1u);
      lists[(size_t)ex1 * NTOK + q1] = t * 2; lists[(size_t)ex2 * NTOK + q2] = t * 2 + 1;
      cw[t * 2] = pg * p1; cw[t * 2 + 1] = pg * p2;
    }
  }
}

template <bool FINAL>
__device__ __forceinline__ void phase_combine(const Params& p, int bid, int nblk) {
  char* ws = p.ws; const int tid = threadIdx.x, lane = tid & 63, w = tid >> 6;
  const bf16_t* y = (const bf16_t*)(ws + OFF_G + G_MIX); bf16_t* hb = (bf16_t*)(ws + OFF_G + G_HB); float* rstd = (float*)(ws + OFF_RSTD);
  for (int t = bid * 8 + w; t < NTOK; t += nblk * 8) {
    float* hrow = p.out + (size_t)t * DM;
    f32x4 v[4]; float ss = 0.f;
#pragma unroll
    for (int i = 0; i < 4; ++i) {
      const int c = i * 256 + lane * 4;
      v[i] = *(const f32x4*)(hrow + c);
      const u32x2 a = *(const u32x2*)(y + (size_t)(2 * t) * DM + c), b = *(const u32x2*)(y + (size_t)(2 * t + 1) * DM + c);
      v[i][0] += bflo(a.x) + bflo(b.x); v[i][1] += bfhi(a.x) + bfhi(b.x); v[i][2] += bflo(a.y) + bflo(b.y); v[i][3] += bfhi(a.y) + bfhi(b.y);
      ss += v[i][0] * v[i][0] + v[i][1] * v[i][1] + v[i][2] * v[i][2] + v[i][3] * v[i][3];
    }
    ss = wave_sum(ss);
    const float rs = rsqrtf(ss * (1.f / DM) + EPS);
#pragma unroll
    for (int i = 0; i < 4; ++i) {
      const int c = i * 256 + lane * 4;
      if (FINAL) {
        const f32x4 g = *(const f32x4*)(p.final_norm + c);
        f32x4 o; o[0] = v[i][0] * rs * g[0]; o[1] = v[i][1] * rs * g[1]; o[2] = v[i][2] * rs * g[2]; o[3] = v[i][3] * rs * g[3];
        *(f32x4*)(hrow + c) = o;
      } else {
        *(f32x4*)(hrow + c) = v[i];
        u32x2 o; o.x = cvt_pk_bf16(v[i][0], v[i][1]); o.y = cvt_pk_bf16(v[i][2], v[i][3]);
        *(u32x2*)(hb + (size_t)t * DM + c) = o;
      }
    }
    if (!FINAL && lane == 0) rstd[t] = rs;
  }
}

__device__ __forceinline__ void phase_memattn(const Params& p, int bid, int nblk, int layer) {
  char* ws = p.ws; const int tid = threadIdx.x, lane = tid & 63, w = tid >> 6;
  bf16_t* P = (bf16_t*)(ws + OFF_P);
  const bf16_t* mkv = (const bf16_t*)(ws + OFF_MEMKV) + (size_t)layer * 2048 * 512;
  for (int u = bid * 8 + w; u < (NTOK / 64) * 4; u += nblk * 8) {
    const int tt = u >> 2, hd = u & 3, t = tt * 64 + lane, b = t / SEQ;
    float q[64];
    const bf16_t* qp = P + (size_t)t * LDP + PC_MQ + hd * 64;
#pragma unroll
    for (int i = 0; i < 8; ++i) { const u32x4 r = *(const u32x4*)(qp + i * 8); q[8 * i] = bflo(r.x); q[8 * i + 1] = bfhi(r.x); q[8 * i + 2] = bflo(r.y); q[8 * i + 3] = bfhi(r.y); q[8 * i + 4] = bflo(r.z); q[8 * i + 5] = bfhi(r.z); q[8 * i + 6] = bflo(r.w); q[8 * i + 7] = bfhi(r.w); }
    float o[64];
#pragma unroll
    for (int i = 0; i < 64; ++i) o[i] = 0.f;
    float mx = -INFINITY, l = 0.f;
    const bf16_t* kb = mkv + (size_t)b * 256 * 512 + hd * 64;
    for (int m = 0; m < 256; ++m) {
      const bf16_t* kp = kb + (size_t)m * 512; const bf16_t* vp = kp + 256;
      float s = 0.f;
#pragma unroll
      for (int i = 0; i < 8; ++i) { const u32x4 r = *(const u32x4*)(kp + i * 8); s += q[8 * i] * bflo(r.x) + q[8 * i + 1] * bfhi(r.x) + q[8 * i + 2] * bflo(r.y) + q[8 * i + 3] * bfhi(r.y) + q[8 * i + 4] * bflo(r.z) + q[8 * i + 5] * bfhi(r.z) + q[8 * i + 6] * bflo(r.w) + q[8 * i + 7] * bfhi(r.w); }
      const float mn = fmaxf(mx, s), sc = exp2f(mx - mn), pr = exp2f(s - mn);
      l = l * sc + pr; mx = mn;
#pragma unroll
      for (int i = 0; i < 8; ++i) { const u32x4 r = *(const u32x4*)(vp + i * 8);
        o[8 * i] = o[8 * i] * sc + pr * bflo(r.x); o[8 * i + 1] = o[8 * i + 1] * sc + pr * bfhi(r.x); o[8 * i + 2] = o[8 * i + 2] * sc + pr * bflo(r.y); o[8 * i + 3] = o[8 * i + 3] * sc + pr * bfhi(r.y);
        o[8 * i + 4] = o[8 * i + 4] * sc + pr * bflo(r.z); o[8 * i + 5] = o[8 * i + 5] * sc + pr * bfhi(r.z); o[8 * i + 6] = o[8 * i + 6] * sc + pr * bflo(r.w); o[8 * i + 7] = o[8 * i + 7] * sc + pr * bfhi(r.w); }
    }
    const float il = 1.f / l;
    bf16_t* op = P + (size_t)t * LDP + PC_MQ + hd * 64;
#pragma unroll
    for (int i = 0; i < 8; ++i) { u32x4 r; r.x = cvt_pk_bf16(o[8 * i] * il, o[8 * i + 1] * il); r.y = cvt_pk_bf16(o[8 * i + 2] * il, o[8 * i + 3] * il); r.z = cvt_pk_bf16(o[8 * i + 4] * il, o[8 * i + 5] * il); r.w = cvt_pk_bf16(o[8 * i + 6] * il, o[8 * i + 7] * il); *(u32x4*)(op + i * 8) = r; }
  }
}

namespace sb {
typedef short s16x4 __attribute__((ext_vector_type(4)));
constexpr int SLOTB = 8192, LDS_K = 0, LDS_V = 3 * SLOTB, LDS_OST = 6 * SLOTB, LDS_BYTES_SB = LDS_OST + 8 * 4096;
__device__ __forceinline__ s16x4 vtr(LAS const char* p) { return __builtin_bit_cast(s16x4, __builtin_amdgcn_ds_read_tr16_b64_v4i16((LAS s16x4*)p)); }

__device__ __forceinline__ void unit(const bf16_t* P, bf16_t* O, int ldo, int b, int h, int qb, LAS char* lds) {
  const int tid = threadIdx.x, lane = tid & 63, r32 = lane & 31, hi = lane >> 5; const int wid = __builtin_amdgcn_readfirstlane(tid >> 6);
  const size_t rowbase = (size_t)b * SEQ; const int q0 = qb * 256;
  const bf16_t* Kh = P + rowbase * LDP + PC_K + h * 64; const bf16_t* Vh = P + rowbase * LDP + PC_V + h * 64;
  const bf16_t* Qw = P + (rowbase + q0 + wid * 32) * LDP + PC_Q + h * 64;
  const bf16_t* ksrc = Kh + (size_t)lane * LDP + wid * 8;
  const bf16_t* vsrc = Vh + (size_t)(16 * (wid & 3) + (lane >> 2)) * LDP + (wid >> 2) * 32 + (lane & 3) * 8;
  LAS char* kdst = lds + LDS_K + wid * 1024; LAS char* vdst = lds + LDS_V + wid * 1024;
#define SB_DMA(t, slot) do { __builtin_amdgcn_global_load_lds((const unsigned*)(ksrc + (size_t)(t) * 64 * LDP), (LAS unsigned*)(kdst + (slot)), 16, 0, 0); \
                             __builtin_amdgcn_global_load_lds((const unsigned*)(vsrc + (size_t)(t) * 64 * LDP), (LAS unsigned*)(vdst + (slot)), 16, 0, 0); } while (0)
  const int NT = 4 * qb + 4;
  SB_DMA(NT - 1, 0);
  bf16x8 qr[4];
#pragma unroll
  for (int d0 = 0; d0 < 4; ++d0) qr[d0] = *(const bf16x8*)(Qw + (size_t)r32 * LDP + d0 * 16 + hi * 8);
  f32x16 o[2]; o[0] = f32x16{}; o[1] = f32x16{};
  float c = 1.f;
  const int qrel = wid * 32 + r32;
  LAS const char* kp0 = lds + LDS_K + hi * 1024 + r32 * 16;
  LAS const char* vp0 = lds + LDS_V + ((lane >> 4) & 1) * 32 + (lane & 3) * 8 + (4 * hi + ((lane & 15) >> 2)) * 64;
  int slot = 0;
  for (int i = 0; i < NT; ++i) {
    const int t = NT - 1 - i;
    const int nslot = (slot == 2 * SLOTB) ? 0 : slot + SLOTB;
    if (t > 0) { SB_DMA(t - 1, nslot); asm volatile("s_waitcnt vmcnt(2) lgkmcnt(0)\n\ts_barrier" ::: "memory"); }
    else { asm volatile("s_waitcnt vmcnt(0) lgkmcnt(0)\n\ts_barrier" ::: "memory"); }
    const int jb = t - (NT - 4);
    if (!(jb >= 0 && 64 * jb > 32 * wid + 30)) {
      f32x16 p0 = f32x16{}, p1 = f32x16{};
#pragma unroll
      for (int d0 = 0; d0 < 4; ++d0) {
        const bf16x8 k0 = *(LAS const bf16x8*)(kp0 + slot + d0 * 2048), k1 = *(LAS const bf16x8*)(kp0 + slot + d0 * 2048 + 512);
        p0 = __builtin_amdgcn_mfma_f32_32x32x16_bf16(k0, qr[d0], p0, 0, 0, 0);
        p1 = __builtin_amdgcn_mfma_f32_32x32x16_bf16(k1, qr[d0], p1, 0, 0, 0);
      }
      if (jb >= 0) {
        const int kb = 64 * jb + 4 * hi;
#pragma unroll
        for (int r = 0; r < 16; ++r) { const int kv = kb + (r & 3) + 8 * (r >> 2); if (kv >= qrel) p0[r] = -INFINITY; if (kv + 32 >= qrel) p1[r] = -INFINITY; }
      }
      float rr[32], be[32];
#pragma unroll
      for (int r = 0; r < 16; ++r) {
        const float e0 = __builtin_amdgcn_exp2f(p0[r]), e1 = __builtin_amdgcn_exp2f(p1[r]);
        rr[r] = __builtin_amdgcn_rcpf(1.f + e0); rr[16 + r] = __builtin_amdgcn_rcpf(1.f + e1);
        be[r] = 1.f - rr[r]; be[16 + r] = 1.f - rr[16 + r];
      }
      float OS[9]; OS[8] = 1.f;
#pragma unroll
      for (int G = 7; G >= 0; --G) { const float gp = (rr[4 * G] * rr[4 * G + 1]) * (rr[4 * G + 2] * rr[4 * G + 3]); OS[G] = OS[G + 1] * gp; }
      float cE[8];
#pragma unroll
      for (int G = 0; G < 8; ++G) {
        const float X = hi ? OS[G] : OS[G + 1], Y = OS[G + 1];
        auto sw = __builtin_amdgcn_permlane32_swap(__float_as_uint(X), __float_as_uint(Y), false, false);
        cE[G] = c * (__uint_as_float(sw[0]) * __uint_as_float(sw[1]));
      }
      { auto sw = __builtin_amdgcn_permlane32_swap(__float_as_uint(OS[0]), __float_as_uint(OS[0]), false, false); c *= __uint_as_float(sw[0]) * __uint_as_float(sw[1]); }
      float a[32];
#pragma unroll
      for (int G = 0; G < 8; ++G) {
        const float t3 = cE[G], t2 = t3 * rr[4 * G + 3], t1 = t2 * rr[4 * G + 2], t0 = t1 * rr[4 * G + 1];
        a[4 * G + 3] = be[4 * G + 3] * t3; a[4 * G + 2] = be[4 * G + 2] * t2; a[4 * G + 1] = be[4 * G + 1] * t1; a[4 * G] = be[4 * G] * t0;
      }
      u32x4 pw[4];
#pragma unroll
      for (int ks = 0; ks < 4; ++ks) { pw[ks].x = cvt_pk_bf16(a[8 * ks], a[8 * ks + 1]); pw[ks].y = cvt_pk_bf16(a[8 * ks + 2], a[8 * ks + 3]); pw[ks].z = cvt_pk_bf16(a[8 * ks + 4], a[8 * ks + 5]); pw[ks].w = cvt_pk_bf16(a[8 * ks + 6], a[8 * ks + 7]); }
      LAS const char* vp = vp0 + slot;
#pragma unroll
      for (int d0 = 0; d0 < 2; ++d0)
#pragma unroll
        for (int ks = 0; ks < 4; ++ks) {
          const s16x4 lo = vtr(vp + d0 * 4096 + ks * 1024), hh = vtr(vp + d0 * 4096 + ks * 1024 + 512);
          const bf16x8 vf = (bf16x8){lo[0], lo[1], lo[2], lo[3], hh[0], hh[1], hh[2], hh[3]};
          o[d0] = __builtin_amdgcn_mfma_f32_32x32x16_bf16(__builtin_bit_cast(bf16x8, pw[ks]), vf, o[d0], 0, 0, 0);
        }
    }
    slot = nslot;
  }
  bf16_t* Ow = O + (rowbase + q0 + wid * 32) * ldo + h * 64;
  LAS bf16_t* stg = (LAS bf16_t*)(lds + LDS_OST) + wid * 2048;
#pragma unroll
  for (int r = 0; r < 16; ++r) { const int orow = (r & 3) + 8 * (r >> 2) + 4 * hi;
#pragma unroll
    for (int d0 = 0; d0 < 2; ++d0) stg[orow * 64 + d0 * 32 + r32] = f2bf(o[d0][r]); }
  asm volatile("s_waitcnt lgkmcnt(0)" ::: "memory");
#pragma unroll
  for (int i = 0; i < 4; ++i) { const int row = i * 8 + (lane >> 3), ch = lane & 7; const u32x4 v = *(LAS const u32x4*)(stg + row * 64 + ch * 8); *(u32x4*)(Ow + (size_t)row * ldo + ch * 8) = v; }
  asm volatile("s_waitcnt vmcnt(0) lgkmcnt(0)\n\ts_barrier" ::: "memory");
#undef SB_DMA
}
}
__device__ __forceinline__ void phase_sb_attn(const Params& p, LAS char* lds, int bid, int nblk) {
  char* ws = p.ws;
  bf16_t* P = (bf16_t*)(ws + OFF_P);
  const int vcu = (nblk % 8 == 0) ? (bid % 8) * (nblk / 8) + bid / 8 : bid;
  for (int pi = vcu; pi < 96 * 8; pi += nblk) {
    const int bh = pi >> 3, s = pi & 7, b = bh / 12, h = bh % 12;
    sb::unit(P, P, LDP, b, h, 15 - s, lds);
    sb::unit(P, P, LDP, b, h, s, lds);
  }
}

namespace gdn {
constexpr int RA_W = 0, RA_QG = 16384, RA_KT = 32768, RA_ATT = 49152, REC_A = 55296, REC_U = 16384, REC = REC_A + REC_U;
constexpr int HALF_LDS = 58368;
constexpr float QSCALE = 0.08838834764831845f;
__device__ __forceinline__ int crow(int r, int hi) { return (r & 3) + 8 * (r >> 2) + 4 * hi; }
}
__device__ __forceinline__ void phase_gdn_prep(const Params& p, LAS char* lds, int bid, int nblk) {
  using namespace gdn;
  char* ws = p.ws; const bf16_t* P = (const bf16_t*)(ws + OFF_P); char* G = ws + OFF_G; float* EGL = (float*)(ws + OFF_EGL);
  const int nrounds = (3072 + 2 * nblk - 1) / (2 * nblk);
  for (int rd = 0; rd < nrounds; ++rd) {
    int tl = threadIdx.x; asm volatile("" : "+v"(tl));
    const int tid = tl, hb = tid >> 8, ht = tid & 255, lane = tid & 63, r32 = lane & 31, hi = lane >> 5;
    const int hw = __builtin_amdgcn_readfirstlane(ht >> 6);
    LAS char* L = lds + hb * HALF_LDS;
    LAS float* sBeta = (LAS float*)(L + REC_A); LAS float* sGc = sBeta + 64; LAS float* sEgc = sGc + 64; LAS float* sRnK = sEgc + 64; LAS float* sRnQ = sRnK + 64;
    LAS char* sQ = L; LAS char* sK = L + 17408;
    LAS float* Amat = (LAS float*)(L + RA_W);
    const int u0 = (rd * nblk + bid) * 2 + hb; const bool valid = u0 < 3072; const int u = valid ? u0 : 0;
    const int bh = u >> 6, n = u & 63, b = bh / 6, h = bh % 6; const size_t row0 = (size_t)b * SEQ + (size_t)n * 64;
    char* rec = G + (size_t)u * REC;
    __syncthreads();
    if (hw == 0) {
      const bf16_t* pr = P + (row0 + lane) * LDP + PC_BA;
      const float braw = bf2f(pr[h]), araw = bf2f(pr[6 + h]);
      const float beta = sigmoidf_(braw), g = -__expf(p.a_log[h]) * softplusf_(araw + p.a_dt_bias[h]);
      float s = g;
#pragma unroll
      for (int o = 1; o < 64; o <<= 1) { const float t = __shfl_up(s, o); if (lane >= o) s += t; }
      sBeta[lane] = beta; sGc[lane] = s; sEgc[lane] = __expf(s);
    }
    float x[64], xq[64];
    {
      const int c = ht & 127; const bool isk = ht >= 128;
      {
        const int col = (isk ? PC_K : PC_V) + h * 128 + c, ch = (isk ? 768 : 1536) + h * 128 + c;
        const float w0 = p.a_conv[ch], w1 = p.a_conv[2304 + ch], w2 = p.a_conv[2 * 2304 + ch], w3 = p.a_conv[3 * 2304 + ch];
        const bf16_t* src = P + row0 * LDP + col;
        float r0 = 0.f, r1 = 0.f, r2 = 0.f;
        if (n > 0) { r0 = bf2f(src[-3 * LDP]); r1 = bf2f(src[-2 * LDP]); r2 = bf2f(src[-LDP]); }
        const bf16_t* sp = src;
#pragma unroll
        for (int i = 0; i < 64; ++i) { const float r3 = bf2f(*sp); sp += LDP; asm volatile("" : "+v"(sp)); x[i] = siluf_(w0 * r0 + w1 * r1 + w2 * r2 + w3 * r3); r0 = r1; r1 = r2; r2 = r3; if ((i & 7) == 7) asm volatile("" ::: "memory"); }
      }
      if (!isk) {
        const int col = PC_Q + h * 128 + c, ch = h * 128 + c;
        const float w0 = p.a_conv[ch], w1 = p.a_conv[2304 + ch], w2 = p.a_conv[2 * 2304 + ch], w3 = p.a_conv[3 * 2304 + ch];
        const bf16_t* src = P + row0 * LDP + col;
        float r0 = 0.f, r1 = 0.f, r2 = 0.f;
        if (n > 0) { r0 = bf2f(src[-3 * LDP]); r1 = bf2f(src[-2 * LDP]); r2 = bf2f(src[-LDP]); }
        const bf16_t* sp = src;
#pragma unroll
        for (int i = 0; i < 64; ++i) { const float r3 = bf2f(*sp); sp += LDP; asm volatile("" : "+v"(sp)); xq[i] = siluf_(w0 * r0 + w1 * r1 + w2 * r2 + w3 * r3); r0 = r1; r1 = r2; r2 = r3; if ((i & 7) == 7) asm volatile("" ::: "memory"); }
#pragma unroll
        for (int i = 0; i < 64; ++i) *(LAS bf16_t*)(sQ + i * 272 + c * 2) = f2bf(xq[i]);
      } else {
#pragma unroll
        for (int i = 0; i < 64; ++i) { xq[i] = x[i]; *(LAS bf16_t*)(sK + i * 272 + c * 2) = f2bf(x[i]); }
      }
    }
    __syncthreads();
    const int it = hw >> 1, jt = hw & 1;
    f32x16 akk = f32x16{}, aqk = f32x16{};
    if (hw != 1) {
#pragma unroll
      for (int ks = 0; ks < 8; ++ks) {
        const bf16x8 ak = *(LAS const bf16x8*)(sK + (32 * it + r32) * 272 + ks * 32 + hi * 16), aq = *(LAS const bf16x8*)(sQ + (32 * it + r32) * 272 + ks * 32 + hi * 16);
        const bf16x8 bk = *(LAS const bf16x8*)(sK + (32 * jt + r32) * 272 + ks * 32 + hi * 16);
        akk = __builtin_amdgcn_mfma_f32_32x32x16_bf16(ak, bk, akk, 0, 0, 0); aqk = __builtin_amdgcn_mfma_f32_32x32x16_bf16(aq, bk, aqk, 0, 0, 0);
      }
    } else {
#pragma unroll
      for (int ks = 0; ks < 8; ++ks) {
        const bf16x8 a0 = *(LAS const bf16x8*)(sQ + r32 * 272 + ks * 32 + hi * 16), a1 = *(LAS const bf16x8*)(sQ + (32 + r32) * 272 + ks * 32 + hi * 16);
        akk = __builtin_amdgcn_mfma_f32_32x32x16_bf16(a0, a0, akk, 0, 0, 0); aqk = __builtin_amdgcn_mfma_f32_32x32x16_bf16(a1, a1, aqk, 0, 0, 0);
      }
    }
    {
      float d0 = 0.f, d1 = 0.f;
#pragma unroll
      for (int r = 0; r < 16; ++r) if (crow(r, hi) == r32) { d0 = akk[r]; d1 = aqk[r]; }
      const bool has = ((r32 >> 2) & 1) == hi;
      if (has && hw == 0) sRnK[r32] = rsqrtf(d0 + EPS);
      if (has && hw == 3) sRnK[32 + r32] = rsqrtf(d0 + EPS);
      if (has && hw == 1) { sRnQ[r32] = rsqrtf(d0 + EPS) * QSCALE; sRnQ[32 + r32] = rsqrtf(d1 + EPS) * QSCALE; }
    }
    __syncthreads();
    if (hw != 1) {
      const int j = 32 * jt + r32; const float rnkj = sRnK[j], gcj = sGc[j];
      const int ksj = 2 * jt + (r32 >> 4), jo = r32 & 15, hip = (jo >> 2) & 1, jp = (jo & 3) + 4 * (jo >> 3);
      LAS char* attf = L + RA_ATT + (it ? 2 + ksj : ksj) * 1024 + hip * 512 + jp * 2;
#pragma unroll
      for (int r = 0; r < 16; ++r) {
        const int il = crow(r, hi), i = 32 * it + il;
        const float dec = __expf(fminf(sGc[i] - gcj, 0.f));
        const float aval = (i > j) ? sBeta[i] * sRnK[i] * rnkj * akk[r] * dec : 0.f;
        const float tval = (i >= j) ? sRnQ[i] * rnkj * aqk[r] * dec : 0.f;
        Amat[i * 64 + j] = aval;
        *(LAS bf16_t*)(attf + il * 16) = f2bf(tval);
        if ((r & 3) == 3) asm volatile("" ::: "memory");
      }
    }
    __syncthreads();
    if (ht < 128) {
      const int c = ht;
      const int co = c & 15, hip = (co >> 2) & 1, jp = (co & 3) + 4 * (co >> 3);
      LAS char* qgf = L + RA_QG + (c >> 4) * 1024 + hip * 512 + jp * 2;
#pragma unroll
      for (int i = 0; i < 64; ++i) { *(LAS bf16_t*)(qgf + (i >> 5) * 8192 + (i & 31) * 16) = f2bf(xq[i] * sRnQ[i] * sEgc[i]); x[i] *= sBeta[i]; if ((i & 7) == 7) asm volatile("" ::: "memory"); }
    } else {
      const int c = ht - 128;
      const float gl = sGc[63];
      LAS char* ktf = L + RA_KT + (c >> 5) * 4096 + (c & 31) * 16;
#pragma unroll
      for (int ks = 0; ks < 4; ++ks)
#pragma unroll
        for (int hp = 0; hp < 2; ++hp) {
          float v[8];
#pragma unroll
          for (int jq = 0; jq < 8; ++jq) { const int i = 16 * ks + (jq & 3) + 8 * (jq >> 2) + 4 * hp; v[jq] = xq[i] * sRnK[i] * __expf(gl - sGc[i]); }
          u32x4 w; w.x = cvt_pk_bf16(v[0], v[1]); w.y = cvt_pk_bf16(v[2], v[3]); w.z = cvt_pk_bf16(v[4], v[5]); w.w = cvt_pk_bf16(v[6], v[7]);
          *(LAS u32x4*)(ktf + ks * 1024 + hp * 512) = w;
          asm volatile("" ::: "memory");
        }
#pragma unroll
      for (int i = 0; i < 64; ++i) { x[i] *= sBeta[i] * sEgc[i] * sRnK[i]; if ((i & 7) == 7) asm volatile("" ::: "memory"); }
    }
    asm volatile("" ::: "memory");
#pragma unroll
    for (int i = 1; i < 64; ++i) {
      float acc = x[i];
#pragma unroll
      for (int j4 = 0; j4 < (i + 3) / 4; ++j4) {
        const f32x4 a = *(LAS const f32x4*)(Amat + i * 64 + j4 * 4);
        acc -= a[0] * x[4 * j4]; acc -= a[1] * x[4 * j4 + 1]; acc -= a[2] * x[4 * j4 + 2]; acc -= a[3] * x[4 * j4 + 3];
      }
      x[i] = acc;
      if ((i & 3) == 3) asm volatile("" ::: "memory");
    }
    __syncthreads();
    if (ht < 128) {
      const int c = ht;
      if (valid) {
        char* ud = rec + REC_A + c * 128;
#pragma unroll
        for (int q = 0; q < 8; ++q) {
          const int ib = 32 * (q >> 2) + 4 * ((q >> 1) & 1) + 16 * (q & 1);
          u32x4 w; w.x = cvt_pk_bf16(x[ib], x[ib + 1]); w.y = cvt_pk_bf16(x[ib + 2], x[ib + 3]); w.z = cvt_pk_bf16(x[ib + 8], x[ib + 9]); w.w = cvt_pk_bf16(x[ib + 10], x[ib + 11]);
          *(u32x4*)(ud + q * 16) = w;
        }
      }
    } else {
      const int c = ht - 128;
      const int co = c & 15, hip = (co >> 2) & 1, jp = (co & 3) + 4 * (co >> 3);
      LAS char* wf = L + RA_W + (c >> 4) * 1024 + hip * 512 + jp * 2;
#pragma unroll
      for (int i = 0; i < 64; ++i) *(LAS bf16_t*)(wf + (i >> 5) * 8192 + (i & 31) * 16) = f2bf(-x[i]);
    }
    if (ht == 0 && valid) EGL[u] = __expf(sGc[63]);
    __syncthreads();
    if (valid) for (int o = ht * 16; o < REC_A; o += 4096) *(u32x4*)(rec + o) = *(LAS const u32x4*)(L + o);
  }
}

__device__ __forceinline__ void phase_gdn_scan(const Params& p, LAS char* lds, int bid, int nblk) {
  using namespace gdn;
  char* ws = p.ws; bf16_t* P = (bf16_t*)(ws + OFF_P); const char* G = ws + OFF_G; const float* EGL = (const float*)(ws + OFF_EGL);
  const int tid = threadIdx.x, lane = tid & 63, r32 = lane & 31, hi = lane >> 5; const int wid = __builtin_amdgcn_readfirstlane(tid >> 6);
  LAS char* OX = lds + 2 * REC_A;
  for (int u = bid; u < NBATCH * 6; u += nblk) {
    const int b = u / 6, h = u % 6; const size_t rowb = (size_t)b * SEQ; const char* recb = G + (size_t)u * 64 * REC;
    __syncthreads();
    if (wid >= 4) {
      const int j = wid - 4;
      for (int f = j; f < 54; f += 4) __builtin_amdgcn_global_load_lds((const unsigned*)(recb + f * 1024 + lane * 16), (LAS unsigned*)(lds + f * 1024), 16, 0, 0);
      float gn[32];
#pragma unroll
      for (int q = 0; q < 8; ++q) { const f32x4 g = *(const f32x4*)(p.a_out_gain + (lane & 3) * 32 + q * 4); gn[4 * q] = g[0]; gn[4 * q + 1] = g[1]; gn[4 * q + 2] = g[2]; gn[4 * q + 3] = g[3]; }
      for (int c = 0; c <= 64; ++c) {
        asm volatile("s_waitcnt vmcnt(0) lgkmcnt(0)\n\ts_barrier" ::: "memory");
        if (c + 1 < 64) { const char* rn = recb + (size_t)(c + 1) * REC; LAS char* dst = lds + ((c + 1) & 1) * REC_A;
          for (int f = j; f < 54; f += 4) __builtin_amdgcn_global_load_lds((const unsigned*)(rn + f * 1024 + lane * 16), (LAS unsigned*)(dst + f * 1024), 16, 0, 0); }
        if (c >= 1) {
          const int cc = c - 1, row = 16 * j + (lane >> 2), cg = (lane & 3) * 32; const size_t t = rowb + (size_t)cc * 64 + row;
          LAS const char* op = OX + (cc & 1) * 16384 + row * 256 + cg * 2;
          const bf16_t* gp = P + t * LDP + PC_GATE + h * 128 + cg;
          float ov[32]; float ss = 0.f;
#pragma unroll
          for (int q = 0; q < 4; ++q) { const u32x4 r = *(LAS const u32x4*)(op + q * 16);
            ov[8 * q] = bflo(r.x); ov[8 * q + 1] = bfhi(r.x); ov[8 * q + 2] = bflo(r.y); ov[8 * q + 3] = bfhi(r.y); ov[8 * q + 4] = bflo(r.z); ov[8 * q + 5] = bfhi(r.z); ov[8 * q + 6] = bflo(r.w); ov[8 * q + 7] = bfhi(r.w); }
#pragma unroll
          for (int q = 0; q < 32; ++q) ss += ov[q] * ov[q];
          ss += __shfl_xor(ss, 1); ss += __shfl_xor(ss, 2);
          const float sc = rsqrtf(ss * (1.f / 128.f) + EPS);
          bf16_t* dp = P + t * LDP + PC_Q + h * 128 + cg;
#pragma unroll
          for (int q = 0; q < 4; ++q) { const u32x4 gr = *(const u32x4*)(gp + q * 8); u32x4 w;
            w.x = cvt_pk_bf16(ov[8 * q] * sc * gn[8 * q] * siluf_(bflo(gr.x)), ov[8 * q + 1] * sc * gn[8 * q + 1] * siluf_(bfhi(gr.x)));
            w.y = cvt_pk_bf16(ov[8 * q + 2] * sc * gn[8 * q + 2] * siluf_(bflo(gr.y)), ov[8 * q + 3] * sc * gn[8 * q + 3] * siluf_(bfhi(gr.y)));
            w.z = cvt_pk_bf16(ov[8 * q + 4] * sc * gn[8 * q + 4] * siluf_(bflo(gr.z)), ov[8 * q + 5] * sc * gn[8 * q + 5] * siluf_(bfhi(gr.z)));
            w.w = cvt_pk_bf16(ov[8 * q + 6] * sc * gn[8 * q + 6] * siluf_(bflo(gr.w)), ov[8 * q + 7] * sc * gn[8 * q + 7] * siluf_(bfhi(gr.w)));
            *(u32x4*)(dp + q * 8) = w; }
        }
      }
    } else {
      const int vs = wid;
      f32x16 S[4];
#pragma unroll
      for (int k = 0; k < 4; ++k) S[k] = f32x16{};
      const char* ub = recb + REC_A + (vs * 32 + r32) * 128 + hi * 32;
      u32x4 un[4];
#pragma unroll
      for (int q = 0; q < 4; ++q) un[q] = *(const u32x4*)(ub + (q >> 1) * 64 + (q & 1) * 16);
      for (int c = 0; c <= 64; ++c) {
        asm volatile("s_waitcnt lgkmcnt(0)\n\ts_barrier" ::: "memory");
        if (c < 64) {
          LAS const char* R = lds + (c & 1) * REC_A + lane * 16;
          const float egl = EGL[u * 64 + c];
          u32x4 uc[4];
#pragma unroll
          for (int q = 0; q < 4; ++q) uc[q] = un[q];
          if (c + 1 < 64) {
#pragma unroll
            for (int q = 0; q < 4; ++q) un[q] = *(const u32x4*)(ub + (size_t)(c + 1) * REC + (q >> 1) * 64 + (q & 1) * 16);
          }
          bf16x8 Sb[8];
#pragma unroll
          for (int ks = 0; ks < 8; ++ks) { const int kt = ks >> 1, o = (ks & 1) * 8; u32x4 w;
            w.x = cvt_pk_bf16(S[kt][o], S[kt][o + 1]); w.y = cvt_pk_bf16(S[kt][o + 2], S[kt][o + 3]); w.z = cvt_pk_bf16(S[kt][o + 4], S[kt][o + 5]); w.w = cvt_pk_bf16(S[kt][o + 6], S[kt][o + 7]);
            Sb[ks] = __builtin_bit_cast(bf16x8, w); }
          f32x16 vn[2];
#pragma unroll
          for (int t2 = 0; t2 < 2; ++t2) {
#pragma unroll
            for (int q = 0; q < 2; ++q) { const u32x4 r = uc[2 * t2 + q];
              vn[t2][8 * q] = bflo(r.x); vn[t2][8 * q + 1] = bfhi(r.x); vn[t2][8 * q + 2] = bflo(r.y); vn[t2][8 * q + 3] = bfhi(r.y); vn[t2][8 * q + 4] = bflo(r.z); vn[t2][8 * q + 5] = bfhi(r.z); vn[t2][8 * q + 6] = bflo(r.w); vn[t2][8 * q + 7] = bfhi(r.w); }
#pragma unroll
            for (int ks = 0; ks < 8; ++ks) vn[t2] = __builtin_amdgcn_mfma_f32_32x32x16_bf16(*(LAS const bf16x8*)(R + RA_W + (t2 * 8 + ks) * 1024), Sb[ks], vn[t2], 0, 0, 0);
          }
          bf16x8 vb[4];
#pragma unroll
          for (int ks = 0; ks < 4; ++ks) { const int t2 = ks >> 1, o = (ks & 1) * 8; u32x4 w;
            w.x = cvt_pk_bf16(vn[t2][o], vn[t2][o + 1]); w.y = cvt_pk_bf16(vn[t2][o + 2], vn[t2][o + 3]); w.z = cvt_pk_bf16(vn[t2][o + 4], vn[t2][o + 5]); w.w = cvt_pk_bf16(vn[t2][o + 6], vn[t2][o + 7]);
            vb[ks] = __builtin_bit_cast(bf16x8, w); }
          f32x16 oo[2];
#pragma unroll
          for (int t2 = 0; t2 < 2; ++t2) {
            oo[t2] = f32x16{};
#pragma unroll
            for (int ks = 0; ks < 8; ++ks) oo[t2] = __builtin_amdgcn_mfma_f32_32x32x16_bf16(*(LAS const bf16x8*)(R + RA_QG + (t2 * 8 + ks) * 1024), Sb[ks], oo[t2], 0, 0, 0);
          }
#pragma unroll
          for (int ks = 0; ks < 2; ++ks) oo[0] = __builtin_amdgcn_mfma_f32_32x32x16_bf16(*(LAS const bf16x8*)(R + RA_ATT + ks * 1024), vb[ks], oo[0], 0, 0, 0);
#pragma unroll
          for (int ks = 0; ks < 4; ++ks) oo[1] = __builtin_amdgcn_mfma_f32_32x32x16_bf16(*(LAS const bf16x8*)(R + RA_ATT + (2 + ks) * 1024), vb[ks], oo[1], 0, 0, 0);
#pragma unroll
          for (int kt = 0; kt < 4; ++kt) {
            S[kt] = S[kt] * egl;
#pragma unroll
            for (int ks = 0; ks < 4; ++ks) S[kt] = __builtin_amdgcn_mfma_f32_32x32x16_bf16(*(LAS const bf16x8*)(R + RA_KT + (kt * 4 + ks) * 1024), vb[ks], S[kt], 0, 0, 0);
          }
          LAS char* ox = OX + (c & 1) * 16384 + (vs * 32 + r32) * 2;
#pragma unroll
          for (int t2 = 0; t2 < 2; ++t2)
#pragma unroll
            for (int r = 0; r < 16; ++r) *(LAS bf16_t*)(ox + (32 * t2 + crow(r, hi)) * 256) = f2bf(oo[t2][r]);
        }
      }
    }
  }
}

constexpr int NPHASE = 15;
__global__ void __launch_bounds__(NTHR, 2) yoco_fwd(Params p, int lo, int hi) {
  extern __shared__ __attribute__((aligned(16))) char smem_raw[];
  LAS char* lds = (LAS char*)smem_raw;
  const int bid = blockIdx.x, nblk = gridDim.x;
  LAS unsigned* xbw = (LAS unsigned*)(lds + LDS_BYTES - 16);
  if (threadIdx.x == 0) { xbw[0] = 0u; xbw[1] = 0u; xbw[2] = 0u; xbw[3] = 0u; }
  __syncthreads();
  XcdBarrier bar; bar.bar = (unsigned*)(p.ws + OFF_CTRL); bar.x = 0; bar.st = (volatile LAS unsigned*)xbw;
  if (hi - lo > 1) bar = xcd_barrier_post((unsigned*)(p.ws + OFF_CTRL), (volatile LAS unsigned*)xbw);
#ifndef PROBE_DOUBLE
#define PROBE_DOUBLE -1
#endif
#define PH(k) if (lo <= (k) && (k) < hi)
#define SEAM(k) if (lo <= (k) && (k) + 1 < hi) xcd_barrier(bar)
  PH(0) phase_prep(p, bid, nblk);
#if PROBE_DOUBLE == 0
  PH(0) { __syncthreads(); phase_prep(p, bid, nblk); }
#endif
  SEAM(0);
  PH(1) phase_gemm_inA(p, lds, bid, nblk);
  SEAM(1);
  PH(2) phase_gdn_prep(p, lds, bid, nblk);
  SEAM(2);
  PH(2) { if (bid < 48) phase_gdn_scan(p, lds, bid, nblk); else phase_memattn(p, bid - 48, nblk - 48, 0); }
  SEAM(2);
  PH(3) phase_gemm_out(p, lds, bid, nblk, 0);
  SEAM(3);
  PH(4) phase_norm_route(p, lds, bid, nblk, 0);
  SEAM(4);
  PH(5) phase_moe1(p, lds, bid, nblk, 0);
  SEAM(5);
  PH(6) phase_moe2(p, lds, bid, nblk, 0);
  SEAM(6);
  PH(7) phase_combine<false>(p, bid, nblk);
  SEAM(7);
  PH(8) phase_gemm_inB(p, lds, bid, nblk);
  SEAM(8);
  PH(9) { phase_sb_attn(p, lds, bid, nblk); phase_memattn(p, bid, nblk, 1); }
#if PROBE_DOUBLE == 9
  PH(9) { phase_sb_attn(p, lds, bid, nblk); }
#endif
  SEAM(9);
  PH(10) phase_gemm_out(p, lds, bid, nblk, 1);
  SEAM(10);
  PH(11) phase_norm_route(p, lds, bid, nblk, 1);
  SEAM(11);
  PH(12) phase_moe1(p, lds, bid, nblk, 1);
  SEAM(12);
  PH(13) phase_moe2(p, lds, bid, nblk, 1);
  SEAM(13);
  PH(14) phase_combine<true>(p, bid, nblk);
#undef PH
#undef SEAM
}

#ifndef N_LAUNCH_SPLIT
#define N_LAUNCH_SPLIT 0
#endif

extern "C" void kernel_launch(void* const* d_in, const int* in_sizes, int n_in, void* d_out, int out_size, void* d_ws, size_t ws_size, hipStream_t stream) {
  (void)in_sizes; (void)n_in; (void)out_size;
  if (ws_size < WS_NEED) return;
  static int grid = 0;
  if (!grid) {
    if (hipFuncSetAttribute((const void*)yoco_fwd, hipFuncAttributeMaxDynamicSharedMemorySize, LDS_BYTES) != hipSuccess) { grid = -1; return; }
    int dev = 0, cus = 0; hipGetDevice(&dev); hipDeviceGetAttribute(&cus, hipDeviceAttributeMultiprocessorCount, dev);
    int per_cu = 0; hipOccupancyMaxActiveBlocksPerMultiprocessor(&per_cu, (const void*)yoco_fwd, NTHR, LDS_BYTES);
    grid = (per_cu >= 1) ? cus : -1;
  }
  if (grid <= 0) return;
  Params p{};
  const float** pf = (const float**)&p;
  for (int i = 0; i < 25; ++i) pf[i] = (const float*)d_in[i];
  p.out = (float*)d_out; p.ws = (char*)d_ws;
  hipMemsetAsync(d_ws, 0, 65536, stream);
#if N_LAUNCH_SPLIT
  for (int k = 0; k < NPHASE; ++k) hipLaunchKernelGGL(yoco_fwd, dim3(grid), dim3(NTHR), LDS_BYTES, stream, p, k, k + 1);
#else
  hipLaunchKernelGGL(yoco_fwd, dim3(grid), dim3(NTHR), LDS_BYTES, stream, p, 0, NPHASE);
#endif
}
```

```cpp
#include <hip/hip_runtime.h>
#include <stdint.h>
#include <stddef.h>

#define LAS __attribute__((address_space(3)))
typedef unsigned short bf16_t;
typedef short bf16x8 __attribute__((ext_vector_type(8)));
typedef float f32x4 __attribute__((ext_vector_type(4)));
typedef float f32x16 __attribute__((ext_vector_type(16)));
typedef unsigned u32x4 __attribute__((ext_vector_type(4)));
typedef unsigned u32x2 __attribute__((ext_vector_type(2)));

constexpr int NTOK = 32768, DM = 1024, SEQ = 4096, NBATCH = 8, MEMLEN = 256, NMEMROW = NBATCH * MEMLEN;
constexpr int LDP = 3392;
constexpr int PC_Q = 0, PC_MQ = 768, PC_K = 1024, PC_V = 1792, PC_GATE = 2560, PC_BA = 3328;
constexpr int NIN_A = 3584;
constexpr int NIN_B = 2560;
constexpr float EPS = 1e-6f;
constexpr float LOG2E = 1.4426950408889634f;
constexpr int NTHR = 512;

constexpr size_t OFF_CTRL  = 0;
constexpr size_t OFF_RSTD  = 65536;
constexpr size_t OFF_MRSTD = OFF_RSTD + (size_t)NTOK * 4;
constexpr size_t OFF_CW    = OFF_MRSTD + 8192;
constexpr size_t OFF_LIST  = OFF_CW + 65536 * 4;
constexpr size_t OFF_MEMKV = OFF_LIST + (size_t)16 * NTOK * 4;
constexpr size_t OFF_WR    = OFF_MEMKV + (size_t)2 * 2048 * 512 * 2;
constexpr size_t OFF_EGL   = OFF_WR + (size_t)2 * 20 * 1024 * 4;
constexpr size_t OFF_W     = 8u << 20;
constexpr size_t W_AIN  = 0;
constexpr size_t W_AOUT = W_AIN + (size_t)NIN_A * 1024 * 2;
constexpr size_t W_BIN  = W_AOUT + (size_t)1024 * 1024 * 2;
constexpr size_t W_BOUT = W_BIN + (size_t)NIN_B * 1024 * 2;
constexpr size_t W_MEM  = W_BOUT + (size_t)1024 * 1024 * 2;
constexpr size_t W_13   = W_MEM + (size_t)2 * 512 * 1024 * 2;
constexpr size_t W_2    = W_13 + (size_t)32 * 512 * 1024 * 2;
constexpr size_t W_END  = W_2 + (size_t)32 * 1024 * 256 * 2;
constexpr size_t OFF_P  = OFF_W + W_END;
constexpr size_t OFF_G  = OFF_P + (size_t)NTOK * LDP * 2;
constexpr size_t G_MIX  = 0;
constexpr size_t G_HB   = (size_t)128 << 20;
constexpr size_t WS_NEED = OFF_G + ((size_t)216 << 20);
static_assert(OFF_EGL + 3072 * 4 <= OFF_W, "small region");
static_assert(WS_NEED <= ((size_t)512 << 20), "workspace");
constexpr int CTRL_CNT = 4096;

constexpr int LDS_BYTES = 147456;

struct Params {
  const float *x, *mem, *a_norm, *a_w_in, *a_conv, *a_log, *a_dt_bias, *a_out_gain, *a_w_out, *kv_norm, *w_kv,
      *b_norm, *b_w_in, *b_w_out, *mem_norm, *w_mem_kv, *ffn_norm, *w_group, *b_group, *w_router, *b_router,
      *w1, *w3, *w2, *final_norm;
  float* out; char* ws;
};

typedef float f32x2_t __attribute__((ext_vector_type(2))); typedef __bf16 bf16x2_t __attribute__((ext_vector_type(2)));
__device__ __forceinline__ unsigned cvt_pk_bf16(float lo, float hi) { const f32x2_t v = {lo, hi}; const bf16x2_t b = __builtin_convertvector(v, bf16x2_t); return __builtin_bit_cast(unsigned, b); }
__device__ __forceinline__ bf16_t f2bf(float f) { return (bf16_t)(cvt_pk_bf16(f, 0.f) & 0xffffu); }
__device__ __forceinline__ float bf2f(bf16_t b) { return __uint_as_float(((unsigned)b) << 16); }
__device__ __forceinline__ float bflo(unsigned u) { return __uint_as_float(u << 16); }
__device__ __forceinline__ float bfhi(unsigned u) { return __uint_as_float(u & 0xffff0000u); }
__device__ __forceinline__ float wave_sum(float v) {
#pragma unroll
  for (int o = 32; o >= 1; o >>= 1) v += __shfl_xor(v, o);
  return v;
}
__device__ __forceinline__ float sigmoidf_(float x) { return __builtin_amdgcn_rcpf(1.f + __expf(-x)); }
__device__ __forceinline__ float siluf_(float x) { return x * __builtin_amdgcn_rcpf(1.f + __expf(-x)); }
__device__ __forceinline__ float softplusf_(float x) { return fmaxf(x, 0.f) + log1pf(__expf(-fabsf(x))); }

#define XB_TMO      128
#define XB_XCNT(j)  (256  + 64 * (j))
#define XB_XSUB(j)  (1280 + 64 * (j))
#define XB_XGEN(j)  (2304 + 64 * (j))
#define XB_TOP      3328
#define XB_TOPGEN   3392
#define XCD_BAR_WORDS 3456
#define XB_SPIN_CAP (1u << 22)
__device__ __forceinline__ unsigned xb_ld(unsigned* p)              { return __hip_atomic_load(p, __ATOMIC_RELAXED, __HIP_MEMORY_SCOPE_AGENT); }
__device__ __forceinline__ unsigned xb_add(unsigned* p, unsigned v) { return __hip_atomic_fetch_add(p, v, __ATOMIC_RELAXED, __HIP_MEMORY_SCOPE_AGENT); }
__device__ __forceinline__ unsigned xb_xcc_id() { return (unsigned)__builtin_amdgcn_s_getreg((3 << 11) | 20) & 0xFu; }
#define XB_SPIN(cond, bar) do { unsigned _sp = 0; while (cond) { __builtin_amdgcn_s_sleep(1); \
    if ((++_sp & 255u) == 0u) { if (xb_ld(&(bar)[XB_TMO])) break; if (_sp > XB_SPIN_CAP) { atomicAdd(&(bar)[XB_TMO], 1u); break; } } } } while (0)
struct XcdBarrier { unsigned* bar; unsigned x; volatile LAS unsigned* st; };
__device__ __forceinline__ XcdBarrier xcd_barrier_post(unsigned* bar, volatile LAS unsigned* st) {
    XcdBarrier b; b.bar = bar; b.x = xb_xcc_id(); b.st = st;
    if (threadIdx.x == 0) (void)xb_add(&bar[XB_XCNT(b.x)], 1u);
    return b;
}
__device__ __forceinline__ void xcd_barrier_complete(unsigned* bar, unsigned x, unsigned& nloc, unsigned& nx) {
    const unsigned G = gridDim.x * gridDim.y * gridDim.z;
    unsigned sum, cnt, mine, sp = 0u;
    for (;;) {
        sum = 0u; cnt = 0u; mine = 0u;
#pragma unroll
        for (unsigned j = 0; j < 16; ++j) { const unsigned c = xb_ld(&bar[XB_XCNT(j)]); sum += c; cnt += (c > 0u) ? 1u : 0u; mine = (j == x) ? c : mine; }
        if (sum == G) break;
        __builtin_amdgcn_s_sleep(1);
        if ((++sp & 255u) == 0u) { if (xb_ld(&bar[XB_TMO])) break; if (sp > XB_SPIN_CAP) { atomicAdd(&bar[XB_TMO], 1u); break; } }
    }
    nloc = mine > 0u ? mine : 1u; nx = cnt > 0u ? cnt : 1u;
}
__device__ __forceinline__ void xcd_barrier(const XcdBarrier& b) {
    asm volatile("s_waitcnt vmcnt(0)" ::: "memory");
    __syncthreads();
    if (threadIdx.x == 0) {
        unsigned* bar = b.bar;
        __builtin_amdgcn_s_waitcnt(0);
        unsigned nloc = b.st[0], nx = b.st[1];
        if (nloc == 0u) { xcd_barrier_complete(bar, b.x, nloc, nx); b.st[0] = nloc; b.st[1] = nx; }
        const unsigned old = xb_add(&bar[XB_XSUB(b.x)], 1u);
        const unsigned gen = old / nloc;
        if (old + 1u == (gen + 1u) * nloc) {
            __builtin_amdgcn_fence(__ATOMIC_RELEASE, "agent");
            asm volatile("s_waitcnt vmcnt(0)" ::: "memory");
            const unsigned og = xb_add(&bar[XB_TOP], 1u);
            const unsigned tg = og / nx;
            if (og + 1u == (tg + 1u) * nx) xb_add(&bar[XB_TOPGEN], 1u);
            else XB_SPIN(xb_ld(&bar[XB_TOPGEN]) == tg, bar);
            __builtin_amdgcn_fence(__ATOMIC_ACQUIRE, "agent");
            xb_add(&bar[XB_XGEN(b.x)], 1u);
            asm volatile("s_waitcnt vmcnt(0)" ::: "memory");
        } else {
            XB_SPIN(xb_ld(&bar[XB_XGEN(b.x)]) == gen, bar);
            __builtin_amdgcn_fence(__ATOMIC_ACQUIRE, "agent");
            asm volatile("s_waitcnt vmcnt(0)" ::: "memory");
        }
    }
    __syncthreads();
}

__device__ __forceinline__ void cvt_rows(bf16_t* dst, int nrows_dst, int K, const float* src, int src_ld, int col0, int nrows_src,
                         const float* gain, float scale, int gtid, int gthreads) {
  const int items = nrows_dst * (K >> 3);
  for (int it = gtid; it < items; it += gthreads) {
    const int r = it % nrows_dst, k8 = it / nrows_dst;
    float v[8];
#pragma unroll
    for (int j = 0; j < 8; ++j) {
      const int k = k8 * 8 + j;
      v[j] = (r < nrows_src) ? src[(size_t)k * src_ld + col0 + r] * (gain ? gain[k] : 1.f) * scale : 0.f;
    }
    u32x4 w; w.x = cvt_pk_bf16(v[0], v[1]); w.y = cvt_pk_bf16(v[2], v[3]); w.z = cvt_pk_bf16(v[4], v[5]); w.w = cvt_pk_bf16(v[6], v[7]);
    *(u32x4*)(dst + (size_t)r * K + k8 * 8) = w;
  }
}

__device__ __forceinline__ void rows_to_bf16(const float* src, bf16_t* dst, float* rstd, int nrows, int gwave, int nwaves, int lane) {
  for (int r = gwave; r < nrows; r += nwaves) {
    const float* s = src + (size_t)r * DM; float ss = 0.f;
#pragma unroll
    for (int i = 0; i < 4; ++i) {
      const f32x4 v = *(const f32x4*)(s + i * 256 + lane * 4);
      ss += v[0] * v[0] + v[1] * v[1] + v[2] * v[2] + v[3] * v[3];
      u32x2 w; w.x = cvt_pk_bf16(v[0], v[1]); w.y = cvt_pk_bf16(v[2], v[3]);
      *(u32x2*)(dst + (size_t)r * DM + i * 256 + lane * 4) = w;
    }
    ss = wave_sum(ss);
    if (lane == 0) rstd[r] = rsqrtf(ss * (1.f / DM) + EPS);
  }
}

__device__ __forceinline__ void phase_prep(const Params& p, int bid, int nblk) {
  const int tid = threadIdx.x, gtid = bid * NTHR + tid, gthreads = nblk * NTHR, lane = tid & 63;
  char* ws = p.ws; bf16_t* W = (bf16_t*)(ws + OFF_W);
  bf16_t* wa = (bf16_t*)((char*)W + W_AIN);
  cvt_rows(wa + (size_t)PC_Q * 1024, 768, 1024, p.a_w_in, 3340, 0, 768, p.a_norm, 1.f, gtid, gthreads);
  cvt_rows(wa + (size_t)PC_MQ * 1024, 256, 1024, p.a_w_in, 3340, 3084, 256, p.a_norm, 0.125f * LOG2E, gtid, gthreads);
  cvt_rows(wa + (size_t)PC_K * 1024, 768, 1024, p.a_w_in, 3340, 768, 768, p.a_norm, 1.f, gtid, gthreads);
  cvt_rows(wa + (size_t)PC_V * 1024, 768, 1024, p.a_w_in, 3340, 1536, 768, p.a_norm, 1.f, gtid, gthreads);
  cvt_rows(wa + (size_t)PC_GATE * 1024, 768, 1024, p.a_w_in, 3340, 2304, 768, p.a_norm, 1.f, gtid, gthreads);
  cvt_rows(wa + (size_t)PC_BA * 1024, NIN_A - PC_BA, 1024, p.a_w_in, 3340, 3072, 12, p.a_norm, 1.f, gtid, gthreads);
  cvt_rows((bf16_t*)((char*)W + W_AOUT), 1024, 1024, p.a_w_out, 1024, 0, 1024, nullptr, 1.f, gtid, gthreads);
  bf16_t* wb = (bf16_t*)((char*)W + W_BIN);
  cvt_rows(wb + (size_t)PC_Q * 1024, 768, 1024, p.b_w_in, 1024, 0, 768, p.b_norm, 0.125f * LOG2E, gtid, gthreads);
  cvt_rows(wb + (size_t)PC_MQ * 1024, 256, 1024, p.b_w_in, 1024, 768, 256, p.b_norm, 0.125f * LOG2E, gtid, gthreads);
  cvt_rows(wb + (size_t)PC_K * 1024, 768, 1024, p.w_kv, 1536, 0, 768, p.kv_norm, 1.f, gtid, gthreads);
  cvt_rows(wb + (size_t)PC_V * 1024, 768, 1024, p.w_kv, 1536, 768, 768, p.kv_norm, 1.f, gtid, gthreads);
  cvt_rows((bf16_t*)((char*)W + W_BOUT), 1024, 1024, p.b_w_out, 1024, 0, 1024, nullptr, 1.f, gtid, gthreads);
  for (int l = 0; l < 2; ++l)
    cvt_rows((bf16_t*)((char*)W + W_MEM) + (size_t)l * 512 * 1024, 512, 1024, p.w_mem_kv + (size_t)l * 1024 * 512, 512, 0, 512, p.mem_norm + l * 1024, 1.f, gtid, gthreads);
  {
    bf16_t* w13 = (bf16_t*)((char*)W + W_13);
    const int items = 32 * 512 * 128;
    for (int it = gtid; it < items; it += gthreads) {
      const int le = it >> 16, rem = it & 65535, r = rem & 511, k8 = rem >> 9;
      const int u = r >> 8, which = (r >> 7) & 1, j = r & 127, l = le >> 4;
      const float* src = (which ? p.w3 : p.w1) + (size_t)le * 1024 * 256 + u * 128 + j;
      const float* g = p.ffn_norm + l * 1024;
      float v[8];
#pragma unroll
      for (int q = 0; q < 8; ++q) { const int k = k8 * 8 + q; v[q] = src[(size_t)k * 256] * g[k]; }
      u32x4 w; w.x = cvt_pk_bf16(v[0], v[1]); w.y = cvt_pk_bf16(v[2], v[3]); w.z = cvt_pk_bf16(v[4], v[5]); w.w = cvt_pk_bf16(v[6], v[7]);
      *(u32x4*)(w13 + ((size_t)le * 512 + r) * 1024 + k8 * 8) = w;
    }
    bf16_t* w2t = (bf16_t*)((char*)W + W_2);
    const int items2 = 32 * 1024 * 32;
    for (int it = gtid; it < items2; it += gthreads) {
      const int le = it >> 15, rem = it & 32767, n = rem & 1023, k8 = rem >> 10;
      const float* src = p.w2 + (size_t)le * 256 * 1024 + n;
      float v[8];
#pragma unroll
      for (int q = 0; q < 8; ++q) v[q] = src[(size_t)(k8 * 8 + q) * 1024];
      u32x4 w; w.x = cvt_pk_bf16(v[0], v[1]); w.y = cvt_pk_bf16(v[2], v[3]); w.z = cvt_pk_bf16(v[4], v[5]); w.w = cvt_pk_bf16(v[6], v[7]);
      *(u32x4*)(w2t + ((size_t)le * 1024 + n) * 256 + k8 * 8) = w;
    }
  }
  {
    float* wr = (float*)(ws + OFF_WR);
    for (int it = gtid; it < 2 * 20 * 1024; it += gthreads) {
      const int l = it / 20480, rem = it % 20480, j = rem >> 10, k = rem & 1023;
      const float w = (j < 4) ? p.w_group[((size_t)l * 1024 + k) * 4 + j] : p.w_router[((size_t)l * 1024 + k) * 16 + (j - 4)];
      wr[it] = w * p.ffn_norm[l * 1024 + k];
    }
  }
  const int gwave = gtid >> 6, nwaves = gthreads >> 6;
  rows_to_bf16(p.x, (bf16_t*)p.out, (float*)(ws + OFF_RSTD), NTOK, gwave, nwaves, lane);
  rows_to_bf16(p.mem, (bf16_t*)((char*)p.out + ((size_t)64 << 20)), (float*)(ws + OFF_MRSTD), NMEMROW, gwave, nwaves, lane);
}

namespace g8 {
constexpr int BM = 256, BK = 64, HALF = 128, HTB = HALF * BK * 2, STAGE_BYTES = 8 * HTB, NXCD = 8, WGM = 8;
__host__ __device__ __forceinline__ int lds_byte(int r, int c) { const int st = (r >> 4) * 2 + (c >> 5), rr = r & 15, cc = c & 31, ob = rr * 64 + cc * 2; return st * 1024 + (ob ^ (((ob >> 9) & 1) << 5)); }
__host__ __device__ __forceinline__ void stage_rc(int b, int& R, int& C) { const int st = b / 1024, sb = b % 1024, swz = sb ^ (((sb >> 9) & 1) << 5); R = (st >> 1) * 16 + swz / 64; C = (st & 1) * 32 + (swz % 64) / 2; }
__host__ __device__ __forceinline__ int perm32(int rho) { const int n = rho >> 4, i = rho & 15; return 8 * (i >> 2) + 4 * n + (i & 3); }

struct Unit { const char* A; const char* B; const int* list; int row0, nvalid, pm, pn, aux; };

struct DenseOrder {
  const char* A; const char* Bt; int K; int nM, nN, nwg, G, c;
  __device__ __forceinline__ void init(const void* A_, const void* Bt_, int K_, int M, int N, int G_, int c_) { A = (const char*)A_; Bt = (const char*)Bt_; K = K_; nM = M / BM; nN = N / BM; nwg = nM * nN; G = G_; c = c_; }
  __device__ __forceinline__ bool next(int i, Unit& u) const {
    const long L = (long)i * G + c; if (L >= nwg) return false;
    int wgid = (int)L; { const int q = nwg / NXCD, r = nwg % NXCD, xcd = wgid % NXCD, off = wgid / NXCD; wgid = (xcd < r ? xcd * (q + 1) : r * (q + 1) + (xcd - r) * q) + off; }
    const int nig = WGM * nN, gid = wgid / nig, fm = gid * WGM, gsz = (nM - fm) < WGM ? (nM - fm) : WGM;
    u.pm = fm + ((wgid % nig) % gsz); u.pn = (wgid % nig) / gsz;
    u.A = A; u.B = Bt + (size_t)u.pn * BM * K * 2; u.list = nullptr; u.row0 = u.pm * BM; u.nvalid = BM; u.aux = 0; return true;
  }
};

template <class Epi, class Sched, int SHIFT>
__device__ __forceinline__ void gemm_phase(LAS unsigned char* lds, const int K, const int lda, const Sched& S, const Epi& E) {
    const int tid = threadIdx.x, wid = __builtin_amdgcn_readfirstlane(tid >> 6), lane = tid & 63, wr = wid >> 2, wc = wid & 3, fr = lane & 15, fq = lane >> 4;
    const int nt = K / BK;
    int RA[2], CA[2]; unsigned voffB[2];
#pragma unroll
    for (int i = 0; i < 2; ++i) { int R, C; stage_rc(tid * 16 + i * 8192, R, C); const int Rb = Epi::PERM ? ((R & ~31) + perm32(R & 31)) : R;
        RA[i] = R; CA[i] = C; voffB[i] = (unsigned)(Rb * K + C) * 2u; }
    const size_t kstep = (size_t)(BK * 2);
    const size_t hstepB = (size_t)HALF * K * 2;
    const unsigned ldsw = (unsigned)wid * 1024u;
    const int aoff = lds_byte(wr * 64 + fr, fq * 8), boff = lds_byte(wc * 32 + fr, fq * 8);
#define G8_AOFF(dst, u) do { _Pragma("unroll") for (int _h = 0; _h < 2; ++_h) _Pragma("unroll") for (int _i = 0; _i < 2; ++_i) { const int _r = _h * HALF + RA[_i]; int _ar; \
        if ((u).list) { const int _rr = _r < (u).nvalid ? _r : 0; _ar = (u).list[(u).row0 + _rr] >> SHIFT; } else _ar = (u).row0 + _r; \
        dst[_h][_i] = (unsigned)(_ar * lda + CA[_i]) * 2u; } } while (0)
#define G8_SA(b, h) (((b) * 2 + (h)) * HTB)
#define G8_SB(b, h) ((4 + (b) * 2 + (h)) * HTB)
#define G8_STAGEA(bufoff, gbase, vo, kb) do { _Pragma("unroll") for (int _i = 0; _i < 2; ++_i) \
        __builtin_amdgcn_global_load_lds((const unsigned*)((gbase) + (size_t)((vo)[_i] + (unsigned)(kb))), (LAS unsigned*)(lds + (bufoff) + ldsw + _i * 8192), 16, 0, 0); } while (0)
#define G8_STAGEB(bufoff, gbase) do { _Pragma("unroll") for (int _i = 0; _i < 2; ++_i) \
        __builtin_amdgcn_global_load_lds((const unsigned*)((const char*)(gbase) + voffB[_i]), (LAS unsigned*)(lds + (bufoff) + ldsw + _i * 8192), 16, 0, 0); } while (0)
#define G8_LDA(dst, b, h) do { _Pragma("unroll") for (int m = 0; m < 4; ++m) _Pragma("unroll") for (int k = 0; k < 2; ++k) dst[m][k] = *(const LAS bf16x8*)(lds + G8_SA(b, h) + aoff + m * 2048 + k * 1024); } while (0)
#define G8_LDB(dst, b, h) do { _Pragma("unroll") for (int n = 0; n < 2; ++n) _Pragma("unroll") for (int k = 0; k < 2; ++k) dst[n][k] = *(const LAS bf16x8*)(lds + G8_SB(b, h) + boff + n * 2048 + k * 1024); } while (0)
#define G8_MMA(ai, bj, At, Bt) do { __builtin_amdgcn_s_setprio(1); _Pragma("unroll") for (int m = 0; m < 4; ++m) _Pragma("unroll") for (int n = 0; n < 2; ++n) _Pragma("unroll") for (int k = 0; k < 2; ++k) \
        acc[ai][bj][m][n] = __builtin_amdgcn_mfma_f32_16x16x32_bf16(Bt[n][k], At[m][k], acc[ai][bj][m][n], 0, 0, 0); __builtin_amdgcn_s_setprio(0); } while (0)
#define G8_WAIT_V(n) asm volatile("s_waitcnt vmcnt(" #n ")" ::: "memory")
#define G8_WAIT_L(n) asm volatile("s_waitcnt lgkmcnt(" #n ")" ::: "memory")
#define G8_BAR __builtin_amdgcn_s_barrier()
#define G8_SCHED __builtin_amdgcn_sched_barrier(0)
    Unit cur, nxt; int ui = 0;
    if (!S.next(0, cur)) return;
    f32x4 acc[2][2][4][2];
#pragma unroll
    for (int a = 0; a < 2; ++a)
#pragma unroll
        for (int b = 0; b < 2; ++b)
#pragma unroll
            for (int m = 0; m < 4; ++m)
#pragma unroll
                for (int n = 0; n < 2; ++n) acc[a][b][m][n] = (f32x4){0.f, 0.f, 0.f, 0.f};
    bf16x8 At[4][2], B0[2][2], B1[2][2];
    unsigned aoC[2][2], aoN[2][2];
    G8_AOFF(aoC, cur);
    const char* cA = cur.A; const char* cB = cur.B;
    G8_STAGEB(G8_SB(0, 0), cB); G8_STAGEB(G8_SB(0, 1), cB + hstepB); G8_STAGEA(G8_SA(0, 0), cA, aoC[0], 0); G8_STAGEA(G8_SA(0, 1), cA, aoC[1], 0);
    if (wr == 1) G8_BAR;
    G8_WAIT_V(2); G8_BAR;
    G8_STAGEB(G8_SB(1, 0), cB + kstep); G8_STAGEA(G8_SA(1, 0), cA, aoC[0], kstep); G8_STAGEB(G8_SB(1, 1), cB + hstepB + kstep);
    G8_WAIT_V(6); G8_BAR;
    for (;;) {
        const bool has_next = S.next(ui + 1, nxt);
        const char* nA = has_next ? nxt.A : cA; const char* nB = has_next ? nxt.B : cB;
        if (has_next) { G8_AOFF(aoN, nxt); } else {
#pragma unroll
            for (int h = 0; h < 2; ++h)
#pragma unroll
                for (int i = 0; i < 2; ++i) aoN[h][i] = aoC[h][i]; }
        for (int t = 0; t < nt; t += 2) {
            const bool last = (t == nt - 2);
            const unsigned k1 = (unsigned)((t + 1) * kstep);
            const char* a2b = last ? nA : cA; const unsigned k2 = last ? 0u : (unsigned)((t + 2) * kstep), k3 = k2 + (unsigned)kstep;
            const char* b2 = last ? nB : cB + (size_t)(t + 2) * kstep; const char* b3 = b2 + kstep;
            unsigned ao2[2][2];
#pragma unroll
            for (int h = 0; h < 2; ++h)
#pragma unroll
                for (int i = 0; i < 2; ++i) ao2[h][i] = last ? aoN[h][i] : aoC[h][i];
            G8_LDB(B0, 0, 0); G8_LDB(B1, 0, 1); G8_SCHED; G8_LDA(At, 0, 0); G8_STAGEA(G8_SA(1, 1), cA, aoC[1], k1);
            G8_WAIT_V(8); G8_WAIT_L(0); G8_BAR; G8_MMA(0, 0, At, B0); G8_MMA(0, 1, At, B1); G8_BAR; G8_SCHED;
            G8_LDA(At, 0, 1); G8_STAGEB(G8_SB(0, 0), b2); G8_STAGEB(G8_SB(0, 1), b2 + hstepB); G8_STAGEA(G8_SA(0, 0), a2b, ao2[0], k2);
            G8_WAIT_V(8); G8_WAIT_L(0); G8_BAR; G8_MMA(1, 0, At, B0); G8_MMA(1, 1, At, B1); G8_BAR; G8_SCHED;
            G8_LDB(B0, 1, 0); G8_LDB(B1, 1, 1); G8_SCHED; G8_LDA(At, 1, 0); G8_STAGEA(G8_SA(0, 1), a2b, ao2[1], k2);
            G8_WAIT_V(8); G8_WAIT_L(0); G8_BAR; G8_MMA(0, 0, At, B0); G8_MMA(0, 1, At, B1); G8_BAR; G8_SCHED;
            G8_LDA(At, 1, 1); G8_STAGEB(G8_SB(1, 0), b3); G8_STAGEB(G8_SB(1, 1), b3 + hstepB); G8_STAGEA(G8_SA(1, 0), a2b, ao2[0], k3);
            G8_WAIT_V(8); G8_WAIT_L(0); G8_BAR; G8_MMA(1, 0, At, B0); G8_MMA(1, 1, At, B1); G8_BAR; G8_SCHED;
        }
        if (wr == 0) G8_BAR;
        E(acc, cur, wr, wc, fr, fq);
        if (!has_next) break;
#pragma unroll
        for (int a = 0; a < 2; ++a)
#pragma unroll
            for (int b = 0; b < 2; ++b)
#pragma unroll
                for (int m = 0; m < 4; ++m)
#pragma unroll
                    for (int n = 0; n < 2; ++n) acc[a][b][m][n] = (f32x4){0.f, 0.f, 0.f, 0.f};
        cur = nxt; cA = nA; cB = nB; ++ui;
#pragma unroll
        for (int h = 0; h < 2; ++h)
#pragma unroll
            for (int i = 0; i < 2; ++i) aoC[h][i] = aoN[h][i];
        if (wr == 1) G8_BAR;
    }
    G8_WAIT_V(0);
    G8_BAR;
#undef G8_AOFF
#undef G8_SA
#undef G8_SB
#undef G8_STAGEA
#undef G8_STAGEB
#undef G8_LDA
#undef G8_LDB
#undef G8_MMA
#undef G8_WAIT_V
#undef G8_WAIT_L
#undef G8_BAR
#undef G8_SCHED
}

struct EpiScaleBf16 {
  static constexpr bool PERM = true;
  bf16_t* C; int ldc; const float* rowscale; int ncol_store;
  __device__ __forceinline__ void operator()(const f32x4 (&acc)[2][2][4][2], const Unit& u, int wr, int wc, int fr, int fq) const {
    const int row0 = u.pm * BM + wr * 64 + fr, col0 = u.pn * BM + wc * 32 + 8 * fq;
#pragma unroll
    for (int ai = 0; ai < 2; ++ai)
#pragma unroll
      for (int m = 0; m < 4; ++m) { const int row = row0 + ai * HALF + m * 16; const float sc = rowscale[row]; bf16_t* rowp = C + (size_t)row * ldc + col0;
#pragma unroll
        for (int bj = 0; bj < 2; ++bj) { const f32x4 v0 = acc[ai][bj][m][0] * sc, v1 = acc[ai][bj][m][1] * sc;
          u32x4 w; w.x = cvt_pk_bf16(v0[0], v0[1]); w.y = cvt_pk_bf16(v0[2], v0[3]); w.z = cvt_pk_bf16(v1[0], v1[1]); w.w = cvt_pk_bf16(v1[2], v1[3]);
          if (col0 + bj * HALF < ncol_store) *(u32x4*)(rowp + bj * HALF) = w; } }
  }
};
struct EpiMem {
  static constexpr bool PERM = true; bf16_t* C; const float* rs;
  __device__ __forceinline__ void operator()(const f32x4 (&acc)[2][2][4][2], const Unit& u, int wr, int wc, int fr, int fq) const {
    const int l = u.pn >> 1; Unit v = u; v.pn = u.pn & 1;
    EpiScaleBf16 e{C + (size_t)l * 2048 * 512, 512, rs, 512}; e(acc, v, wr, wc, fr, fq); }
};
struct EpiResidF32 {
  static constexpr bool PERM = false;
  float* out; const float* resid;
  __device__ __forceinline__ void operator()(const f32x4 (&acc)[2][2][4][2], const Unit& u, int wr, int wc, int fr, int fq) const {
    const int row0 = u.pm * BM + wr * 64 + fr, col0 = u.pn * BM + wc * 32 + 4 * fq;
#pragma unroll
    for (int ai = 0; ai < 2; ++ai)
#pragma unroll
      for (int m = 0; m < 4; ++m) { const size_t base = (size_t)(row0 + ai * HALF + m * 16) * DM + col0;
#pragma unroll
        for (int bj = 0; bj < 2; ++bj)
#pragma unroll
          for (int n = 0; n < 2; ++n) { const size_t o = base + bj * HALF + n * 16; const f32x4 rv = *(const f32x4*)(resid + o); *(f32x4*)(out + o) = rv + acc[ai][bj][m][n]; } }
  }
};
struct EpiMoe1 {
  static constexpr bool PERM = true;
  bf16_t* hid; const float* rstd;
  __device__ __forceinline__ void operator()(const f32x4 (&acc)[2][2][4][2], const Unit& u, int wr, int wc, int fr, int fq) const {
#pragma unroll
    for (int ai = 0; ai < 2; ++ai)
#pragma unroll
      for (int m = 0; m < 4; ++m) { const int r = ai * HALF + wr * 64 + m * 16 + fr;
        if (r < u.nvalid) { const int slot = u.list[u.row0 + r]; const float rs = rstd[slot >> 1];
          float h[8];
#pragma unroll
          for (int n = 0; n < 2; ++n)
#pragma unroll
            for (int j = 0; j < 4; ++j) { const float a = acc[ai][0][m][n][j] * rs, b = acc[ai][1][m][n][j] * rs; h[4 * n + j] = siluf_(a) * b; }
          u32x4 w; w.x = cvt_pk_bf16(h[0], h[1]); w.y = cvt_pk_bf16(h[2], h[3]); w.z = cvt_pk_bf16(h[4], h[5]); w.w = cvt_pk_bf16(h[6], h[7]);
          *(u32x4*)(hid + (size_t)slot * 256 + u.pn * 128 + wc * 32 + 8 * fq) = w; } }
  }
};
struct EpiMoe2 {
  static constexpr bool PERM = true;
  bf16_t* y; const float* cw;
  __device__ __forceinline__ void operator()(const f32x4 (&acc)[2][2][4][2], const Unit& u, int wr, int wc, int fr, int fq) const {
#pragma unroll
    for (int ai = 0; ai < 2; ++ai)
#pragma unroll
      for (int m = 0; m < 4; ++m) { const int r = ai * HALF + wr * 64 + m * 16 + fr;
        if (r < u.nvalid) { const int slot = u.list[u.row0 + r]; const float c = cw[slot];
          bf16_t* yp = y + (size_t)slot * DM + u.pn * BM + wc * 32 + 8 * fq;
#pragma unroll
          for (int bj = 0; bj < 2; ++bj) { const f32x4 v0 = acc[ai][bj][m][0] * c, v1 = acc[ai][bj][m][1] * c;
            u32x4 w; w.x = cvt_pk_bf16(v0[0], v0[1]); w.y = cvt_pk_bf16(v0[2], v0[3]); w.z = cvt_pk_bf16(v1[0], v1[1]); w.w = cvt_pk_bf16(v1[2], v1[3]);
            *(u32x4*)(yp + bj * HALF) = w; } } }
  }
};

template <int NPN>
struct MoeOrder {
  const char* A; const char* Wt; const int* lists; int cn[16]; int G, c; size_t wstride_e, wstride_pn;
  __device__ __forceinline__ bool next(int i, Unit& u) const {
    int L = i * G + c; bool found = false;
#pragma unroll
    for (int e = 0; e < 16; ++e) { const int nu = ((cn[e] + 255) >> 8) * NPN;
      if (!found) { if (L < nu) { found = true; const int tile = L / NPN, pn = L % NPN; u.pm = tile; u.pn = pn; u.aux = e; u.A = A; u.B = Wt + (size_t)e * wstride_e + (size_t)pn * wstride_pn;
          u.list = lists + (size_t)e * NTOK; u.row0 = tile * 256; u.nvalid = (cn[e] - tile * 256) < 256 ? (cn[e] - tile * 256) : 256; } else L -= nu; } }
    return found;
  }
};
}

__device__ __forceinline__ void phase_gemm_inA(const Params& p, LAS char* lds, int bid, int nblk) {
  char* ws = p.ws;
  const bf16_t* hb = (const bf16_t*)p.out; const bf16_t* memb = (const bf16_t*)((char*)p.out + ((size_t)64 << 20));
  const bf16_t* wa = (const bf16_t*)(ws + OFF_W + W_AIN); const bf16_t* wm = (const bf16_t*)(ws + OFF_W + W_MEM);
  { g8::DenseOrder S; S.init(hb, wa, 1024, NTOK, NIN_A, nblk, bid);
    g8::EpiScaleBf16 E{(bf16_t*)(ws + OFF_P), LDP, (const float*)(ws + OFF_RSTD), LDP};
    g8::gemm_phase<g8::EpiScaleBf16, g8::DenseOrder, 0>((LAS unsigned char*)lds, 1024, DM, S, E); }
  { g8::DenseOrder S; S.init(memb, wm, 1024, NMEMROW, 1024, nblk, bid);
    g8::EpiMem E{(bf16_t*)(ws + OFF_MEMKV), (const float*)(ws + OFF_MRSTD)};
    g8::gemm_phase<g8::EpiMem, g8::DenseOrder, 0>((LAS unsigned char*)lds, 1024, DM, S, E); }
}
__device__ __forceinline__ void phase_gemm_inB(const Params& p, LAS char* lds, int bid, int nblk) {
  char* ws = p.ws;
  g8::DenseOrder S; S.init(ws + OFF_G + G_HB, ws + OFF_W + W_BIN, 1024, NTOK, NIN_B, nblk, bid);
  g8::EpiScaleBf16 E{(bf16_t*)(ws + OFF_P), LDP, (const float*)(ws + OFF_RSTD), LDP};
  g8::gemm_phase<g8::EpiScaleBf16, g8::DenseOrder, 0>((LAS unsigned char*)lds, 1024, DM, S, E);
}
__device__ __forceinline__ void phase_gemm_out(const Params& p, LAS char* lds, int bid, int nblk, int layer) {
  char* ws = p.ws;
  g8::DenseOrder S; S.init(ws + OFF_P, ws + OFF_W + (layer ? W_BOUT : W_AOUT), 1024, NTOK, 1024, nblk, bid);
  g8::EpiResidF32 E{p.out, layer ? (const float*)p.out : p.x};
  g8::gemm_phase<g8::EpiResidF32, g8::DenseOrder, 0>((LAS unsigned char*)lds, 1024, LDP, S, E);
}
__device__ __forceinline__ void phase_moe1(const Params& p, LAS char* lds, int bid, int nblk, int layer) {
  char* ws = p.ws;
  const unsigned* cnt = (const unsigned*)(ws + OFF_CTRL) + CTRL_CNT + layer * 16 * 64;
  g8::MoeOrder<2> S; S.A = ws + OFF_G + G_HB; S.Wt = ws + OFF_W + W_13 + (size_t)layer * 16 * 512 * 1024 * 2; S.lists = (const int*)(ws + OFF_LIST);
#pragma unroll
  for (int e = 0; e < 16; ++e) S.cn[e] = (int)cnt[e * 64];
  S.G = nblk; S.c = bid; S.wstride_e = (size_t)512 * 1024 * 2; S.wstride_pn = (size_t)256 * 1024 * 2;
  g8::EpiMoe1 E{(bf16_t*)(ws + OFF_P), (const float*)(ws + OFF_RSTD)};
  g8::gemm_phase<g8::EpiMoe1, g8::MoeOrder<2>, 1>((LAS unsigned char*)lds, 1024, DM, S, E);
}
__device__ __forceinline__ void phase_moe2(const Params& p, LAS char* lds, int bid, int nblk, int layer) {
  char* ws = p.ws;
  const unsigned* cnt = (const unsigned*)(ws + OFF_CTRL) + CTRL_CNT + layer * 16 * 64;
  g8::MoeOrder<4> S; S.A = ws + OFF_P; S.Wt = ws + OFF_W + W_2 + (size_t)layer * 16 * 1024 * 256 * 2; S.lists = (const int*)(ws + OFF_LIST);
#pragma unroll
  for (int e = 0; e < 16; ++e) S.cn[e] = (int)cnt[e * 64];
  S.G = nblk; S.c = bid; S.wstride_e = (size_t)1024 * 256 * 2; S.wstride_pn = (size_t)256 * 256 * 2;
  g8::EpiMoe2 E{(bf16_t*)(ws + OFF_G + G_MIX), (const float*)(ws + OFF_CW)};
  g8::gemm_phase<g8::EpiMoe2, g8::MoeOrder<4>, 0>((LAS unsigned char*)lds, 256, 256, S, E);
}


typedef float f32x2v __attribute__((ext_vector_type(2)));
__device__ __forceinline__ void phase_norm_route(const Params& p, LAS char* lds, int bid, int nblk, int layer) {
  char* ws = p.ws; const int tid = threadIdx.x, lane = tid & 63, r32 = lane & 31, hi = lane >> 5; const int w = __builtin_amdgcn_readfirstlane(tid >> 6);
  constexpr int WROW = 1028;
  LAS float* wl = (LAS float*)lds;
  LAS float* lgx = (LAS float*)(lds + 20 * WROW * 4);
  LAS float* ssx = lgx + 8 * 32 * 33;
  const float* wr = (const float*)(ws + OFF_WR) + (size_t)layer * 20480;
  __syncthreads();
  for (int i = tid; i < 20480 / 4; i += NTHR) { const int j = i >> 8, c = (i & 255) * 4; *(LAS f32x4*)(wl + j * WROW + c) = *(const f32x4*)(wr + j * 1024 + c); }
  __syncthreads();
  bf16_t* hb = (bf16_t*)(ws + OFF_G + G_HB); float* rstd = (float*)(ws + OFF_RSTD); float* cw = (float*)(ws + OFF_CW);
  unsigned* cnt = (unsigned*)(ws + OFF_CTRL) + CTRL_CNT + layer * 16 * 64; int* lists = (int*)(ws + OFF_LIST);
  const float* bg = p.b_group + layer * 4; const float* br = p.b_router + layer * 16;
  const int nn = r32 < 20 ? r32 : 19;
  for (int base = bid * 4; base < NTOK / 32; base += nblk * 4) {
    const int tile = base + (w & 3), kh = w >> 2, t0 = tile * 32;
    const float* hrow = p.out + (size_t)(t0 + r32) * DM + kh * 512 + 4 * hi;
    bf16_t* hbrow = hb + (size_t)(t0 + r32) * DM + kh * 512 + 4 * hi;
    LAS const float* wrow = wl + nn * WROW + kh * 512 + 4 * hi;
    f32x16 acc = f32x16{}; float ss = 0.f;
    for (int j0 = 0; j0 < 64; j0 += 8) {
      f32x4 hv[8];
#pragma unroll
      for (int q = 0; q < 8; ++q) hv[q] = *(const f32x4*)(hrow + (j0 + q) * 8);
#pragma unroll
      for (int q = 0; q < 8; ++q) {
        const f32x4 wv = *(LAS const f32x4*)(wrow + (j0 + q) * 8);
        ss += hv[q][0] * hv[q][0] + hv[q][1] * hv[q][1] + hv[q][2] * hv[q][2] + hv[q][3] * hv[q][3];
        u32x2 o; o.x = cvt_pk_bf16(hv[q][0], hv[q][1]); o.y = cvt_pk_bf16(hv[q][2], hv[q][3]);
        *(u32x2*)(hbrow + (j0 + q) * 8) = o;
#pragma unroll
        for (int e = 0; e < 4; ++e) acc = __builtin_amdgcn_mfma_f32_32x32x2f32(wv[e], hv[q][e], acc, 0, 0, 0);
      }
    }
    { auto sw = __builtin_amdgcn_permlane32_swap(__float_as_uint(ss), __float_as_uint(ss), false, false); ss = __uint_as_float(sw[0]) + __uint_as_float(sw[1]); }
    LAS float* lg = lgx + w * 32 * 33;
#pragma unroll
    for (int r = 0; r < 16; ++r) { const int n = (r & 3) + 8 * (r >> 2) + 4 * hi; lg[r32 * 33 + n] = acc[r]; }
    if (hi == 0) ssx[w * 32 + r32] = ss;
    __syncthreads();
    if (w < 4 && hi == 0) {
      LAS const float* la = lgx + w * 32 * 33 + r32 * 33; LAS const float* lb = lgx + (w + 4) * 32 * 33 + r32 * 33;
      const int t = t0 + r32;
      const float rs = rsqrtf((ssx[w * 32 + r32] + ssx[(w + 4) * 32 + r32]) * (1.f / DM) + EPS);
      float lgt[20];
#pragma unroll
      for (int j = 0; j < 20; ++j) lgt[j] = (la[j] + lb[j]) * rs + (j < 4 ? bg[j] : br[j - 4]);
      int gs = 0; float gm = lgt[0];
#pragma unroll
      for (int j = 1; j < 4; ++j) if (lgt[j] > gm) { gm = lgt[j]; gs = j; }
      float den = 0.f;
#pragma unroll
      for (int j = 0; j < 4; ++j) den += __expf(lgt[j] - gm);
      const float pg = 1.f / den;
      float el[4];
#pragma unroll
      for (int j = 0; j < 4; ++j) el[j] = gs == 0 ? lgt[4 + j] : gs == 1 ? lgt[8 + j] : gs == 2 ? lgt[12 + j] : lgt[16 + j];
      int i1 = 0; float m1 = el[0];
#pragma unroll
      for (int j = 1; j < 4; ++j) if (el[j] > m1) { m1 = el[j]; i1 = j; }
      int i2 = -1; float m2 = -INFINITY;
#pragma unroll
      for (int j = 0; j < 4; ++j) if (j != i1 && el[j] > m2) { m2 = el[j]; i2 = j; }
      const float e2 = __expf(m2 - m1), p1 = 1.f / (1.f + e2), p2 = e2 * p1;
      const int ex1 = gs * 4 + i1, ex2 = gs * 4 + i2;
      unsigned myc = 0u; int rk1 = 0, rk2 = 0;
      const unsigned long long lt = (1ull << r32) - 1ull;
#pragma unroll
      for (int e = 0; e < 16; ++e) {
        const unsigned long long b1 = __ballot(ex1 == e), b2 = __ballot(ex2 == e);
        const int c1 = __popcll(b1), c2 = __popcll(b2);
        if (r32 == e) myc = (unsigned)(c1 + c2);
        if (ex1 == e) rk1 = __popcll(b1 & lt);
        if (ex2 == e) rk2 = c1 + __popcll(b2 & lt);
      }
      unsigned basev = 0u;
      if (r32 < 16 && myc) basev = atomicAdd(&cnt[r32 * 64], myc);
      const unsigned q1 = (unsigned)__shfl((int)basev, ex1) + (unsigned)rk1, q2 = (unsigned)__shfl((int)basev, ex2) + (unsigned)rk2;
      lists[(size_t)ex1 * NTOK + q1] = t * 2; lists[(size_t)ex2 * NTOK + q2] = t * 2 + 1;
      cw[t * 2] = pg * p1; cw[t * 2 + 1] = pg * p2; rstd[t] = rs;
    }
    __syncthreads();
  }
}

template <bool FINAL>
__device__ __forceinline__ void phase_combine(const Params& p, int bid, int nblk) {
  char* ws = p.ws; const int tid = threadIdx.x, lane = tid & 63, w = tid >> 6;
  const bf16_t* y = (const bf16_t*)(ws + OFF_G + G_MIX); bf16_t* hb = (bf16_t*)(ws + OFF_G + G_HB); float* rstd = (float*)(ws + OFF_RSTD);
  for (int t = bid * 8 + w; t < NTOK; t += nblk * 8) {
    float* hrow = p.out + (size_t)t * DM;
    f32x4 v[4]; float ss = 0.f;
#pragma unroll
    for (int i = 0; i < 4; ++i) {
      const int c = i * 256 + lane * 4;
      v[i] = *(const f32x4*)(hrow + c);
      const u32x2 a = *(const u32x2*)(y + (size_t)(2 * t) * DM + c), b = *(const u32x2*)(y + (size_t)(2 * t + 1) * DM + c);
      v[i][0] += bflo(a.x) + bflo(b.x); v[i][1] += bfhi(a.x) + bfhi(b.x); v[i][2] += bflo(a.y) + bflo(b.y); v[i][3] += bfhi(a.y) + bfhi(b.y);
      ss += v[i][0] * v[i][0] + v[i][1] * v[i][1] + v[i][2] * v[i][2] + v[i][3] * v[i][3];
    }
    ss = wave_sum(ss);
    const float rs = rsqrtf(ss * (1.f / DM) + EPS);
#pragma unroll
    for (int i = 0; i < 4; ++i) {
      const int c = i * 256 + lane * 4;
      if (FINAL) {
        const f32x4 g = *(const f32x4*)(p.final_norm + c);
        f32x4 o; o[0] = v[i][0] * rs * g[0]; o[1] = v[i][1] * rs * g[1]; o[2] = v[i][2] * rs * g[2]; o[3] = v[i][3] * rs * g[3];
        *(f32x4*)(hrow + c) = o;
      } else {
        *(f32x4*)(hrow + c) = v[i];
        u32x2 o; o.x = cvt_pk_bf16(v[i][0], v[i][1]); o.y = cvt_pk_bf16(v[i][2], v[i][3]);
        *(u32x2*)(hb + (size_t)t * DM + c) = o;
      }
    }
    if (!FINAL && lane == 0) rstd[t] = rs;
  }
}

namespace mem {
typedef short s16x4 __attribute__((ext_vector_type(4)));
constexpr int TILEB = 8192, LDS_K = 0, LDS_V = 4 * TILEB, LDS_WS = 8 * TILEB, LDS_OST = LDS_WS + 8 * 256;
__device__ __forceinline__ s16x4 vtr(LAS const char* p) { return __builtin_bit_cast(s16x4, __builtin_amdgcn_ds_read_tr16_b64_v4i16((LAS s16x4*)p)); }
__device__ __forceinline__ void unit(bf16_t* P, const bf16_t* mkv, int b, int hd, int qb, LAS char* lds) {
  const int tid = threadIdx.x, lane = tid & 63, r32 = lane & 31, hi = lane >> 5; const int wid = __builtin_amdgcn_readfirstlane(tid >> 6);
  const bf16_t* Kh = mkv + (size_t)b * 256 * 512 + hd * 64; const bf16_t* Vh = Kh + 256;
  bf16_t* Qw = P + ((size_t)b * SEQ + qb * 256 + wid * 32) * LDP + PC_MQ + hd * 64;
  const bf16_t* ksrc = Kh + (size_t)lane * 512 + wid * 8;
  const bf16_t* vsrc = Vh + (size_t)(16 * (wid & 3) + (lane >> 2)) * 512 + (wid >> 2) * 32 + (lane & 3) * 8;
#pragma unroll
  for (int t = 0; t < 4; ++t) {
    __builtin_amdgcn_global_load_lds((const unsigned*)(ksrc + (size_t)t * 64 * 512), (LAS unsigned*)(lds + LDS_K + t * TILEB + wid * 1024), 16, 0, 0);
    __builtin_amdgcn_global_load_lds((const unsigned*)(vsrc + (size_t)t * 64 * 512), (LAS unsigned*)(lds + LDS_V + t * TILEB + wid * 1024), 16, 0, 0);
  }
  bf16x8 qr[4];
#pragma unroll
  for (int d0 = 0; d0 < 4; ++d0) qr[d0] = *(const bf16x8*)(Qw + (size_t)r32 * LDP + d0 * 16 + hi * 8);
  asm volatile("s_waitcnt vmcnt(0) lgkmcnt(0)\n\ts_barrier" ::: "memory");
  LAS const char* kp0 = lds + LDS_K + hi * 1024 + r32 * 16;
  LAS const char* vp0 = lds + LDS_V + ((lane >> 4) & 1) * 32 + (lane & 3) * 8 + (4 * hi + ((lane & 15) >> 2)) * 64;
  float mx = -INFINITY;
#pragma unroll
  for (int t = 0; t < 4; ++t) {
    f32x16 p0 = f32x16{}, p1 = f32x16{};
#pragma unroll
    for (int d0 = 0; d0 < 4; ++d0) {
      const bf16x8 k0 = *(LAS const bf16x8*)(kp0 + t * TILEB + d0 * 2048), k1 = *(LAS const bf16x8*)(kp0 + t * TILEB + d0 * 2048 + 512);
      p0 = __builtin_amdgcn_mfma_f32_32x32x16_bf16(k0, qr[d0], p0, 0, 0, 0); p1 = __builtin_amdgcn_mfma_f32_32x32x16_bf16(k1, qr[d0], p1, 0, 0, 0);
    }
#pragma unroll
    for (int r = 0; r < 16; ++r) mx = fmaxf(mx, fmaxf(p0[r], p1[r]));
  }
  { auto sw = __builtin_amdgcn_permlane32_swap(__float_as_uint(mx), __float_as_uint(mx), false, false); mx = fmaxf(__uint_as_float(sw[0]), __uint_as_float(sw[1])); }
  f32x16 o[2]; o[0] = f32x16{}; o[1] = f32x16{};
  float lsum = 0.f;
#pragma unroll
  for (int t = 0; t < 4; ++t) {
    f32x16 p0 = f32x16{}, p1 = f32x16{};
#pragma unroll
    for (int d0 = 0; d0 < 4; ++d0) {
      const bf16x8 k0 = *(LAS const bf16x8*)(kp0 + t * TILEB + d0 * 2048), k1 = *(LAS const bf16x8*)(kp0 + t * TILEB + d0 * 2048 + 512);
      p0 = __builtin_amdgcn_mfma_f32_32x32x16_bf16(k0, qr[d0], p0, 0, 0, 0); p1 = __builtin_amdgcn_mfma_f32_32x32x16_bf16(k1, qr[d0], p1, 0, 0, 0);
    }
    float a[32];
#pragma unroll
    for (int r = 0; r < 16; ++r) { a[r] = __builtin_amdgcn_exp2f(p0[r] - mx); a[16 + r] = __builtin_amdgcn_exp2f(p1[r] - mx); lsum += a[r] + a[16 + r]; }
    u32x4 pw[4];
#pragma unroll
    for (int ks = 0; ks < 4; ++ks) { pw[ks].x = cvt_pk_bf16(a[8 * ks], a[8 * ks + 1]); pw[ks].y = cvt_pk_bf16(a[8 * ks + 2], a[8 * ks + 3]); pw[ks].z = cvt_pk_bf16(a[8 * ks + 4], a[8 * ks + 5]); pw[ks].w = cvt_pk_bf16(a[8 * ks + 6], a[8 * ks + 7]); }
    LAS const char* vp = vp0 + t * TILEB;
#pragma unroll
    for (int d0 = 0; d0 < 2; ++d0)
#pragma unroll
      for (int ks = 0; ks < 4; ++ks) {
        const s16x4 lo = vtr(vp + d0 * 4096 + ks * 1024), hh = vtr(vp + d0 * 4096 + ks * 1024 + 512);
        const bf16x8 vf = (bf16x8){lo[0], lo[1], lo[2], lo[3], hh[0], hh[1], hh[2], hh[3]};
        o[d0] = __builtin_amdgcn_mfma_f32_32x32x16_bf16(__builtin_bit_cast(bf16x8, pw[ks]), vf, o[d0], 0, 0, 0);
      }
  }
  { auto sw = __builtin_amdgcn_permlane32_swap(__float_as_uint(lsum), __float_as_uint(lsum), false, false); lsum = __uint_as_float(sw[0]) + __uint_as_float(sw[1]); }
  LAS float* wsf = (LAS float*)(lds + LDS_WS) + wid * 64;
  if (hi == 0) wsf[r32] = __builtin_amdgcn_rcpf(lsum);
  asm volatile("s_waitcnt lgkmcnt(0)" ::: "memory");
  LAS bf16_t* stg = (LAS bf16_t*)(lds + LDS_OST) + wid * 2048;
#pragma unroll
  for (int r = 0; r < 16; ++r) { const int orow = (r & 3) + 8 * (r >> 2) + 4 * hi; const float il = wsf[orow];
#pragma unroll
    for (int d0 = 0; d0 < 2; ++d0) stg[orow * 64 + d0 * 32 + r32] = f2bf(o[d0][r] * il); }
  asm volatile("s_waitcnt lgkmcnt(0)" ::: "memory");
#pragma unroll
  for (int i = 0; i < 4; ++i) { const int row = i * 8 + (lane >> 3), ch = lane & 7; const u32x4 v = *(LAS const u32x4*)(stg + row * 64 + ch * 8); *(u32x4*)(Qw + (size_t)row * LDP + ch * 8) = v; }
  asm volatile("s_waitcnt vmcnt(0) lgkmcnt(0)\n\ts_barrier" ::: "memory");
}
}
__device__ __forceinline__ void phase_memattn(const Params& p, LAS char* lds, int bid, int nblk, int layer) {
  char* ws = p.ws; bf16_t* P = (bf16_t*)(ws + OFF_P);
  const bf16_t* mkv = (const bf16_t*)(ws + OFF_MEMKV) + (size_t)layer * 2048 * 512;
  for (int u = bid; u < NBATCH * 4 * 16; u += nblk) { const int bh = u >> 4, qb = u & 15; mem::unit(P, mkv, bh >> 2, bh & 3, qb, lds); }
}

namespace sb {
typedef short s16x4 __attribute__((ext_vector_type(4)));
constexpr int SLOTB = 8192, LDS_K = 0, LDS_V = 3 * SLOTB, LDS_OST = 6 * SLOTB, LDS_BYTES_SB = LDS_OST + 8 * 4096;
__device__ __forceinline__ s16x4 vtr(LAS const char* p) { return __builtin_bit_cast(s16x4, __builtin_amdgcn_ds_read_tr16_b64_v4i16((LAS s16x4*)p)); }

__device__ __forceinline__ void unit(const bf16_t* P, bf16_t* O, int ldo, int b, int h, int qb, LAS char* lds) {
  const int tid = threadIdx.x, lane = tid & 63, r32 = lane & 31, hi = lane >> 5; const int wid = __builtin_amdgcn_readfirstlane(tid >> 6);
  const size_t rowbase = (size_t)b * SEQ; const int q0 = qb * 256;
  const bf16_t* Kh = P + rowbase * LDP + PC_K + h * 64; const bf16_t* Vh = P + rowbase * LDP + PC_V + h * 64;
  const bf16_t* Qw = P + (rowbase + q0 + wid * 32) * LDP + PC_Q + h * 64;
  const bf16_t* ksrc = Kh + (size_t)lane * LDP + wid * 8;
  const bf16_t* vsrc = Vh + (size_t)(16 * (wid & 3) + (lane >> 2)) * LDP + (wid >> 2) * 32 + (lane & 3) * 8;
  LAS char* kdst = lds + LDS_K + wid * 1024; LAS char* vdst = lds + LDS_V + wid * 1024;
#define SB_DMA(t, slot) do { __builtin_amdgcn_global_load_lds((const unsigned*)(ksrc + (size_t)(t) * 64 * LDP), (LAS unsigned*)(kdst + (slot)), 16, 0, 0); \
                             __builtin_amdgcn_global_load_lds((const unsigned*)(vsrc + (size_t)(t) * 64 * LDP), (LAS unsigned*)(vdst + (slot)), 16, 0, 0); } while (0)
  const int NT = 4 * qb + 4;
  SB_DMA(NT - 1, 0);
  bf16x8 qr[4];
#pragma unroll
  for (int d0 = 0; d0 < 4; ++d0) qr[d0] = *(const bf16x8*)(Qw + (size_t)r32 * LDP + d0 * 16 + hi * 8);
  f32x16 o[2]; o[0] = f32x16{}; o[1] = f32x16{};
  float c = 1.f;
  const int qrel = wid * 32 + r32;
  LAS const char* kp0 = lds + LDS_K + hi * 1024 + r32 * 16;
  LAS const char* vp0 = lds + LDS_V + ((lane >> 4) & 1) * 32 + (lane & 3) * 8 + (4 * hi + ((lane & 15) >> 2)) * 64;
  int slot = 0;
  for (int i = 0; i < NT; ++i) {
    const int t = NT - 1 - i;
    const int nslot = (slot == 2 * SLOTB) ? 0 : slot + SLOTB;
    if (t > 0) { SB_DMA(t - 1, nslot); asm volatile("s_waitcnt vmcnt(2) lgkmcnt(0)\n\ts_barrier" ::: "memory"); }
    else { asm volatile("s_waitcnt vmcnt(0) lgkmcnt(0)\n\ts_barrier" ::: "memory"); }
    const int jb = t - (NT - 4);
    if (!(jb >= 0 && 64 * jb > 32 * wid + 30)) {
      f32x16 p0 = f32x16{}, p1 = f32x16{};
#pragma unroll
      for (int d0 = 0; d0 < 4; ++d0) {
        const bf16x8 k0 = *(LAS const bf16x8*)(kp0 + slot + d0 * 2048), k1 = *(LAS const bf16x8*)(kp0 + slot + d0 * 2048 + 512);
        p0 = __builtin_amdgcn_mfma_f32_32x32x16_bf16(k0, qr[d0], p0, 0, 0, 0);
        p1 = __builtin_amdgcn_mfma_f32_32x32x16_bf16(k1, qr[d0], p1, 0, 0, 0);
      }
      if (jb >= 0) {
        const int kb = 64 * jb + 4 * hi;
#pragma unroll
        for (int r = 0; r < 16; ++r) { const int kv = kb + (r & 3) + 8 * (r >> 2); if (kv >= qrel) p0[r] = -INFINITY; if (kv + 32 >= qrel) p1[r] = -INFINITY; }
      }
      float rr[32], be[32];
#pragma unroll
      for (int r = 0; r < 16; ++r) {
        const float e0 = __builtin_amdgcn_exp2f(p0[r]), e1 = __builtin_amdgcn_exp2f(p1[r]);
        rr[r] = __builtin_amdgcn_rcpf(1.f + e0); rr[16 + r] = __builtin_amdgcn_rcpf(1.f + e1);
        be[r] = 1.f - rr[r]; be[16 + r] = 1.f - rr[16 + r];
      }
      float OS[9]; OS[8] = 1.f;
#pragma unroll
      for (int G = 7; G >= 0; --G) { const float gp = (rr[4 * G] * rr[4 * G + 1]) * (rr[4 * G + 2] * rr[4 * G + 3]); OS[G] = OS[G + 1] * gp; }
      float cE[8];
#pragma unroll
      for (int G = 0; G < 8; ++G) {
        const float X = hi ? OS[G] : OS[G + 1], Y = OS[G + 1];
        auto sw = __builtin_amdgcn_permlane32_swap(__float_as_uint(X), __float_as_uint(Y), false, false);
        cE[G] = c * (__uint_as_float(sw[0]) * __uint_as_float(sw[1]));
      }
      { auto sw = __builtin_amdgcn_permlane32_swap(__float_as_uint(OS[0]), __float_as_uint(OS[0]), false, false); c *= __uint_as_float(sw[0]) * __uint_as_float(sw[1]); }
      float a[32];
#pragma unroll
      for (int G = 0; G < 8; ++G) {
        const float t3 = cE[G], t2 = t3 * rr[4 * G + 3], t1 = t2 * rr[4 * G + 2], t0 = t1 * rr[4 * G + 1];
        a[4 * G + 3] = be[4 * G + 3] * t3; a[4 * G + 2] = be[4 * G + 2] * t2; a[4 * G + 1] = be[4 * G + 1] * t1; a[4 * G] = be[4 * G] * t0;
      }
      u32x4 pw[4];
#pragma unroll
      for (int ks = 0; ks < 4; ++ks) { pw[ks].x = cvt_pk_bf16(a[8 * ks], a[8 * ks + 1]); pw[ks].y = cvt_pk_bf16(a[8 * ks + 2], a[8 * ks + 3]); pw[ks].z = cvt_pk_bf16(a[8 * ks + 4], a[8 * ks + 5]); pw[ks].w = cvt_pk_bf16(a[8 * ks + 6], a[8 * ks + 7]); }
      LAS const char* vp = vp0 + slot;
#pragma unroll
      for (int d0 = 0; d0 < 2; ++d0)
#pragma unroll
        for (int ks = 0; ks < 4; ++ks) {
          const s16x4 lo = vtr(vp + d0 * 4096 + ks * 1024), hh = vtr(vp + d0 * 4096 + ks * 1024 + 512);
          const bf16x8 vf = (bf16x8){lo[0], lo[1], lo[2], lo[3], hh[0], hh[1], hh[2], hh[3]};
          o[d0] = __builtin_amdgcn_mfma_f32_32x32x16_bf16(__builtin_bit_cast(bf16x8, pw[ks]), vf, o[d0], 0, 0, 0);
        }
    }
    slot = nslot;
  }
  bf16_t* Ow = O + (rowbase + q0 + wid * 32) * ldo + h * 64;
  LAS bf16_t* stg = (LAS bf16_t*)(lds + LDS_OST) + wid * 2048;
#pragma unroll
  for (int r = 0; r < 16; ++r) { const int orow = (r & 3) + 8 * (r >> 2) + 4 * hi;
#pragma unroll
    for (int d0 = 0; d0 < 2; ++d0) stg[orow * 64 + d0 * 32 + r32] = f2bf(o[d0][r]); }
  asm volatile("s_waitcnt lgkmcnt(0)" ::: "memory");
#pragma unroll
  for (int i = 0; i < 4; ++i) { const int row = i * 8 + (lane >> 3), ch = lane & 7; const u32x4 v = *(LAS const u32x4*)(stg + row * 64 + ch * 8); *(u32x4*)(Ow + (size_t)row * ldo + ch * 8) = v; }
  asm volatile("s_waitcnt vmcnt(0) lgkmcnt(0)\n\ts_barrier" ::: "memory");
#undef SB_DMA
}
}
__device__ __forceinline__ void phase_sb_attn(const Params& p, LAS char* lds, int bid, int nblk) {
  char* ws = p.ws;
  bf16_t* P = (bf16_t*)(ws + OFF_P);
  const int vcu = (nblk % 8 == 0) ? (bid % 8) * (nblk / 8) + bid / 8 : bid;
  for (int pi = vcu; pi < 96 * 8; pi += nblk) {
    const int bh = pi >> 3, s = pi & 7, b = bh / 12, h = bh % 12;
    sb::unit(P, P, LDP, b, h, 15 - s, lds);
    sb::unit(P, P, LDP, b, h, s, lds);
  }
}

namespace gdn {
constexpr int RA_W = 0, RA_QG = 16384, RA_KT = 32768, RA_ATT = 49152, REC_A = 55296, REC_U = 16384, REC = REC_A + REC_U;
constexpr int HALF_LDS = 58368;
constexpr float QSCALE = 0.08838834764831845f;
__device__ __forceinline__ int crow(int r, int hi) { return (r & 3) + 8 * (r >> 2) + 4 * hi; }
}
__device__ __forceinline__ void phase_gdn_prep(const Params& p, LAS char* lds, int bid, int nblk) {
  using namespace gdn;
  char* ws = p.ws; const bf16_t* P = (const bf16_t*)(ws + OFF_P); char* G = ws + OFF_G; float* EGL = (float*)(ws + OFF_EGL);
  const int nrounds = (3072 + 2 * nblk - 1) / (2 * nblk);
  for (int rd = 0; rd < nrounds; ++rd) {
    int tl = threadIdx.x; asm volatile("" : "+v"(tl));
    const int tid = tl, hb = tid >> 8, ht = tid & 255, lane = tid & 63, r32 = lane & 31, hi = lane >> 5;
    const int hw = __builtin_amdgcn_readfirstlane(ht >> 6);
    LAS char* L = lds + hb * HALF_LDS;
    LAS float* sBeta = (LAS float*)(L + REC_A); LAS float* sGc = sBeta + 64; LAS float* sEgc = sGc + 64; LAS float* sRnK = sEgc + 64; LAS float* sRnQ = sRnK + 64;
    LAS char* sQ = L; LAS char* sK = L + 17408;
    LAS float* Amat = (LAS float*)(L + RA_W);
    const int u0 = (rd * nblk + bid) * 2 + hb; const bool valid = u0 < 3072; const int u = valid ? u0 : 0;
    const int bh = u >> 6, n = u & 63, b = bh / 6, h = bh % 6; const size_t row0 = (size_t)b * SEQ + (size_t)n * 64;
    char* rec = G + (size_t)u * REC;
    __syncthreads();
    if (hw == 0) {
      const bf16_t* pr = P + (row0 + lane) * LDP + PC_BA;
      const float braw = bf2f(pr[h]), araw = bf2f(pr[6 + h]);
      const float beta = sigmoidf_(braw), g = -__expf(p.a_log[h]) * softplusf_(araw + p.a_dt_bias[h]);
      float s = g;
#pragma unroll
      for (int o = 1; o < 64; o <<= 1) { const float t = __shfl_up(s, o); if (lane >= o) s += t; }
      sBeta[lane] = beta; sGc[lane] = s; sEgc[lane] = __expf(s);
    }
    float x[64], xq[64];
    {
      const int c = ht & 127; const bool isk = ht >= 128;
      {
        const int col = (isk ? PC_K : PC_V) + h * 128 + c, ch = (isk ? 768 : 1536) + h * 128 + c;
        const float w0 = p.a_conv[ch], w1 = p.a_conv[2304 + ch], w2 = p.a_conv[2 * 2304 + ch], w3 = p.a_conv[3 * 2304 + ch];
        const bf16_t* src = P + row0 * LDP + col;
        float r0 = 0.f, r1 = 0.f, r2 = 0.f;
        if (n > 0) { r0 = bf2f(src[-3 * LDP]); r1 = bf2f(src[-2 * LDP]); r2 = bf2f(src[-LDP]); }
        const bf16_t* sp = src;
#pragma unroll
        for (int i = 0; i < 64; ++i) { const float r3 = bf2f(*sp); sp += LDP; asm volatile("" : "+v"(sp)); x[i] = siluf_(w0 * r0 + w1 * r1 + w2 * r2 + w3 * r3); r0 = r1; r1 = r2; r2 = r3; if ((i & 7) == 7) asm volatile("" ::: "memory"); }
      }
      if (!isk) {
        const int col = PC_Q + h * 128 + c, ch = h * 128 + c;
        const float w0 = p.a_conv[ch], w1 = p.a_conv[2304 + ch], w2 = p.a_conv[2 * 2304 + ch], w3 = p.a_conv[3 * 2304 + ch];
        const bf16_t* src = P + row0 * LDP + col;
        float r0 = 0.f, r1 = 0.f, r2 = 0.f;
        if (n > 0) { r0 = bf2f(src[-3 * LDP]); r1 = bf2f(src[-2 * LDP]); r2 = bf2f(src[-LDP]); }
        const bf16_t* sp = src;
#pragma unroll
        for (int i = 0; i < 64; ++i) { const float r3 = bf2f(*sp); sp += LDP; asm volatile("" : "+v"(sp)); xq[i] = siluf_(w0 * r0 + w1 * r1 + w2 * r2 + w3 * r3); r0 = r1; r1 = r2; r2 = r3; if ((i & 7) == 7) asm volatile("" ::: "memory"); }
#pragma unroll
        for (int i = 0; i < 64; ++i) *(LAS bf16_t*)(sQ + i * 272 + c * 2) = f2bf(xq[i]);
      } else {
#pragma unroll
        for (int i = 0; i < 64; ++i) { xq[i] = x[i]; *(LAS bf16_t*)(sK + i * 272 + c * 2) = f2bf(x[i]); }
      }
    }
    __syncthreads();
    const int it = hw >> 1, jt = hw & 1;
    f32x16 akk = f32x16{}, aqk = f32x16{};
    if (hw != 1) {
#pragma unroll
      for (int ks = 0; ks < 8; ++ks) {
        const bf16x8 ak = *(LAS const bf16x8*)(sK + (32 * it + r32) * 272 + ks * 32 + hi * 16), aq = *(LAS const bf16x8*)(sQ + (32 * it + r32) * 272 + ks * 32 + hi * 16);
        const bf16x8 bk = *(LAS const bf16x8*)(sK + (32 * jt + r32) * 272 + ks * 32 + hi * 16);
        akk = __builtin_amdgcn_mfma_f32_32x32x16_bf16(ak, bk, akk, 0, 0, 0); aqk = __builtin_amdgcn_mfma_f32_32x32x16_bf16(aq, bk, aqk, 0, 0, 0);
      }
    } else {
#pragma unroll
      for (int ks = 0; ks < 8; ++ks) {
        const bf16x8 a0 = *(LAS const bf16x8*)(sQ + r32 * 272 + ks * 32 + hi * 16), a1 = *(LAS const bf16x8*)(sQ + (32 + r32) * 272 + ks * 32 + hi * 16);
        akk = __builtin_amdgcn_mfma_f32_32x32x16_bf16(a0, a0, akk, 0, 0, 0); aqk = __builtin_amdgcn_mfma_f32_32x32x16_bf16(a1, a1, aqk, 0, 0, 0);
      }
    }
    {
      float d0 = 0.f, d1 = 0.f;
#pragma unroll
      for (int r = 0; r < 16; ++r) if (crow(r, hi) == r32) { d0 = akk[r]; d1 = aqk[r]; }
      const bool has = ((r32 >> 2) & 1) == hi;
      if (has && hw == 0) sRnK[r32] = rsqrtf(d0 + EPS);
      if (has && hw == 3) sRnK[32 + r32] = rsqrtf(d0 + EPS);
      if (has && hw == 1) { sRnQ[r32] = rsqrtf(d0 + EPS) * QSCALE; sRnQ[32 + r32] = rsqrtf(d1 + EPS) * QSCALE; }
    }
    __syncthreads();
    if (hw != 1) {
      const int j = 32 * jt + r32; const float rnkj = sRnK[j], gcj = sGc[j];
      const int ksj = 2 * jt + (r32 >> 4), jo = r32 & 15, hip = (jo >> 2) & 1, jp = (jo & 3) + 4 * (jo >> 3);
      LAS char* attf = L + RA_ATT + (it ? 2 + ksj : ksj) * 1024 + hip * 512 + jp * 2;
#pragma unroll
      for (int r = 0; r < 16; ++r) {
        const int il = crow(r, hi), i = 32 * it + il;
        const float dec = __expf(fminf(sGc[i] - gcj, 0.f));
        const float aval = (i > j) ? sBeta[i] * sRnK[i] * rnkj * akk[r] * dec : 0.f;
        const float tval = (i >= j) ? sRnQ[i] * rnkj * aqk[r] * dec : 0.f;
        Amat[i * 64 + j] = aval;
        *(LAS bf16_t*)(attf + il * 16) = f2bf(tval);
        if ((r & 3) == 3) asm volatile("" ::: "memory");
      }
    }
    __syncthreads();
    if (ht < 128) {
      const int c = ht;
      const int co = c & 15, hip = (co >> 2) & 1, jp = (co & 3) + 4 * (co >> 3);
      LAS char* qgf = L + RA_QG + (c >> 4) * 1024 + hip * 512 + jp * 2;
#pragma unroll
      for (int i = 0; i < 64; ++i) { *(LAS bf16_t*)(qgf + (i >> 5) * 8192 + (i & 31) * 16) = f2bf(xq[i] * sRnQ[i] * sEgc[i]); x[i] *= sBeta[i]; if ((i & 7) == 7) asm volatile("" ::: "memory"); }
    } else {
      const int c = ht - 128;
      const float gl = sGc[63];
      LAS char* ktf = L + RA_KT + (c >> 5) * 4096 + (c & 31) * 16;
#pragma unroll
      for (int ks = 0; ks < 4; ++ks)
#pragma unroll
        for (int hp = 0; hp < 2; ++hp) {
          float v[8];
#pragma unroll
          for (int jq = 0; jq < 8; ++jq) { const int i = 16 * ks + (jq & 3) + 8 * (jq >> 2) + 4 * hp; v[jq] = xq[i] * sRnK[i] * __expf(gl - sGc[i]); }
          u32x4 w; w.x = cvt_pk_bf16(v[0], v[1]); w.y = cvt_pk_bf16(v[2], v[3]); w.z = cvt_pk_bf16(v[4], v[5]); w.w = cvt_pk_bf16(v[6], v[7]);
          *(LAS u32x4*)(ktf + ks * 1024 + hp * 512) = w;
          asm volatile("" ::: "memory");
        }
#pragma unroll
      for (int i = 0; i < 64; ++i) { x[i] *= sBeta[i] * sEgc[i] * sRnK[i]; if ((i & 7) == 7) asm volatile("" ::: "memory"); }
    }
    asm volatile("" ::: "memory");
#pragma unroll
    for (int i = 1; i < 64; ++i) {
      float acc = x[i];
#pragma unroll
      for (int j4 = 0; j4 < (i + 3) / 4; ++j4) {
        const f32x4 a = *(LAS const f32x4*)(Amat + i * 64 + j4 * 4);
        acc -= a[0] * x[4 * j4]; acc -= a[1] * x[4 * j4 + 1]; acc -= a[2] * x[4 * j4 + 2]; acc -= a[3] * x[4 * j4 + 3];
      }
      x[i] = acc;
      if ((i & 3) == 3) asm volatile("" ::: "memory");
    }
    __syncthreads();
    if (ht < 128) {
      const int c = ht;
      if (valid) {
        char* ud = rec + REC_A + c * 128;
#pragma unroll
        for (int q = 0; q < 8; ++q) {
          const int ib = 32 * (q >> 2) + 4 * ((q >> 1) & 1) + 16 * (q & 1);
          u32x4 w; w.x = cvt_pk_bf16(x[ib], x[ib + 1]); w.y = cvt_pk_bf16(x[ib + 2], x[ib + 3]); w.z = cvt_pk_bf16(x[ib + 8], x[ib + 9]); w.w = cvt_pk_bf16(x[ib + 10], x[ib + 11]);
          *(u32x4*)(ud + q * 16) = w;
        }
      }
    } else {
      const int c = ht - 128;
      const int co = c & 15, hip = (co >> 2) & 1, jp = (co & 3) + 4 * (co >> 3);
      LAS char* wf = L + RA_W + (c >> 4) * 1024 + hip * 512 + jp * 2;
#pragma unroll
      for (int i = 0; i < 64; ++i) *(LAS bf16_t*)(wf + (i >> 5) * 8192 + (i & 31) * 16) = f2bf(-x[i]);
    }
    if (ht == 0 && valid) EGL[u] = __expf(sGc[63]);
    __syncthreads();
    if (valid) for (int o = ht * 16; o < REC_A; o += 4096) *(u32x4*)(rec + o) = *(LAS const u32x4*)(L + o);
  }
}

__device__ __forceinline__ void phase_gdn_scan(const Params& p, LAS char* lds, int bid, int nblk) {
  using namespace gdn;
  char* ws = p.ws; bf16_t* P = (bf16_t*)(ws + OFF_P); const char* G = ws + OFF_G; const float* EGL = (const float*)(ws + OFF_EGL);
  const int tid = threadIdx.x, lane = tid & 63, r32 = lane & 31, hi = lane >> 5; const int wid = __builtin_amdgcn_readfirstlane(tid >> 6);
  LAS char* OX = lds + 2 * REC_A;
  for (int u = bid; u < NBATCH * 6; u += nblk) {
    const int b = u / 6, h = u % 6; const size_t rowb = (size_t)b * SEQ; const char* recb = G + (size_t)u * 64 * REC;
    __syncthreads();
    if (wid >= 4) {
      const int j = wid - 4;
      for (int f = j; f < 54; f += 4) __builtin_amdgcn_global_load_lds((const unsigned*)(recb + f * 1024 + lane * 16), (LAS unsigned*)(lds + f * 1024), 16, 0, 0);
      float gn[32];
#pragma unroll
      for (int q = 0; q < 8; ++q) { const f32x4 g = *(const f32x4*)(p.a_out_gain + (lane & 3) * 32 + q * 4); gn[4 * q] = g[0]; gn[4 * q + 1] = g[1]; gn[4 * q + 2] = g[2]; gn[4 * q + 3] = g[3]; }
      for (int c = 0; c <= 64; ++c) {
        asm volatile("s_waitcnt vmcnt(0) lgkmcnt(0)\n\ts_barrier" ::: "memory");
        if (c + 1 < 64) { const char* rn = recb + (size_t)(c + 1) * REC; LAS char* dst = lds + ((c + 1) & 1) * REC_A;
          for (int f = j; f < 54; f += 4) __builtin_amdgcn_global_load_lds((const unsigned*)(rn + f * 1024 + lane * 16), (LAS unsigned*)(dst + f * 1024), 16, 0, 0); }
        if (c >= 1) {
          const int cc = c - 1, row = 16 * j + (lane >> 2), cg = (lane & 3) * 32; const size_t t = rowb + (size_t)cc * 64 + row;
          LAS const char* op = OX + (cc & 1) * 16384 + row * 256 + cg * 2;
          const bf16_t* gp = P + t * LDP + PC_GATE + h * 128 + cg;
          float ov[32]; float ss = 0.f;
#pragma unroll
          for (int q = 0; q < 4; ++q) { const u32x4 r = *(LAS const u32x4*)(op + q * 16);
            ov[8 * q] = bflo(r.x); ov[8 * q + 1] = bfhi(r.x); ov[8 * q + 2] = bflo(r.y); ov[8 * q + 3] = bfhi(r.y); ov[8 * q + 4] = bflo(r.z); ov[8 * q + 5] = bfhi(r.z); ov[8 * q + 6] = bflo(r.w); ov[8 * q + 7] = bfhi(r.w); }
#pragma unroll
          for (int q = 0; q < 32; ++q) ss += ov[q] * ov[q];
          ss += __shfl_xor(ss, 1); ss += __shfl_xor(ss, 2);
          const float sc = rsqrtf(ss * (1.f / 128.f) + EPS);
          bf16_t* dp = P + t * LDP + PC_Q + h * 128 + cg;
#pragma unroll
          for (int q = 0; q < 4; ++q) { const u32x4 gr = *(const u32x4*)(gp + q * 8); u32x4 w;
            w.x = cvt_pk_bf16(ov[8 * q] * sc * gn[8 * q] * siluf_(bflo(gr.x)), ov[8 * q + 1] * sc * gn[8 * q + 1] * siluf_(bfhi(gr.x)));
            w.y = cvt_pk_bf16(ov[8 * q + 2] * sc * gn[8 * q + 2] * siluf_(bflo(gr.y)), ov[8 * q + 3] * sc * gn[8 * q + 3] * siluf_(bfhi(gr.y)));
            w.z = cvt_pk_bf16(ov[8 * q + 4] * sc * gn[8 * q + 4] * siluf_(bflo(gr.z)), ov[8 * q + 5] * sc * gn[8 * q + 5] * siluf_(bfhi(gr.z)));
            w.w = cvt_pk_bf16(ov[8 * q + 6] * sc * gn[8 * q + 6] * siluf_(bflo(gr.w)), ov[8 * q + 7] * sc * gn[8 * q + 7] * siluf_(bfhi(gr.w)));
            *(u32x4*)(dp + q * 8) = w; }
        }
      }
    } else {
      const int vs = wid;
      f32x16 S[4];
#pragma unroll
      for (int k = 0; k < 4; ++k) S[k] = f32x16{};
      const char* ub = recb + REC_A + (vs * 32 + r32) * 128 + hi * 32;
      u32x4 un[4];
#pragma unroll
      for (int q = 0; q < 4; ++q) un[q] = *(const u32x4*)(ub + (q >> 1) * 64 + (q & 1) * 16);
      for (int c = 0; c <= 64; ++c) {
        asm volatile("s_waitcnt lgkmcnt(0)\n\ts_barrier" ::: "memory");
        if (c < 64) {
          LAS const char* R = lds + (c & 1) * REC_A + lane * 16;
          const float egl = EGL[u * 64 + c];
          u32x4 uc[4];
#pragma unroll
          for (int q = 0; q < 4; ++q) uc[q] = un[q];
          if (c + 1 < 64) {
#pragma unroll
            for (int q = 0; q < 4; ++q) un[q] = *(const u32x4*)(ub + (size_t)(c + 1) * REC + (q >> 1) * 64 + (q & 1) * 16);
          }
          bf16x8 Sb[8];
#pragma unroll
          for (int ks = 0; ks < 8; ++ks) { const int kt = ks >> 1, o = (ks & 1) * 8; u32x4 w;
            w.x = cvt_pk_bf16(S[kt][o], S[kt][o + 1]); w.y = cvt_pk_bf16(S[kt][o + 2], S[kt][o + 3]); w.z = cvt_pk_bf16(S[kt][o + 4], S[kt][o + 5]); w.w = cvt_pk_bf16(S[kt][o + 6], S[kt][o + 7]);
            Sb[ks] = __builtin_bit_cast(bf16x8, w); }
          f32x16 vn[2];
#pragma unroll
          for (int t2 = 0; t2 < 2; ++t2) {
#pragma unroll
            for (int q = 0; q < 2; ++q) { const u32x4 r = uc[2 * t2 + q];
              vn[t2][8 * q] = bflo(r.x); vn[t2][8 * q + 1] = bfhi(r.x); vn[t2][8 * q + 2] = bflo(r.y); vn[t2][8 * q + 3] = bfhi(r.y); vn[t2][8 * q + 4] = bflo(r.z); vn[t2][8 * q + 5] = bfhi(r.z); vn[t2][8 * q + 6] = bflo(r.w); vn[t2][8 * q + 7] = bfhi(r.w); }
#pragma unroll
            for (int ks = 0; ks < 8; ++ks) vn[t2] = __builtin_amdgcn_mfma_f32_32x32x16_bf16(*(LAS const bf16x8*)(R + RA_W + (t2 * 8 + ks) * 1024), Sb[ks], vn[t2], 0, 0, 0);
          }
          bf16x8 vb[4];
#pragma unroll
          for (int ks = 0; ks < 4; ++ks) { const int t2 = ks >> 1, o = (ks & 1) * 8; u32x4 w;
            w.x = cvt_pk_bf16(vn[t2][o], vn[t2][o + 1]); w.y = cvt_pk_bf16(vn[t2][o + 2], vn[t2][o + 3]); w.z = cvt_pk_bf16(vn[t2][o + 4], vn[t2][o + 5]); w.w = cvt_pk_bf16(vn[t2][o + 6], vn[t2][o + 7]);
            vb[ks] = __builtin_bit_cast(bf16x8, w); }
          f32x16 oo[2];
#pragma unroll
          for (int t2 = 0; t2 < 2; ++t2) {
            oo[t2] = f32x16{};
#pragma unroll
            for (int ks = 0; ks < 8; ++ks) oo[t2] = __builtin_amdgcn_mfma_f32_32x32x16_bf16(*(LAS const bf16x8*)(R + RA_QG + (t2 * 8 + ks) * 1024), Sb[ks], oo[t2], 0, 0, 0);
          }
#pragma unroll
          for (int ks = 0; ks < 2; ++ks) oo[0] = __builtin_amdgcn_mfma_f32_32x32x16_bf16(*(LAS const bf16x8*)(R + RA_ATT + ks * 1024), vb[ks], oo[0], 0, 0, 0);
#pragma unroll
          for (int ks = 0; ks < 4; ++ks) oo[1] = __builtin_amdgcn_mfma_f32_32x32x16_bf16(*(LAS const bf16x8*)(R + RA_ATT + (2 + ks) * 1024), vb[ks], oo[1], 0, 0, 0);
#pragma unroll
          for (int kt = 0; kt < 4; ++kt) {
            S[kt] = S[kt] * egl;
#pragma unroll
            for (int ks = 0; ks < 4; ++ks) S[kt] = __builtin_amdgcn_mfma_f32_32x32x16_bf16(*(LAS const bf16x8*)(R + RA_KT + (kt * 4 + ks) * 1024), vb[ks], S[kt], 0, 0, 0);
          }
          LAS char* ox = OX + (c & 1) * 16384 + (vs * 32 + r32) * 2;
#pragma unroll
          for (int t2 = 0; t2 < 2; ++t2)
#pragma unroll
            for (int r = 0; r < 16; ++r) *(LAS bf16_t*)(ox + (32 * t2 + crow(r, hi)) * 256) = f2bf(oo[t2][r]);
        }
      }
    }
  }
}

constexpr int NPHASE = 15;
__global__ void __launch_bounds__(NTHR, 2) yoco_fwd(Params p, int lo, int hi) {
  extern __shared__ __attribute__((aligned(16))) char smem_raw[];
  LAS char* lds = (LAS char*)smem_raw;
  const int bid = blockIdx.x, nblk = gridDim.x;
  LAS unsigned* xbw = (LAS unsigned*)(lds + LDS_BYTES - 16);
  if (threadIdx.x == 0) { xbw[0] = 0u; xbw[1] = 0u; xbw[2] = 0u; xbw[3] = 0u; }
  __syncthreads();
  XcdBarrier bar; bar.bar = (unsigned*)(p.ws + OFF_CTRL); bar.x = 0; bar.st = (volatile LAS unsigned*)xbw;
  if (hi - lo > 1) bar = xcd_barrier_post((unsigned*)(p.ws + OFF_CTRL), (volatile LAS unsigned*)xbw);
#ifndef PROBE_DOUBLE
#define PROBE_DOUBLE -1
#endif
#define PH(k) if (lo <= (k) && (k) < hi)
#define SEAM(k) if (lo <= (k) && (k) + 1 < hi) xcd_barrier(bar)
  PH(0) phase_prep(p, bid, nblk);
#if PROBE_DOUBLE == 0
  PH(0) { __syncthreads(); phase_prep(p, bid, nblk); }
#endif
  SEAM(0);
  PH(1) phase_gemm_inA(p, lds, bid, nblk);
  SEAM(1);
  PH(2) phase_gdn_prep(p, lds, bid, nblk);
#if PROBE_DOUBLE == 20
  PH(2) phase_gdn_prep(p, lds, bid, nblk);
#endif
  SEAM(2);
  PH(2) { if (bid < 48) phase_gdn_scan(p, lds, bid, nblk); else phase_memattn(p, lds, bid - 48, nblk - 48, 0); }
#if PROBE_DOUBLE == 21
  PH(2) { if (bid < 48) phase_gdn_scan(p, lds, bid, nblk); }
#endif
  SEAM(2);
  PH(3) phase_gemm_out(p, lds, bid, nblk, 0);
  SEAM(3);
  PH(4) phase_norm_route(p, lds, bid, nblk, 0);
  SEAM(4);
  PH(5) phase_moe1(p, lds, bid, nblk, 0);
  SEAM(5);
  PH(6) phase_moe2(p, lds, bid, nblk, 0);
  SEAM(6);
  PH(7) phase_combine<false>(p, bid, nblk);
  SEAM(7);
  PH(8) phase_gemm_inB(p, lds, bid, nblk);
  SEAM(8);
  PH(9) { phase_sb_attn(p, lds, bid, nblk); phase_memattn(p, lds, bid, nblk, 1); }
#if PROBE_DOUBLE == 9
  PH(9) { phase_sb_attn(p, lds, bid, nblk); }
#endif
#if PROBE_DOUBLE == 91
  PH(9) { phase_memattn(p, lds, bid, nblk, 1); }
#endif
  SEAM(9);
  PH(10) phase_gemm_out(p, lds, bid, nblk, 1);
  SEAM(10);
  PH(11) phase_norm_route(p, lds, bid, nblk, 1);
  SEAM(11);
  PH(12) phase_moe1(p, lds, bid, nblk, 1);
  SEAM(12);
  PH(13) phase_moe2(p, lds, bid, nblk, 1);
  SEAM(13);
  PH(14) phase_combine<true>(p, bid, nblk);
#undef PH
#undef SEAM
}

#ifndef N_LAUNCH_SPLIT
#define N_LAUNCH_SPLIT 0
#endif

extern "C" void kernel_launch(void* const* d_in, const int* in_sizes, int n_in, void* d_out, int out_size, void* d_ws, size_t ws_size, hipStream_t stream) {
  (void)in_sizes; (void)n_in; (void)out_size;
  if (ws_size < WS_NEED) return;
  static int grid = 0;
  if (!grid) {
    if (hipFuncSetAttribute((const void*)yoco_fwd, hipFuncAttributeMaxDynamicSharedMemorySize, LDS_BYTES) != hipSuccess) { grid = -1; return; }
    int dev = 0, cus = 0; hipGetDevice(&dev); hipDeviceGetAttribute(&cus, hipDeviceAttributeMultiprocessorCount, dev);
    int per_cu = 0; hipOccupancyMaxActiveBlocksPerMultiprocessor(&per_cu, (const void*)yoco_fwd, NTHR, LDS_BYTES);
    grid = (per_cu >= 1) ? cus : -1;
  }
  if (grid <= 0) return;
  Params p{};
  const float** pf = (const float**)&p;
  for (int i = 0; i < 25; ++i) pf[i] = (const float*)d_in[i];
  p.out = (float*)d_out; p.ws = (char*)d_ws;
  hipMemsetAsync(d_ws, 0, 65536, stream);
#if N_LAUNCH_SPLIT
  for (int k = 0; k < NPHASE; ++k) hipLaunchKernelGGL(yoco_fwd, dim3(grid), dim3(NTHR), LDS_BYTES, stream, p, k, k + 1);
#else
  hipLaunchKernelGGL(yoco_fwd, dim3(grid), dim3(NTHR), LDS_BYTES, stream, p, 0, NPHASE);
#endif
}
```

```cpp
#include <hip/hip_runtime.h>
#include <stdint.h>
#include <stddef.h>

#define LAS __attribute__((address_space(3)))
typedef unsigned short bf16_t;
typedef short bf16x8 __attribute__((ext_vector_type(8)));
typedef float f32x4 __attribute__((ext_vector_type(4)));
typedef float f32x16 __attribute__((ext_vector_type(16)));
typedef unsigned u32x4 __attribute__((ext_vector_type(4)));
typedef unsigned u32x2 __attribute__((ext_vector_type(2)));

constexpr int NTOK = 32768, DM = 1024, SEQ = 4096, NBATCH = 8, MEMLEN = 256, NMEMROW = NBATCH * MEMLEN;
constexpr int LDP = 3392;
constexpr int PC_Q = 0, PC_MQ = 768, PC_K = 1024, PC_V = 1792, PC_GATE = 2560, PC_BA = 3328;
constexpr int NIN_A = 3584;
constexpr int NIN_B = 2560;
constexpr float EPS = 1e-6f;
constexpr float LOG2E = 1.4426950408889634f;
constexpr int NTHR = 512;

constexpr size_t OFF_CTRL  = 0;
constexpr size_t OFF_RSTD  = 65536;
constexpr size_t OFF_MRSTD = OFF_RSTD + (size_t)NTOK * 4;
constexpr size_t OFF_CW    = OFF_MRSTD + 8192;
constexpr size_t OFF_LIST  = OFF_CW + 65536 * 4;
constexpr size_t OFF_MEMKV = OFF_LIST + (size_t)16 * NTOK * 4;
constexpr size_t OFF_WR    = OFF_MEMKV + (size_t)2 * 2048 * 512 * 2;
constexpr size_t OFF_EGL   = OFF_WR + (size_t)2 * 20 * 1024 * 4;
constexpr size_t OFF_W     = 8u << 20;
constexpr size_t W_AIN  = 0;
constexpr size_t W_AOUT = W_AIN + (size_t)NIN_A * 1024 * 2;
constexpr size_t W_BIN  = W_AOUT + (size_t)1024 * 1024 * 2;
constexpr size_t W_BOUT = W_BIN + (size_t)NIN_B * 1024 * 2;
constexpr size_t W_MEM  = W_BOUT + (size_t)1024 * 1024 * 2;
constexpr size_t W_13   = W_MEM + (size_t)2 * 512 * 1024 * 2;
constexpr size_t W_2    = W_13 + (size_t)32 * 512 * 1024 * 2;
constexpr size_t W_END  = W_2 + (size_t)32 * 1024 * 256 * 2;
constexpr size_t OFF_P  = OFF_W + W_END;
constexpr size_t OFF_G  = OFF_P + (size_t)NTOK * LDP * 2;
constexpr size_t G_MIX  = 0;
constexpr size_t G_HB   = (size_t)128 << 20;
constexpr size_t WS_NEED = OFF_G + ((size_t)216 << 20);
static_assert(OFF_EGL + 3072 * 4 <= OFF_W, "small region");
static_assert(WS_NEED <= ((size_t)512 << 20), "workspace");
constexpr int CTRL_CNT = 4096;

constexpr int LDS_BYTES = 147456;

struct Params {
  const float *x, *mem, *a_norm, *a_w_in, *a_conv, *a_log, *a_dt_bias, *a_out_gain, *a_w_out, *kv_norm, *w_kv,
      *b_norm, *b_w_in, *b_w_out, *mem_norm, *w_mem_kv, *ffn_norm, *w_group, *b_group, *w_router, *b_router,
      *w1, *w3, *w2, *final_norm;
  float* out; char* ws;
};

typedef float f32x2_t __attribute__((ext_vector_type(2))); typedef __bf16 bf16x2_t __attribute__((ext_vector_type(2)));
__device__ __forceinline__ unsigned cvt_pk_bf16(float lo, float hi) { const f32x2_t v = {lo, hi}; const bf16x2_t b = __builtin_convertvector(v, bf16x2_t); return __builtin_bit_cast(unsigned, b); }
__device__ __forceinline__ bf16_t f2bf(float f) { return (bf16_t)(cvt_pk_bf16(f, 0.f) & 0xffffu); }
__device__ __forceinline__ float bf2f(bf16_t b) { return __uint_as_float(((unsigned)b) << 16); }
__device__ __forceinline__ float bflo(unsigned u) { return __uint_as_float(u << 16); }
__device__ __forceinline__ float bfhi(unsigned u) { return __uint_as_float(u & 0xffff0000u); }
__device__ __forceinline__ float wave_sum(float v) {
#pragma unroll
  for (int o = 32; o >= 1; o >>= 1) v += __shfl_xor(v, o);
  return v;
}
__device__ __forceinline__ float sigmoidf_(float x) { return __builtin_amdgcn_rcpf(1.f + __expf(-x)); }
__device__ __forceinline__ float siluf_(float x) { return x * __builtin_amdgcn_rcpf(1.f + __expf(-x)); }
__device__ __forceinline__ float softplusf_(float x) { return fmaxf(x, 0.f) + log1pf(__expf(-fabsf(x))); }

#define XB_TMO      128
#define XB_XCNT(j)  (256  + 64 * (j))
#define XB_XSUB(j)  (1280 + 64 * (j))
#define XB_XGEN(j)  (2304 + 64 * (j))
#define XB_TOP      3328
#define XB_TOPGEN   3392
#define XCD_BAR_WORDS 3456
#define XB_SPIN_CAP (1u << 22)
__device__ __forceinline__ unsigned xb_ld(unsigned* p)              { return __hip_atomic_load(p, __ATOMIC_RELAXED, __HIP_MEMORY_SCOPE_AGENT); }
__device__ __forceinline__ unsigned xb_add(unsigned* p, unsigned v) { return __hip_atomic_fetch_add(p, v, __ATOMIC_RELAXED, __HIP_MEMORY_SCOPE_AGENT); }
__device__ __forceinline__ unsigned xb_xcc_id() { return (unsigned)__builtin_amdgcn_s_getreg((3 << 11) | 20) & 0xFu; }
#define XB_SPIN(cond, bar) do { unsigned _sp = 0; while (cond) { __builtin_amdgcn_s_sleep(1); \
    if ((++_sp & 255u) == 0u) { if (xb_ld(&(bar)[XB_TMO])) break; if (_sp > XB_SPIN_CAP) { atomicAdd(&(bar)[XB_TMO], 1u); break; } } } } while (0)
struct XcdBarrier { unsigned* bar; unsigned x; volatile LAS unsigned* st; };
__device__ __forceinline__ XcdBarrier xcd_barrier_post(unsigned* bar, volatile LAS unsigned* st) {
    XcdBarrier b; b.bar = bar; b.x = xb_xcc_id(); b.st = st;
    if (threadIdx.x == 0) (void)xb_add(&bar[XB_XCNT(b.x)], 1u);
    return b;
}
__device__ __forceinline__ void xcd_barrier_complete(unsigned* bar, unsigned x, unsigned& nloc, unsigned& nx) {
    const unsigned G = gridDim.x * gridDim.y * gridDim.z;
    unsigned sum, cnt, mine, sp = 0u;
    for (;;) {
        sum = 0u; cnt = 0u; mine = 0u;
#pragma unroll
        for (unsigned j = 0; j < 16; ++j) { const unsigned c = xb_ld(&bar[XB_XCNT(j)]); sum += c; cnt += (c > 0u) ? 1u : 0u; mine = (j == x) ? c : mine; }
        if (sum == G) break;
        __builtin_amdgcn_s_sleep(1);
        if ((++sp & 255u) == 0u) { if (xb_ld(&bar[XB_TMO])) break; if (sp > XB_SPIN_CAP) { atomicAdd(&bar[XB_TMO], 1u); break; } }
    }
    nloc = mine > 0u ? mine : 1u; nx = cnt > 0u ? cnt : 1u;
}
__device__ __forceinline__ void xcd_barrier(const XcdBarrier& b) {
    asm volatile("s_waitcnt vmcnt(0)" ::: "memory");
    __syncthreads();
    if (threadIdx.x == 0) {
        unsigned* bar = b.bar;
        __builtin_amdgcn_s_waitcnt(0);
        unsigned nloc = b.st[0], nx = b.st[1];
        if (nloc == 0u) { xcd_barrier_complete(bar, b.x, nloc, nx); b.st[0] = nloc; b.st[1] = nx; }
        const unsigned old = xb_add(&bar[XB_XSUB(b.x)], 1u);
        const unsigned gen = old / nloc;
        if (old + 1u == (gen + 1u) * nloc) {
            __builtin_amdgcn_fence(__ATOMIC_RELEASE, "agent");
            asm volatile("s_waitcnt vmcnt(0)" ::: "memory");
            const unsigned og = xb_add(&bar[XB_TOP], 1u);
            const unsigned tg = og / nx;
            if (og + 1u == (tg + 1u) * nx) xb_add(&bar[XB_TOPGEN], 1u);
            else XB_SPIN(xb_ld(&bar[XB_TOPGEN]) == tg, bar);
            __builtin_amdgcn_fence(__ATOMIC_ACQUIRE, "agent");
            xb_add(&bar[XB_XGEN(b.x)], 1u);
            asm volatile("s_waitcnt vmcnt(0)" ::: "memory");
        } else {
            XB_SPIN(xb_ld(&bar[XB_XGEN(b.x)]) == gen, bar);
            __builtin_amdgcn_fence(__ATOMIC_ACQUIRE, "agent");
            asm volatile("s_waitcnt vmcnt(0)" ::: "memory");
        }
    }
    __syncthreads();
}

__device__ __forceinline__ void cvt_rows(bf16_t* dst, int nrows_dst, int K, const float* src, int src_ld, int col0, int nrows_src,
                         const float* gain, float scale, int gtid, int gthreads) {
  const int items = nrows_dst * (K >> 3);
  for (int it = gtid; it < items; it += gthreads) {
    const int r = it % nrows_dst, k8 = it / nrows_dst;
    float v[8];
#pragma unroll
    for (int j = 0; j < 8; ++j) {
      const int k = k8 * 8 + j;
      v[j] = (r < nrows_src) ? src[(size_t)k * src_ld + col0 + r] * (gain ? gain[k] : 1.f) * scale : 0.f;
    }
    u32x4 w; w.x = cvt_pk_bf16(v[0], v[1]); w.y = cvt_pk_bf16(v[2], v[3]); w.z = cvt_pk_bf16(v[4], v[5]); w.w = cvt_pk_bf16(v[6], v[7]);
    *(u32x4*)(dst + (size_t)r * K + k8 * 8) = w;
  }
}

__device__ __forceinline__ void rows_to_bf16(const float* src, bf16_t* dst, float* rstd, int nrows, int gwave, int nwaves, int lane) {
  for (int r = gwave; r < nrows; r += nwaves) {
    const float* s = src + (size_t)r * DM; float ss = 0.f;
#pragma unroll
    for (int i = 0; i < 4; ++i) {
      const f32x4 v = *(const f32x4*)(s + i * 256 + lane * 4);
      ss += v[0] * v[0] + v[1] * v[1] + v[2] * v[2] + v[3] * v[3];
      u32x2 w; w.x = cvt_pk_bf16(v[0], v[1]); w.y = cvt_pk_bf16(v[2], v[3]);
      *(u32x2*)(dst + (size_t)r * DM + i * 256 + lane * 4) = w;
    }
    ss = wave_sum(ss);
    if (lane == 0) rstd[r] = rsqrtf(ss * (1.f / DM) + EPS);
  }
}

__device__ __forceinline__ void phase_prep(const Params& p, int bid, int nblk) {
  const int tid = threadIdx.x, gtid = bid * NTHR + tid, gthreads = nblk * NTHR, lane = tid & 63;
  char* ws = p.ws; bf16_t* W = (bf16_t*)(ws + OFF_W);
  bf16_t* wa = (bf16_t*)((char*)W + W_AIN);
  cvt_rows(wa + (size_t)PC_Q * 1024, 768, 1024, p.a_w_in, 3340, 0, 768, p.a_norm, 1.f, gtid, gthreads);
  cvt_rows(wa + (size_t)PC_MQ * 1024, 256, 1024, p.a_w_in, 3340, 3084, 256, p.a_norm, 0.125f * LOG2E, gtid, gthreads);
  cvt_rows(wa + (size_t)PC_K * 1024, 768, 1024, p.a_w_in, 3340, 768, 768, p.a_norm, 1.f, gtid, gthreads);
  cvt_rows(wa + (size_t)PC_V * 1024, 768, 1024, p.a_w_in, 3340, 1536, 768, p.a_norm, 1.f, gtid, gthreads);
  cvt_rows(wa + (size_t)PC_GATE * 1024, 768, 1024, p.a_w_in, 3340, 2304, 768, p.a_norm, 1.f, gtid, gthreads);
  cvt_rows(wa + (size_t)PC_BA * 1024, NIN_A - PC_BA, 1024, p.a_w_in, 3340, 3072, 12, p.a_norm, 1.f, gtid, gthreads);
  cvt_rows((bf16_t*)((char*)W + W_AOUT), 1024, 1024, p.a_w_out, 1024, 0, 1024, nullptr, 1.f, gtid, gthreads);
  bf16_t* wb = (bf16_t*)((char*)W + W_BIN);
  cvt_rows(wb + (size_t)PC_Q * 1024, 768, 1024, p.b_w_in, 1024, 0, 768, p.b_norm, 0.125f * LOG2E, gtid, gthreads);
  cvt_rows(wb + (size_t)PC_MQ * 1024, 256, 1024, p.b_w_in, 1024, 768, 256, p.b_norm, 0.125f * LOG2E, gtid, gthreads);
  cvt_rows(wb + (size_t)PC_K * 1024, 768, 1024, p.w_kv, 1536, 0, 768, p.kv_norm, 1.f, gtid, gthreads);
  cvt_rows(wb + (size_t)PC_V * 1024, 768, 1024, p.w_kv, 1536, 768, 768, p.kv_norm, 1.f, gtid, gthreads);
  cvt_rows((bf16_t*)((char*)W + W_BOUT), 1024, 1024, p.b_w_out, 1024, 0, 1024, nullptr, 1.f, gtid, gthreads);
  for (int l = 0; l < 2; ++l)
    cvt_rows((bf16_t*)((char*)W + W_MEM) + (size_t)l * 512 * 1024, 512, 1024, p.w_mem_kv + (size_t)l * 1024 * 512, 512, 0, 512, p.mem_norm + l * 1024, 1.f, gtid, gthreads);
  {
    bf16_t* w13 = (bf16_t*)((char*)W + W_13);
    const int items = 32 * 512 * 128;
    for (int it = gtid; it < items; it += gthreads) {
      const int le = it >> 16, rem = it & 65535, r = rem & 511, k8 = rem >> 9;
      const int u = r >> 8, which = (r >> 7) & 1, j = r & 127, l = le >> 4;
      const float* src = (which ? p.w3 : p.w1) + (size_t)le * 1024 * 256 + u * 128 + j;
      const float* g = p.ffn_norm + l * 1024;
      float v[8];
#pragma unroll
      for (int q = 0; q < 8; ++q) { const int k = k8 * 8 + q; v[q] = src[(size_t)k * 256] * g[k]; }
      u32x4 w; w.x = cvt_pk_bf16(v[0], v[1]); w.y = cvt_pk_bf16(v[2], v[3]); w.z = cvt_pk_bf16(v[4], v[5]); w.w = cvt_pk_bf16(v[6], v[7]);
      *(u32x4*)(w13 + ((size_t)le * 512 + r) * 1024 + k8 * 8) = w;
    }
    bf16_t* w2t = (bf16_t*)((char*)W + W_2);
    const int items2 = 32 * 1024 * 32;
    for (int it = gtid; it < items2; it += gthreads) {
      const int le = it >> 15, rem = it & 32767, n = rem & 1023, k8 = rem >> 10;
      const float* src = p.w2 + (size_t)le * 256 * 1024 + n;
      float v[8];
#pragma unroll
      for (int q = 0; q < 8; ++q) v[q] = src[(size_t)(k8 * 8 + q) * 1024];
      u32x4 w; w.x = cvt_pk_bf16(v[0], v[1]); w.y = cvt_pk_bf16(v[2], v[3]); w.z = cvt_pk_bf16(v[4], v[5]); w.w = cvt_pk_bf16(v[6], v[7]);
      *(u32x4*)(w2t + ((size_t)le * 1024 + n) * 256 + k8 * 8) = w;
    }
  }
  {
    float* wr = (float*)(ws + OFF_WR);
    for (int it = gtid; it < 2 * 20 * 1024; it += gthreads) {
      const int l = it / 20480, rem = it % 20480, j = rem >> 10, k = rem & 1023;
      const float w = (j < 4) ? p.w_group[((size_t)l * 1024 + k) * 4 + j] : p.w_router[((size_t)l * 1024 + k) * 16 + (j - 4)];
      wr[it] = w * p.ffn_norm[l * 1024 + k];
    }
  }
  const int gwave = gtid >> 6, nwaves = gthreads >> 6;
  rows_to_bf16(p.x, (bf16_t*)p.out, (float*)(ws + OFF_RSTD), NTOK, gwave, nwaves, lane);
  rows_to_bf16(p.mem, (bf16_t*)((char*)p.out + ((size_t)64 << 20)), (float*)(ws + OFF_MRSTD), NMEMROW, gwave, nwaves, lane);
}

namespace g8 {
constexpr int BM = 256, BK = 64, HALF = 128, HTB = HALF * BK * 2, STAGE_BYTES = 8 * HTB, NXCD = 8, WGM = 8;
__host__ __device__ __forceinline__ int lds_byte(int r, int c) { const int st = (r >> 4) * 2 + (c >> 5), rr = r & 15, cc = c & 31, ob = rr * 64 + cc * 2; return st * 1024 + (ob ^ (((ob >> 9) & 1) << 5)); }
__host__ __device__ __forceinline__ void stage_rc(int b, int& R, int& C) { const int st = b / 1024, sb = b % 1024, swz = sb ^ (((sb >> 9) & 1) << 5); R = (st >> 1) * 16 + swz / 64; C = (st & 1) * 32 + (swz % 64) / 2; }
__host__ __device__ __forceinline__ int perm32(int rho) { const int n = rho >> 4, i = rho & 15; return 8 * (i >> 2) + 4 * n + (i & 3); }

struct Unit { const char* A; const char* B; const int* list; int row0, nvalid, pm, pn, aux; };

struct DenseOrder {
  const char* A; const char* Bt; int K; int nM, nN, nwg, G, c;
  __device__ __forceinline__ void init(const void* A_, const void* Bt_, int K_, int M, int N, int G_, int c_) { A = (const char*)A_; Bt = (const char*)Bt_; K = K_; nM = M / BM; nN = N / BM; nwg = nM * nN; G = G_; c = c_; }
  __device__ __forceinline__ bool next(int i, Unit& u) const {
    const long L = (long)i * G + c; if (L >= nwg) return false;
    int wgid = (int)L; { const int q = nwg / NXCD, r = nwg % NXCD, xcd = wgid % NXCD, off = wgid / NXCD; wgid = (xcd < r ? xcd * (q + 1) : r * (q + 1) + (xcd - r) * q) + off; }
    const int nig = WGM * nN, gid = wgid / nig, fm = gid * WGM, gsz = (nM - fm) < WGM ? (nM - fm) : WGM;
    u.pm = fm + ((wgid % nig) % gsz); u.pn = (wgid % nig) / gsz;
    u.A = A; u.B = Bt + (size_t)u.pn * BM * K * 2; u.list = nullptr; u.row0 = u.pm * BM; u.nvalid = BM; u.aux = 0; return true;
  }
};

template <class Epi, class Sched, int SHIFT>
__device__ __forceinline__ void gemm_phase(LAS unsigned char* lds, const int K, const int lda, const Sched& S, const Epi& E) {
    const int tid = threadIdx.x, wid = __builtin_amdgcn_readfirstlane(tid >> 6), lane = tid & 63, wr = wid >> 2, wc = wid & 3, fr = lane & 15, fq = lane >> 4;
    const int nt = K / BK;
    int RA[2], CA[2]; unsigned voffB[2];
#pragma unroll
    for (int i = 0; i < 2; ++i) { int R, C; stage_rc(tid * 16 + i * 8192, R, C); const int Rb = Epi::PERM ? ((R & ~31) + perm32(R & 31)) : R;
        RA[i] = R; CA[i] = C; voffB[i] = (unsigned)(Rb * K + C) * 2u; }
    const size_t kstep = (size_t)(BK * 2);
    const size_t hstepB = (size_t)HALF * K * 2;
    const unsigned ldsw = (unsigned)wid * 1024u;
    const int aoff = lds_byte(wr * 64 + fr, fq * 8), boff = lds_byte(wc * 32 + fr, fq * 8);
#define G8_AOFF(dst, u) do { _Pragma("unroll") for (int _h = 0; _h < 2; ++_h) _Pragma("unroll") for (int _i = 0; _i < 2; ++_i) { const int _r = _h * HALF + RA[_i]; int _ar; \
        if ((u).list) { const int _rr = _r < (u).nvalid ? _r : 0; _ar = (u).list[(u).row0 + _rr] >> SHIFT; } else _ar = (u).row0 + _r; \
        dst[_h][_i] = (unsigned)(_ar * lda + CA[_i]) * 2u; } } while (0)
#define G8_SA(b, h) (((b) * 2 + (h)) * HTB)
#define G8_SB(b, h) ((4 + (b) * 2 + (h)) * HTB)
#define G8_STAGEA(bufoff, gbase, vo, kb) do { _Pragma("unroll") for (int _i = 0; _i < 2; ++_i) \
        __builtin_amdgcn_global_load_lds((const unsigned*)((gbase) + (size_t)((vo)[_i] + (unsigned)(kb))), (LAS unsigned*)(lds + (bufoff) + ldsw + _i * 8192), 16, 0, 0); } while (0)
#define G8_STAGEB(bufoff, gbase) do { _Pragma("unroll") for (int _i = 0; _i < 2; ++_i) \
        __builtin_amdgcn_global_load_lds((const unsigned*)((const char*)(gbase) + voffB[_i]), (LAS unsigned*)(lds + (bufoff) + ldsw + _i * 8192), 16, 0, 0); } while (0)
#define G8_LDA(dst, b, h) do { _Pragma("unroll") for (int m = 0; m < 4; ++m) _Pragma("unroll") for (int k = 0; k < 2; ++k) dst[m][k] = *(const LAS bf16x8*)(lds + G8_SA(b, h) + aoff + m * 2048 + k * 1024); } while (0)
#define G8_LDB(dst, b, h) do { _Pragma("unroll") for (int n = 0; n < 2; ++n) _Pragma("unroll") for (int k = 0; k < 2; ++k) dst[n][k] = *(const LAS bf16x8*)(lds + G8_SB(b, h) + boff + n * 2048 + k * 1024); } while (0)
#define G8_MMA(ai, bj, At, Bt) do { __builtin_amdgcn_s_setprio(1); _Pragma("unroll") for (int m = 0; m < 4; ++m) _Pragma("unroll") for (int n = 0; n < 2; ++n) _Pragma("unroll") for (int k = 0; k < 2; ++k) \
        acc[ai][bj][m][n] = __builtin_amdgcn_mfma_f32_16x16x32_bf16(Bt[n][k], At[m][k], acc[ai][bj][m][n], 0, 0, 0); __builtin_amdgcn_s_setprio(0); } while (0)
#define G8_WAIT_V(n) asm volatile("s_waitcnt vmcnt(" #n ")" ::: "memory")
#define G8_WAIT_L(n) asm volatile("s_waitcnt lgkmcnt(" #n ")" ::: "memory")
#define G8_BAR __builtin_amdgcn_s_barrier()
#define G8_SCHED __builtin_amdgcn_sched_barrier(0)
    Unit cur, nxt; int ui = 0;
    if (!S.next(0, cur)) return;
    f32x4 acc[2][2][4][2];
#pragma unroll
    for (int a = 0; a < 2; ++a)
#pragma unroll
        for (int b = 0; b < 2; ++b)
#pragma unroll
            for (int m = 0; m < 4; ++m)
#pragma unroll
                for (int n = 0; n < 2; ++n) acc[a][b][m][n] = (f32x4){0.f, 0.f, 0.f, 0.f};
    bf16x8 At[4][2], B0[2][2], B1[2][2];
    unsigned aoC[2][2], aoN[2][2];
    G8_AOFF(aoC, cur);
    const char* cA = cur.A; const char* cB = cur.B;
    G8_STAGEB(G8_SB(0, 0), cB); G8_STAGEB(G8_SB(0, 1), cB + hstepB); G8_STAGEA(G8_SA(0, 0), cA, aoC[0], 0); G8_STAGEA(G8_SA(0, 1), cA, aoC[1], 0);
    if (wr == 1) G8_BAR;
    G8_WAIT_V(2); G8_BAR;
    G8_STAGEB(G8_SB(1, 0), cB + kstep); G8_STAGEA(G8_SA(1, 0), cA, aoC[0], kstep); G8_STAGEB(G8_SB(1, 1), cB + hstepB + kstep);
    G8_WAIT_V(6); G8_BAR;
    for (;;) {
        const bool has_next = S.next(ui + 1, nxt);
        const char* nA = has_next ? nxt.A : cA; const char* nB = has_next ? nxt.B : cB;
        if (has_next) { G8_AOFF(aoN, nxt); } else {
#pragma unroll
            for (int h = 0; h < 2; ++h)
#pragma unroll
                for (int i = 0; i < 2; ++i) aoN[h][i] = aoC[h][i]; }
        for (int t = 0; t < nt; t += 2) {
            const bool last = (t == nt - 2);
            const unsigned k1 = (unsigned)((t + 1) * kstep);
            const char* a2b = last ? nA : cA; const unsigned k2 = last ? 0u : (unsigned)((t + 2) * kstep), k3 = k2 + (unsigned)kstep;
            const char* b2 = last ? nB : cB + (size_t)(t + 2) * kstep; const char* b3 = b2 + kstep;
            unsigned ao2[2][2];
#pragma unroll
            for (int h = 0; h < 2; ++h)
#pragma unroll
                for (int i = 0; i < 2; ++i) ao2[h][i] = last ? aoN[h][i] : aoC[h][i];
            G8_LDB(B0, 0, 0); G8_LDB(B1, 0, 1); G8_SCHED; G8_LDA(At, 0, 0); G8_STAGEA(G8_SA(1, 1), cA, aoC[1], k1);
            G8_WAIT_V(8); G8_WAIT_L(0); G8_BAR; G8_MMA(0, 0, At, B0); G8_MMA(0, 1, At, B1); G8_BAR; G8_SCHED;
            G8_LDA(At, 0, 1); G8_STAGEB(G8_SB(0, 0), b2); G8_STAGEB(G8_SB(0, 1), b2 + hstepB); G8_STAGEA(G8_SA(0, 0), a2b, ao2[0], k2);
            G8_WAIT_V(8); G8_WAIT_L(0); G8_BAR; G8_MMA(1, 0, At, B0); G8_MMA(1, 1, At, B1); G8_BAR; G8_SCHED;
            G8_LDB(B0, 1, 0); G8_LDB(B1, 1, 1); G8_SCHED; G8_LDA(At, 1, 0); G8_STAGEA(G8_SA(0, 1), a2b, ao2[1], k2);
            G8_WAIT_V(8); G8_WAIT_L(0); G8_BAR; G8_MMA(0, 0, At, B0); G8_MMA(0, 1, At, B1); G8_BAR; G8_SCHED;
            G8_LDA(At, 1, 1); G8_STAGEB(G8_SB(1, 0), b3); G8_STAGEB(G8_SB(1, 1), b3 + hstepB); G8_STAGEA(G8_SA(1, 0), a2b, ao2[0], k3);
            G8_WAIT_V(8); G8_WAIT_L(0); G8_BAR; G8_MMA(1, 0, At, B0); G8_MMA(1, 1, At, B1); G8_BAR; G8_SCHED;
        }
        if (wr == 0) G8_BAR;
        E(acc, cur, wr, wc, fr, fq);
        if (!has_next) break;
#pragma unroll
        for (int a = 0; a < 2; ++a)
#pragma unroll
            for (int b = 0; b < 2; ++b)
#pragma unroll
                for (int m = 0; m < 4; ++m)
#pragma unroll
                    for (int n = 0; n < 2; ++n) acc[a][b][m][n] = (f32x4){0.f, 0.f, 0.f, 0.f};
        cur = nxt; cA = nA; cB = nB; ++ui;
#pragma unroll
        for (int h = 0; h < 2; ++h)
#pragma unroll
            for (int i = 0; i < 2; ++i) aoC[h][i] = aoN[h][i];
        if (wr == 1) G8_BAR;
    }
    G8_WAIT_V(0);
    G8_BAR;
#undef G8_AOFF
#undef G8_SA
#undef G8_SB
#undef G8_STAGEA
#undef G8_STAGEB
#undef G8_LDA
#undef G8_LDB
#undef G8_MMA
#undef G8_WAIT_V
#undef G8_WAIT_L
#undef G8_BAR
#undef G8_SCHED
}

struct EpiScaleBf16 {
  static constexpr bool PERM = true;
  bf16_t* C; int ldc; const float* rowscale; int ncol_store;
  __device__ __forceinline__ void operator()(const f32x4 (&acc)[2][2][4][2], const Unit& u, int wr, int wc, int fr, int fq) const {
    const int row0 = u.pm * BM + wr * 64 + fr, col0 = u.pn * BM + wc * 32 + 8 * fq;
#pragma unroll
    for (int ai = 0; ai < 2; ++ai)
#pragma unroll
      for (int m = 0; m < 4; ++m) { const int row = row0 + ai * HALF + m * 16; const float sc = rowscale[row]; bf16_t* rowp = C + (size_t)row * ldc + col0;
#pragma unroll
        for (int bj = 0; bj < 2; ++bj) { const f32x4 v0 = acc[ai][bj][m][0] * sc, v1 = acc[ai][bj][m][1] * sc;
          u32x4 w; w.x = cvt_pk_bf16(v0[0], v0[1]); w.y = cvt_pk_bf16(v0[2], v0[3]); w.z = cvt_pk_bf16(v1[0], v1[1]); w.w = cvt_pk_bf16(v1[2], v1[3]);
          if (col0 + bj * HALF < ncol_store) *(u32x4*)(rowp + bj * HALF) = w; } }
  }
};
struct EpiMem {
  static constexpr bool PERM = true; bf16_t* C; const float* rs;
  __device__ __forceinline__ void operator()(const f32x4 (&acc)[2][2][4][2], const Unit& u, int wr, int wc, int fr, int fq) const {
    const int l = u.pn >> 1; Unit v = u; v.pn = u.pn & 1;
    EpiScaleBf16 e{C + (size_t)l * 2048 * 512, 512, rs, 512}; e(acc, v, wr, wc, fr, fq); }
};
struct EpiResidF32 {
  static constexpr bool PERM = false;
  float* out; const float* resid;
  __device__ __forceinline__ void operator()(const f32x4 (&acc)[2][2][4][2], const Unit& u, int wr, int wc, int fr, int fq) const {
    const int row0 = u.pm * BM + wr * 64 + fr, col0 = u.pn * BM + wc * 32 + 4 * fq;
#pragma unroll
    for (int ai = 0; ai < 2; ++ai)
#pragma unroll
      for (int m = 0; m < 4; ++m) { const size_t base = (size_t)(row0 + ai * HALF + m * 16) * DM + col0;
#pragma unroll
        for (int bj = 0; bj < 2; ++bj)
#pragma unroll
          for (int n = 0; n < 2; ++n) { const size_t o = base + bj * HALF + n * 16; const f32x4 rv = *(const f32x4*)(resid + o); *(f32x4*)(out + o) = rv + acc[ai][bj][m][n]; } }
  }
};
struct EpiMoe1 {
  static constexpr bool PERM = true;
  bf16_t* hid; const float* rstd;
  __device__ __forceinline__ void operator()(const f32x4 (&acc)[2][2][4][2], const Unit& u, int wr, int wc, int fr, int fq) const {
#pragma unroll
    for (int ai = 0; ai < 2; ++ai)
#pragma unroll
      for (int m = 0; m < 4; ++m) { const int r = ai * HALF + wr * 64 + m * 16 + fr;
        if (r < u.nvalid) { const int slot = u.list[u.row0 + r]; const float rs = rstd[slot >> 1];
          float h[8];
#pragma unroll
          for (int n = 0; n < 2; ++n)
#pragma unroll
            for (int j = 0; j < 4; ++j) { const float a = acc[ai][0][m][n][j] * rs, b = acc[ai][1][m][n][j] * rs; h[4 * n + j] = siluf_(a) * b; }
          u32x4 w; w.x = cvt_pk_bf16(h[0], h[1]); w.y = cvt_pk_bf16(h[2], h[3]); w.z = cvt_pk_bf16(h[4], h[5]); w.w = cvt_pk_bf16(h[6], h[7]);
          *(u32x4*)(hid + (size_t)slot * 256 + u.pn * 128 + wc * 32 + 8 * fq) = w; } }
  }
};
struct EpiMoe2 {
  static constexpr bool PERM = true;
  bf16_t* y; const float* cw;
  __device__ __forceinline__ void operator()(const f32x4 (&acc)[2][2][4][2], const Unit& u, int wr, int wc, int fr, int fq) const {
#pragma unroll
    for (int ai = 0; ai < 2; ++ai)
#pragma unroll
      for (int m = 0; m < 4; ++m) { const int r = ai * HALF + wr * 64 + m * 16 + fr;
        if (r < u.nvalid) { const int slot = u.list[u.row0 + r]; const float c = cw[slot];
          bf16_t* yp = y + (size_t)slot * DM + u.pn * BM + wc * 32 + 8 * fq;
#pragma unroll
          for (int bj = 0; bj < 2; ++bj) { const f32x4 v0 = acc[ai][bj][m][0] * c, v1 = acc[ai][bj][m][1] * c;
            u32x4 w; w.x = cvt_pk_bf16(v0[0], v0[1]); w.y = cvt_pk_bf16(v0[2], v0[3]); w.z = cvt_pk_bf16(v1[0], v1[1]); w.w = cvt_pk_bf16(v1[2], v1[3]);
            *(u32x4*)(yp + bj * HALF) = w; } } }
  }
};

template <int NPN>
struct MoeOrder {
  const char* A; const char* Wt; const int* lists; int cn[16]; int G, c; size_t wstride_e, wstride_pn;
  __device__ __forceinline__ bool next(int i, Unit& u) const {
    int L = i * G + c; bool found = false;
#pragma unroll
    for (int e = 0; e < 16; ++e) { const int nu = ((cn[e] + 255) >> 8) * NPN;
      if (!found) { if (L < nu) { found = true; const int tile = L / NPN, pn = L % NPN; u.pm = tile; u.pn = pn; u.aux = e; u.A = A; u.B = Wt + (size_t)e * wstride_e + (size_t)pn * wstride_pn;
          u.list = lists + (size_t)e * NTOK; u.row0 = tile * 256; u.nvalid = (cn[e] - tile * 256) < 256 ? (cn[e] - tile * 256) : 256; } else L -= nu; } }
    return found;
  }
};
}

__device__ __forceinline__ void phase_gemm_inA(const Params& p, LAS char* lds, int bid, int nblk) {
  char* ws = p.ws;
  const bf16_t* hb = (const bf16_t*)p.out; const bf16_t* memb = (const bf16_t*)((char*)p.out + ((size_t)64 << 20));
  const bf16_t* wa = (const bf16_t*)(ws + OFF_W + W_AIN); const bf16_t* wm = (const bf16_t*)(ws + OFF_W + W_MEM);
  { g8::DenseOrder S; S.init(hb, wa, 1024, NTOK, NIN_A, nblk, bid);
    g8::EpiScaleBf16 E{(bf16_t*)(ws + OFF_P), LDP, (const float*)(ws + OFF_RSTD), LDP};
    g8::gemm_phase<g8::EpiScaleBf16, g8::DenseOrder, 0>((LAS unsigned char*)lds, 1024, DM, S, E); }
  { g8::DenseOrder S; S.init(memb, wm, 1024, NMEMROW, 1024, nblk, bid);
    g8::EpiMem E{(bf16_t*)(ws + OFF_MEMKV), (const float*)(ws + OFF_MRSTD)};
    g8::gemm_phase<g8::EpiMem, g8::DenseOrder, 0>((LAS unsigned char*)lds, 1024, DM, S, E); }
}
__device__ __forceinline__ void phase_gemm_inB(const Params& p, LAS char* lds, int bid, int nblk) {
  char* ws = p.ws;
  g8::DenseOrder S; S.init(ws + OFF_G + G_HB, ws + OFF_W + W_BIN, 1024, NTOK, NIN_B, nblk, bid);
  g8::EpiScaleBf16 E{(bf16_t*)(ws + OFF_P), LDP, (const float*)(ws + OFF_RSTD), LDP};
  g8::gemm_phase<g8::EpiScaleBf16, g8::DenseOrder, 0>((LAS unsigned char*)lds, 1024, DM, S, E);
}
__device__ __forceinline__ void phase_gemm_out(const Params& p, LAS char* lds, int bid, int nblk, int layer) {
  char* ws = p.ws;
  g8::DenseOrder S; S.init(ws + OFF_P, ws + OFF_W + (layer ? W_BOUT : W_AOUT), 1024, NTOK, 1024, nblk, bid);
  g8::EpiResidF32 E{p.out, layer ? (const float*)p.out : p.x};
  g8::gemm_phase<g8::EpiResidF32, g8::DenseOrder, 0>((LAS unsigned char*)lds, 1024, LDP, S, E);
}
__device__ __forceinline__ void phase_moe1(const Params& p, LAS char* lds, int bid, int nblk, int layer) {
  char* ws = p.ws;
  const unsigned* cnt = (const unsigned*)(ws + OFF_CTRL) + CTRL_CNT + layer * 16 * 64;
  g8::MoeOrder<2> S; S.A = ws + OFF_G + G_HB; S.Wt = ws + OFF_W + W_13 + (size_t)layer * 16 * 512 * 1024 * 2; S.lists = (const int*)(ws + OFF_LIST);
#pragma unroll
  for (int e = 0; e < 16; ++e) S.cn[e] = (int)cnt[e * 64];
  S.G = nblk; S.c = bid; S.wstride_e = (size_t)512 * 1024 * 2; S.wstride_pn = (size_t)256 * 1024 * 2;
  g8::EpiMoe1 E{(bf16_t*)(ws + OFF_P), (const float*)(ws + OFF_RSTD)};
  g8::gemm_phase<g8::EpiMoe1, g8::MoeOrder<2>, 1>((LAS unsigned char*)lds, 1024, DM, S, E);
}
__device__ __forceinline__ void phase_moe2(const Params& p, LAS char* lds, int bid, int nblk, int layer) {
  char* ws = p.ws;
  const unsigned* cnt = (const unsigned*)(ws + OFF_CTRL) + CTRL_CNT + layer * 16 * 64;
  g8::MoeOrder<4> S; S.A = ws + OFF_P; S.Wt = ws + OFF_W + W_2 + (size_t)layer * 16 * 1024 * 256 * 2; S.lists = (const int*)(ws + OFF_LIST);
#pragma unroll
  for (int e = 0; e < 16; ++e) S.cn[e] = (int)cnt[e * 64];
  S.G = nblk; S.c = bid; S.wstride_e = (size_t)1024 * 256 * 2; S.wstride_pn = (size_t)256 * 256 * 2;
  g8::EpiMoe2 E{(bf16_t*)(ws + OFF_G + G_MIX), (const float*)(ws + OFF_CW)};
  g8::gemm_phase<g8::EpiMoe2, g8::MoeOrder<4>, 0>((LAS unsigned char*)lds, 256, 256, S, E);
}


typedef float f32x2v __attribute__((ext_vector_type(2)));
__device__ __forceinline__ void phase_norm_route(const Params& p, LAS char* lds, int bid, int nblk, int layer) {
  char* ws = p.ws; const int tid = threadIdx.x, lane = tid & 63, r32 = lane & 31, hi = lane >> 5; const int w = __builtin_amdgcn_readfirstlane(tid >> 6);
  constexpr int WROW = 1028;
  LAS float* wl = (LAS float*)lds;
  LAS float* lgx = (LAS float*)(lds + 20 * WROW * 4);
  LAS float* ssx = lgx + 8 * 32 * 33;
  const float* wr = (const float*)(ws + OFF_WR) + (size_t)layer * 20480;
  __syncthreads();
  for (int i = tid; i < 20480 / 4; i += NTHR) { const int j = i >> 8, c = (i & 255) * 4; *(LAS f32x4*)(wl + j * WROW + c) = *(const f32x4*)(wr + j * 1024 + c); }
  __syncthreads();
  bf16_t* hb = (bf16_t*)(ws + OFF_G + G_HB); float* rstd = (float*)(ws + OFF_RSTD); float* cw = (float*)(ws + OFF_CW);
  unsigned* cnt = (unsigned*)(ws + OFF_CTRL) + CTRL_CNT + layer * 16 * 64; int* lists = (int*)(ws + OFF_LIST);
  const float* bg = p.b_group + layer * 4; const float* br = p.b_router + layer * 16;
  const int nn = r32 < 20 ? r32 : 19;
  for (int base = bid * 4; base < NTOK / 32; base += nblk * 4) {
    const int tile = base + (w & 3), kh = w >> 2, t0 = tile * 32;
    const float* hrow = p.out + (size_t)(t0 + r32) * DM + kh * 512 + 4 * hi;
    bf16_t* hbrow = hb + (size_t)(t0 + r32) * DM + kh * 512 + 4 * hi;
    LAS const float* wrow = wl + nn * WROW + kh * 512 + 4 * hi;
    f32x16 acc = f32x16{}; float ss = 0.f;
    for (int j0 = 0; j0 < 64; j0 += 8) {
      f32x4 hv[8];
#pragma unroll
      for (int q = 0; q < 8; ++q) hv[q] = *(const f32x4*)(hrow + (j0 + q) * 8);
#pragma unroll
      for (int q = 0; q < 8; ++q) {
        const f32x4 wv = *(LAS const f32x4*)(wrow + (j0 + q) * 8);
        ss += hv[q][0] * hv[q][0] + hv[q][1] * hv[q][1] + hv[q][2] * hv[q][2] + hv[q][3] * hv[q][3];
        u32x2 o; o.x = cvt_pk_bf16(hv[q][0], hv[q][1]); o.y = cvt_pk_bf16(hv[q][2], hv[q][3]);
        *(u32x2*)(hbrow + (j0 + q) * 8) = o;
#pragma unroll
        for (int e = 0; e < 4; ++e) acc = __builtin_amdgcn_mfma_f32_32x32x2f32(wv[e], hv[q][e], acc, 0, 0, 0);
      }
    }
    { auto sw = __builtin_amdgcn_permlane32_swap(__float_as_uint(ss), __float_as_uint(ss), false, false); ss = __uint_as_float(sw[0]) + __uint_as_float(sw[1]); }
    LAS float* lg = lgx + w * 32 * 33;
#pragma unroll
    for (int r = 0; r < 16; ++r) { const int n = (r & 3) + 8 * (r >> 2) + 4 * hi; lg[r32 * 33 + n] = acc[r]; }
    if (hi == 0) ssx[w * 32 + r32] = ss;
    __syncthreads();
    if (w < 4 && hi == 0) {
      LAS const float* la = lgx + w * 32 * 33 + r32 * 33; LAS const float* lb = lgx + (w + 4) * 32 * 33 + r32 * 33;
      const int t = t0 + r32;
      const float rs = rsqrtf((ssx[w * 32 + r32] + ssx[(w + 4) * 32 + r32]) * (1.f / DM) + EPS);
      float lgt[20];
#pragma unroll
      for (int j = 0; j < 20; ++j) lgt[j] = (la[j] + lb[j]) * rs + (j < 4 ? bg[j] : br[j - 4]);
      int gs = 0; float gm = lgt[0];
#pragma unroll
      for (int j = 1; j < 4; ++j) if (lgt[j] > gm) { gm = lgt[j]; gs = j; }
      float den = 0.f;
#pragma unroll
      for (int j = 0; j < 4; ++j) den += __expf(lgt[j] - gm);
      const float pg = 1.f / den;
      float el[4];
#pragma unroll
      for (int j = 0; j < 4; ++j) el[j] = gs == 0 ? lgt[4 + j] : gs == 1 ? lgt[8 + j] : gs == 2 ? lgt[12 + j] : lgt[16 + j];
      int i1 = 0; float m1 = el[0];
#pragma unroll
      for (int j = 1; j < 4; ++j) if (el[j] > m1) { m1 = el[j]; i1 = j; }
      int i2 = -1; float m2 = -INFINITY;
#pragma unroll
      for (int j = 0; j < 4; ++j) if (j != i1 && el[j] > m2) { m2 = el[j]; i2 = j; }
      const float e2 = __expf(m2 - m1), p1 = 1.f / (1.f + e2), p2 = e2 * p1;
      const int ex1 = gs * 4 + i1, ex2 = gs * 4 + i2;
      unsigned myc = 0u; int rk1 = 0, rk2 = 0;
      const unsigned long long lt = (1ull << r32) - 1ull;
#pragma unroll
      for (int e = 0; e < 16; ++e) {
        const unsigned long long b1 = __ballot(ex1 == e), b2 = __ballot(ex2 == e);
        const int c1 = __popcll(b1), c2 = __popcll(b2);
        if (r32 == e) myc = (unsigned)(c1 + c2);
        if (ex1 == e) rk1 = __popcll(b1 & lt);
        if (ex2 == e) rk2 = c1 + __popcll(b2 & lt);
      }
      unsigned basev = 0u;
      if (r32 < 16 && myc) basev = atomicAdd(&cnt[r32 * 64], myc);
      const unsigned q1 = (unsigned)__shfl((int)basev, ex1) + (unsigned)rk1, q2 = (unsigned)__shfl((int)basev, ex2) + (unsigned)rk2;
      lists[(size_t)ex1 * NTOK + q1] = t * 2; lists[(size_t)ex2 * NTOK + q2] = t * 2 + 1;
      cw[t * 2] = pg * p1; cw[t * 2 + 1] = pg * p2; rstd[t] = rs;
    }
    __syncthreads();
  }
}

template <bool FINAL>
__device__ __forceinline__ void phase_combine(const Params& p, int bid, int nblk) {
  char* ws = p.ws; const int tid = threadIdx.x, lane = tid & 63, w = tid >> 6;
  const bf16_t* y = (const bf16_t*)(ws + OFF_G + G_MIX); bf16_t* hb = (bf16_t*)(ws + OFF_G + G_HB); float* rstd = (float*)(ws + OFF_RSTD);
  for (int t = bid * 8 + w; t < NTOK; t += nblk * 8) {
    float* hrow = p.out + (size_t)t * DM;
    f32x4 v[4]; float ss = 0.f;
#pragma unroll
    for (int i = 0; i < 4; ++i) {
      const int c = i * 256 + lane * 4;
      v[i] = *(const f32x4*)(hrow + c);
      const u32x2 a = *(const u32x2*)(y + (size_t)(2 * t) * DM + c), b = *(const u32x2*)(y + (size_t)(2 * t + 1) * DM + c);
      v[i][0] += bflo(a.x) + bflo(b.x); v[i][1] += bfhi(a.x) + bfhi(b.x); v[i][2] += bflo(a.y) + bflo(b.y); v[i][3] += bfhi(a.y) + bfhi(b.y);
      ss += v[i][0] * v[i][0] + v[i][1] * v[i][1] + v[i][2] * v[i][2] + v[i][3] * v[i][3];
    }
    ss = wave_sum(ss);
    const float rs = rsqrtf(ss * (1.f / DM) + EPS);
#pragma unroll
    for (int i = 0; i < 4; ++i) {
      const int c = i * 256 + lane * 4;
      if (FINAL) {
        const f32x4 g = *(const f32x4*)(p.final_norm + c);
        f32x4 o; o[0] = v[i][0] * rs * g[0]; o[1] = v[i][1] * rs * g[1]; o[2] = v[i][2] * rs * g[2]; o[3] = v[i][3] * rs * g[3];
        *(f32x4*)(hrow + c) = o;
      } else {
        *(f32x4*)(hrow + c) = v[i];
        u32x2 o; o.x = cvt_pk_bf16(v[i][0], v[i][1]); o.y = cvt_pk_bf16(v[i][2], v[i][3]);
        *(u32x2*)(hb + (size_t)t * DM + c) = o;
      }
    }
    if (!FINAL && lane == 0) rstd[t] = rs;
  }
}

namespace mem {
typedef short s16x4 __attribute__((ext_vector_type(4)));
constexpr int TILEB = 8192, LDS_K = 0, LDS_V = 4 * TILEB, LDS_WS = 8 * TILEB, LDS_OST = LDS_WS + 8 * 256;
__device__ __forceinline__ s16x4 vtr(LAS const char* p) { return __builtin_bit_cast(s16x4, __builtin_amdgcn_ds_read_tr16_b64_v4i16((LAS s16x4*)p)); }
__device__ __forceinline__ void unit(bf16_t* P, const bf16_t* mkv, int b, int hd, int qb, LAS char* lds) {
  const int tid = threadIdx.x, lane = tid & 63, r32 = lane & 31, hi = lane >> 5; const int wid = __builtin_amdgcn_readfirstlane(tid >> 6);
  const bf16_t* Kh = mkv + (size_t)b * 256 * 512 + hd * 64; const bf16_t* Vh = Kh + 256;
  bf16_t* Qw = P + ((size_t)b * SEQ + qb * 256 + wid * 32) * LDP + PC_MQ + hd * 64;
  const bf16_t* ksrc = Kh + (size_t)lane * 512 + wid * 8;
  const bf16_t* vsrc = Vh + (size_t)(16 * (wid & 3) + (lane >> 2)) * 512 + (wid >> 2) * 32 + (lane & 3) * 8;
#pragma unroll
  for (int t = 0; t < 4; ++t) {
    __builtin_amdgcn_global_load_lds((const unsigned*)(ksrc + (size_t)t * 64 * 512), (LAS unsigned*)(lds + LDS_K + t * TILEB + wid * 1024), 16, 0, 0);
    __builtin_amdgcn_global_load_lds((const unsigned*)(vsrc + (size_t)t * 64 * 512), (LAS unsigned*)(lds + LDS_V + t * TILEB + wid * 1024), 16, 0, 0);
  }
  bf16x8 qr[4];
#pragma unroll
  for (int d0 = 0; d0 < 4; ++d0) qr[d0] = *(const bf16x8*)(Qw + (size_t)r32 * LDP + d0 * 16 + hi * 8);
  asm volatile("s_waitcnt vmcnt(0) lgkmcnt(0)\n\ts_barrier" ::: "memory");
  LAS const char* kp0 = lds + LDS_K + hi * 1024 + r32 * 16;
  LAS const char* vp0 = lds + LDS_V + ((lane >> 4) & 1) * 32 + (lane & 3) * 8 + (4 * hi + ((lane & 15) >> 2)) * 64;
  float mx = -INFINITY;
#pragma unroll
  for (int t = 0; t < 4; ++t) {
    f32x16 p0 = f32x16{}, p1 = f32x16{};
#pragma unroll
    for (int d0 = 0; d0 < 4; ++d0) {
      const bf16x8 k0 = *(LAS const bf16x8*)(kp0 + t * TILEB + d0 * 2048), k1 = *(LAS const bf16x8*)(kp0 + t * TILEB + d0 * 2048 + 512);
      p0 = __builtin_amdgcn_mfma_f32_32x32x16_bf16(k0, qr[d0], p0, 0, 0, 0); p1 = __builtin_amdgcn_mfma_f32_32x32x16_bf16(k1, qr[d0], p1, 0, 0, 0);
    }
#pragma unroll
    for (int r = 0; r < 16; ++r) mx = fmaxf(mx, fmaxf(p0[r], p1[r]));
  }
  { auto sw = __builtin_amdgcn_permlane32_swap(__float_as_uint(mx), __float_as_uint(mx), false, false); mx = fmaxf(__uint_as_float(sw[0]), __uint_as_float(sw[1])); }
  f32x16 o[2]; o[0] = f32x16{}; o[1] = f32x16{};
  float lsum = 0.f;
#pragma unroll
  for (int t = 0; t < 4; ++t) {
    f32x16 p0 = f32x16{}, p1 = f32x16{};
#pragma unroll
    for (int d0 = 0; d0 < 4; ++d0) {
      const bf16x8 k0 = *(LAS const bf16x8*)(kp0 + t * TILEB + d0 * 2048), k1 = *(LAS const bf16x8*)(kp0 + t * TILEB + d0 * 2048 + 512);
      p0 = __builtin_amdgcn_mfma_f32_32x32x16_bf16(k0, qr[d0], p0, 0, 0, 0); p1 = __builtin_amdgcn_mfma_f32_32x32x16_bf16(k1, qr[d0], p1, 0, 0, 0);
    }
    float a[32];
#pragma unroll
    for (int r = 0; r < 16; ++r) { a[r] = __builtin_amdgcn_exp2f(p0[r] - mx); a[16 + r] = __builtin_amdgcn_exp2f(p1[r] - mx); lsum += a[r] + a[16 + r]; }
    u32x4 pw[4];
#pragma unroll
    for (int ks = 0; ks < 4; ++ks) { pw[ks].x = cvt_pk_bf16(a[8 * ks], a[8 * ks + 1]); pw[ks].y = cvt_pk_bf16(a[8 * ks + 2], a[8 * ks + 3]); pw[ks].z = cvt_pk_bf16(a[8 * ks + 4], a[8 * ks + 5]); pw[ks].w = cvt_pk_bf16(a[8 * ks + 6], a[8 * ks + 7]); }
    LAS const char* vp = vp0 + t * TILEB;
#pragma unroll
    for (int d0 = 0; d0 < 2; ++d0)
#pragma unroll
      for (int ks = 0; ks < 4; ++ks) {
        const s16x4 lo = vtr(vp + d0 * 4096 + ks * 1024), hh = vtr(vp + d0 * 4096 + ks * 1024 + 512);
        const bf16x8 vf = (bf16x8){lo[0], lo[1], lo[2], lo[3], hh[0], hh[1], hh[2], hh[3]};
        o[d0] = __builtin_amdgcn_mfma_f32_32x32x16_bf16(__builtin_bit_cast(bf16x8, pw[ks]), vf, o[d0], 0, 0, 0);
      }
  }
  { auto sw = __builtin_amdgcn_permlane32_swap(__float_as_uint(lsum), __float_as_uint(lsum), false, false); lsum = __uint_as_float(sw[0]) + __uint_as_float(sw[1]); }
  LAS float* wsf = (LAS float*)(lds + LDS_WS) + wid * 64;
  if (hi == 0) wsf[r32] = __builtin_amdgcn_rcpf(lsum);
  asm volatile("s_waitcnt lgkmcnt(0)" ::: "memory");
  LAS bf16_t* stg = (LAS bf16_t*)(lds + LDS_OST) + wid * 2048;
#pragma unroll
  for (int r = 0; r < 16; ++r) { const int orow = (r & 3) + 8 * (r >> 2) + 4 * hi; const float il = wsf[orow];
#pragma unroll
    for (int d0 = 0; d0 < 2; ++d0) stg[orow * 64 + d0 * 32 + r32] = f2bf(o[d0][r] * il); }
  asm volatile("s_waitcnt lgkmcnt(0)" ::: "memory");
#pragma unroll
  for (int i = 0; i < 4; ++i) { const int row = i * 8 + (lane >> 3), ch = lane & 7; const u32x4 v = *(LAS const u32x4*)(stg + row * 64 + ch * 8); *(u32x4*)(Qw + (size_t)row * LDP + ch * 8) = v; }
  asm volatile("s_waitcnt vmcnt(0) lgkmcnt(0)\n\ts_barrier" ::: "memory");
}
}
__device__ __forceinline__ void phase_memattn(const Params& p, LAS char* lds, int bid, int nblk, int layer) {
  char* ws = p.ws; bf16_t* P = (bf16_t*)(ws + OFF_P);
  const bf16_t* mkv = (const bf16_t*)(ws + OFF_MEMKV) + (size_t)layer * 2048 * 512;
  for (int u = bid; u < NBATCH * 4 * 16; u += nblk) { const int bh = u >> 4, qb = u & 15; mem::unit(P, mkv, bh >> 2, bh & 3, qb, lds); }
}

namespace sb {
typedef short s16x4 __attribute__((ext_vector_type(4)));
constexpr int SLOTB = 8192, LDS_K = 0, LDS_V = 3 * SLOTB, LDS_OST = 6 * SLOTB, LDS_FLAG = LDS_OST + 8 * 4096, LDS_BYTES_SB = LDS_FLAG + 64;
__device__ __forceinline__ s16x4 vtr(LAS const char* p) { return __builtin_bit_cast(s16x4, __builtin_amdgcn_ds_read_tr16_b64_v4i16((LAS s16x4*)p)); }

__device__ __forceinline__ void unit(const bf16_t* P, bf16_t* O, int ldo, int b, int h, int qb, LAS char* lds) {
  const int tid = threadIdx.x, lane = tid & 63, r32 = lane & 31, hi = lane >> 5; const int wid = __builtin_amdgcn_readfirstlane(tid >> 6);
  const size_t rowbase = (size_t)b * SEQ; const int q0 = qb * 256;
  const bf16_t* Kh = P + rowbase * LDP + PC_K + h * 64; const bf16_t* Vh = P + rowbase * LDP + PC_V + h * 64;
  const bf16_t* Qw = P + (rowbase + q0 + wid * 32) * LDP + PC_Q + h * 64;
  const bf16_t* ksrc = Kh + (size_t)lane * LDP + wid * 8;
  const bf16_t* vsrc = Vh + (size_t)(16 * (wid & 3) + (lane >> 2)) * LDP + (wid >> 2) * 32 + (lane & 3) * 8;
  LAS char* kdst = lds + LDS_K + wid * 1024; LAS char* vdst = lds + LDS_V + wid * 1024;
#define SB_DMA(t, slot) do { __builtin_amdgcn_global_load_lds((const unsigned*)(ksrc + (size_t)(t) * 64 * LDP), (LAS unsigned*)(kdst + (slot)), 16, 0, 0); \
                             __builtin_amdgcn_global_load_lds((const unsigned*)(vsrc + (size_t)(t) * 64 * LDP), (LAS unsigned*)(vdst + (slot)), 16, 0, 0); } while (0)
  const int NT = 4 * qb + 4;
  SB_DMA(NT - 1, 0);
  bf16x8 qr[4];
#pragma unroll
  for (int d0 = 0; d0 < 4; ++d0) qr[d0] = *(const bf16x8*)(Qw + (size_t)r32 * LDP + d0 * 16 + hi * 8);
  f32x16 o[2]; o[0] = f32x16{}; o[1] = f32x16{};
  float c = 1.f;
  const int qrel = wid * 32 + r32;
  LAS const char* kp0 = lds + LDS_K + hi * 1024 + r32 * 16;
  LAS const char* vp0 = lds + LDS_V + ((lane >> 4) & 1) * 32 + (lane & 3) * 8 + (4 * hi + ((lane & 15) >> 2)) * 64;
  int slot = 0; bool wave_alive = true;
  LAS unsigned* fl = (LAS unsigned*)(lds + LDS_FLAG);
  for (int i = 0; i < NT; ++i) {
    const int t = NT - 1 - i;
    const int nslot = (slot == 2 * SLOTB) ? 0 : slot + SLOTB;
    if (t > 0) { SB_DMA(t - 1, nslot); asm volatile("s_waitcnt vmcnt(2) lgkmcnt(0)\n\ts_barrier" ::: "memory"); }
    else { asm volatile("s_waitcnt vmcnt(0) lgkmcnt(0)\n\ts_barrier" ::: "memory"); }
    if (i > 0) { const u32x4 f0 = *(LAS const u32x4*)(fl + ((i - 1) & 1) * 8), f1 = *(LAS const u32x4*)(fl + ((i - 1) & 1) * 8 + 4);
      if (__builtin_amdgcn_readfirstlane((int)(f0.x | f0.y | f0.z | f0.w | f1.x | f1.y | f1.z | f1.w)) == 0) break; }
    const int jb = t - (NT - 4);
    if (!(jb >= 0 && 64 * jb > 32 * wid + 30) && wave_alive) {
      f32x16 p0 = f32x16{}, p1 = f32x16{};
#pragma unroll
      for (int d0 = 0; d0 < 4; ++d0) {
        const bf16x8 k0 = *(LAS const bf16x8*)(kp0 + slot + d0 * 2048), k1 = *(LAS const bf16x8*)(kp0 + slot + d0 * 2048 + 512);
        p0 = __builtin_amdgcn_mfma_f32_32x32x16_bf16(k0, qr[d0], p0, 0, 0, 0);
        p1 = __builtin_amdgcn_mfma_f32_32x32x16_bf16(k1, qr[d0], p1, 0, 0, 0);
      }
      if (jb >= 0) {
        const int kb = 64 * jb + 4 * hi;
#pragma unroll
        for (int r = 0; r < 16; ++r) { const int kv = kb + (r & 3) + 8 * (r >> 2); if (kv >= qrel) p0[r] = -INFINITY; if (kv + 32 >= qrel) p1[r] = -INFINITY; }
      }
      float rr[32], be[32];
#pragma unroll
      for (int r = 0; r < 16; ++r) {
        const float e0 = __builtin_amdgcn_exp2f(p0[r]), e1 = __builtin_amdgcn_exp2f(p1[r]);
        rr[r] = __builtin_amdgcn_rcpf(1.f + e0); rr[16 + r] = __builtin_amdgcn_rcpf(1.f + e1);
        be[r] = 1.f - rr[r]; be[16 + r] = 1.f - rr[16 + r];
      }
      float OS[9]; OS[8] = 1.f;
#pragma unroll
      for (int G = 7; G >= 0; --G) { const float gp = (rr[4 * G] * rr[4 * G + 1]) * (rr[4 * G + 2] * rr[4 * G + 3]); OS[G] = OS[G + 1] * gp; }
      float cE[8];
#pragma unroll
      for (int G = 0; G < 8; ++G) {
        const float X = hi ? OS[G] : OS[G + 1], Y = OS[G + 1];
        auto sw = __builtin_amdgcn_permlane32_swap(__float_as_uint(X), __float_as_uint(Y), false, false);
        cE[G] = c * (__uint_as_float(sw[0]) * __uint_as_float(sw[1]));
      }
      { auto sw = __builtin_amdgcn_permlane32_swap(__float_as_uint(OS[0]), __float_as_uint(OS[0]), false, false); c *= __uint_as_float(sw[0]) * __uint_as_float(sw[1]); }
      float a[32];
#pragma unroll
      for (int G = 0; G < 8; ++G) {
        const float t3 = cE[G], t2 = t3 * rr[4 * G + 3], t1 = t2 * rr[4 * G + 2], t0 = t1 * rr[4 * G + 1];
        a[4 * G + 3] = be[4 * G + 3] * t3; a[4 * G + 2] = be[4 * G + 2] * t2; a[4 * G + 1] = be[4 * G + 1] * t1; a[4 * G] = be[4 * G] * t0;
      }
      u32x4 pw[4];
#pragma unroll
      for (int ks = 0; ks < 4; ++ks) { pw[ks].x = cvt_pk_bf16(a[8 * ks], a[8 * ks + 1]); pw[ks].y = cvt_pk_bf16(a[8 * ks + 2], a[8 * ks + 3]); pw[ks].z = cvt_pk_bf16(a[8 * ks + 4], a[8 * ks + 5]); pw[ks].w = cvt_pk_bf16(a[8 * ks + 6], a[8 * ks + 7]); }
      LAS const char* vp = vp0 + slot;
#pragma unroll
      for (int d0 = 0; d0 < 2; ++d0)
#pragma unroll
        for (int ks = 0; ks < 4; ++ks) {
          const s16x4 lo = vtr(vp + d0 * 4096 + ks * 1024), hh = vtr(vp + d0 * 4096 + ks * 1024 + 512);
          const bf16x8 vf = (bf16x8){lo[0], lo[1], lo[2], lo[3], hh[0], hh[1], hh[2], hh[3]};
          o[d0] = __builtin_amdgcn_mfma_f32_32x32x16_bf16(__builtin_bit_cast(bf16x8, pw[ks]), vf, o[d0], 0, 0, 0);
        }
    }
    wave_alive = __any(c != 0.f);
    if (lane == 0) fl[(i & 1) * 8 + wid] = wave_alive ? 1u : 0u;
    slot = nslot;
  }
  bf16_t* Ow = O + (rowbase + q0 + wid * 32) * ldo + h * 64;
  LAS bf16_t* stg = (LAS bf16_t*)(lds + LDS_OST) + wid * 2048;
#pragma unroll
  for (int r = 0; r < 16; ++r) { const int orow = (r & 3) + 8 * (r >> 2) + 4 * hi;
#pragma unroll
    for (int d0 = 0; d0 < 2; ++d0) stg[orow * 64 + d0 * 32 + r32] = f2bf(o[d0][r]); }
  asm volatile("s_waitcnt lgkmcnt(0)" ::: "memory");
#pragma unroll
  for (int i = 0; i < 4; ++i) { const int row = i * 8 + (lane >> 3), ch = lane & 7; const u32x4 v = *(LAS const u32x4*)(stg + row * 64 + ch * 8); *(u32x4*)(Ow + (size_t)row * ldo + ch * 8) = v; }
  asm volatile("s_waitcnt vmcnt(0) lgkmcnt(0)\n\ts_barrier" ::: "memory");
#undef SB_DMA
}
}
__device__ __forceinline__ void phase_sb_attn(const Params& p, LAS char* lds, int bid, int nblk, bool dummy = false) {
  char* ws = p.ws;
  bf16_t* P = (bf16_t*)(ws + OFF_P); bf16_t* Od = dummy ? (bf16_t*)(ws + OFF_G + G_MIX) : P; const int ldo = dummy ? DM : LDP;
  const int vcu = (nblk % 8 == 0) ? (bid % 8) * (nblk / 8) + bid / 8 : bid;
  for (int pi = vcu; pi < 96 * 8; pi += nblk) {
    const int bh = pi >> 3, s = pi & 7, b = bh / 12, h = bh % 12;
    sb::unit(P, Od, ldo, b, h, 15 - s, lds);
    sb::unit(P, Od, ldo, b, h, s, lds);
  }
}

namespace gdn {
constexpr int RA_W = 0, RA_QG = 16384, RA_KT = 32768, RA_ATT = 49152, REC_A = 55296, REC_U = 16384, REC = REC_A + REC_U;
constexpr int HALF_LDS = 58368;
constexpr float QSCALE = 0.08838834764831845f;
__device__ __forceinline__ int crow(int r, int hi) { return (r & 3) + 8 * (r >> 2) + 4 * hi; }
}
__device__ __forceinline__ void phase_gdn_prep(const Params& p, LAS char* lds, int bid, int nblk) {
  using namespace gdn;
  char* ws = p.ws; const bf16_t* P = (const bf16_t*)(ws + OFF_P); char* G = ws + OFF_G; float* EGL = (float*)(ws + OFF_EGL);
  const int nrounds = (3072 + 2 * nblk - 1) / (2 * nblk);
  for (int rd = 0; rd < nrounds; ++rd) {
    int tl = threadIdx.x; asm volatile("" : "+v"(tl));
    const int tid = tl, hb = tid >> 8, ht = tid & 255, lane = tid & 63, r32 = lane & 31, hi = lane >> 5;
    const int hw = __builtin_amdgcn_readfirstlane(ht >> 6);
    LAS char* L = lds + hb * HALF_LDS;
    LAS float* sBeta = (LAS float*)(L + REC_A); LAS float* sGc = sBeta + 64; LAS float* sEgc = sGc + 64; LAS float* sRnK = sEgc + 64; LAS float* sRnQ = sRnK + 64;
    LAS char* sQ = L; LAS char* sK = L + 17408;
    LAS float* Amat = (LAS float*)(L + RA_W);
    const int u0 = (rd * nblk + bid) * 2 + hb; const bool valid = u0 < 3072; const int u = valid ? u0 : 0;
    const int bh = u >> 6, n = u & 63, b = bh / 6, h = bh % 6; const size_t row0 = (size_t)b * SEQ + (size_t)n * 64;
    char* rec = G + (size_t)u * REC;
    __syncthreads();
    if (hw == 0) {
      const bf16_t* pr = P + (row0 + lane) * LDP + PC_BA;
      const float braw = bf2f(pr[h]), araw = bf2f(pr[6 + h]);
      const float beta = sigmoidf_(braw), g = -__expf(p.a_log[h]) * softplusf_(araw + p.a_dt_bias[h]);
      float s = g;
#pragma unroll
      for (int o = 1; o < 64; o <<= 1) { const float t = __shfl_up(s, o); if (lane >= o) s += t; }
      sBeta[lane] = beta; sGc[lane] = s; sEgc[lane] = __expf(s);
    }
    for (int i = ht; i < 67 * 48; i += 256) {
      const int rr = i / 48, cc = i % 48, part = cc >> 4, c8 = (cc & 15) * 8;
      u32x4 v = (u32x4){0u, 0u, 0u, 0u};
      if (n > 0 || rr >= 3) v = *(const u32x4*)(P + (row0 + rr - 3) * LDP + (part == 0 ? PC_Q : part == 1 ? PC_K : PC_V) + h * 128 + c8);
      *(LAS u32x4*)(L + rr * 768 + cc * 16) = v;
    }
    __syncthreads();
    float x[64], xq[64];
    {
      const int c = ht & 127; const bool isk = ht >= 128;
      {
        const int ch = (isk ? 768 : 1536) + h * 128 + c;
        const float w0 = p.a_conv[ch], w1 = p.a_conv[2304 + ch], w2 = p.a_conv[2 * 2304 + ch], w3 = p.a_conv[3 * 2304 + ch];
        LAS const char* src = L + (isk ? 256 : 512) + c * 2;
        float r0 = bf2f(*(LAS const bf16_t*)(src)), r1 = bf2f(*(LAS const bf16_t*)(src + 768)), r2 = bf2f(*(LAS const bf16_t*)(src + 2 * 768));
#pragma unroll
        for (int i = 0; i < 64; ++i) { const float r3 = bf2f(*(LAS const bf16_t*)(src + (i + 3) * 768)); x[i] = siluf_(w0 * r0 + w1 * r1 + w2 * r2 + w3 * r3); r0 = r1; r1 = r2; r2 = r3; }
      }
      if (!isk) {
        const int ch = h * 128 + c;
        const float w0 = p.a_conv[ch], w1 = p.a_conv[2304 + ch], w2 = p.a_conv[2 * 2304 + ch], w3 = p.a_conv[3 * 2304 + ch];
        LAS const char* src = L + c * 2;
        float r0 = bf2f(*(LAS const bf16_t*)(src)), r1 = bf2f(*(LAS const bf16_t*)(src + 768)), r2 = bf2f(*(LAS const bf16_t*)(src + 2 * 768));
#pragma unroll
        for (int i = 0; i < 64; ++i) { const float r3 = bf2f(*(LAS const bf16_t*)(src + (i + 3) * 768)); xq[i] = siluf_(w0 * r0 + w1 * r1 + w2 * r2 + w3 * r3); r0 = r1; r1 = r2; r2 = r3; }
      } else {
#pragma unroll
        for (int i = 0; i < 64; ++i) xq[i] = x[i];
      }
    }
    __syncthreads();
    if (ht < 128) {
#pragma unroll
      for (int i = 0; i < 64; ++i) *(LAS bf16_t*)(sQ + i * 272 + ht * 2) = f2bf(xq[i]);
    } else {
#pragma unroll
      for (int i = 0; i < 64; ++i) *(LAS bf16_t*)(sK + i * 272 + (ht - 128) * 2) = f2bf(x[i]);
    }
    __syncthreads();
    const int it = hw >> 1, jt = hw & 1;
    f32x16 akk = f32x16{}, aqk = f32x16{};
    if (hw != 1) {
#pragma unroll
      for (int ks = 0; ks < 8; ++ks) {
        const bf16x8 ak = *(LAS const bf16x8*)(sK + (32 * it + r32) * 272 + ks * 32 + hi * 16), aq = *(LAS const bf16x8*)(sQ + (32 * it + r32) * 272 + ks * 32 + hi * 16);
        const bf16x8 bk = *(LAS const bf16x8*)(sK + (32 * jt + r32) * 272 + ks * 32 + hi * 16);
        akk = __builtin_amdgcn_mfma_f32_32x32x16_bf16(ak, bk, akk, 0, 0, 0); aqk = __builtin_amdgcn_mfma_f32_32x32x16_bf16(aq, bk, aqk, 0, 0, 0);
      }
    } else {
#pragma unroll
      for (int ks = 0; ks < 8; ++ks) {
        const bf16x8 a0 = *(LAS const bf16x8*)(sQ + r32 * 272 + ks * 32 + hi * 16), a1 = *(LAS const bf16x8*)(sQ + (32 + r32) * 272 + ks * 32 + hi * 16);
        akk = __builtin_amdgcn_mfma_f32_32x32x16_bf16(a0, a0, akk, 0, 0, 0); aqk = __builtin_amdgcn_mfma_f32_32x32x16_bf16(a1, a1, aqk, 0, 0, 0);
      }
    }
    {
      float d0 = 0.f, d1 = 0.f;
#pragma unroll
      for (int r = 0; r < 16; ++r) if (crow(r, hi) == r32) { d0 = akk[r]; d1 = aqk[r]; }
      const bool has = ((r32 >> 2) & 1) == hi;
      if (has && hw == 0) sRnK[r32] = rsqrtf(d0 + EPS);
      if (has && hw == 3) sRnK[32 + r32] = rsqrtf(d0 + EPS);
      if (has && hw == 1) { sRnQ[r32] = rsqrtf(d0 + EPS) * QSCALE; sRnQ[32 + r32] = rsqrtf(d1 + EPS) * QSCALE; }
    }
    __syncthreads();
    if (hw != 1) {
      const int j = 32 * jt + r32; const float rnkj = sRnK[j], gcj = sGc[j];
      const int ksj = 2 * jt + (r32 >> 4), jo = r32 & 15, hip = (jo >> 2) & 1, jp = (jo & 3) + 4 * (jo >> 3);
      LAS char* attf = L + RA_ATT + (it ? 2 + ksj : ksj) * 1024 + hip * 512 + jp * 2;
#pragma unroll
      for (int r = 0; r < 16; ++r) {
        const int il = crow(r, hi), i = 32 * it + il;
        const float dec = __expf(fminf(sGc[i] - gcj, 0.f));
        const float aval = (i > j) ? sBeta[i] * sRnK[i] * rnkj * akk[r] * dec : 0.f;
        const float tval = (i >= j) ? sRnQ[i] * rnkj * aqk[r] * dec : 0.f;
        Amat[i * 64 + j] = aval;
        *(LAS bf16_t*)(attf + il * 16) = f2bf(tval);
        if ((r & 3) == 3) asm volatile("" ::: "memory");
      }
    }
    __syncthreads();
    if (ht < 128) {
      const int c = ht;
      const int co = c & 15, hip = (co >> 2) & 1, jp = (co & 3) + 4 * (co >> 3);
      LAS char* qgf = L + RA_QG + (c >> 4) * 1024 + hip * 512 + jp * 2;
#pragma unroll
      for (int i = 0; i < 64; ++i) { *(LAS bf16_t*)(qgf + (i >> 5) * 8192 + (i & 31) * 16) = f2bf(xq[i] * sRnQ[i] * sEgc[i]); x[i] *= sBeta[i]; if ((i & 7) == 7) asm volatile("" ::: "memory"); }
    } else {
      const int c = ht - 128;
      const float gl = sGc[63];
      LAS char* ktf = L + RA_KT + (c >> 5) * 4096 + (c & 31) * 16;
#pragma unroll
      for (int ks = 0; ks < 4; ++ks)
#pragma unroll
        for (int hp = 0; hp < 2; ++hp) {
          float v[8];
#pragma unroll
          for (int jq = 0; jq < 8; ++jq) { const int i = 16 * ks + (jq & 3) + 8 * (jq >> 2) + 4 * hp; v[jq] = xq[i] * sRnK[i] * __expf(gl - sGc[i]); }
          u32x4 w; w.x = cvt_pk_bf16(v[0], v[1]); w.y = cvt_pk_bf16(v[2], v[3]); w.z = cvt_pk_bf16(v[4], v[5]); w.w = cvt_pk_bf16(v[6], v[7]);
          *(LAS u32x4*)(ktf + ks * 1024 + hp * 512) = w;
          asm volatile("" ::: "memory");
        }
#pragma unroll
      for (int i = 0; i < 64; ++i) { x[i] *= sBeta[i] * sEgc[i] * sRnK[i]; if ((i & 7) == 7) asm volatile("" ::: "memory"); }
    }
    asm volatile("" ::: "memory");
#pragma unroll
    for (int i = 1; i < 64; ++i) {
      float acc = x[i];
#pragma unroll
      for (int j4 = 0; j4 < (i + 3) / 4; ++j4) {
        const f32x4 a = *(LAS const f32x4*)(Amat + i * 64 + j4 * 4);
        acc -= a[0] * x[4 * j4]; acc -= a[1] * x[4 * j4 + 1]; acc -= a[2] * x[4 * j4 + 2]; acc -= a[3] * x[4 * j4 + 3];
      }
      x[i] = acc;
      if ((i & 3) == 3) asm volatile("" ::: "memory");
    }
    __syncthreads();
    if (ht < 128) {
      const int c = ht;
      if (valid) {
        char* ud = rec + REC_A + c * 128;
#pragma unroll
        for (int q = 0; q < 8; ++q) {
          const int ib = 32 * (q >> 2) + 4 * ((q >> 1) & 1) + 16 * (q & 1);
          u32x4 w; w.x = cvt_pk_bf16(x[ib], x[ib + 1]); w.y = cvt_pk_bf16(x[ib + 2], x[ib + 3]); w.z = cvt_pk_bf16(x[ib + 8], x[ib + 9]); w.w = cvt_pk_bf16(x[ib + 10], x[ib + 11]);
          *(u32x4*)(ud + q * 16) = w;
        }
      }
    } else {
      const int c = ht - 128;
      const int co = c & 15, hip = (co >> 2) & 1, jp = (co & 3) + 4 * (co >> 3);
      LAS char* wf = L + RA_W + (c >> 4) * 1024 + hip * 512 + jp * 2;
#pragma unroll
      for (int i = 0; i < 64; ++i) *(LAS bf16_t*)(wf + (i >> 5) * 8192 + (i & 31) * 16) = f2bf(-x[i]);
    }
    if (ht == 0 && valid) EGL[u] = __expf(sGc[63]);
    __syncthreads();
    if (valid) for (int o = ht * 16; o < REC_A; o += 4096) *(u32x4*)(rec + o) = *(LAS const u32x4*)(L + o);
  }
}

__device__ __forceinline__ void phase_gdn_scan(const Params& p, LAS char* lds, int bid, int nblk) {
  using namespace gdn;
  char* ws = p.ws; bf16_t* P = (bf16_t*)(ws + OFF_P); const char* G = ws + OFF_G; const float* EGL = (const float*)(ws + OFF_EGL);
  const int tid = threadIdx.x, lane = tid & 63, r32 = lane & 31, hi = lane >> 5; const int wid = __builtin_amdgcn_readfirstlane(tid >> 6);
  LAS char* OX = lds + 2 * REC_A;
  {
    const int u = bid; const int b = u / 6, h = u % 6; const size_t rowb = (size_t)b * SEQ; const char* recb = G + (size_t)u * 64 * REC;
    __syncthreads();
    if (wid >= 4) {
      const int j = wid - 4, row = 16 * j + (lane >> 2), cg = (lane & 3) * 32;
      if (j < 2) for (int f = j; f < 54; f += 2) __builtin_amdgcn_global_load_lds((const unsigned*)(recb + f * 1024 + lane * 16), (LAS unsigned*)(lds + f * 1024), 16, 0, 0);
      float gn[32];
#pragma unroll
      for (int q = 0; q < 8; ++q) { const f32x4 g = *(const f32x4*)(p.a_out_gain + cg + q * 4); gn[4 * q] = g[0]; gn[4 * q + 1] = g[1]; gn[4 * q + 2] = g[2]; gn[4 * q + 3] = g[3]; }
      float sg[32]; u32x4 gr[4];
#pragma unroll
      for (int q = 0; q < 4; ++q) gr[q] = (u32x4){0u, 0u, 0u, 0u};
      const bf16_t* gp0 = P + (rowb + row) * LDP + PC_GATE + h * 128 + cg;
      bf16_t* dp0 = P + (rowb + row) * LDP + PC_Q + h * 128 + cg;
      for (int c = 0; c <= 64; ++c) {
        asm volatile("s_waitcnt vmcnt(0) lgkmcnt(0)\n\ts_barrier" ::: "memory");
        if (j < 2 && c + 1 < 64) { const char* rn = recb + (size_t)(c + 1) * REC; LAS char* dst = lds + ((c + 1) & 1) * REC_A;
          for (int f = j; f < 54; f += 2) __builtin_amdgcn_global_load_lds((const unsigned*)(rn + f * 1024 + lane * 16), (LAS unsigned*)(dst + f * 1024), 16, 0, 0); }
        if (c >= 1) {
#pragma unroll
          for (int q = 0; q < 4; ++q) {
            sg[8 * q] = gn[8 * q] * siluf_(bflo(gr[q].x)); sg[8 * q + 1] = gn[8 * q + 1] * siluf_(bfhi(gr[q].x)); sg[8 * q + 2] = gn[8 * q + 2] * siluf_(bflo(gr[q].y)); sg[8 * q + 3] = gn[8 * q + 3] * siluf_(bfhi(gr[q].y));
            sg[8 * q + 4] = gn[8 * q + 4] * siluf_(bflo(gr[q].z)); sg[8 * q + 5] = gn[8 * q + 5] * siluf_(bfhi(gr[q].z)); sg[8 * q + 6] = gn[8 * q + 6] * siluf_(bflo(gr[q].w)); sg[8 * q + 7] = gn[8 * q + 7] * siluf_(bfhi(gr[q].w)); }
        }
        if (c < 64) {
#pragma unroll
          for (int q = 0; q < 4; ++q) gr[q] = *(const u32x4*)(gp0 + (size_t)c * 64 * LDP + q * 8);
        }
        if (c >= 1) {
          const int cc = c - 1;
          LAS const char* op = OX + (cc & 1) * 16384 + row * 256 + cg * 2;
          float ov[32]; float ss = 0.f;
#pragma unroll
          for (int q = 0; q < 4; ++q) { const u32x4 r = *(LAS const u32x4*)(op + q * 16);
            ov[8 * q] = bflo(r.x); ov[8 * q + 1] = bfhi(r.x); ov[8 * q + 2] = bflo(r.y); ov[8 * q + 3] = bfhi(r.y); ov[8 * q + 4] = bflo(r.z); ov[8 * q + 5] = bfhi(r.z); ov[8 * q + 6] = bflo(r.w); ov[8 * q + 7] = bfhi(r.w); }
#pragma unroll
          for (int q = 0; q < 32; ++q) ss += ov[q] * ov[q];
          ss += __shfl_xor(ss, 1); ss += __shfl_xor(ss, 2);
          const float sc = rsqrtf(ss * (1.f / 128.f) + EPS);
          bf16_t* dp = dp0 + (size_t)cc * 64 * LDP;
#pragma unroll
          for (int q = 0; q < 4; ++q) { u32x4 w;
            w.x = cvt_pk_bf16(ov[8 * q] * sc * sg[8 * q], ov[8 * q + 1] * sc * sg[8 * q + 1]); w.y = cvt_pk_bf16(ov[8 * q + 2] * sc * sg[8 * q + 2], ov[8 * q + 3] * sc * sg[8 * q + 3]);
            w.z = cvt_pk_bf16(ov[8 * q + 4] * sc * sg[8 * q + 4], ov[8 * q + 5] * sc * sg[8 * q + 5]); w.w = cvt_pk_bf16(ov[8 * q + 6] * sc * sg[8 * q + 6], ov[8 * q + 7] * sc * sg[8 * q + 7]);
            *(u32x4*)(dp + q * 8) = w; }
        }
      }
    } else {
      const int vs = wid;
      f32x16 S[4];
#pragma unroll
      for (int k = 0; k < 4; ++k) S[k] = f32x16{};
      const char* ub = recb + REC_A + (vs * 32 + r32) * 128 + hi * 32;
      u32x4 un[4];
#pragma unroll
      for (int q = 0; q < 4; ++q) un[q] = *(const u32x4*)(ub + (q >> 1) * 64 + (q & 1) * 16);
      float egn = EGL[u * 64];
      for (int c = 0; c <= 64; ++c) {
        asm volatile("s_waitcnt lgkmcnt(0)\n\ts_barrier" ::: "memory");
        if (c < 64) {
          LAS const char* R = lds + (c & 1) * REC_A + lane * 16;
          const float egl = egn; if (c + 1 < 64) egn = EGL[u * 64 + c + 1];
          u32x4 uc[4];
#pragma unroll
          for (int q = 0; q < 4; ++q) uc[q] = un[q];
          if (c + 1 < 64) {
#pragma unroll
            for (int q = 0; q < 4; ++q) un[q] = *(const u32x4*)(ub + (size_t)(c + 1) * REC + (q >> 1) * 64 + (q & 1) * 16);
          }
          bf16x8 Sb[8];
#pragma unroll
          for (int ks = 0; ks < 8; ++ks) { const int kt = ks >> 1, o = (ks & 1) * 8; u32x4 w;
            w.x = cvt_pk_bf16(S[kt][o], S[kt][o + 1]); w.y = cvt_pk_bf16(S[kt][o + 2], S[kt][o + 3]); w.z = cvt_pk_bf16(S[kt][o + 4], S[kt][o + 5]); w.w = cvt_pk_bf16(S[kt][o + 6], S[kt][o + 7]);
            Sb[ks] = __builtin_bit_cast(bf16x8, w); }
          f32x16 vn[2];
#pragma unroll
          for (int t2 = 0; t2 < 2; ++t2) {
#pragma unroll
            for (int q = 0; q < 2; ++q) { const u32x4 r = uc[2 * t2 + q];
              vn[t2][8 * q] = bflo(r.x); vn[t2][8 * q + 1] = bfhi(r.x); vn[t2][8 * q + 2] = bflo(r.y); vn[t2][8 * q + 3] = bfhi(r.y); vn[t2][8 * q + 4] = bflo(r.z); vn[t2][8 * q + 5] = bfhi(r.z); vn[t2][8 * q + 6] = bflo(r.w); vn[t2][8 * q + 7] = bfhi(r.w); }
#pragma unroll
            for (int ks = 0; ks < 8; ++ks) vn[t2] = __builtin_amdgcn_mfma_f32_32x32x16_bf16(*(LAS const bf16x8*)(R + RA_W + (t2 * 8 + ks) * 1024), Sb[ks], vn[t2], 0, 0, 0);
          }
          bf16x8 vb[4];
#pragma unroll
          for (int ks = 0; ks < 4; ++ks) { const int t2 = ks >> 1, o = (ks & 1) * 8; u32x4 w;
            w.x = cvt_pk_bf16(vn[t2][o], vn[t2][o + 1]); w.y = cvt_pk_bf16(vn[t2][o + 2], vn[t2][o + 3]); w.z = cvt_pk_bf16(vn[t2][o + 4], vn[t2][o + 5]); w.w = cvt_pk_bf16(vn[t2][o + 6], vn[t2][o + 7]);
            vb[ks] = __builtin_bit_cast(bf16x8, w); }
          f32x16 oo[2];
#pragma unroll
          for (int t2 = 0; t2 < 2; ++t2) {
            oo[t2] = f32x16{};
#pragma unroll
            for (int ks = 0; ks < 8; ++ks) oo[t2] = __builtin_amdgcn_mfma_f32_32x32x16_bf16(*(LAS const bf16x8*)(R + RA_QG + (t2 * 8 + ks) * 1024), Sb[ks], oo[t2], 0, 0, 0);
          }
#pragma unroll
          for (int ks = 0; ks < 2; ++ks) oo[0] = __builtin_amdgcn_mfma_f32_32x32x16_bf16(*(LAS const bf16x8*)(R + RA_ATT + ks * 1024), vb[ks], oo[0], 0, 0, 0);
#pragma unroll
          for (int ks = 0; ks < 4; ++ks) oo[1] = __builtin_amdgcn_mfma_f32_32x32x16_bf16(*(LAS const bf16x8*)(R + RA_ATT + (2 + ks) * 1024), vb[ks], oo[1], 0, 0, 0);
#pragma unroll
          for (int kt = 0; kt < 4; ++kt) {
            S[kt] = S[kt] * egl;
#pragma unroll
            for (int ks = 0; ks < 4; ++ks) S[kt] = __builtin_amdgcn_mfma_f32_32x32x16_bf16(*(LAS const bf16x8*)(R + RA_KT + (kt * 4 + ks) * 1024), vb[ks], S[kt], 0, 0, 0);
          }
          LAS char* ox = OX + (c & 1) * 16384 + (vs * 32 + r32) * 2;
#pragma unroll
          for (int t2 = 0; t2 < 2; ++t2)
#pragma unroll
            for (int r = 0; r < 16; ++r) *(LAS bf16_t*)(ox + (32 * t2 + crow(r, hi)) * 256) = f2bf(oo[t2][r]);
        }
      }
    }
  }
}

constexpr int NPHASE = 15;
__global__ void __launch_bounds__(NTHR, 2) yoco_fwd(Params p, int lo, int hi) {
  extern __shared__ __attribute__((aligned(16))) char smem_raw[];
  LAS char* lds = (LAS char*)smem_raw;
  const int bid = blockIdx.x, nblk = gridDim.x;
  LAS unsigned* xbw = (LAS unsigned*)(lds + LDS_BYTES - 16);
  if (threadIdx.x == 0) { xbw[0] = 0u; xbw[1] = 0u; xbw[2] = 0u; xbw[3] = 0u; }
  __syncthreads();
  XcdBarrier bar; bar.bar = (unsigned*)(p.ws + OFF_CTRL); bar.x = 0; bar.st = (volatile LAS unsigned*)xbw;
  if (hi - lo > 1) bar = xcd_barrier_post((unsigned*)(p.ws + OFF_CTRL), (volatile LAS unsigned*)xbw);
#ifndef PROBE_DOUBLE
#define PROBE_DOUBLE -1
#endif
#define PH(k) if (lo <= (k) && (k) < hi)
#define SEAM(k) if (lo <= (k) && (k) + 1 < hi) xcd_barrier(bar)
  PH(0) phase_prep(p, bid, nblk);
#if PROBE_DOUBLE == 0
  PH(0) { __syncthreads(); phase_prep(p, bid, nblk); }
#endif
  SEAM(0);
  PH(1) phase_gemm_inA(p, lds, bid, nblk);
#if PROBE_DOUBLE == 1
  PH(1) phase_gemm_inA(p, lds, bid, nblk);
#endif
  SEAM(1);
  PH(2) phase_gdn_prep(p, lds, bid, nblk);
#if PROBE_DOUBLE == 20
  PH(2) phase_gdn_prep(p, lds, bid, nblk);
#endif
  SEAM(2);
  PH(2) { if (bid < 48) phase_gdn_scan(p, lds, bid, nblk); else phase_memattn(p, lds, bid - 48, nblk - 48, 0); }
#if PROBE_DOUBLE == 21
  PH(2) { if (bid < 48) phase_gdn_scan(p, lds, bid, nblk); }
#endif
  SEAM(2);
  PH(3) phase_gemm_out(p, lds, bid, nblk, 0);
#if PROBE_DOUBLE == 3
  PH(3) phase_gemm_out(p, lds, bid, nblk, 0);
#endif
  SEAM(3);
  PH(4) phase_norm_route(p, lds, bid, nblk, 0);
  SEAM(4);
  PH(5) phase_moe1(p, lds, bid, nblk, 0);
#if PROBE_DOUBLE == 5
  PH(5) phase_moe1(p, lds, bid, nblk, 0);
#endif
  SEAM(5);
  PH(6) phase_moe2(p, lds, bid, nblk, 0);
#if PROBE_DOUBLE == 6
  PH(6) phase_moe2(p, lds, bid, nblk, 0);
#endif
  SEAM(6);
  PH(7) phase_combine<false>(p, bid, nblk);
  SEAM(7);
  PH(8) phase_gemm_inB(p, lds, bid, nblk);
#if PROBE_DOUBLE == 8
  PH(8) phase_gemm_inB(p, lds, bid, nblk);
#endif
  SEAM(8);
#if PROBE_DOUBLE == 9
  PH(9) { phase_sb_attn(p, lds, bid, nblk, true); }
#endif
  PH(9) { phase_sb_attn(p, lds, bid, nblk); phase_memattn(p, lds, bid, nblk, 1); }
#if PROBE_DOUBLE == 91
  PH(9) { phase_memattn(p, lds, bid, nblk, 1); }
#endif
  SEAM(9);
  PH(10) phase_gemm_out(p, lds, bid, nblk, 1);
  SEAM(10);
  PH(11) phase_norm_route(p, lds, bid, nblk, 1);
  SEAM(11);
  PH(12) phase_moe1(p, lds, bid, nblk, 1);
  SEAM(12);
  PH(13) phase_moe2(p, lds, bid, nblk, 1);
  SEAM(13);
  PH(14) phase_combine<true>(p, bid, nblk);
#undef PH
#undef SEAM
}

#ifndef N_LAUNCH_SPLIT
#define N_LAUNCH_SPLIT 0
#endif

extern "C" void kernel_launch(void* const* d_in, const int* in_sizes, int n_in, void* d_out, int out_size, void* d_ws, size_t ws_size, hipStream_t stream) {
  (void)in_sizes; (void)n_in; (void)out_size;
  if (ws_size < WS_NEED) return;
  static int grid = 0;
  if (!grid) {
    if (hipFuncSetAttribute((const void*)yoco_fwd, hipFuncAttributeMaxDynamicSharedMemorySize, LDS_BYTES) != hipSuccess) { grid = -1; return; }
    int dev = 0, cus = 0; hipGetDevice(&dev); hipDeviceGetAttribute(&cus, hipDeviceAttributeMultiprocessorCount, dev);
    int per_cu = 0; hipOccupancyMaxActiveBlocksPerMultiprocessor(&per_cu, (const void*)yoco_fwd, NTHR, LDS_BYTES);
    grid = (per_cu >= 1) ? cus : -1;
  }
  if (grid <= 0) return;
  Params p{};
  const float** pf = (const float**)&p;
  for (int i = 0; i < 25; ++i) pf[i] = (const float*)d_in[i];
  p.out = (float*)d_out; p.ws = (char*)d_ws;
  hipMemsetAsync(d_ws, 0, 65536, stream);
#if N_LAUNCH_SPLIT
  for (int k = 0; k < NPHASE; ++k) hipLaunchKernelGGL(yoco_fwd, dim3(grid), dim3(NTHR), LDS_BYTES, stream, p, k, k + 1);
#else
  hipLaunchKernelGGL(yoco_fwd, dim3(grid), dim3(NTHR), LDS_BYTES, stream, p, 0, NPHASE);
#endif
}
```

```cpp
#include <hip/hip_runtime.h>
#include <stdint.h>
#include <stddef.h>

#define LAS __attribute__((address_space(3)))
typedef unsigned short bf16_t;
typedef short bf16x8 __attribute__((ext_vector_type(8)));
typedef float f32x4 __attribute__((ext_vector_type(4)));
typedef float f32x16 __attribute__((ext_vector_type(16)));
typedef unsigned u32x4 __attribute__((ext_vector_type(4)));
typedef unsigned u32x2 __attribute__((ext_vector_type(2)));

constexpr int NTOK = 32768, DM = 1024, SEQ = 4096, NBATCH = 8, MEMLEN = 256, NMEMROW = NBATCH * MEMLEN;
constexpr int LDP = 3392;
constexpr int PC_Q = 0, PC_MQ = 768, PC_K = 1024, PC_V = 1792, PC_GATE = 2560, PC_BA = 3328;
constexpr int NIN_A = 3584;
constexpr int NIN_B = 2560;
constexpr float EPS = 1e-6f;
constexpr float LOG2E = 1.4426950408889634f;
constexpr int NTHR = 512;

constexpr size_t OFF_CTRL  = 0;
constexpr size_t OFF_RSTD  = 65536;
constexpr size_t OFF_MRSTD = OFF_RSTD + (size_t)NTOK * 4;
constexpr size_t OFF_CW    = OFF_MRSTD + 8192;
constexpr size_t OFF_LIST  = OFF_CW + 65536 * 4;
constexpr size_t OFF_MEMKV = OFF_LIST + (size_t)16 * NTOK * 4;
constexpr size_t OFF_WR    = OFF_MEMKV + (size_t)2 * 2048 * 512 * 2;
constexpr size_t OFF_EGL   = OFF_WR + (size_t)2 * 20 * 1024 * 4;
constexpr size_t OFF_W     = 8u << 20;
constexpr size_t W_AIN  = 0;
constexpr size_t W_AOUT = W_AIN + (size_t)NIN_A * 1024 * 2;
constexpr size_t W_BIN  = W_AOUT + (size_t)1024 * 1024 * 2;
constexpr size_t W_BOUT = W_BIN + (size_t)NIN_B * 1024 * 2;
constexpr size_t W_MEM  = W_BOUT + (size_t)1024 * 1024 * 2;
constexpr size_t W_13   = W_MEM + (size_t)2 * 512 * 1024 * 2;
constexpr size_t W_2    = W_13 + (size_t)32 * 512 * 1024 * 2;
constexpr size_t W_END  = W_2 + (size_t)32 * 1024 * 256 * 2;
constexpr size_t OFF_P  = OFF_W + W_END;
constexpr size_t OFF_G  = OFF_P + (size_t)NTOK * LDP * 2;
constexpr size_t G_MIX  = 0;
constexpr size_t G_HB   = (size_t)128 << 20;
constexpr size_t WS_NEED = OFF_G + ((size_t)216 << 20);
static_assert(OFF_EGL + 3072 * 4 <= OFF_W, "small region");
static_assert(WS_NEED <= ((size_t)512 << 20), "workspace");
constexpr int CTRL_CNT = 4096;

constexpr int LDS_BYTES = 147456;

struct Params {
  const float *x, *mem, *a_norm, *a_w_in, *a_conv, *a_log, *a_dt_bias, *a_out_gain, *a_w_out, *kv_norm, *w_kv,
      *b_norm, *b_w_in, *b_w_out, *mem_norm, *w_mem_kv, *ffn_norm, *w_group, *b_group, *w_router, *b_router,
      *w1, *w3, *w2, *final_norm;
  float* out; char* ws;
};

typedef float f32x2_t __attribute__((ext_vector_type(2))); typedef __bf16 bf16x2_t __attribute__((ext_vector_type(2)));
__device__ __forceinline__ unsigned cvt_pk_bf16(float lo, float hi) { const f32x2_t v = {lo, hi}; const bf16x2_t b = __builtin_convertvector(v, bf16x2_t); return __builtin_bit_cast(unsigned, b); }
__device__ __forceinline__ bf16_t f2bf(float f) { return (bf16_t)(cvt_pk_bf16(f, 0.f) & 0xffffu); }
__device__ __forceinline__ float bf2f(bf16_t b) { return __uint_as_float(((unsigned)b) << 16); }
__device__ __forceinline__ float bflo(unsigned u) { return __uint_as_float(u << 16); }
__device__ __forceinline__ float bfhi(unsigned u) { return __uint_as_float(u & 0xffff0000u); }
__device__ __forceinline__ float wave_sum(float v) {
#pragma unroll
  for (int o = 32; o >= 1; o >>= 1) v += __shfl_xor(v, o);
  return v;
}
__device__ __forceinline__ float sigmoidf_(float x) { return __builtin_amdgcn_rcpf(1.f + __expf(-x)); }
__device__ __forceinline__ float siluf_(float x) { return x * __builtin_amdgcn_rcpf(1.f + __expf(-x)); }
__device__ __forceinline__ float softplusf_(float x) { return fmaxf(x, 0.f) + log1pf(__expf(-fabsf(x))); }

#define XB_TMO      128
#define XB_XCNT(j)  (256  + 64 * (j))
#define XB_XSUB(j)  (1280 + 64 * (j))
#define XB_XGEN(j)  (2304 + 64 * (j))
#define XB_TOP      3328
#define XB_TOPGEN   3392
#define XCD_BAR_WORDS 3456
#define XB_SPIN_CAP (1u << 22)
__device__ __forceinline__ unsigned xb_ld(unsigned* p)              { return __hip_atomic_load(p, __ATOMIC_RELAXED, __HIP_MEMORY_SCOPE_AGENT); }
__device__ __forceinline__ unsigned xb_add(unsigned* p, unsigned v) { return __hip_atomic_fetch_add(p, v, __ATOMIC_RELAXED, __HIP_MEMORY_SCOPE_AGENT); }
__device__ __forceinline__ unsigned xb_xcc_id() { return (unsigned)__builtin_amdgcn_s_getreg((3 << 11) | 20) & 0xFu; }
#define XB_SPIN(cond, bar) do { unsigned _sp = 0; while (cond) { __builtin_amdgcn_s_sleep(1); \
    if ((++_sp & 255u) == 0u) { if (xb_ld(&(bar)[XB_TMO])) break; if (_sp > XB_SPIN_CAP) { atomicAdd(&(bar)[XB_TMO], 1u); break; } } } } while (0)
struct XcdBarrier { unsigned* bar; unsigned x; volatile LAS unsigned* st; };
__device__ __forceinline__ XcdBarrier xcd_barrier_post(unsigned* bar, volatile LAS unsigned* st) {
    XcdBarrier b; b.bar = bar; b.x = xb_xcc_id(); b.st = st;
    if (threadIdx.x == 0) (void)xb_add(&bar[XB_XCNT(b.x)], 1u);
    return b;
}
__device__ __forceinline__ void xcd_barrier_complete(unsigned* bar, unsigned x, unsigned& nloc, unsigned& nx) {
    const unsigned G = gridDim.x * gridDim.y * gridDim.z;
    unsigned sum, cnt, mine, sp = 0u;
    for (;;) {
        sum = 0u; cnt = 0u; mine = 0u;
#pragma unroll
        for (unsigned j = 0; j < 16; ++j) { const unsigned c = xb_ld(&bar[XB_XCNT(j)]); sum += c; cnt += (c > 0u) ? 1u : 0u; mine = (j == x) ? c : mine; }
        if (sum == G) break;
        __builtin_amdgcn_s_sleep(1);
        if ((++sp & 255u) == 0u) { if (xb_ld(&bar[XB_TMO])) break; if (sp > XB_SPIN_CAP) { atomicAdd(&bar[XB_TMO], 1u); break; } }
    }
    nloc = mine > 0u ? mine : 1u; nx = cnt > 0u ? cnt : 1u;
}
__device__ __forceinline__ void xcd_barrier(const XcdBarrier& b) {
    asm volatile("s_waitcnt vmcnt(0)" ::: "memory");
    __syncthreads();
    if (threadIdx.x == 0) {
        unsigned* bar = b.bar;
        __builtin_amdgcn_s_waitcnt(0);
        unsigned nloc = b.st[0], nx = b.st[1];
        if (nloc == 0u) { xcd_barrier_complete(bar, b.x, nloc, nx); b.st[0] = nloc; b.st[1] = nx; }
        const unsigned old = xb_add(&bar[XB_XSUB(b.x)], 1u);
        const unsigned gen = old / nloc;
        if (old + 1u == (gen + 1u) * nloc) {
            __builtin_amdgcn_fence(__ATOMIC_RELEASE, "agent");
            asm volatile("s_waitcnt vmcnt(0)" ::: "memory");
            const unsigned og = xb_add(&bar[XB_TOP], 1u);
            const unsigned tg = og / nx;
            if (og + 1u == (tg + 1u) * nx) xb_add(&bar[XB_TOPGEN], 1u);
            else XB_SPIN(xb_ld(&bar[XB_TOPGEN]) == tg, bar);
            __builtin_amdgcn_fence(__ATOMIC_ACQUIRE, "agent");
            xb_add(&bar[XB_XGEN(b.x)], 1u);
            asm volatile("s_waitcnt vmcnt(0)" ::: "memory");
        } else {
            XB_SPIN(xb_ld(&bar[XB_XGEN(b.x)]) == gen, bar);
            __builtin_amdgcn_fence(__ATOMIC_ACQUIRE, "agent");
            asm volatile("s_waitcnt vmcnt(0)" ::: "memory");
        }
    }
    __syncthreads();
}

__device__ __forceinline__ void cvt_rows(bf16_t* dst, int nrows_dst, int K, const float* src, int src_ld, int col0, int nrows_src,
                         const float* gain, float scale, int gtid, int gthreads) {
  const int items = nrows_dst * (K >> 3);
  for (int it = gtid; it < items; it += gthreads) {
    const int r = it % nrows_dst, k8 = it / nrows_dst;
    float v[8];
#pragma unroll
    for (int j = 0; j < 8; ++j) {
      const int k = k8 * 8 + j;
      v[j] = (r < nrows_src) ? src[(size_t)k * src_ld + col0 + r] * (gain ? gain[k] : 1.f) * scale : 0.f;
    }
    u32x4 w; w.x = cvt_pk_bf16(v[0], v[1]); w.y = cvt_pk_bf16(v[2], v[3]); w.z = cvt_pk_bf16(v[4], v[5]); w.w = cvt_pk_bf16(v[6], v[7]);
    *(u32x4*)(dst + (size_t)r * K + k8 * 8) = w;
  }
}

__device__ __forceinline__ void rows_to_bf16(const float* src, bf16_t* dst, float* rstd, int nrows, int gwave, int nwaves, int lane) {
  for (int r = gwave; r < nrows; r += nwaves) {
    const float* s = src + (size_t)r * DM; float ss = 0.f;
#pragma unroll
    for (int i = 0; i < 4; ++i) {
      const f32x4 v = *(const f32x4*)(s + i * 256 + lane * 4);
      ss += v[0] * v[0] + v[1] * v[1] + v[2] * v[2] + v[3] * v[3];
      u32x2 w; w.x = cvt_pk_bf16(v[0], v[1]); w.y = cvt_pk_bf16(v[2], v[3]);
      *(u32x2*)(dst + (size_t)r * DM + i * 256 + lane * 4) = w;
    }
    ss = wave_sum(ss);
    if (lane == 0) rstd[r] = rsqrtf(ss * (1.f / DM) + EPS);
  }
}

template <bool LATE>
__device__ __forceinline__ void phase_prep(const Params& p, int bid, int nblk) {
  const int tid = threadIdx.x, gtid = bid * NTHR + tid, gthreads = nblk * NTHR, lane = tid & 63;
  char* ws = p.ws; bf16_t* W = (bf16_t*)(ws + OFF_W);
  if (!LATE) {
  bf16_t* wa = (bf16_t*)((char*)W + W_AIN);
  cvt_rows(wa + (size_t)PC_Q * 1024, 768, 1024, p.a_w_in, 3340, 0, 768, p.a_norm, 1.f, gtid, gthreads);
  cvt_rows(wa + (size_t)PC_MQ * 1024, 256, 1024, p.a_w_in, 3340, 3084, 256, p.a_norm, 0.125f * LOG2E, gtid, gthreads);
  cvt_rows(wa + (size_t)PC_K * 1024, 768, 1024, p.a_w_in, 3340, 768, 768, p.a_norm, 1.f, gtid, gthreads);
  cvt_rows(wa + (size_t)PC_V * 1024, 768, 1024, p.a_w_in, 3340, 1536, 768, p.a_norm, 1.f, gtid, gthreads);
  cvt_rows(wa + (size_t)PC_GATE * 1024, 768, 1024, p.a_w_in, 3340, 2304, 768, p.a_norm, 1.f, gtid, gthreads);
  cvt_rows(wa + (size_t)PC_BA * 1024, NIN_A - PC_BA, 1024, p.a_w_in, 3340, 3072, 12, p.a_norm, 1.f, gtid, gthreads);
  cvt_rows((bf16_t*)((char*)W + W_AOUT), 1024, 1024, p.a_w_out, 1024, 0, 1024, nullptr, 1.f, gtid, gthreads);
  for (int l = 0; l < 2; ++l)
    cvt_rows((bf16_t*)((char*)W + W_MEM) + (size_t)l * 512 * 1024, 512, 1024, p.w_mem_kv + (size_t)l * 1024 * 512, 512, 0, 512, p.mem_norm + l * 1024, 1.f, gtid, gthreads);
  } else {
  bf16_t* wb = (bf16_t*)((char*)W + W_BIN);
  cvt_rows(wb + (size_t)PC_Q * 1024, 768, 1024, p.b_w_in, 1024, 0, 768, p.b_norm, 0.125f * LOG2E, gtid, gthreads);
  cvt_rows(wb + (size_t)PC_MQ * 1024, 256, 1024, p.b_w_in, 1024, 768, 256, p.b_norm, 0.125f * LOG2E, gtid, gthreads);
  cvt_rows(wb + (size_t)PC_K * 1024, 768, 1024, p.w_kv, 1536, 0, 768, p.kv_norm, 1.f, gtid, gthreads);
  cvt_rows(wb + (size_t)PC_V * 1024, 768, 1024, p.w_kv, 1536, 768, 768, p.kv_norm, 1.f, gtid, gthreads);
  cvt_rows((bf16_t*)((char*)W + W_BOUT), 1024, 1024, p.b_w_out, 1024, 0, 1024, nullptr, 1.f, gtid, gthreads);
  {
    bf16_t* w13 = (bf16_t*)((char*)W + W_13);
    const int items = 32 * 512 * 128;
    for (int it = gtid; it < items; it += gthreads) {
      const int le = it >> 16, rem = it & 65535, r = rem & 511, k8 = rem >> 9;
      const int u = r >> 8, which = (r >> 7) & 1, j = r & 127, l = le >> 4;
      const float* src = (which ? p.w3 : p.w1) + (size_t)le * 1024 * 256 + u * 128 + j;
      const float* g = p.ffn_norm + l * 1024;
      float v[8];
#pragma unroll
      for (int q = 0; q < 8; ++q) { const int k = k8 * 8 + q; v[q] = src[(size_t)k * 256] * g[k]; }
      u32x4 w; w.x = cvt_pk_bf16(v[0], v[1]); w.y = cvt_pk_bf16(v[2], v[3]); w.z = cvt_pk_bf16(v[4], v[5]); w.w = cvt_pk_bf16(v[6], v[7]);
      *(u32x4*)(w13 + ((size_t)le * 512 + r) * 1024 + k8 * 8) = w;
    }
    bf16_t* w2t = (bf16_t*)((char*)W + W_2);
    const int items2 = 32 * 1024 * 32;
    for (int it = gtid; it < items2; it += gthreads) {
      const int le = it >> 15, rem = it & 32767, n = rem & 1023, k8 = rem >> 10;
      const float* src = p.w2 + (size_t)le * 256 * 1024 + n;
      float v[8];
#pragma unroll
      for (int q = 0; q < 8; ++q) v[q] = src[(size_t)(k8 * 8 + q) * 1024];
      u32x4 w; w.x = cvt_pk_bf16(v[0], v[1]); w.y = cvt_pk_bf16(v[2], v[3]); w.z = cvt_pk_bf16(v[4], v[5]); w.w = cvt_pk_bf16(v[6], v[7]);
      *(u32x4*)(w2t + ((size_t)le * 1024 + n) * 256 + k8 * 8) = w;
    }
  }
  }
  if (!LATE) {
  {
    float* wr = (float*)(ws + OFF_WR);
    for (int it = gtid; it < 2 * 20 * 1024; it += gthreads) {
      const int l = it / 20480, rem = it % 20480, j = rem >> 10, k = rem & 1023;
      const float w = (j < 4) ? p.w_group[((size_t)l * 1024 + k) * 4 + j] : p.w_router[((size_t)l * 1024 + k) * 16 + (j - 4)];
      wr[it] = w * p.ffn_norm[l * 1024 + k];
    }
  }
  const int gwave = gtid >> 6, nwaves = gthreads >> 6;
  rows_to_bf16(p.x, (bf16_t*)p.out, (float*)(ws + OFF_RSTD), NTOK, gwave, nwaves, lane);
  rows_to_bf16(p.mem, (bf16_t*)((char*)p.out + ((size_t)64 << 20)), (float*)(ws + OFF_MRSTD), NMEMROW, gwave, nwaves, lane);
  }
}

namespace g8 {
constexpr int BM = 256, BK = 64, HALF = 128, HTB = HALF * BK * 2, STAGE_BYTES = 8 * HTB, NXCD = 8, WGM = 8;
__host__ __device__ __forceinline__ int lds_byte(int r, int c) { const int st = (r >> 4) * 2 + (c >> 5), rr = r & 15, cc = c & 31, ob = rr * 64 + cc * 2; return st * 1024 + (ob ^ (((ob >> 9) & 1) << 5)); }
__host__ __device__ __forceinline__ void stage_rc(int b, int& R, int& C) { const int st = b / 1024, sb = b % 1024, swz = sb ^ (((sb >> 9) & 1) << 5); R = (st >> 1) * 16 + swz / 64; C = (st & 1) * 32 + (swz % 64) / 2; }
__host__ __device__ __forceinline__ int perm32(int rho) { const int n = rho >> 4, i = rho & 15; return 8 * (i >> 2) + 4 * n + (i & 3); }

struct Unit { const char* A; const char* B; const int* list; int row0, nvalid, pm, pn, aux; };

struct DenseOrder {
  const char* A; const char* Bt; int K; int nM, nN, nwg, G, c;
  __device__ __forceinline__ void init(const void* A_, const void* Bt_, int K_, int M, int N, int G_, int c_) { A = (const char*)A_; Bt = (const char*)Bt_; K = K_; nM = M / BM; nN = N / BM; nwg = nM * nN; G = G_; c = c_; }
  __device__ __forceinline__ bool next(int i, Unit& u) const {
    const long L = (long)i * G + c; if (L >= nwg) return false;
    int wgid = (int)L; { const int q = nwg / NXCD, r = nwg % NXCD, xcd = wgid % NXCD, off = wgid / NXCD; wgid = (xcd < r ? xcd * (q + 1) : r * (q + 1) + (xcd - r) * q) + off; }
    const int nig = WGM * nN, gid = wgid / nig, fm = gid * WGM, gsz = (nM - fm) < WGM ? (nM - fm) : WGM;
    u.pm = fm + ((wgid % nig) % gsz); u.pn = (wgid % nig) / gsz;
    u.A = A; u.B = Bt + (size_t)u.pn * BM * K * 2; u.list = nullptr; u.row0 = u.pm * BM; u.nvalid = BM; u.aux = 0; return true;
  }
};

template <class Epi, class Sched, int SHIFT>
__device__ __forceinline__ void gemm_phase(LAS unsigned char* lds, const int K, const int lda, const Sched& S, const Epi& E) {
    const int tid = threadIdx.x, wid = __builtin_amdgcn_readfirstlane(tid >> 6), lane = tid & 63, wr = wid >> 2, wc = wid & 3, fr = lane & 15, fq = lane >> 4;
    const int nt = K / BK;
    int RA[2], CA[2]; unsigned voffB[2];
#pragma unroll
    for (int i = 0; i < 2; ++i) { int R, C; stage_rc(tid * 16 + i * 8192, R, C); const int Rb = Epi::PERM ? ((R & ~31) + perm32(R & 31)) : R;
        RA[i] = R; CA[i] = C; voffB[i] = (unsigned)(Rb * K + C) * 2u; }
    const size_t kstep = (size_t)(BK * 2);
    const size_t hstepB = (size_t)HALF * K * 2;
    const unsigned ldsw = (unsigned)wid * 1024u;
    const int aoff = lds_byte(wr * 64 + fr, fq * 8), boff = lds_byte(wc * 32 + fr, fq * 8);
#define G8_AOFF(dst, u) do { _Pragma("unroll") for (int _h = 0; _h < 2; ++_h) _Pragma("unroll") for (int _i = 0; _i < 2; ++_i) { const int _r = _h * HALF + RA[_i]; int _ar; \
        if ((u).list) { const int _rr = _r < (u).nvalid ? _r : 0; _ar = (u).list[(u).row0 + _rr] >> SHIFT; } else _ar = (u).row0 + _r; \
        dst[_h][_i] = (unsigned)(_ar * lda + CA[_i]) * 2u; } } while (0)
#define G8_SA(b, h) (((b) * 2 + (h)) * HTB)
#define G8_SB(b, h) ((4 + (b) * 2 + (h)) * HTB)
#define G8_STAGEA(bufoff, gbase, vo, kb) do { _Pragma("unroll") for (int _i = 0; _i < 2; ++_i) \
        __builtin_amdgcn_global_load_lds((const unsigned*)((gbase) + (size_t)((vo)[_i] + (unsigned)(kb))), (LAS unsigned*)(lds + (bufoff) + ldsw + _i * 8192), 16, 0, 0); } while (0)
#define G8_STAGEB(bufoff, gbase) do { _Pragma("unroll") for (int _i = 0; _i < 2; ++_i) \
        __builtin_amdgcn_global_load_lds((const unsigned*)((const char*)(gbase) + voffB[_i]), (LAS unsigned*)(lds + (bufoff) + ldsw + _i * 8192), 16, 0, 0); } while (0)
#define G8_LDA(dst, b, h) do { _Pragma("unroll") for (int m = 0; m < 4; ++m) _Pragma("unroll") for (int k = 0; k < 2; ++k) dst[m][k] = *(const LAS bf16x8*)(lds + G8_SA(b, h) + aoff + m * 2048 + k * 1024); } while (0)
#define G8_LDB(dst, b, h) do { _Pragma("unroll") for (int n = 0; n < 2; ++n) _Pragma("unroll") for (int k = 0; k < 2; ++k) dst[n][k] = *(const LAS bf16x8*)(lds + G8_SB(b, h) + boff + n * 2048 + k * 1024); } while (0)
#define G8_MMA(ai, bj, At, Bt) do { __builtin_amdgcn_s_setprio(1); _Pragma("unroll") for (int m = 0; m < 4; ++m) _Pragma("unroll") for (int n = 0; n < 2; ++n) _Pragma("unroll") for (int k = 0; k < 2; ++k) \
        acc[ai][bj][m][n] = __builtin_amdgcn_mfma_f32_16x16x32_bf16(Bt[n][k], At[m][k], acc[ai][bj][m][n], 0, 0, 0); __builtin_amdgcn_s_setprio(0); } while (0)
#define G8_WAIT_V(n) asm volatile("s_waitcnt vmcnt(" #n ")" ::: "memory")
#define G8_WAIT_L(n) asm volatile("s_waitcnt lgkmcnt(" #n ")" ::: "memory")
#define G8_BAR __builtin_amdgcn_s_barrier()
#define G8_SCHED __builtin_amdgcn_sched_barrier(0)
    Unit cur, nxt; int ui = 0;
    if (!S.next(0, cur)) return;
    f32x4 acc[2][2][4][2];
#pragma unroll
    for (int a = 0; a < 2; ++a)
#pragma unroll
        for (int b = 0; b < 2; ++b)
#pragma unroll
            for (int m = 0; m < 4; ++m)
#pragma unroll
                for (int n = 0; n < 2; ++n) acc[a][b][m][n] = (f32x4){0.f, 0.f, 0.f, 0.f};
    bf16x8 At[4][2], B0[2][2], B1[2][2];
    unsigned aoC[2][2], aoN[2][2];
    G8_AOFF(aoC, cur);
    const char* cA = cur.A; const char* cB = cur.B;
    G8_STAGEB(G8_SB(0, 0), cB); G8_STAGEB(G8_SB(0, 1), cB + hstepB); G8_STAGEA(G8_SA(0, 0), cA, aoC[0], 0); G8_STAGEA(G8_SA(0, 1), cA, aoC[1], 0);
    if (wr == 1) G8_BAR;
    G8_WAIT_V(2); G8_BAR;
    G8_STAGEB(G8_SB(1, 0), cB + kstep); G8_STAGEA(G8_SA(1, 0), cA, aoC[0], kstep); G8_STAGEB(G8_SB(1, 1), cB + hstepB + kstep);
    G8_WAIT_V(6); G8_BAR;
    for (;;) {
        const bool has_next = S.next(ui + 1, nxt);
        const char* nA = has_next ? nxt.A : cA; const char* nB = has_next ? nxt.B : cB;
        if (has_next) { G8_AOFF(aoN, nxt); } else {
#pragma unroll
            for (int h = 0; h < 2; ++h)
#pragma unroll
                for (int i = 0; i < 2; ++i) aoN[h][i] = aoC[h][i]; }
        for (int t = 0; t < nt; t += 2) {
            const bool last = (t == nt - 2);
            const unsigned k1 = (unsigned)((t + 1) * kstep);
            const char* a2b = last ? nA : cA; const unsigned k2 = last ? 0u : (unsigned)((t + 2) * kstep), k3 = k2 + (unsigned)kstep;
            const char* b2 = last ? nB : cB + (size_t)(t + 2) * kstep; const char* b3 = b2 + kstep;
            unsigned ao2[2][2];
#pragma unroll
            for (int h = 0; h < 2; ++h)
#pragma unroll
                for (int i = 0; i < 2; ++i) ao2[h][i] = last ? aoN[h][i] : aoC[h][i];
            G8_LDB(B0, 0, 0); G8_LDB(B1, 0, 1); G8_SCHED; G8_LDA(At, 0, 0); G8_STAGEA(G8_SA(1, 1), cA, aoC[1], k1);
            G8_WAIT_V(8); G8_WAIT_L(0); G8_BAR; G8_MMA(0, 0, At, B0); G8_MMA(0, 1, At, B1); G8_BAR; G8_SCHED;
            G8_LDA(At, 0, 1); G8_STAGEB(G8_SB(0, 0), b2); G8_STAGEB(G8_SB(0, 1), b2 + hstepB); G8_STAGEA(G8_SA(0, 0), a2b, ao2[0], k2);
            G8_WAIT_V(8); G8_WAIT_L(0); G8_BAR; G8_MMA(1, 0, At, B0); G8_MMA(1, 1, At, B1); G8_BAR; G8_SCHED;
            G8_LDB(B0, 1, 0); G8_LDB(B1, 1, 1); G8_SCHED; G8_LDA(At, 1, 0); G8_STAGEA(G8_SA(0, 1), a2b, ao2[1], k2);
            G8_WAIT_V(8); G8_WAIT_L(0); G8_BAR; G8_MMA(0, 0, At, B0); G8_MMA(0, 1, At, B1); G8_BAR; G8_SCHED;
            G8_LDA(At, 1, 1); G8_STAGEB(G8_SB(1, 0), b3); G8_STAGEB(G8_SB(1, 1), b3 + hstepB); G8_STAGEA(G8_SA(1, 0), a2b, ao2[0], k3);
            G8_WAIT_V(8); G8_WAIT_L(0); G8_BAR; G8_MMA(1, 0, At, B0); G8_MMA(1, 1, At, B1); G8_BAR; G8_SCHED;
        }
        if (wr == 0) G8_BAR;
        E(acc, cur, wr, wc, fr, fq);
        if (!has_next) break;
#pragma unroll
        for (int a = 0; a < 2; ++a)
#pragma unroll
            for (int b = 0; b < 2; ++b)
#pragma unroll
                for (int m = 0; m < 4; ++m)
#pragma unroll
                    for (int n = 0; n < 2; ++n) acc[a][b][m][n] = (f32x4){0.f, 0.f, 0.f, 0.f};
        cur = nxt; cA = nA; cB = nB; ++ui;
#pragma unroll
        for (int h = 0; h < 2; ++h)
#pragma unroll
            for (int i = 0; i < 2; ++i) aoC[h][i] = aoN[h][i];
        if (wr == 1) G8_BAR;
    }
    G8_WAIT_V(0);
    G8_BAR;
#undef G8_AOFF
#undef G8_SA
#undef G8_SB
#undef G8_STAGEA
#undef G8_STAGEB
#undef G8_LDA
#undef G8_LDB
#undef G8_MMA
#undef G8_WAIT_V
#undef G8_WAIT_L
#undef G8_BAR
#undef G8_SCHED
}

struct EpiScaleBf16 {
  static constexpr bool PERM = true;
  bf16_t* C; int ldc; const float* rowscale; int ncol_store;
  __device__ __forceinline__ void operator()(const f32x4 (&acc)[2][2][4][2], const Unit& u, int wr, int wc, int fr, int fq) const {
    const int row0 = u.pm * BM + wr * 64 + fr, col0 = u.pn * BM + wc * 32 + 8 * fq;
#pragma unroll
    for (int ai = 0; ai < 2; ++ai)
#pragma unroll
      for (int m = 0; m < 4; ++m) { const int row = row0 + ai * HALF + m * 16; const float sc = rowscale[row]; bf16_t* rowp = C + (size_t)row * ldc + col0;
#pragma unroll
        for (int bj = 0; bj < 2; ++bj) { const f32x4 v0 = acc[ai][bj][m][0] * sc, v1 = acc[ai][bj][m][1] * sc;
          u32x4 w; w.x = cvt_pk_bf16(v0[0], v0[1]); w.y = cvt_pk_bf16(v0[2], v0[3]); w.z = cvt_pk_bf16(v1[0], v1[1]); w.w = cvt_pk_bf16(v1[2], v1[3]);
          if (col0 + bj * HALF < ncol_store) *(u32x4*)(rowp + bj * HALF) = w; } }
  }
};
struct EpiMem {
  static constexpr bool PERM = true; bf16_t* C; const float* rs;
  __device__ __forceinline__ void operator()(const f32x4 (&acc)[2][2][4][2], const Unit& u, int wr, int wc, int fr, int fq) const {
    const int l = u.pn >> 1; Unit v = u; v.pn = u.pn & 1;
    EpiScaleBf16 e{C + (size_t)l * 2048 * 512, 512, rs, 512}; e(acc, v, wr, wc, fr, fq); }
};
struct EpiResidF32 {
  static constexpr bool PERM = false;
  float* out; const float* resid;
  __device__ __forceinline__ void operator()(const f32x4 (&acc)[2][2][4][2], const Unit& u, int wr, int wc, int fr, int fq) const {
    const int row0 = u.pm * BM + wr * 64 + fr, col0 = u.pn * BM + wc * 32 + 4 * fq;
#pragma unroll
    for (int ai = 0; ai < 2; ++ai)
#pragma unroll
      for (int m = 0; m < 4; ++m) { const size_t base = (size_t)(row0 + ai * HALF + m * 16) * DM + col0;
#pragma unroll
        for (int bj = 0; bj < 2; ++bj)
#pragma unroll
          for (int n = 0; n < 2; ++n) { const size_t o = base + bj * HALF + n * 16; const f32x4 rv = *(const f32x4*)(resid + o); *(f32x4*)(out + o) = rv + acc[ai][bj][m][n]; } }
  }
};
struct EpiMoe1 {
  static constexpr bool PERM = true;
  bf16_t* hid; const float* rstd;
  __device__ __forceinline__ void operator()(const f32x4 (&acc)[2][2][4][2], const Unit& u, int wr, int wc, int fr, int fq) const {
#pragma unroll
    for (int ai = 0; ai < 2; ++ai)
#pragma unroll
      for (int m = 0; m < 4; ++m) { const int r = ai * HALF + wr * 64 + m * 16 + fr;
        if (r < u.nvalid) { const int slot = u.list[u.row0 + r]; const float rs = rstd[slot >> 1];
          float h[8];
#pragma unroll
          for (int n = 0; n < 2; ++n)
#pragma unroll
            for (int j = 0; j < 4; ++j) { const float a = acc[ai][0][m][n][j] * rs, b = acc[ai][1][m][n][j] * rs; h[4 * n + j] = siluf_(a) * b; }
          u32x4 w; w.x = cvt_pk_bf16(h[0], h[1]); w.y = cvt_pk_bf16(h[2], h[3]); w.z = cvt_pk_bf16(h[4], h[5]); w.w = cvt_pk_bf16(h[6], h[7]);
          *(u32x4*)(hid + (size_t)slot * 256 + u.pn * 128 + wc * 32 + 8 * fq) = w; } }
  }
};
struct EpiMoe2 {
  static constexpr bool PERM = true;
  bf16_t* y; const float* cw;
  __device__ __forceinline__ void operator()(const f32x4 (&acc)[2][2][4][2], const Unit& u, int wr, int wc, int fr, int fq) const {
#pragma unroll
    for (int ai = 0; ai < 2; ++ai)
#pragma unroll
      for (int m = 0; m < 4; ++m) { const int r = ai * HALF + wr * 64 + m * 16 + fr;
        if (r < u.nvalid) { const int slot = u.list[u.row0 + r]; const float c = cw[slot];
          bf16_t* yp = y + (size_t)slot * DM + u.pn * BM + wc * 32 + 8 * fq;
#pragma unroll
          for (int bj = 0; bj < 2; ++bj) { const f32x4 v0 = acc[ai][bj][m][0] * c, v1 = acc[ai][bj][m][1] * c;
            u32x4 w; w.x = cvt_pk_bf16(v0[0], v0[1]); w.y = cvt_pk_bf16(v0[2], v0[3]); w.z = cvt_pk_bf16(v1[0], v1[1]); w.w = cvt_pk_bf16(v1[2], v1[3]);
            *(u32x4*)(yp + bj * HALF) = w; } } }
  }
};

template <int NPN>
struct MoeOrder {
  const char* A; const char* Wt; const int* lists; int cn[16]; int G, c; size_t wstride_e, wstride_pn;
  __device__ __forceinline__ bool next(int i, Unit& u) const {
    int L = i * G + c; bool found = false;
#pragma unroll
    for (int e = 0; e < 16; ++e) { const int nu = ((cn[e] + 255) >> 8) * NPN;
      if (!found) { if (L < nu) { found = true; const int tile = L / NPN, pn = L % NPN; u.pm = tile; u.pn = pn; u.aux = e; u.A = A; u.B = Wt + (size_t)e * wstride_e + (size_t)pn * wstride_pn;
          u.list = lists + (size_t)e * NTOK; u.row0 = tile * 256; u.nvalid = (cn[e] - tile * 256) < 256 ? (cn[e] - tile * 256) : 256; } else L -= nu; } }
    return found;
  }
};
}

__device__ __forceinline__ void phase_gemm_inA(const Params& p, LAS char* lds, int bid, int nblk) {
  char* ws = p.ws;
  const bf16_t* hb = (const bf16_t*)p.out; const bf16_t* memb = (const bf16_t*)((char*)p.out + ((size_t)64 << 20));
  const bf16_t* wa = (const bf16_t*)(ws + OFF_W + W_AIN); const bf16_t* wm = (const bf16_t*)(ws + OFF_W + W_MEM);
  { g8::DenseOrder S; S.init(hb, wa, 1024, NTOK, NIN_A, nblk, bid);
    g8::EpiScaleBf16 E{(bf16_t*)(ws + OFF_P), LDP, (const float*)(ws + OFF_RSTD), LDP};
    g8::gemm_phase<g8::EpiScaleBf16, g8::DenseOrder, 0>((LAS unsigned char*)lds, 1024, DM, S, E); }
  { g8::DenseOrder S; S.init(memb, wm, 1024, NMEMROW, 1024, nblk, bid);
    g8::EpiMem E{(bf16_t*)(ws + OFF_MEMKV), (const float*)(ws + OFF_MRSTD)};
    g8::gemm_phase<g8::EpiMem, g8::DenseOrder, 0>((LAS unsigned char*)lds, 1024, DM, S, E); }
}
__device__ __forceinline__ void phase_gemm_inB(const Params& p, LAS char* lds, int bid, int nblk) {
  char* ws = p.ws;
  g8::DenseOrder S; S.init(ws + OFF_G + G_HB, ws + OFF_W + W_BIN, 1024, NTOK, NIN_B, nblk, bid);
  g8::EpiScaleBf16 E{(bf16_t*)(ws + OFF_P), LDP, (const float*)(ws + OFF_RSTD), LDP};
  g8::gemm_phase<g8::EpiScaleBf16, g8::DenseOrder, 0>((LAS unsigned char*)lds, 1024, DM, S, E);
}
__device__ __forceinline__ void phase_gemm_out(const Params& p, LAS char* lds, int bid, int nblk, int layer) {
  char* ws = p.ws;
  g8::DenseOrder S; S.init(ws + OFF_P, ws + OFF_W + (layer ? W_BOUT : W_AOUT), 1024, NTOK, 1024, nblk, bid);
  g8::EpiResidF32 E{p.out, layer ? (const float*)p.out : p.x};
  g8::gemm_phase<g8::EpiResidF32, g8::DenseOrder, 0>((LAS unsigned char*)lds, 1024, LDP, S, E);
}
__device__ __forceinline__ void phase_moe1(const Params& p, LAS char* lds, int bid, int nblk, int layer) {
  char* ws = p.ws;
  const unsigned* cnt = (const unsigned*)(ws + OFF_CTRL) + CTRL_CNT + layer * 16 * 64;
  g8::MoeOrder<2> S; S.A = ws + OFF_G + G_HB; S.Wt = ws + OFF_W + W_13 + (size_t)layer * 16 * 512 * 1024 * 2; S.lists = (const int*)(ws + OFF_LIST);
#pragma unroll
  for (int e = 0; e < 16; ++e) S.cn[e] = (int)cnt[e * 64];
  S.G = nblk; S.c = bid; S.wstride_e = (size_t)512 * 1024 * 2; S.wstride_pn = (size_t)256 * 1024 * 2;
  g8::EpiMoe1 E{(bf16_t*)(ws + OFF_P), (const float*)(ws + OFF_RSTD)};
  g8::gemm_phase<g8::EpiMoe1, g8::MoeOrder<2>, 1>((LAS unsigned char*)lds, 1024, DM, S, E);
}
__device__ __forceinline__ void phase_moe2(const Params& p, LAS char* lds, int bid, int nblk, int layer) {
  char* ws = p.ws;
  const unsigned* cnt = (const unsigned*)(ws + OFF_CTRL) + CTRL_CNT + layer * 16 * 64;
  g8::MoeOrder<4> S; S.A = ws + OFF_P; S.Wt = ws + OFF_W + W_2 + (size_t)layer * 16 * 1024 * 256 * 2; S.lists = (const int*)(ws + OFF_LIST);
#pragma unroll
  for (int e = 0; e < 16; ++e) S.cn[e] = (int)cnt[e * 64];
  S.G = nblk; S.c = bid; S.wstride_e = (size_t)1024 * 256 * 2; S.wstride_pn = (size_t)256 * 256 * 2;
  g8::EpiMoe2 E{(bf16_t*)(ws + OFF_G + G_MIX), (const float*)(ws + OFF_CW)};
  g8::gemm_phase<g8::EpiMoe2, g8::MoeOrder<4>, 0>((LAS unsigned char*)lds, 256, 256, S, E);
}


typedef float f32x2v __attribute__((ext_vector_type(2)));
__device__ __forceinline__ void phase_norm_route(const Params& p, LAS char* lds, int bid, int nblk, int layer) {
  char* ws = p.ws; const int tid = threadIdx.x, lane = tid & 63, r32 = lane & 31, hi = lane >> 5; const int w = __builtin_amdgcn_readfirstlane(tid >> 6);
  constexpr int WROW = 1028;
  LAS float* wl = (LAS float*)lds;
  LAS float* lgx = (LAS float*)(lds + 20 * WROW * 4);
  LAS float* ssx = lgx + 8 * 32 * 33;
  const float* wr = (const float*)(ws + OFF_WR) + (size_t)layer * 20480;
  __syncthreads();
  for (int i = tid; i < 20480 / 4; i += NTHR) { const int j = i >> 8, c = (i & 255) * 4; *(LAS f32x4*)(wl + j * WROW + c) = *(const f32x4*)(wr + j * 1024 + c); }
  __syncthreads();
  bf16_t* hb = (bf16_t*)(ws + OFF_G + G_HB); float* rstd = (float*)(ws + OFF_RSTD); float* cw = (float*)(ws + OFF_CW);
  unsigned* cnt = (unsigned*)(ws + OFF_CTRL) + CTRL_CNT + layer * 16 * 64; int* lists = (int*)(ws + OFF_LIST);
  const float* bg = p.b_group + layer * 4; const float* br = p.b_router + layer * 16;
  const int nn = r32 < 20 ? r32 : 19;
  for (int base = bid * 4; base < NTOK / 32; base += nblk * 4) {
    const int tile = base + (w & 3), kh = w >> 2, t0 = tile * 32;
    const float* hrow = p.out + (size_t)(t0 + r32) * DM + kh * 512 + 4 * hi;
    bf16_t* hbrow = hb + (size_t)(t0 + r32) * DM + kh * 512 + 4 * hi;
    LAS const float* wrow = wl + nn * WROW + kh * 512 + 4 * hi;
    f32x16 acc = f32x16{}; float ss = 0.f;
    for (int j0 = 0; j0 < 64; j0 += 8) {
      f32x4 hv[8];
#pragma unroll
      for (int q = 0; q < 8; ++q) hv[q] = *(const f32x4*)(hrow + (j0 + q) * 8);
#pragma unroll
      for (int q = 0; q < 8; ++q) {
        const f32x4 wv = *(LAS const f32x4*)(wrow + (j0 + q) * 8);
        ss += hv[q][0] * hv[q][0] + hv[q][1] * hv[q][1] + hv[q][2] * hv[q][2] + hv[q][3] * hv[q][3];
        u32x2 o; o.x = cvt_pk_bf16(hv[q][0], hv[q][1]); o.y = cvt_pk_bf16(hv[q][2], hv[q][3]);
        *(u32x2*)(hbrow + (j0 + q) * 8) = o;
#pragma unroll
        for (int e = 0; e < 4; ++e) acc = __builtin_amdgcn_mfma_f32_32x32x2f32(wv[e], hv[q][e], acc, 0, 0, 0);
      }
    }
    { auto sw = __builtin_amdgcn_permlane32_swap(__float_as_uint(ss), __float_as_uint(ss), false, false); ss = __uint_as_float(sw[0]) + __uint_as_float(sw[1]); }
    LAS float* lg = lgx + w * 32 * 33;
#pragma unroll
    for (int r = 0; r < 16; ++r) { const int n = (r & 3) + 8 * (r >> 2) + 4 * hi; lg[r32 * 33 + n] = acc[r]; }
    if (hi == 0) ssx[w * 32 + r32] = ss;
    __syncthreads();
    if (w < 4 && hi == 0) {
      LAS const float* la = lgx + w * 32 * 33 + r32 * 33; LAS const float* lb = lgx + (w + 4) * 32 * 33 + r32 * 33;
      const int t = t0 + r32;
      const float rs = rsqrtf((ssx[w * 32 + r32] + ssx[(w + 4) * 32 + r32]) * (1.f / DM) + EPS);
      float lgt[20];
#pragma unroll
      for (int j = 0; j < 20; ++j) lgt[j] = (la[j] + lb[j]) * rs + (j < 4 ? bg[j] : br[j - 4]);
      int gs = 0; float gm = lgt[0];
#pragma unroll
      for (int j = 1; j < 4; ++j) if (lgt[j] > gm) { gm = lgt[j]; gs = j; }
      float den = 0.f;
#pragma unroll
      for (int j = 0; j < 4; ++j) den += __expf(lgt[j] - gm);
      const float pg = 1.f / den;
      float el[4];
#pragma unroll
      for (int j = 0; j < 4; ++j) el[j] = gs == 0 ? lgt[4 + j] : gs == 1 ? lgt[8 + j] : gs == 2 ? lgt[12 + j] : lgt[16 + j];
      int i1 = 0; float m1 = el[0];
#pragma unroll
      for (int j = 1; j < 4; ++j) if (el[j] > m1) { m1 = el[j]; i1 = j; }
      int i2 = -1; float m2 = -INFINITY;
#pragma unroll
      for (int j = 0; j < 4; ++j) if (j != i1 && el[j] > m2) { m2 = el[j]; i2 = j; }
      const float e2 = __expf(m2 - m1), p1 = 1.f / (1.f + e2), p2 = e2 * p1;
      const int ex1 = gs * 4 + i1, ex2 = gs * 4 + i2;
      unsigned myc = 0u; int rk1 = 0, rk2 = 0;
      const unsigned long long lt = (1ull << r32) - 1ull;
#pragma unroll
      for (int e = 0; e < 16; ++e) {
        const unsigned long long b1 = __ballot(ex1 == e), b2 = __ballot(ex2 == e);
        const int c1 = __popcll(b1), c2 = __popcll(b2);
        if (r32 == e) myc = (unsigned)(c1 + c2);
        if (ex1 == e) rk1 = __popcll(b1 & lt);
        if (ex2 == e) rk2 = c1 + __popcll(b2 & lt);
      }
      unsigned basev = 0u;
      if (r32 < 16 && myc) basev = atomicAdd(&cnt[r32 * 64], myc);
      const unsigned q1 = (unsigned)__shfl((int)basev, ex1) + (unsigned)rk1, q2 = (unsigned)__shfl((int)basev, ex2) + (unsigned)rk2;
      lists[(size_t)ex1 * NTOK + q1] = t * 2; lists[(size_t)ex2 * NTOK + q2] = t * 2 + 1;
      cw[t * 2] = pg * p1; cw[t * 2 + 1] = pg * p2; rstd[t] = rs;
    }
    __syncthreads();
  }
}

template <bool FINAL>
__device__ __forceinline__ void phase_combine(const Params& p, int bid, int nblk) {
  char* ws = p.ws; const int tid = threadIdx.x, lane = tid & 63, w = tid >> 6;
  const bf16_t* y = (const bf16_t*)(ws + OFF_G + G_MIX); bf16_t* hb = (bf16_t*)(ws + OFF_G + G_HB); float* rstd = (float*)(ws + OFF_RSTD);
  for (int t = bid * 8 + w; t < NTOK; t += nblk * 8) {
    float* hrow = p.out + (size_t)t * DM;
    f32x4 v[4]; float ss = 0.f;
#pragma unroll
    for (int i = 0; i < 4; ++i) {
      const int c = i * 256 + lane * 4;
      v[i] = *(const f32x4*)(hrow + c);
      const u32x2 a = *(const u32x2*)(y + (size_t)(2 * t) * DM + c), b = *(const u32x2*)(y + (size_t)(2 * t + 1) * DM + c);
      v[i][0] += bflo(a.x) + bflo(b.x); v[i][1] += bfhi(a.x) + bfhi(b.x); v[i][2] += bflo(a.y) + bflo(b.y); v[i][3] += bfhi(a.y) + bfhi(b.y);
      ss += v[i][0] * v[i][0] + v[i][1] * v[i][1] + v[i][2] * v[i][2] + v[i][3] * v[i][3];
    }
    ss = wave_sum(ss);
    const float rs = rsqrtf(ss * (1.f / DM) + EPS);
#pragma unroll
    for (int i = 0; i < 4; ++i) {
      const int c = i * 256 + lane * 4;
      if (FINAL) {
        const f32x4 g = *(const f32x4*)(p.final_norm + c);
        f32x4 o; o[0] = v[i][0] * rs * g[0]; o[1] = v[i][1] * rs * g[1]; o[2] = v[i][2] * rs * g[2]; o[3] = v[i][3] * rs * g[3];
        *(f32x4*)(hrow + c) = o;
      } else {
        *(f32x4*)(hrow + c) = v[i];
        u32x2 o; o.x = cvt_pk_bf16(v[i][0], v[i][1]); o.y = cvt_pk_bf16(v[i][2], v[i][3]);
        *(u32x2*)(hb + (size_t)t * DM + c) = o;
      }
    }
    if (!FINAL && lane == 0) rstd[t] = rs;
  }
}

namespace mem {
typedef short s16x4 __attribute__((ext_vector_type(4)));
constexpr int TILEB = 8192, LDS_K = 0, LDS_V = 4 * TILEB, LDS_WS = 8 * TILEB, LDS_OST = LDS_WS + 8 * 256;
__device__ __forceinline__ s16x4 vtr(LAS const char* p) { return __builtin_bit_cast(s16x4, __builtin_amdgcn_ds_read_tr16_b64_v4i16((LAS s16x4*)p)); }
__device__ __forceinline__ void unit(bf16_t* P, const bf16_t* mkv, int b, int hd, int qb, LAS char* lds) {
  const int tid = threadIdx.x, lane = tid & 63, r32 = lane & 31, hi = lane >> 5; const int wid = __builtin_amdgcn_readfirstlane(tid >> 6);
  const bf16_t* Kh = mkv + (size_t)b * 256 * 512 + hd * 64; const bf16_t* Vh = Kh + 256;
  bf16_t* Qw = P + ((size_t)b * SEQ + qb * 256 + wid * 32) * LDP + PC_MQ + hd * 64;
  const bf16_t* ksrc = Kh + (size_t)lane * 512 + wid * 8;
  const bf16_t* vsrc = Vh + (size_t)(16 * (wid & 3) + (lane >> 2)) * 512 + (wid >> 2) * 32 + (lane & 3) * 8;
#pragma unroll
  for (int t = 0; t < 4; ++t) {
    __builtin_amdgcn_global_load_lds((const unsigned*)(ksrc + (size_t)t * 64 * 512), (LAS unsigned*)(lds + LDS_K + t * TILEB + wid * 1024), 16, 0, 0);
    __builtin_amdgcn_global_load_lds((const unsigned*)(vsrc + (size_t)t * 64 * 512), (LAS unsigned*)(lds + LDS_V + t * TILEB + wid * 1024), 16, 0, 0);
  }
  bf16x8 qr[4];
#pragma unroll
  for (int d0 = 0; d0 < 4; ++d0) qr[d0] = *(const bf16x8*)(Qw + (size_t)r32 * LDP + d0 * 16 + hi * 8);
  asm volatile("s_waitcnt vmcnt(0) lgkmcnt(0)\n\ts_barrier" ::: "memory");
  LAS const char* kp0 = lds + LDS_K + hi * 1024 + r32 * 16;
  LAS const char* vp0 = lds + LDS_V + ((lane >> 4) & 1) * 32 + (lane & 3) * 8 + (4 * hi + ((lane & 15) >> 2)) * 64;
  float mx = -INFINITY;
#pragma unroll
  for (int t = 0; t < 4; ++t) {
    f32x16 p0 = f32x16{}, p1 = f32x16{};
#pragma unroll
    for (int d0 = 0; d0 < 4; ++d0) {
      const bf16x8 k0 = *(LAS const bf16x8*)(kp0 + t * TILEB + d0 * 2048), k1 = *(LAS const bf16x8*)(kp0 + t * TILEB + d0 * 2048 + 512);
      p0 = __builtin_amdgcn_mfma_f32_32x32x16_bf16(k0, qr[d0], p0, 0, 0, 0); p1 = __builtin_amdgcn_mfma_f32_32x32x16_bf16(k1, qr[d0], p1, 0, 0, 0);
    }
#pragma unroll
    for (int r = 0; r < 16; ++r) mx = fmaxf(mx, fmaxf(p0[r], p1[r]));
  }
  { auto sw = __builtin_amdgcn_permlane32_swap(__float_as_uint(mx), __float_as_uint(mx), false, false); mx = fmaxf(__uint_as_float(sw[0]), __uint_as_float(sw[1])); }
  f32x16 o[2]; o[0] = f32x16{}; o[1] = f32x16{};
  float lsum = 0.f;
#pragma unroll
  for (int t = 0; t < 4; ++t) {
    f32x16 p0 = f32x16{}, p1 = f32x16{};
#pragma unroll
    for (int d0 = 0; d0 < 4; ++d0) {
      const bf16x8 k0 = *(LAS const bf16x8*)(kp0 + t * TILEB + d0 * 2048), k1 = *(LAS const bf16x8*)(kp0 + t * TILEB + d0 * 2048 + 512);
      p0 = __builtin_amdgcn_mfma_f32_32x32x16_bf16(k0, qr[d0], p0, 0, 0, 0); p1 = __builtin_amdgcn_mfma_f32_32x32x16_bf16(k1, qr[d0], p1, 0, 0, 0);
    }
    float a[32];
#pragma unroll
    for (int r = 0; r < 16; ++r) { a[r] = __builtin_amdgcn_exp2f(p0[r] - mx); a[16 + r] = __builtin_amdgcn_exp2f(p1[r] - mx); lsum += a[r] + a[16 + r]; }
    u32x4 pw[4];
#pragma unroll
    for (int ks = 0; ks < 4; ++ks) { pw[ks].x = cvt_pk_bf16(a[8 * ks], a[8 * ks + 1]); pw[ks].y = cvt_pk_bf16(a[8 * ks + 2], a[8 * ks + 3]); pw[ks].z = cvt_pk_bf16(a[8 * ks + 4], a[8 * ks + 5]); pw[ks].w = cvt_pk_bf16(a[8 * ks + 6], a[8 * ks + 7]); }
    LAS const char* vp = vp0 + t * TILEB;
#pragma unroll
    for (int d0 = 0; d0 < 2; ++d0)
#pragma unroll
      for (int ks = 0; ks < 4; ++ks) {
        const s16x4 lo = vtr(vp + d0 * 4096 + ks * 1024), hh = vtr(vp + d0 * 4096 + ks * 1024 + 512);
        const bf16x8 vf = (bf16x8){lo[0], lo[1], lo[2], lo[3], hh[0], hh[1], hh[2], hh[3]};
        o[d0] = __builtin_amdgcn_mfma_f32_32x32x16_bf16(__builtin_bit_cast(bf16x8, pw[ks]), vf, o[d0], 0, 0, 0);
      }
  }
  { auto sw = __builtin_amdgcn_permlane32_swap(__float_as_uint(lsum), __float_as_uint(lsum), false, false); lsum = __uint_as_float(sw[0]) + __uint_as_float(sw[1]); }
  LAS float* wsf = (LAS float*)(lds + LDS_WS) + wid * 64;
  if (hi == 0) wsf[r32] = __builtin_amdgcn_rcpf(lsum);
  asm volatile("s_waitcnt lgkmcnt(0)" ::: "memory");
  LAS bf16_t* stg = (LAS bf16_t*)(lds + LDS_OST) + wid * 2048;
#pragma unroll
  for (int r = 0; r < 16; ++r) { const int orow = (r & 3) + 8 * (r >> 2) + 4 * hi; const float il = wsf[orow];
#pragma unroll
    for (int d0 = 0; d0 < 2; ++d0) stg[orow * 64 + d0 * 32 + r32] = f2bf(o[d0][r] * il); }
  asm volatile("s_waitcnt lgkmcnt(0)" ::: "memory");
#pragma unroll
  for (int i = 0; i < 4; ++i) { const int row = i * 8 + (lane >> 3), ch = lane & 7; const u32x4 v = *(LAS const u32x4*)(stg + row * 64 + ch * 8); *(u32x4*)(Qw + (size_t)row * LDP + ch * 8) = v; }
  asm volatile("s_waitcnt vmcnt(0) lgkmcnt(0)\n\ts_barrier" ::: "memory");
}
}
__device__ __forceinline__ void phase_memattn(const Params& p, LAS char* lds, int bid, int nblk, int layer) {
  char* ws = p.ws; bf16_t* P = (bf16_t*)(ws + OFF_P);
  const bf16_t* mkv = (const bf16_t*)(ws + OFF_MEMKV) + (size_t)layer * 2048 * 512;
  for (int u = bid; u < NBATCH * 4 * 16; u += nblk) { const int bh = u >> 4, qb = u & 15; mem::unit(P, mkv, bh >> 2, bh & 3, qb, lds); }
}

namespace sb {
typedef short s16x4 __attribute__((ext_vector_type(4)));
constexpr int SLOTB = 8192, LDS_K = 0, LDS_V = 3 * SLOTB, LDS_OST = 6 * SLOTB, LDS_FLAG = LDS_OST + 8 * 4096, LDS_BYTES_SB = LDS_FLAG + 64;
__device__ __forceinline__ s16x4 vtr(LAS const char* p) { return __builtin_bit_cast(s16x4, __builtin_amdgcn_ds_read_tr16_b64_v4i16((LAS s16x4*)p)); }

__device__ __forceinline__ void unit(const bf16_t* P, bf16_t* O, int ldo, int b, int h, int qb, LAS char* lds) {
  const int tid = threadIdx.x, lane = tid & 63, r32 = lane & 31, hi = lane >> 5; const int wid = __builtin_amdgcn_readfirstlane(tid >> 6);
  const size_t rowbase = (size_t)b * SEQ; const int q0 = qb * 256;
  const bf16_t* Kh = P + rowbase * LDP + PC_K + h * 64; const bf16_t* Vh = P + rowbase * LDP + PC_V + h * 64;
  const bf16_t* Qw = P + (rowbase + q0 + wid * 32) * LDP + PC_Q + h * 64;
  const bf16_t* ksrc = Kh + (size_t)lane * LDP + wid * 8;
  const bf16_t* vsrc = Vh + (size_t)(16 * (wid & 3) + (lane >> 2)) * LDP + (wid >> 2) * 32 + (lane & 3) * 8;
  LAS char* kdst = lds + LDS_K + wid * 1024; LAS char* vdst = lds + LDS_V + wid * 1024;
#define SB_DMA(t, slot) do { __builtin_amdgcn_global_load_lds((const unsigned*)(ksrc + (size_t)(t) * 64 * LDP), (LAS unsigned*)(kdst + (slot)), 16, 0, 0); \
                             __builtin_amdgcn_global_load_lds((const unsigned*)(vsrc + (size_t)(t) * 64 * LDP), (LAS unsigned*)(vdst + (slot)), 16, 0, 0); } while (0)
  const int NT = 4 * qb + 4;
  SB_DMA(NT - 1, 0);
  bf16x8 qr[4];
#pragma unroll
  for (int d0 = 0; d0 < 4; ++d0) qr[d0] = *(const bf16x8*)(Qw + (size_t)r32 * LDP + d0 * 16 + hi * 8);
  f32x16 o[2]; o[0] = f32x16{}; o[1] = f32x16{};
  float c = 1.f;
  const int qrel = wid * 32 + r32;
  LAS const char* kp0 = lds + LDS_K + hi * 1024 + r32 * 16;
  LAS const char* vp0 = lds + LDS_V + ((lane >> 4) & 1) * 32 + (lane & 3) * 8 + (4 * hi + ((lane & 15) >> 2)) * 64;
  int slot = 0; bool wave_alive = true;
  LAS unsigned* fl = (LAS unsigned*)(lds + LDS_FLAG);
  for (int i = 0; i < NT; ++i) {
    const int t = NT - 1 - i;
    const int nslot = (slot == 2 * SLOTB) ? 0 : slot + SLOTB;
    if (t > 0) { SB_DMA(t - 1, nslot); asm volatile("s_waitcnt vmcnt(2) lgkmcnt(0)\n\ts_barrier" ::: "memory"); }
    else { asm volatile("s_waitcnt vmcnt(0) lgkmcnt(0)\n\ts_barrier" ::: "memory"); }
    if (i > 0) { const u32x4 f0 = *(LAS const u32x4*)(fl + ((i - 1) & 1) * 8), f1 = *(LAS const u32x4*)(fl + ((i - 1) & 1) * 8 + 4);
      if (__builtin_amdgcn_readfirstlane((int)(f0.x | f0.y | f0.z | f0.w | f1.x | f1.y | f1.z | f1.w)) == 0) break; }
    const int jb = t - (NT - 4);
    if (!(jb >= 0 && 64 * jb > 32 * wid + 30) && wave_alive) {
      f32x16 p0 = f32x16{}, p1 = f32x16{};
#pragma unroll
      for (int d0 = 0; d0 < 4; ++d0) {
        const bf16x8 k0 = *(LAS const bf16x8*)(kp0 + slot + d0 * 2048), k1 = *(LAS const bf16x8*)(kp0 + slot + d0 * 2048 + 512);
        p0 = __builtin_amdgcn_mfma_f32_32x32x16_bf16(k0, qr[d0], p0, 0, 0, 0);
        p1 = __builtin_amdgcn_mfma_f32_32x32x16_bf16(k1, qr[d0], p1, 0, 0, 0);
      }
      if (jb >= 0) {
        const int kb = 64 * jb + 4 * hi;
#pragma unroll
        for (int r = 0; r < 16; ++r) { const int kv = kb + (r & 3) + 8 * (r >> 2); if (kv >= qrel) p0[r] = -INFINITY; if (kv + 32 >= qrel) p1[r] = -INFINITY; }
      }
      float rr[32], be[32];
#pragma unroll
      for (int r = 0; r < 16; ++r) {
        const float e0 = __builtin_amdgcn_exp2f(p0[r]), e1 = __builtin_amdgcn_exp2f(p1[r]);
        rr[r] = __builtin_amdgcn_rcpf(1.f + e0); rr[16 + r] = __builtin_amdgcn_rcpf(1.f + e1);
        be[r] = 1.f - rr[r]; be[16 + r] = 1.f - rr[16 + r];
      }
      float OS[9]; OS[8] = 1.f;
#pragma unroll
      for (int G = 7; G >= 0; --G) { const float gp = (rr[4 * G] * rr[4 * G + 1]) * (rr[4 * G + 2] * rr[4 * G + 3]); OS[G] = OS[G + 1] * gp; }
      float cE[8];
#pragma unroll
      for (int G = 0; G < 8; ++G) {
        const float X = hi ? OS[G] : OS[G + 1], Y = OS[G + 1];
        auto sw = __builtin_amdgcn_permlane32_swap(__float_as_uint(X), __float_as_uint(Y), false, false);
        cE[G] = c * (__uint_as_float(sw[0]) * __uint_as_float(sw[1]));
      }
      { auto sw = __builtin_amdgcn_permlane32_swap(__float_as_uint(OS[0]), __float_as_uint(OS[0]), false, false); c *= __uint_as_float(sw[0]) * __uint_as_float(sw[1]); }
      float a[32];
#pragma unroll
      for (int G = 0; G < 8; ++G) {
        const float t3 = cE[G], t2 = t3 * rr[4 * G + 3], t1 = t2 * rr[4 * G + 2], t0 = t1 * rr[4 * G + 1];
        a[4 * G + 3] = be[4 * G + 3] * t3; a[4 * G + 2] = be[4 * G + 2] * t2; a[4 * G + 1] = be[4 * G + 1] * t1; a[4 * G] = be[4 * G] * t0;
      }
      u32x4 pw[4];
#pragma unroll
      for (int ks = 0; ks < 4; ++ks) { pw[ks].x = cvt_pk_bf16(a[8 * ks], a[8 * ks + 1]); pw[ks].y = cvt_pk_bf16(a[8 * ks + 2], a[8 * ks + 3]); pw[ks].z = cvt_pk_bf16(a[8 * ks + 4], a[8 * ks + 5]); pw[ks].w = cvt_pk_bf16(a[8 * ks + 6], a[8 * ks + 7]); }
      LAS const char* vp = vp0 + slot;
#pragma unroll
      for (int d0 = 0; d0 < 2; ++d0)
#pragma unroll
        for (int ks = 0; ks < 4; ++ks) {
          const s16x4 lo = vtr(vp + d0 * 4096 + ks * 1024), hh = vtr(vp + d0 * 4096 + ks * 1024 + 512);
          const bf16x8 vf = (bf16x8){lo[0], lo[1], lo[2], lo[3], hh[0], hh[1], hh[2], hh[3]};
          o[d0] = __builtin_amdgcn_mfma_f32_32x32x16_bf16(__builtin_bit_cast(bf16x8, pw[ks]), vf, o[d0], 0, 0, 0);
        }
    }
    wave_alive = __any(c != 0.f);
    if (lane == 0) fl[(i & 1) * 8 + wid] = wave_alive ? 1u : 0u;
    slot = nslot;
  }
  bf16_t* Ow = O + (rowbase + q0 + wid * 32) * ldo + h * 64;
  LAS bf16_t* stg = (LAS bf16_t*)(lds + LDS_OST) + wid * 2048;
#pragma unroll
  for (int r = 0; r < 16; ++r) { const int orow = (r & 3) + 8 * (r >> 2) + 4 * hi;
#pragma unroll
    for (int d0 = 0; d0 < 2; ++d0) stg[orow * 64 + d0 * 32 + r32] = f2bf(o[d0][r]); }
  asm volatile("s_waitcnt lgkmcnt(0)" ::: "memory");
#pragma unroll
  for (int i = 0; i < 4; ++i) { const int row = i * 8 + (lane >> 3), ch = lane & 7; const u32x4 v = *(LAS const u32x4*)(stg + row * 64 + ch * 8); *(u32x4*)(Ow + (size_t)row * ldo + ch * 8) = v; }
  asm volatile("s_waitcnt vmcnt(0) lgkmcnt(0)\n\ts_barrier" ::: "memory");
#undef SB_DMA
}
}
__device__ __forceinline__ void phase_sb_attn(const Params& p, LAS char* lds, int bid, int nblk, bool dummy = false) {
  char* ws = p.ws;
  bf16_t* P = (bf16_t*)(ws + OFF_P); bf16_t* Od = dummy ? (bf16_t*)(ws + OFF_G + G_MIX) : P; const int ldo = dummy ? DM : LDP;
  const int vcu = (nblk % 8 == 0) ? (bid % 8) * (nblk / 8) + bid / 8 : bid;
  for (int pi = vcu; pi < 96 * 8; pi += nblk) {
    const int bh = pi >> 3, s = pi & 7, b = bh / 12, h = bh % 12;
    sb::unit(P, Od, ldo, b, h, 15 - s, lds);
    sb::unit(P, Od, ldo, b, h, s, lds);
  }
}

namespace gdn {
constexpr int RA_W = 0, RA_QG = 16384, RA_KT = 32768, RA_ATT = 49152, REC_A = 55296, REC_U = 16384, REC = REC_A + REC_U;
constexpr int HALF_LDS = 58368;
constexpr float QSCALE = 0.08838834764831845f;
__device__ __forceinline__ int crow(int r, int hi) { return (r & 3) + 8 * (r >> 2) + 4 * hi; }
}
__device__ __forceinline__ void phase_gdn_prep(const Params& p, LAS char* lds, int bid, int nblk) {
  using namespace gdn;
  char* ws = p.ws; const bf16_t* P = (const bf16_t*)(ws + OFF_P); char* G = ws + OFF_G; float* EGL = (float*)(ws + OFF_EGL);
  const int nrounds = (3072 + 2 * nblk - 1) / (2 * nblk);
  for (int rd = 0; rd < nrounds; ++rd) {
    int tl = threadIdx.x; asm volatile("" : "+v"(tl));
    const int tid = tl, hb = tid >> 8, ht = tid & 255, lane = tid & 63, r32 = lane & 31, hi = lane >> 5;
    const int hw = __builtin_amdgcn_readfirstlane(ht >> 6);
    LAS char* L = lds + hb * HALF_LDS;
    LAS float* sBeta = (LAS float*)(L + REC_A); LAS float* sGc = sBeta + 64; LAS float* sEgc = sGc + 64; LAS float* sRnK = sEgc + 64; LAS float* sRnQ = sRnK + 64;
    LAS char* sQ = L; LAS char* sK = L + 17408;
    LAS float* Amat = (LAS float*)(L + RA_W);
    const int u0 = (rd * nblk + bid) * 2 + hb; const bool valid = u0 < 3072; const int u = valid ? u0 : 0;
    const int bh = u >> 6, n = u & 63, b = bh / 6, h = bh % 6; const size_t row0 = (size_t)b * SEQ + (size_t)n * 64;
    char* rec = G + (size_t)u * REC;
    __syncthreads();
    if (hw == 0) {
      const bf16_t* pr = P + (row0 + lane) * LDP + PC_BA;
      const float braw = bf2f(pr[h]), araw = bf2f(pr[6 + h]);
      const float beta = sigmoidf_(braw), g = -__expf(p.a_log[h]) * softplusf_(araw + p.a_dt_bias[h]);
      float s = g;
#pragma unroll
      for (int o = 1; o < 64; o <<= 1) { const float t = __shfl_up(s, o); if (lane >= o) s += t; }
      sBeta[lane] = beta; sGc[lane] = s; sEgc[lane] = __expf(s);
    }
    for (int i = ht; i < 67 * 48; i += 256) {
      const int rr = i / 48, cc = i % 48, part = cc >> 4, c8 = (cc & 15) * 8;
      u32x4 v = (u32x4){0u, 0u, 0u, 0u};
      if (n > 0 || rr >= 3) v = *(const u32x4*)(P + (row0 + rr - 3) * LDP + (part == 0 ? PC_Q : part == 1 ? PC_K : PC_V) + h * 128 + c8);
      *(LAS u32x4*)(L + rr * 768 + cc * 16) = v;
    }
    __syncthreads();
    float x[64], xq[64];
    {
      const int c = ht & 127; const bool isk = ht >= 128;
      {
        const int ch = (isk ? 768 : 1536) + h * 128 + c;
        const float w0 = p.a_conv[ch], w1 = p.a_conv[2304 + ch], w2 = p.a_conv[2 * 2304 + ch], w3 = p.a_conv[3 * 2304 + ch];
        LAS const char* src = L + (isk ? 256 : 512) + c * 2;
        float r0 = bf2f(*(LAS const bf16_t*)(src)), r1 = bf2f(*(LAS const bf16_t*)(src + 768)), r2 = bf2f(*(LAS const bf16_t*)(src + 2 * 768));
#pragma unroll
        for (int i = 0; i < 64; ++i) { const float r3 = bf2f(*(LAS const bf16_t*)(src + (i + 3) * 768)); x[i] = siluf_(w0 * r0 + w1 * r1 + w2 * r2 + w3 * r3); r0 = r1; r1 = r2; r2 = r3; }
      }
      if (!isk) {
        const int ch = h * 128 + c;
        const float w0 = p.a_conv[ch], w1 = p.a_conv[2304 + ch], w2 = p.a_conv[2 * 2304 + ch], w3 = p.a_conv[3 * 2304 + ch];
        LAS const char* src = L + c * 2;
        float r0 = bf2f(*(LAS const bf16_t*)(src)), r1 = bf2f(*(LAS const bf16_t*)(src + 768)), r2 = bf2f(*(LAS const bf16_t*)(src + 2 * 768));
#pragma unroll
        for (int i = 0; i < 64; ++i) { const float r3 = bf2f(*(LAS const bf16_t*)(src + (i + 3) * 768)); xq[i] = siluf_(w0 * r0 + w1 * r1 + w2 * r2 + w3 * r3); r0 = r1; r1 = r2; r2 = r3; }
      } else {
#pragma unroll
        for (int i = 0; i < 64; ++i) xq[i] = x[i];
      }
    }
    __syncthreads();
    if (ht < 128) {
#pragma unroll
      for (int i = 0; i < 64; ++i) *(LAS bf16_t*)(sQ + i * 272 + ht * 2) = f2bf(xq[i]);
    } else {
#pragma unroll
      for (int i = 0; i < 64; ++i) *(LAS bf16_t*)(sK + i * 272 + (ht - 128) * 2) = f2bf(x[i]);
    }
    __syncthreads();
    const int it = hw >> 1, jt = hw & 1;
    f32x16 akk = f32x16{}, aqk = f32x16{};
    if (hw != 1) {
#pragma unroll
      for (int ks = 0; ks < 8; ++ks) {
        const bf16x8 ak = *(LAS const bf16x8*)(sK + (32 * it + r32) * 272 + ks * 32 + hi * 16), aq = *(LAS const bf16x8*)(sQ + (32 * it + r32) * 272 + ks * 32 + hi * 16);
        const bf16x8 bk = *(LAS const bf16x8*)(sK + (32 * jt + r32) * 272 + ks * 32 + hi * 16);
        akk = __builtin_amdgcn_mfma_f32_32x32x16_bf16(ak, bk, akk, 0, 0, 0); aqk = __builtin_amdgcn_mfma_f32_32x32x16_bf16(aq, bk, aqk, 0, 0, 0);
      }
    } else {
#pragma unroll
      for (int ks = 0; ks < 8; ++ks) {
        const bf16x8 a0 = *(LAS const bf16x8*)(sQ + r32 * 272 + ks * 32 + hi * 16), a1 = *(LAS const bf16x8*)(sQ + (32 + r32) * 272 + ks * 32 + hi * 16);
        akk = __builtin_amdgcn_mfma_f32_32x32x16_bf16(a0, a0, akk, 0, 0, 0); aqk = __builtin_amdgcn_mfma_f32_32x32x16_bf16(a1, a1, aqk, 0, 0, 0);
      }
    }
    {
      float d0 = 0.f, d1 = 0.f;
#pragma unroll
      for (int r = 0; r < 16; ++r) if (crow(r, hi) == r32) { d0 = akk[r]; d1 = aqk[r]; }
      const bool has = ((r32 >> 2) & 1) == hi;
      if (has && hw == 0) sRnK[r32] = rsqrtf(d0 + EPS);
      if (has && hw == 3) sRnK[32 + r32] = rsqrtf(d0 + EPS);
      if (has && hw == 1) { sRnQ[r32] = rsqrtf(d0 + EPS) * QSCALE; sRnQ[32 + r32] = rsqrtf(d1 + EPS) * QSCALE; }
    }
    __syncthreads();
    if (hw != 1) {
      const int j = 32 * jt + r32; const float rnkj = sRnK[j], gcj = sGc[j];
      const int ksj = 2 * jt + (r32 >> 4), jo = r32 & 15, hip = (jo >> 2) & 1, jp = (jo & 3) + 4 * (jo >> 3);
      LAS char* attf = L + RA_ATT + (it ? 2 + ksj : ksj) * 1024 + hip * 512 + jp * 2;
#pragma unroll
      for (int r = 0; r < 16; ++r) {
        const int il = crow(r, hi), i = 32 * it + il;
        const float dec = __expf(fminf(sGc[i] - gcj, 0.f));
        const float aval = (i > j) ? sBeta[i] * sRnK[i] * rnkj * akk[r] * dec : 0.f;
        const float tval = (i >= j) ? sRnQ[i] * rnkj * aqk[r] * dec : 0.f;
        Amat[i * 64 + j] = aval;
        *(LAS bf16_t*)(attf + il * 16) = f2bf(tval);
        if ((r & 3) == 3) asm volatile("" ::: "memory");
      }
    }
    __syncthreads();
    if (ht < 128) {
      const int c = ht;
      const int co = c & 15, hip = (co >> 2) & 1, jp = (co & 3) + 4 * (co >> 3);
      LAS char* qgf = L + RA_QG + (c >> 4) * 1024 + hip * 512 + jp * 2;
#pragma unroll
      for (int i = 0; i < 64; ++i) { *(LAS bf16_t*)(qgf + (i >> 5) * 8192 + (i & 31) * 16) = f2bf(xq[i] * sRnQ[i] * sEgc[i]); x[i] *= sBeta[i]; if ((i & 7) == 7) asm volatile("" ::: "memory"); }
    } else {
      const int c = ht - 128;
      const float gl = sGc[63];
      LAS char* ktf = L + RA_KT + (c >> 5) * 4096 + (c & 31) * 16;
#pragma unroll
      for (int ks = 0; ks < 4; ++ks)
#pragma unroll
        for (int hp = 0; hp < 2; ++hp) {
          float v[8];
#pragma unroll
          for (int jq = 0; jq < 8; ++jq) { const int i = 16 * ks + (jq & 3) + 8 * (jq >> 2) + 4 * hp; v[jq] = xq[i] * sRnK[i] * __expf(gl - sGc[i]); }
          u32x4 w; w.x = cvt_pk_bf16(v[0], v[1]); w.y = cvt_pk_bf16(v[2], v[3]); w.z = cvt_pk_bf16(v[4], v[5]); w.w = cvt_pk_bf16(v[6], v[7]);
          *(LAS u32x4*)(ktf + ks * 1024 + hp * 512) = w;
          asm volatile("" ::: "memory");
        }
#pragma unroll
      for (int i = 0; i < 64; ++i) { x[i] *= sBeta[i] * sEgc[i] * sRnK[i]; if ((i & 7) == 7) asm volatile("" ::: "memory"); }
    }
    asm volatile("" ::: "memory");
#pragma unroll
    for (int i = 1; i < 64; ++i) {
      float acc = x[i];
#pragma unroll
      for (int j4 = 0; j4 < (i + 3) / 4; ++j4) {
        const f32x4 a = *(LAS const f32x4*)(Amat + i * 64 + j4 * 4);
        acc -= a[0] * x[4 * j4]; acc -= a[1] * x[4 * j4 + 1]; acc -= a[2] * x[4 * j4 + 2]; acc -= a[3] * x[4 * j4 + 3];
      }
      x[i] = acc;
      if ((i & 3) == 3) asm volatile("" ::: "memory");
    }
    __syncthreads();
    if (ht < 128) {
      const int c = ht;
      if (valid) {
        char* ud = rec + REC_A + c * 128;
#pragma unroll
        for (int q = 0; q < 8; ++q) {
          const int ib = 32 * (q >> 2) + 4 * ((q >> 1) & 1) + 16 * (q & 1);
          u32x4 w; w.x = cvt_pk_bf16(x[ib], x[ib + 1]); w.y = cvt_pk_bf16(x[ib + 2], x[ib + 3]); w.z = cvt_pk_bf16(x[ib + 8], x[ib + 9]); w.w = cvt_pk_bf16(x[ib + 10], x[ib + 11]);
          *(u32x4*)(ud + q * 16) = w;
        }
      }
    } else {
      const int c = ht - 128;
      const int co = c & 15, hip = (co >> 2) & 1, jp = (co & 3) + 4 * (co >> 3);
      LAS char* wf = L + RA_W + (c >> 4) * 1024 + hip * 512 + jp * 2;
#pragma unroll
      for (int i = 0; i < 64; ++i) *(LAS bf16_t*)(wf + (i >> 5) * 8192 + (i & 31) * 16) = f2bf(-x[i]);
    }
    if (ht == 0 && valid) EGL[u] = __expf(sGc[63]);
    __syncthreads();
    if (valid) for (int o = ht * 16; o < REC_A; o += 4096) *(u32x4*)(rec + o) = *(LAS const u32x4*)(L + o);
  }
}

__device__ __forceinline__ void phase_gdn_scan(const Params& p, LAS char* lds, int bid, int nblk) {
  using namespace gdn;
  char* ws = p.ws; bf16_t* P = (bf16_t*)(ws + OFF_P); const char* G = ws + OFF_G; const float* EGL = (const float*)(ws + OFF_EGL);
  const int tid = threadIdx.x, lane = tid & 63, r32 = lane & 31, hi = lane >> 5; const int wid = __builtin_amdgcn_readfirstlane(tid >> 6);
  LAS char* OX = lds + 2 * REC_A;
  {
    const int u = bid; const int b = u / 6, h = u % 6; const size_t rowb = (size_t)b * SEQ; const char* recb = G + (size_t)u * 64 * REC;
    __syncthreads();
    if (wid >= 4) {
      const int j = wid - 4, row = 16 * j + (lane >> 2), cg = (lane & 3) * 32;
      if (j < 2) for (int f = j; f < 54; f += 2) __builtin_amdgcn_global_load_lds((const unsigned*)(recb + f * 1024 + lane * 16), (LAS unsigned*)(lds + f * 1024), 16, 0, 0);
      float gn[32];
#pragma unroll
      for (int q = 0; q < 8; ++q) { const f32x4 g = *(const f32x4*)(p.a_out_gain + cg + q * 4); gn[4 * q] = g[0]; gn[4 * q + 1] = g[1]; gn[4 * q + 2] = g[2]; gn[4 * q + 3] = g[3]; }
      float sg[32]; u32x4 gr[4];
#pragma unroll
      for (int q = 0; q < 4; ++q) gr[q] = (u32x4){0u, 0u, 0u, 0u};
      const bf16_t* gp0 = P + (rowb + row) * LDP + PC_GATE + h * 128 + cg;
      bf16_t* dp0 = P + (rowb + row) * LDP + PC_Q + h * 128 + cg;
      for (int c = 0; c <= 64; ++c) {
        asm volatile("s_waitcnt vmcnt(0) lgkmcnt(0)\n\ts_barrier" ::: "memory");
        if (j < 2 && c + 1 < 64) { const char* rn = recb + (size_t)(c + 1) * REC; LAS char* dst = lds + ((c + 1) & 1) * REC_A;
          for (int f = j; f < 54; f += 2) __builtin_amdgcn_global_load_lds((const unsigned*)(rn + f * 1024 + lane * 16), (LAS unsigned*)(dst + f * 1024), 16, 0, 0); }
        if (c >= 1) {
#pragma unroll
          for (int q = 0; q < 4; ++q) {
            sg[8 * q] = gn[8 * q] * siluf_(bflo(gr[q].x)); sg[8 * q + 1] = gn[8 * q + 1] * siluf_(bfhi(gr[q].x)); sg[8 * q + 2] = gn[8 * q + 2] * siluf_(bflo(gr[q].y)); sg[8 * q + 3] = gn[8 * q + 3] * siluf_(bfhi(gr[q].y));
            sg[8 * q + 4] = gn[8 * q + 4] * siluf_(bflo(gr[q].z)); sg[8 * q + 5] = gn[8 * q + 5] * siluf_(bfhi(gr[q].z)); sg[8 * q + 6] = gn[8 * q + 6] * siluf_(bflo(gr[q].w)); sg[8 * q + 7] = gn[8 * q + 7] * siluf_(bfhi(gr[q].w)); }
        }
        if (c < 64) {
#pragma unroll
          for (int q = 0; q < 4; ++q) gr[q] = *(const u32x4*)(gp0 + (size_t)c * 64 * LDP + q * 8);
        }
        if (c >= 1) {
          const int cc = c - 1;
          LAS const char* op = OX + (cc & 1) * 16384 + row * 256 + cg * 2;
          float ov[32]; float ss = 0.f;
#pragma unroll
          for (int q = 0; q < 4; ++q) { const u32x4 r = *(LAS const u32x4*)(op + q * 16);
            ov[8 * q] = bflo(r.x); ov[8 * q + 1] = bfhi(r.x); ov[8 * q + 2] = bflo(r.y); ov[8 * q + 3] = bfhi(r.y); ov[8 * q + 4] = bflo(r.z); ov[8 * q + 5] = bfhi(r.z); ov[8 * q + 6] = bflo(r.w); ov[8 * q + 7] = bfhi(r.w); }
#pragma unroll
          for (int q = 0; q < 32; ++q) ss += ov[q] * ov[q];
          ss += __shfl_xor(ss, 1); ss += __shfl_xor(ss, 2);
          const float sc = rsqrtf(ss * (1.f / 128.f) + EPS);
          bf16_t* dp = dp0 + (size_t)cc * 64 * LDP;
#pragma unroll
          for (int q = 0; q < 4; ++q) { u32x4 w;
            w.x = cvt_pk_bf16(ov[8 * q] * sc * sg[8 * q], ov[8 * q + 1] * sc * sg[8 * q + 1]); w.y = cvt_pk_bf16(ov[8 * q + 2] * sc * sg[8 * q + 2], ov[8 * q + 3] * sc * sg[8 * q + 3]);
            w.z = cvt_pk_bf16(ov[8 * q + 4] * sc * sg[8 * q + 4], ov[8 * q + 5] * sc * sg[8 * q + 5]); w.w = cvt_pk_bf16(ov[8 * q + 6] * sc * sg[8 * q + 6], ov[8 * q + 7] * sc * sg[8 * q + 7]);
            *(u32x4*)(dp + q * 8) = w; }
        }
      }
    } else {
      const int vs = wid;
      f32x16 S[4];
#pragma unroll
      for (int k = 0; k < 4; ++k) S[k] = f32x16{};
      const char* ub = recb + REC_A + (vs * 32 + r32) * 128 + hi * 32;
      u32x4 un[4];
#pragma unroll
      for (int q = 0; q < 4; ++q) un[q] = *(const u32x4*)(ub + (q >> 1) * 64 + (q & 1) * 16);
      float egn = EGL[u * 64];
      for (int c = 0; c <= 64; ++c) {
        asm volatile("s_waitcnt lgkmcnt(0)\n\ts_barrier" ::: "memory");
        if (c < 64) {
          LAS const char* R = lds + (c & 1) * REC_A + lane * 16;
          const float egl = egn; if (c + 1 < 64) egn = EGL[u * 64 + c + 1];
          u32x4 uc[4];
#pragma unroll
          for (int q = 0; q < 4; ++q) uc[q] = un[q];
          if (c + 1 < 64) {
#pragma unroll
            for (int q = 0; q < 4; ++q) un[q] = *(const u32x4*)(ub + (size_t)(c + 1) * REC + (q >> 1) * 64 + (q & 1) * 16);
          }
          bf16x8 Sb[8];
#pragma unroll
          for (int ks = 0; ks < 8; ++ks) { const int kt = ks >> 1, o = (ks & 1) * 8; u32x4 w;
            w.x = cvt_pk_bf16(S[kt][o], S[kt][o + 1]); w.y = cvt_pk_bf16(S[kt][o + 2], S[kt][o + 3]); w.z = cvt_pk_bf16(S[kt][o + 4], S[kt][o + 5]); w.w = cvt_pk_bf16(S[kt][o + 6], S[kt][o + 7]);
            Sb[ks] = __builtin_bit_cast(bf16x8, w); }
#define GB_LD(dst, off0, off1) do { _Pragma("unroll") for (int q_ = 0; q_ < 4; ++q_) { dst[q_] = *(LAS const bf16x8*)(R + (off0) + q_ * 1024); dst[4 + q_] = *(LAS const bf16x8*)(R + (off1) + q_ * 1024); } } while (0)
#define GB_SCHED __builtin_amdgcn_sched_barrier(0)
          bf16x8 fa[8], fb[8];
          GB_LD(fa, RA_W, RA_W + 8192);
          f32x16 vn[2];
#pragma unroll
          for (int t2 = 0; t2 < 2; ++t2)
#pragma unroll
            for (int q = 0; q < 2; ++q) { const u32x4 r = uc[2 * t2 + q];
              vn[t2][8 * q] = bflo(r.x); vn[t2][8 * q + 1] = bfhi(r.x); vn[t2][8 * q + 2] = bflo(r.y); vn[t2][8 * q + 3] = bfhi(r.y); vn[t2][8 * q + 4] = bflo(r.z); vn[t2][8 * q + 5] = bfhi(r.z); vn[t2][8 * q + 6] = bflo(r.w); vn[t2][8 * q + 7] = bfhi(r.w); }
          GB_LD(fb, RA_W + 4096, RA_W + 8192 + 4096); GB_SCHED;
#pragma unroll
          for (int ks = 0; ks < 4; ++ks) { vn[0] = __builtin_amdgcn_mfma_f32_32x32x16_bf16(fa[ks], Sb[ks], vn[0], 0, 0, 0); vn[1] = __builtin_amdgcn_mfma_f32_32x32x16_bf16(fa[4 + ks], Sb[ks], vn[1], 0, 0, 0); }
          GB_SCHED; GB_LD(fa, RA_KT, RA_KT + 4096); GB_SCHED;
#pragma unroll
          for (int ks = 0; ks < 4; ++ks) { vn[0] = __builtin_amdgcn_mfma_f32_32x32x16_bf16(fb[ks], Sb[4 + ks], vn[0], 0, 0, 0); vn[1] = __builtin_amdgcn_mfma_f32_32x32x16_bf16(fb[4 + ks], Sb[4 + ks], vn[1], 0, 0, 0); }
          bf16x8 vb[4];
#pragma unroll
          for (int ks = 0; ks < 4; ++ks) { const int t2 = ks >> 1, o = (ks & 1) * 8; u32x4 w;
            w.x = cvt_pk_bf16(vn[t2][o], vn[t2][o + 1]); w.y = cvt_pk_bf16(vn[t2][o + 2], vn[t2][o + 3]); w.z = cvt_pk_bf16(vn[t2][o + 4], vn[t2][o + 5]); w.w = cvt_pk_bf16(vn[t2][o + 6], vn[t2][o + 7]);
            vb[ks] = __builtin_bit_cast(bf16x8, w); }
          f32x16 oo[2]; oo[0] = f32x16{}; oo[1] = f32x16{};
          GB_SCHED; GB_LD(fb, RA_KT + 8192, RA_KT + 12288); GB_SCHED;
          S[0] = S[0] * egl; S[1] = S[1] * egl;
#pragma unroll
          for (int ks = 0; ks < 4; ++ks) { S[0] = __builtin_amdgcn_mfma_f32_32x32x16_bf16(fa[ks], vb[ks], S[0], 0, 0, 0); S[1] = __builtin_amdgcn_mfma_f32_32x32x16_bf16(fa[4 + ks], vb[ks], S[1], 0, 0, 0); }
          GB_SCHED; GB_LD(fa, RA_QG, RA_QG + 8192); GB_SCHED;
          S[2] = S[2] * egl; S[3] = S[3] * egl;
#pragma unroll
          for (int ks = 0; ks < 4; ++ks) { S[2] = __builtin_amdgcn_mfma_f32_32x32x16_bf16(fb[ks], vb[ks], S[2], 0, 0, 0); S[3] = __builtin_amdgcn_mfma_f32_32x32x16_bf16(fb[4 + ks], vb[ks], S[3], 0, 0, 0); }
          GB_SCHED; GB_LD(fb, RA_QG + 4096, RA_QG + 8192 + 4096); GB_SCHED;
#pragma unroll
          for (int ks = 0; ks < 4; ++ks) { oo[0] = __builtin_amdgcn_mfma_f32_32x32x16_bf16(fa[ks], Sb[ks], oo[0], 0, 0, 0); oo[1] = __builtin_amdgcn_mfma_f32_32x32x16_bf16(fa[4 + ks], Sb[ks], oo[1], 0, 0, 0); }
          GB_SCHED;
#pragma unroll
          for (int q = 0; q < 6; ++q) fa[q] = *(LAS const bf16x8*)(R + RA_ATT + q * 1024);
          GB_SCHED;
#pragma unroll
          for (int ks = 0; ks < 4; ++ks) { oo[0] = __builtin_amdgcn_mfma_f32_32x32x16_bf16(fb[ks], Sb[4 + ks], oo[0], 0, 0, 0); oo[1] = __builtin_amdgcn_mfma_f32_32x32x16_bf16(fb[4 + ks], Sb[4 + ks], oo[1], 0, 0, 0); }
          oo[0] = __builtin_amdgcn_mfma_f32_32x32x16_bf16(fa[0], vb[0], oo[0], 0, 0, 0); oo[1] = __builtin_amdgcn_mfma_f32_32x32x16_bf16(fa[2], vb[0], oo[1], 0, 0, 0);
          oo[0] = __builtin_amdgcn_mfma_f32_32x32x16_bf16(fa[1], vb[1], oo[0], 0, 0, 0); oo[1] = __builtin_amdgcn_mfma_f32_32x32x16_bf16(fa[3], vb[1], oo[1], 0, 0, 0);
          oo[1] = __builtin_amdgcn_mfma_f32_32x32x16_bf16(fa[4], vb[2], oo[1], 0, 0, 0); oo[1] = __builtin_amdgcn_mfma_f32_32x32x16_bf16(fa[5], vb[3], oo[1], 0, 0, 0);
#undef GB_LD
#undef GB_SCHED
          LAS char* ox = OX + (c & 1) * 16384 + (vs * 32 + r32) * 2;
#pragma unroll
          for (int t2 = 0; t2 < 2; ++t2)
#pragma unroll
            for (int r = 0; r < 16; ++r) *(LAS bf16_t*)(ox + (32 * t2 + crow(r, hi)) * 256) = f2bf(oo[t2][r]);
        }
      }
    }
  }
}

constexpr int NPHASE = 15;
__global__ void __launch_bounds__(NTHR, 2) yoco_fwd(Params p, int lo, int hi) {
  extern __shared__ __attribute__((aligned(16))) char smem_raw[];
  LAS char* lds = (LAS char*)smem_raw;
  const int bid = blockIdx.x, nblk = gridDim.x;
  LAS unsigned* xbw = (LAS unsigned*)(lds + LDS_BYTES - 16);
  if (threadIdx.x == 0) { xbw[0] = 0u; xbw[1] = 0u; xbw[2] = 0u; xbw[3] = 0u; }
  __syncthreads();
  XcdBarrier bar; bar.bar = (unsigned*)(p.ws + OFF_CTRL); bar.x = 0; bar.st = (volatile LAS unsigned*)xbw;
  if (hi - lo > 1) bar = xcd_barrier_post((unsigned*)(p.ws + OFF_CTRL), (volatile LAS unsigned*)xbw);
#ifndef PROBE_DOUBLE
#define PROBE_DOUBLE -1
#endif
#define PH(k) if (lo <= (k) && (k) < hi)
#define SEAM(k) if (lo <= (k) && (k) + 1 < hi) xcd_barrier(bar)
  PH(0) phase_prep<false>(p, bid, nblk);
#if PROBE_DOUBLE == 0
  PH(0) { __syncthreads(); phase_prep<false>(p, bid, nblk); }
#endif
  SEAM(0);
  PH(1) phase_gemm_inA(p, lds, bid, nblk);
#if PROBE_DOUBLE == 1
  PH(1) phase_gemm_inA(p, lds, bid, nblk);
#endif
  SEAM(1);
  PH(2) phase_gdn_prep(p, lds, bid, nblk);
#if PROBE_DOUBLE == 20
  PH(2) phase_gdn_prep(p, lds, bid, nblk);
#endif
  SEAM(2);
  PH(2) { if (bid < 48) phase_gdn_scan(p, lds, bid, nblk); else { phase_memattn(p, lds, bid - 48, nblk - 48, 0); phase_prep<true>(p, bid - 48, nblk - 48); } }
#if PROBE_DOUBLE == 21
  PH(2) { if (bid < 48) phase_gdn_scan(p, lds, bid, nblk); }
#endif
  SEAM(2);
  PH(3) phase_gemm_out(p, lds, bid, nblk, 0);
#if PROBE_DOUBLE == 3
  PH(3) phase_gemm_out(p, lds, bid, nblk, 0);
#endif
  SEAM(3);
  PH(4) phase_norm_route(p, lds, bid, nblk, 0);
  SEAM(4);
  PH(5) phase_moe1(p, lds, bid, nblk, 0);
#if PROBE_DOUBLE == 5
  PH(5) phase_moe1(p, lds, bid, nblk, 0);
#endif
  SEAM(5);
  PH(6) phase_moe2(p, lds, bid, nblk, 0);
#if PROBE_DOUBLE == 6
  PH(6) phase_moe2(p, lds, bid, nblk, 0);
#endif
  SEAM(6);
  PH(7) phase_combine<false>(p, bid, nblk);
  SEAM(7);
  PH(8) phase_gemm_inB(p, lds, bid, nblk);
#if PROBE_DOUBLE == 8
  PH(8) phase_gemm_inB(p, lds, bid, nblk);
#endif
  SEAM(8);
#if PROBE_DOUBLE == 9
  PH(9) { phase_sb_attn(p, lds, bid, nblk, true); }
#endif
  PH(9) { phase_sb_attn(p, lds, bid, nblk); phase_memattn(p, lds, bid, nblk, 1); }
#if PROBE_DOUBLE == 91
  PH(9) { phase_memattn(p, lds, bid, nblk, 1); }
#endif
  SEAM(9);
  PH(10) phase_gemm_out(p, lds, bid, nblk, 1);
  SEAM(10);
  PH(11) phase_norm_route(p, lds, bid, nblk, 1);
  SEAM(11);
  PH(12) phase_moe1(p, lds, bid, nblk, 1);
  SEAM(12);
  PH(13) phase_moe2(p, lds, bid, nblk, 1);
  SEAM(13);
  PH(14) phase_combine<true>(p, bid, nblk);
#undef PH
#undef SEAM
}

#ifndef N_LAUNCH_SPLIT
#define N_LAUNCH_SPLIT 0
#endif

extern "C" void kernel_launch(void* const* d_in, const int* in_sizes, int n_in, void* d_out, int out_size, void* d_ws, size_t ws_size, hipStream_t stream) {
  (void)in_sizes; (void)n_in; (void)out_size;
  if (ws_size < WS_NEED) return;
  static int grid = 0;
  if (!grid) {
    if (hipFuncSetAttribute((const void*)yoco_fwd, hipFuncAttributeMaxDynamicSharedMemorySize, LDS_BYTES) != hipSuccess) { grid = -1; return; }
    int dev = 0, cus = 0; hipGetDevice(&dev); hipDeviceGetAttribute(&cus, hipDeviceAttributeMultiprocessorCount, dev);
    int per_cu = 0; hipOccupancyMaxActiveBlocksPerMultiprocessor(&per_cu, (const void*)yoco_fwd, NTHR, LDS_BYTES);
    grid = (per_cu >= 1) ? cus : -1;
  }
  if (grid <= 0) return;
  Params p{};
  const float** pf = (const float**)&p;
  for (int i = 0; i < 25; ++i) pf[i] = (const float*)d_in[i];
  p.out = (float*)d_out; p.ws = (char*)d_ws;
  hipMemsetAsync(d_ws, 0, 65536, stream);
#if N_LAUNCH_SPLIT
  for (int k = 0; k < NPHASE; ++k) hipLaunchKernelGGL(yoco_fwd, dim3(grid), dim3(NTHR), LDS_BYTES, stream, p, k, k + 1);
#else
  hipLaunchKernelGGL(yoco_fwd, dim3(grid), dim3(NTHR), LDS_BYTES, stream, p, 0, NPHASE);
#endif
}
```

```cpp
#include <hip/hip_runtime.h>
#include <stdint.h>
#include <stddef.h>

#define LAS __attribute__((address_space(3)))
typedef unsigned short bf16_t;
typedef short bf16x8 __attribute__((ext_vector_type(8)));
typedef float f32x4 __attribute__((ext_vector_type(4)));
typedef float f32x16 __attribute__((ext_vector_type(16)));
typedef unsigned u32x4 __attribute__((ext_vector_type(4)));
typedef unsigned u32x2 __attribute__((ext_vector_type(2)));

constexpr int NTOK = 32768, DM = 1024, SEQ = 4096, NBATCH = 8, MEMLEN = 256, NMEMROW = NBATCH * MEMLEN;
constexpr int LDP = 3392;
constexpr int PC_Q = 0, PC_MQ = 768, PC_K = 1024, PC_V = 1792, PC_GATE = 2560, PC_BA = 3328;
constexpr int NIN_A = 3584;
constexpr int NIN_B = 2560;
constexpr float EPS = 1e-6f;
constexpr float LOG2E = 1.4426950408889634f;
constexpr int NTHR = 512;

constexpr size_t OFF_CTRL  = 0;
constexpr size_t OFF_RSTD  = 65536;
constexpr size_t OFF_MRSTD = OFF_RSTD + (size_t)NTOK * 4;
constexpr size_t OFF_CW    = OFF_MRSTD + 8192;
constexpr size_t OFF_LIST  = OFF_CW + 65536 * 4;
constexpr size_t OFF_MEMKV = OFF_LIST + (size_t)16 * NTOK * 4;
constexpr size_t OFF_WR    = OFF_MEMKV + (size_t)2 * 2048 * 512 * 2;
constexpr size_t OFF_EGL   = OFF_WR + (size_t)2 * 20 * 1024 * 4;
constexpr size_t OFF_W     = 8u << 20;
constexpr size_t W_AIN  = 0;
constexpr size_t W_AOUT = W_AIN + (size_t)NIN_A * 1024 * 2;
constexpr size_t W_BIN  = W_AOUT + (size_t)1024 * 1024 * 2;
constexpr size_t W_BOUT = W_BIN + (size_t)NIN_B * 1024 * 2;
constexpr size_t W_MEM  = W_BOUT + (size_t)1024 * 1024 * 2;
constexpr size_t W_13   = W_MEM + (size_t)2 * 512 * 1024 * 2;
constexpr size_t W_2    = W_13 + (size_t)32 * 512 * 1024 * 2;
constexpr size_t W_END  = W_2 + (size_t)32 * 1024 * 256 * 2;
constexpr size_t OFF_P  = OFF_W + W_END;
constexpr size_t OFF_G  = OFF_P + (size_t)NTOK * LDP * 2;
constexpr size_t G_MIX  = 0;
constexpr size_t G_HB   = (size_t)128 << 20;
constexpr size_t WS_NEED = OFF_G + ((size_t)216 << 20);
static_assert(OFF_EGL + 3072 * 4 <= OFF_W, "small region");
static_assert(WS_NEED <= ((size_t)512 << 20), "workspace");
constexpr int CTRL_CNT = 4096;
constexpr int CTRL_PCNT = 8192;
constexpr size_t P_PLIST = (size_t)40 << 20;

constexpr int LDS_BYTES = 147456;

struct Params {
  const float *x, *mem, *a_norm, *a_w_in, *a_conv, *a_log, *a_dt_bias, *a_out_gain, *a_w_out, *kv_norm, *w_kv,
      *b_norm, *b_w_in, *b_w_out, *mem_norm, *w_mem_kv, *ffn_norm, *w_group, *b_group, *w_router, *b_router,
      *w1, *w3, *w2, *final_norm;
  float* out; char* ws;
};

typedef float f32x2_t __attribute__((ext_vector_type(2))); typedef __bf16 bf16x2_t __attribute__((ext_vector_type(2)));
__device__ __forceinline__ unsigned cvt_pk_bf16(float lo, float hi) { const f32x2_t v = {lo, hi}; const bf16x2_t b = __builtin_convertvector(v, bf16x2_t); return __builtin_bit_cast(unsigned, b); }
__device__ __forceinline__ bf16_t f2bf(float f) { return (bf16_t)(cvt_pk_bf16(f, 0.f) & 0xffffu); }
__device__ __forceinline__ float bf2f(bf16_t b) { return __uint_as_float(((unsigned)b) << 16); }
__device__ __forceinline__ float bflo(unsigned u) { return __uint_as_float(u << 16); }
__device__ __forceinline__ float bfhi(unsigned u) { return __uint_as_float(u & 0xffff0000u); }
__device__ __forceinline__ float wave_sum(float v) {
#pragma unroll
  for (int o = 32; o >= 1; o >>= 1) v += __shfl_xor(v, o);
  return v;
}
__device__ __forceinline__ float sigmoidf_(float x) { return __builtin_amdgcn_rcpf(1.f + __expf(-x)); }
__device__ __forceinline__ float siluf_(float x) { return x * __builtin_amdgcn_rcpf(1.f + __expf(-x)); }
__device__ __forceinline__ float softplusf_(float x) { return fmaxf(x, 0.f) + log1pf(__expf(-fabsf(x))); }

#define XB_TMO      128
#define XB_XCNT(j)  (256  + 64 * (j))
#define XB_XSUB(j)  (1280 + 64 * (j))
#define XB_XGEN(j)  (2304 + 64 * (j))
#define XB_TOP      3328
#define XB_TOPGEN   3392
#define XCD_BAR_WORDS 3456
#define XB_SPIN_CAP (1u << 22)
__device__ __forceinline__ unsigned xb_ld(unsigned* p)              { return __hip_atomic_load(p, __ATOMIC_RELAXED, __HIP_MEMORY_SCOPE_AGENT); }
__device__ __forceinline__ unsigned xb_add(unsigned* p, unsigned v) { return __hip_atomic_fetch_add(p, v, __ATOMIC_RELAXED, __HIP_MEMORY_SCOPE_AGENT); }
__device__ __forceinline__ unsigned xb_xcc_id() { return (unsigned)__builtin_amdgcn_s_getreg((3 << 11) | 20) & 0xFu; }
#define XB_SPIN(cond, bar) do { unsigned _sp = 0; while (cond) { __builtin_amdgcn_s_sleep(1); \
    if ((++_sp & 255u) == 0u) { if (xb_ld(&(bar)[XB_TMO])) break; if (_sp > XB_SPIN_CAP) { atomicAdd(&(bar)[XB_TMO], 1u); break; } } } } while (0)
struct XcdBarrier { unsigned* bar; unsigned x; volatile LAS unsigned* st; };
__device__ __forceinline__ XcdBarrier xcd_barrier_post(unsigned* bar, volatile LAS unsigned* st) {
    XcdBarrier b; b.bar = bar; b.x = xb_xcc_id(); b.st = st;
    if (threadIdx.x == 0) (void)xb_add(&bar[XB_XCNT(b.x)], 1u);
    return b;
}
__device__ __forceinline__ void xcd_barrier_complete(unsigned* bar, unsigned x, unsigned& nloc, unsigned& nx) {
    const unsigned G = gridDim.x * gridDim.y * gridDim.z;
    unsigned sum, cnt, mine, sp = 0u;
    for (;;) {
        sum = 0u; cnt = 0u; mine = 0u;
#pragma unroll
        for (unsigned j = 0; j < 16; ++j) { const unsigned c = xb_ld(&bar[XB_XCNT(j)]); sum += c; cnt += (c > 0u) ? 1u : 0u; mine = (j == x) ? c : mine; }
        if (sum == G) break;
        __builtin_amdgcn_s_sleep(1);
        if ((++sp & 255u) == 0u) { if (xb_ld(&bar[XB_TMO])) break; if (sp > XB_SPIN_CAP) { atomicAdd(&bar[XB_TMO], 1u); break; } }
    }
    nloc = mine > 0u ? mine : 1u; nx = cnt > 0u ? cnt : 1u;
}
__device__ __forceinline__ void xcd_barrier(const XcdBarrier& b) {
    asm volatile("s_waitcnt vmcnt(0)" ::: "memory");
    __syncthreads();
    if (threadIdx.x == 0) {
        unsigned* bar = b.bar;
        __builtin_amdgcn_s_waitcnt(0);
        unsigned nloc = b.st[0], nx = b.st[1];
        if (nloc == 0u) { xcd_barrier_complete(bar, b.x, nloc, nx); b.st[0] = nloc; b.st[1] = nx; }
        const unsigned old = xb_add(&bar[XB_XSUB(b.x)], 1u);
        const unsigned gen = old / nloc;
        if (old + 1u == (gen + 1u) * nloc) {
            __builtin_amdgcn_fence(__ATOMIC_RELEASE, "agent");
            asm volatile("s_waitcnt vmcnt(0)" ::: "memory");
            const unsigned og = xb_add(&bar[XB_TOP], 1u);
            const unsigned tg = og / nx;
            if (og + 1u == (tg + 1u) * nx) xb_add(&bar[XB_TOPGEN], 1u);
            else XB_SPIN(xb_ld(&bar[XB_TOPGEN]) == tg, bar);
            __builtin_amdgcn_fence(__ATOMIC_ACQUIRE, "agent");
            xb_add(&bar[XB_XGEN(b.x)], 1u);
            asm volatile("s_waitcnt vmcnt(0)" ::: "memory");
        } else {
            XB_SPIN(xb_ld(&bar[XB_XGEN(b.x)]) == gen, bar);
            __builtin_amdgcn_fence(__ATOMIC_ACQUIRE, "agent");
            asm volatile("s_waitcnt vmcnt(0)" ::: "memory");
        }
    }
    __syncthreads();
}

__device__ __forceinline__ void cvt_rows(bf16_t* dst, int nrows_dst, int K, const float* src, int src_ld, int col0, int nrows_src,
                         const float* gain, float scale, int gtid, int gthreads) {
  const int items = nrows_dst * (K >> 3);
  for (int it = gtid; it < items; it += gthreads) {
    const int r = it % nrows_dst, k8 = it / nrows_dst;
    float v[8];
#pragma unroll
    for (int j = 0; j < 8; ++j) {
      const int k = k8 * 8 + j;
      v[j] = (r < nrows_src) ? src[(size_t)k * src_ld + col0 + r] * (gain ? gain[k] : 1.f) * scale : 0.f;
    }
    u32x4 w; w.x = cvt_pk_bf16(v[0], v[1]); w.y = cvt_pk_bf16(v[2], v[3]); w.z = cvt_pk_bf16(v[4], v[5]); w.w = cvt_pk_bf16(v[6], v[7]);
    *(u32x4*)(dst + (size_t)r * K + k8 * 8) = w;
  }
}

__device__ __forceinline__ void rows_to_bf16(const float* src, bf16_t* dst, float* rstd, int nrows, int gwave, int nwaves, int lane) {
  for (int r = gwave; r < nrows; r += nwaves) {
    const float* s = src + (size_t)r * DM; float ss = 0.f;
#pragma unroll
    for (int i = 0; i < 4; ++i) {
      const f32x4 v = *(const f32x4*)(s + i * 256 + lane * 4);
      ss += v[0] * v[0] + v[1] * v[1] + v[2] * v[2] + v[3] * v[3];
      u32x2 w; w.x = cvt_pk_bf16(v[0], v[1]); w.y = cvt_pk_bf16(v[2], v[3]);
      *(u32x2*)(dst + (size_t)r * DM + i * 256 + lane * 4) = w;
    }
    ss = wave_sum(ss);
    if (lane == 0) rstd[r] = rsqrtf(ss * (1.f / DM) + EPS);
  }
}

template <bool LATE>
__device__ __forceinline__ void phase_prep(const Params& p, int bid, int nblk) {
  const int tid = threadIdx.x, gtid = bid * NTHR + tid, gthreads = nblk * NTHR, lane = tid & 63;
  char* ws = p.ws; bf16_t* W = (bf16_t*)(ws + OFF_W);
  if (!LATE) {
  bf16_t* wa = (bf16_t*)((char*)W + W_AIN);
  cvt_rows(wa + (size_t)PC_Q * 1024, 768, 1024, p.a_w_in, 3340, 0, 768, p.a_norm, 1.f, gtid, gthreads);
  cvt_rows(wa + (size_t)PC_MQ * 1024, 256, 1024, p.a_w_in, 3340, 3084, 256, p.a_norm, 0.125f * LOG2E, gtid, gthreads);
  cvt_rows(wa + (size_t)PC_K * 1024, 768, 1024, p.a_w_in, 3340, 768, 768, p.a_norm, 1.f, gtid, gthreads);
  cvt_rows(wa + (size_t)PC_V * 1024, 768, 1024, p.a_w_in, 3340, 1536, 768, p.a_norm, 1.f, gtid, gthreads);
  cvt_rows(wa + (size_t)PC_GATE * 1024, 768, 1024, p.a_w_in, 3340, 2304, 768, p.a_norm, 1.f, gtid, gthreads);
  cvt_rows(wa + (size_t)PC_BA * 1024, NIN_A - PC_BA, 1024, p.a_w_in, 3340, 3072, 12, p.a_norm, 1.f, gtid, gthreads);
  cvt_rows((bf16_t*)((char*)W + W_AOUT), 1024, 1024, p.a_w_out, 1024, 0, 1024, nullptr, 1.f, gtid, gthreads);
  for (int l = 0; l < 2; ++l)
    cvt_rows((bf16_t*)((char*)W + W_MEM) + (size_t)l * 512 * 1024, 512, 1024, p.w_mem_kv + (size_t)l * 1024 * 512, 512, 0, 512, p.mem_norm + l * 1024, 1.f, gtid, gthreads);
  } else {
  bf16_t* wb = (bf16_t*)((char*)W + W_BIN);
  cvt_rows(wb + (size_t)PC_Q * 1024, 768, 1024, p.b_w_in, 1024, 0, 768, p.b_norm, 0.125f * LOG2E, gtid, gthreads);
  cvt_rows(wb + (size_t)PC_MQ * 1024, 256, 1024, p.b_w_in, 1024, 768, 256, p.b_norm, 0.125f * LOG2E, gtid, gthreads);
  cvt_rows(wb + (size_t)PC_K * 1024, 768, 1024, p.w_kv, 1536, 0, 768, p.kv_norm, 1.f, gtid, gthreads);
  cvt_rows(wb + (size_t)PC_V * 1024, 768, 1024, p.w_kv, 1536, 768, 768, p.kv_norm, 1.f, gtid, gthreads);
  cvt_rows((bf16_t*)((char*)W + W_BOUT), 1024, 1024, p.b_w_out, 1024, 0, 1024, nullptr, 1.f, gtid, gthreads);
  {
    bf16_t* w13 = (bf16_t*)((char*)W + W_13);
    const int items = 32 * 512 * 128;
    for (int it = gtid; it < items; it += gthreads) {
      const int le = it >> 16, rem = it & 65535, r = rem & 511, k8 = rem >> 9;
      const int u = r >> 8, which = (r >> 7) & 1, j = r & 127, l = le >> 4;
      const float* src = (which ? p.w3 : p.w1) + (size_t)le * 1024 * 256 + u * 128 + j;
      const float* g = p.ffn_norm + l * 1024;
      float v[8];
#pragma unroll
      for (int q = 0; q < 8; ++q) { const int k = k8 * 8 + q; v[q] = src[(size_t)k * 256] * g[k]; }
      u32x4 w; w.x = cvt_pk_bf16(v[0], v[1]); w.y = cvt_pk_bf16(v[2], v[3]); w.z = cvt_pk_bf16(v[4], v[5]); w.w = cvt_pk_bf16(v[6], v[7]);
      *(u32x4*)(w13 + ((size_t)le * 512 + r) * 1024 + k8 * 8) = w;
    }
    bf16_t* w2t = (bf16_t*)((char*)W + W_2);
    const int items2 = 32 * 1024 * 32;
    for (int it = gtid; it < items2; it += gthreads) {
      const int le = it >> 15, rem = it & 32767, n = rem & 1023, k8 = rem >> 10;
      const float* src = p.w2 + (size_t)le * 256 * 1024 + n;
      float v[8];
#pragma unroll
      for (int q = 0; q < 8; ++q) v[q] = src[(size_t)(k8 * 8 + q) * 1024];
      u32x4 w; w.x = cvt_pk_bf16(v[0], v[1]); w.y = cvt_pk_bf16(v[2], v[3]); w.z = cvt_pk_bf16(v[4], v[5]); w.w = cvt_pk_bf16(v[6], v[7]);
      *(u32x4*)(w2t + ((size_t)le * 1024 + n) * 256 + k8 * 8) = w;
    }
  }
  }
  if (!LATE) {
  {
    float* wr = (float*)(ws + OFF_WR);
    for (int it = gtid; it < 2 * 20 * 1024; it += gthreads) {
      const int l = it / 20480, rem = it % 20480, j = rem >> 10, k = rem & 1023;
      const float w = (j < 4) ? p.w_group[((size_t)l * 1024 + k) * 4 + j] : p.w_router[((size_t)l * 1024 + k) * 16 + (j - 4)];
      wr[it] = w * p.ffn_norm[l * 1024 + k];
    }
  }
  const int gwave = gtid >> 6, nwaves = gthreads >> 6;
  rows_to_bf16(p.x, (bf16_t*)p.out, (float*)(ws + OFF_RSTD), NTOK, gwave, nwaves, lane);
  rows_to_bf16(p.mem, (bf16_t*)((char*)p.out + ((size_t)64 << 20)), (float*)(ws + OFF_MRSTD), NMEMROW, gwave, nwaves, lane);
  }
}

namespace g8 {
constexpr int BM = 256, BK = 64, HALF = 128, HTB = HALF * BK * 2, STAGE_BYTES = 8 * HTB, NXCD = 8, WGM = 8;
__host__ __device__ __forceinline__ int lds_byte(int r, int c) { const int st = (r >> 4) * 2 + (c >> 5), rr = r & 15, cc = c & 31, ob = rr * 64 + cc * 2; return st * 1024 + (ob ^ (((ob >> 9) & 1) << 5)); }
__host__ __device__ __forceinline__ void stage_rc(int b, int& R, int& C) { const int st = b / 1024, sb = b % 1024, swz = sb ^ (((sb >> 9) & 1) << 5); R = (st >> 1) * 16 + swz / 64; C = (st & 1) * 32 + (swz % 64) / 2; }
__host__ __device__ __forceinline__ int perm32(int rho) { const int n = rho >> 4, i = rho & 15; return 8 * (i >> 2) + 4 * n + (i & 3); }

struct Unit { const char* A; const char* B; const int* list; int row0, nvalid, pm, pn, aux; };

struct DenseOrder {
  const char* A; const char* Bt; int K; int nM, nN, nwg, G, c;
  __device__ __forceinline__ void init(const void* A_, const void* Bt_, int K_, int M, int N, int G_, int c_) { A = (const char*)A_; Bt = (const char*)Bt_; K = K_; nM = M / BM; nN = N / BM; nwg = nM * nN; G = G_; c = c_; }
  __device__ __forceinline__ bool next(int i, Unit& u) const {
    const long L = (long)i * G + c; if (L >= nwg) return false;
    int wgid = (int)L; { const int q = nwg / NXCD, r = nwg % NXCD, xcd = wgid % NXCD, off = wgid / NXCD; wgid = (xcd < r ? xcd * (q + 1) : r * (q + 1) + (xcd - r) * q) + off; }
    const int nig = WGM * nN, gid = wgid / nig, fm = gid * WGM, gsz = (nM - fm) < WGM ? (nM - fm) : WGM;
    u.pm = fm + ((wgid % nig) % gsz); u.pn = (wgid % nig) / gsz;
    u.A = A; u.B = Bt + (size_t)u.pn * BM * K * 2; u.list = nullptr; u.row0 = u.pm * BM; u.nvalid = BM; u.aux = 0; return true;
  }
};

template <class Epi, class Sched, int SHIFT, bool SPLITB = false>
__device__ __forceinline__ void gemm_phase(LAS unsigned char* lds, const int K, const int lda, const Sched& S, const Epi& E) {
    const int tid = threadIdx.x, wid = __builtin_amdgcn_readfirstlane(tid >> 6), lane = tid & 63, wr = wid >> 2, wc = wid & 3, fr = lane & 15, fq = lane >> 4;
    const int nt = K / BK, nth = nt / 2, ldb = SPLITB ? K / 2 : K;
    int RA[2], CA[2]; unsigned voffB[2];
#pragma unroll
    for (int i = 0; i < 2; ++i) { int R, C; stage_rc(tid * 16 + i * 8192, R, C); const int Rb = Epi::PERM ? ((R & ~31) + perm32(R & 31)) : R;
        RA[i] = R; CA[i] = C; voffB[i] = (unsigned)(Rb * ldb + C) * 2u; }
    const size_t kstep = (size_t)(BK * 2);
    const size_t hstepB = (size_t)HALF * ldb * 2;
#define G8_BP(b_, d_, kt_) ((b_) + (size_t)(kt_) * kstep + ((SPLITB && (kt_) >= nth) ? (size_t)(d_) : (size_t)0))
    const unsigned ldsw = (unsigned)wid * 1024u;
    const int aoff = lds_byte(wr * 64 + fr, fq * 8), boff = lds_byte(wc * 32 + fr, fq * 8);
#define G8_AOFF(dst, u) do { _Pragma("unroll") for (int _h = 0; _h < 2; ++_h) _Pragma("unroll") for (int _i = 0; _i < 2; ++_i) { const int _r = _h * HALF + RA[_i]; int _ar; \
        if ((u).list) { const int _rr = _r < (u).nvalid ? _r : 0; _ar = (u).list[(u).row0 + _rr] >> SHIFT; } else _ar = (u).row0 + _r; \
        dst[_h][_i] = (unsigned)(_ar * lda + CA[_i]) * 2u; } } while (0)
#define G8_SA(b, h) (((b) * 2 + (h)) * HTB)
#define G8_SB(b, h) ((4 + (b) * 2 + (h)) * HTB)
#define G8_STAGEA(bufoff, gbase, vo, kb) do { _Pragma("unroll") for (int _i = 0; _i < 2; ++_i) \
        __builtin_amdgcn_global_load_lds((const unsigned*)((gbase) + (size_t)((vo)[_i] + (unsigned)(kb))), (LAS unsigned*)(lds + (bufoff) + ldsw + _i * 8192), 16, 0, 0); } while (0)
#define G8_STAGEB(bufoff, gbase) do { _Pragma("unroll") for (int _i = 0; _i < 2; ++_i) \
        __builtin_amdgcn_global_load_lds((const unsigned*)((const char*)(gbase) + voffB[_i]), (LAS unsigned*)(lds + (bufoff) + ldsw + _i * 8192), 16, 0, 0); } while (0)
#define G8_LDA(dst, b, h) do { _Pragma("unroll") for (int m = 0; m < 4; ++m) _Pragma("unroll") for (int k = 0; k < 2; ++k) dst[m][k] = *(const LAS bf16x8*)(lds + G8_SA(b, h) + aoff + m * 2048 + k * 1024); } while (0)
#define G8_LDB(dst, b, h) do { _Pragma("unroll") for (int n = 0; n < 2; ++n) _Pragma("unroll") for (int k = 0; k < 2; ++k) dst[n][k] = *(const LAS bf16x8*)(lds + G8_SB(b, h) + boff + n * 2048 + k * 1024); } while (0)
#define G8_MMA(ai, bj, At, Bt) do { __builtin_amdgcn_s_setprio(1); _Pragma("unroll") for (int m = 0; m < 4; ++m) _Pragma("unroll") for (int n = 0; n < 2; ++n) _Pragma("unroll") for (int k = 0; k < 2; ++k) \
        acc[ai][bj][m][n] = __builtin_amdgcn_mfma_f32_16x16x32_bf16(Bt[n][k], At[m][k], acc[ai][bj][m][n], 0, 0, 0); __builtin_amdgcn_s_setprio(0); } while (0)
#define G8_WAIT_V(n) asm volatile("s_waitcnt vmcnt(" #n ")" ::: "memory")
#define G8_WAIT_L(n) asm volatile("s_waitcnt lgkmcnt(" #n ")" ::: "memory")
#define G8_BAR __builtin_amdgcn_s_barrier()
#define G8_SCHED __builtin_amdgcn_sched_barrier(0)
    Unit cur, nxt; int ui = 0;
    if (!S.next(0, cur)) return;
    f32x4 acc[2][2][4][2];
#pragma unroll
    for (int a = 0; a < 2; ++a)
#pragma unroll
        for (int b = 0; b < 2; ++b)
#pragma unroll
            for (int m = 0; m < 4; ++m)
#pragma unroll
                for (int n = 0; n < 2; ++n) acc[a][b][m][n] = (f32x4){0.f, 0.f, 0.f, 0.f};
    bf16x8 At[4][2], B0[2][2], B1[2][2];
    unsigned aoC[2][2], aoN[2][2];
    G8_AOFF(aoC, cur);
    const char* cA = cur.A; const char* cB = cur.B; long cD = ((long)cur.aux << 19) - (long)nth * (long)kstep;
    G8_STAGEB(G8_SB(0, 0), cB); G8_STAGEB(G8_SB(0, 1), cB + hstepB); G8_STAGEA(G8_SA(0, 0), cA, aoC[0], 0); G8_STAGEA(G8_SA(0, 1), cA, aoC[1], 0);
    if (wr == 1) G8_BAR;
    G8_WAIT_V(2); G8_BAR;
    G8_STAGEB(G8_SB(1, 0), cB + kstep); G8_STAGEA(G8_SA(1, 0), cA, aoC[0], kstep); G8_STAGEB(G8_SB(1, 1), cB + hstepB + kstep);
    G8_WAIT_V(6); G8_BAR;
    for (;;) {
        const bool has_next = S.next(ui + 1, nxt);
        const char* nA = has_next ? nxt.A : cA; const char* nB = has_next ? nxt.B : cB; const long nD = has_next ? ((long)nxt.aux << 19) - (long)nth * (long)kstep : cD;
        if (has_next) { G8_AOFF(aoN, nxt); } else {
#pragma unroll
            for (int h = 0; h < 2; ++h)
#pragma unroll
                for (int i = 0; i < 2; ++i) aoN[h][i] = aoC[h][i]; }
        for (int t = 0; t < nt; t += 2) {
            const bool last = (t == nt - 2);
            const unsigned k1 = (unsigned)((t + 1) * kstep);
            const char* a2b = last ? nA : cA; const unsigned k2 = last ? 0u : (unsigned)((t + 2) * kstep), k3 = k2 + (unsigned)kstep;
            const char* b2 = last ? nB : G8_BP(cB, cD, t + 2); const char* b3 = last ? nB + kstep : G8_BP(cB, cD, t + 3);
            unsigned ao2[2][2];
#pragma unroll
            for (int h = 0; h < 2; ++h)
#pragma unroll
                for (int i = 0; i < 2; ++i) ao2[h][i] = last ? aoN[h][i] : aoC[h][i];
            G8_LDB(B0, 0, 0); G8_LDB(B1, 0, 1); G8_SCHED; G8_LDA(At, 0, 0); G8_STAGEA(G8_SA(1, 1), cA, aoC[1], k1);
            G8_WAIT_V(8); G8_WAIT_L(0); G8_BAR; G8_MMA(0, 0, At, B0); G8_MMA(0, 1, At, B1); G8_BAR; G8_SCHED;
            G8_LDA(At, 0, 1); G8_STAGEB(G8_SB(0, 0), b2); G8_STAGEB(G8_SB(0, 1), b2 + hstepB); G8_STAGEA(G8_SA(0, 0), a2b, ao2[0], k2);
            G8_WAIT_V(8); G8_WAIT_L(0); G8_BAR; G8_MMA(1, 0, At, B0); G8_MMA(1, 1, At, B1); G8_BAR; G8_SCHED;
            G8_LDB(B0, 1, 0); G8_LDB(B1, 1, 1); G8_SCHED; G8_LDA(At, 1, 0); G8_STAGEA(G8_SA(0, 1), a2b, ao2[1], k2);
            G8_WAIT_V(8); G8_WAIT_L(0); G8_BAR; G8_MMA(0, 0, At, B0); G8_MMA(0, 1, At, B1); G8_BAR; G8_SCHED;
            G8_LDA(At, 1, 1); G8_STAGEB(G8_SB(1, 0), b3); G8_STAGEB(G8_SB(1, 1), b3 + hstepB); G8_STAGEA(G8_SA(1, 0), a2b, ao2[0], k3);
            G8_WAIT_V(8); G8_WAIT_L(0); G8_BAR; G8_MMA(1, 0, At, B0); G8_MMA(1, 1, At, B1); G8_BAR; G8_SCHED;
        }
        if (wr == 0) G8_BAR;
        E(acc, cur, wr, wc, fr, fq);
        if (!has_next) break;
#pragma unroll
        for (int a = 0; a < 2; ++a)
#pragma unroll
            for (int b = 0; b < 2; ++b)
#pragma unroll
                for (int m = 0; m < 4; ++m)
#pragma unroll
                    for (int n = 0; n < 2; ++n) acc[a][b][m][n] = (f32x4){0.f, 0.f, 0.f, 0.f};
        cur = nxt; cA = nA; cB = nB; cD = nD; ++ui;
#pragma unroll
        for (int h = 0; h < 2; ++h)
#pragma unroll
            for (int i = 0; i < 2; ++i) aoC[h][i] = aoN[h][i];
        if (wr == 1) G8_BAR;
    }
    G8_WAIT_V(0);
    G8_BAR;
#undef G8_AOFF
#undef G8_SA
#undef G8_SB
#undef G8_STAGEA
#undef G8_STAGEB
#undef G8_BP
#undef G8_LDA
#undef G8_LDB
#undef G8_MMA
#undef G8_WAIT_V
#undef G8_WAIT_L
#undef G8_BAR
#undef G8_SCHED
}

struct EpiScaleBf16 {
  static constexpr bool PERM = true;
  bf16_t* C; int ldc; const float* rowscale; int ncol_store;
  __device__ __forceinline__ void operator()(const f32x4 (&acc)[2][2][4][2], const Unit& u, int wr, int wc, int fr, int fq) const {
    const int row0 = u.pm * BM + wr * 64 + fr, col0 = u.pn * BM + wc * 32 + 8 * fq;
#pragma unroll
    for (int ai = 0; ai < 2; ++ai)
#pragma unroll
      for (int m = 0; m < 4; ++m) { const int row = row0 + ai * HALF + m * 16; const float sc = rowscale[row]; bf16_t* rowp = C + (size_t)row * ldc + col0;
#pragma unroll
        for (int bj = 0; bj < 2; ++bj) { const f32x4 v0 = acc[ai][bj][m][0] * sc, v1 = acc[ai][bj][m][1] * sc;
          u32x4 w; w.x = cvt_pk_bf16(v0[0], v0[1]); w.y = cvt_pk_bf16(v0[2], v0[3]); w.z = cvt_pk_bf16(v1[0], v1[1]); w.w = cvt_pk_bf16(v1[2], v1[3]);
          if (col0 + bj * HALF < ncol_store) *(u32x4*)(rowp + bj * HALF) = w; } }
  }
};
struct EpiMem {
  static constexpr bool PERM = true; bf16_t* C; const float* rs;
  __device__ __forceinline__ void operator()(const f32x4 (&acc)[2][2][4][2], const Unit& u, int wr, int wc, int fr, int fq) const {
    const int l = u.pn >> 1; Unit v = u; v.pn = u.pn & 1;
    EpiScaleBf16 e{C + (size_t)l * 2048 * 512, 512, rs, 512}; e(acc, v, wr, wc, fr, fq); }
};
struct EpiResidF32 {
  static constexpr bool PERM = false;
  float* out; const float* resid;
  __device__ __forceinline__ void operator()(const f32x4 (&acc)[2][2][4][2], const Unit& u, int wr, int wc, int fr, int fq) const {
    const int row0 = u.pm * BM + wr * 64 + fr, col0 = u.pn * BM + wc * 32 + 4 * fq;
#pragma unroll
    for (int ai = 0; ai < 2; ++ai)
#pragma unroll
      for (int m = 0; m < 4; ++m) { const size_t base = (size_t)(row0 + ai * HALF + m * 16) * DM + col0;
#pragma unroll
        for (int bj = 0; bj < 2; ++bj)
#pragma unroll
          for (int n = 0; n < 2; ++n) { const size_t o = base + bj * HALF + n * 16; const f32x4 rv = *(const f32x4*)(resid + o); *(f32x4*)(out + o) = rv + acc[ai][bj][m][n]; } }
  }
};
struct EpiMoe1 {
  static constexpr bool PERM = true;
  bf16_t* hid; const float* rstd; const float* cw;
  __device__ __forceinline__ void operator()(const f32x4 (&acc)[2][2][4][2], const Unit& u, int wr, int wc, int fr, int fq) const {
#pragma unroll
    for (int ai = 0; ai < 2; ++ai)
#pragma unroll
      for (int m = 0; m < 4; ++m) { const int r = ai * HALF + wr * 64 + m * 16 + fr;
        if (r < u.nvalid) { const int slot = u.list[u.row0 + r]; const float rs = rstd[slot >> 1], cs = cw[slot] * rs;
          float h[8];
#pragma unroll
          for (int n = 0; n < 2; ++n)
#pragma unroll
            for (int j = 0; j < 4; ++j) { const float a = acc[ai][0][m][n][j] * rs, b = acc[ai][1][m][n][j] * cs; h[4 * n + j] = siluf_(a) * b; }
          u32x4 w; w.x = cvt_pk_bf16(h[0], h[1]); w.y = cvt_pk_bf16(h[2], h[3]); w.z = cvt_pk_bf16(h[4], h[5]); w.w = cvt_pk_bf16(h[6], h[7]);
          *(u32x4*)(hid + (size_t)slot * 256 + u.pn * 128 + wc * 32 + 8 * fq) = w; } }
  }
};
struct EpiMoe2 {
  static constexpr bool PERM = true;
  bf16_t* y;
  __device__ __forceinline__ void operator()(const f32x4 (&acc)[2][2][4][2], const Unit& u, int wr, int wc, int fr, int fq) const {
#pragma unroll
    for (int ai = 0; ai < 2; ++ai)
#pragma unroll
      for (int m = 0; m < 4; ++m) { const int r = ai * HALF + wr * 64 + m * 16 + fr;
        if (r < u.nvalid) { const int tok = u.list[u.row0 + r];
          bf16_t* yp = y + (size_t)tok * DM + u.pn * BM + wc * 32 + 8 * fq;
#pragma unroll
          for (int bj = 0; bj < 2; ++bj) { const f32x4 v0 = acc[ai][bj][m][0], v1 = acc[ai][bj][m][1];
            u32x4 w; w.x = cvt_pk_bf16(v0[0], v0[1]); w.y = cvt_pk_bf16(v0[2], v0[3]); w.z = cvt_pk_bf16(v1[0], v1[1]); w.w = cvt_pk_bf16(v1[2], v1[3]);
            *(u32x4*)(yp + bj * HALF) = w; } } }
  }
};
struct PairOrder {
  const char* A; const char* Wt; const int* plist; LAS const int* cn; int G, c;
  __device__ __forceinline__ bool next(int i, Unit& u) const {
    int L = i * G + c; bool found = false;
    for (int e = 0; e < 24; ++e) { const int cne = __builtin_amdgcn_readfirstlane(cn[e]); const int nu = ((cne + 255) >> 8) * 4;
      if (!found) { if (L < nu) { found = true; const int tile = L >> 2, pn = L & 3, g = e / 6, pr = e % 6;
          const int la = pr < 3 ? 0 : pr < 5 ? 1 : 2, lb = pr < 3 ? pr + 1 : pr < 5 ? pr - 1 : 3;
          u.pm = tile; u.pn = pn; u.aux = lb - la; u.A = A;
          u.B = Wt + ((size_t)(g * 4 + la) * 1024 + (size_t)pn * 256) * 256 * 2;
          u.list = plist + (size_t)e * NTOK; u.row0 = tile * 256; u.nvalid = (cne - tile * 256) < 256 ? (cne - tile * 256) : 256; } else L -= nu; } }
    return found;
  }
};
template <int NPN>
struct MoeOrder {
  const char* A; const char* Wt; const int* lists; int cn[16]; int G, c; size_t wstride_e, wstride_pn;
  __device__ __forceinline__ bool next(int i, Unit& u) const {
    int L = i * G + c; bool found = false;
#pragma unroll
    for (int e = 0; e < 16; ++e) { const int nu = ((cn[e] + 255) >> 8) * NPN;
      if (!found) { if (L < nu) { found = true; const int tile = L / NPN, pn = L % NPN; u.pm = tile; u.pn = pn; u.aux = e; u.A = A; u.B = Wt + (size_t)e * wstride_e + (size_t)pn * wstride_pn;
          u.list = lists + (size_t)e * NTOK; u.row0 = tile * 256; u.nvalid = (cn[e] - tile * 256) < 256 ? (cn[e] - tile * 256) : 256; } else L -= nu; } }
    return found;
  }
};
}

__device__ __forceinline__ void phase_gemm_inA(const Params& p, LAS char* lds, int bid, int nblk) {
  char* ws = p.ws;
  const bf16_t* hb = (const bf16_t*)p.out; const bf16_t* memb = (const bf16_t*)((char*)p.out + ((size_t)64 << 20));
  const bf16_t* wa = (const bf16_t*)(ws + OFF_W + W_AIN); const bf16_t* wm = (const bf16_t*)(ws + OFF_W + W_MEM);
  { g8::DenseOrder S; S.init(hb, wa, 1024, NTOK, NIN_A, nblk, bid);
    g8::EpiScaleBf16 E{(bf16_t*)(ws + OFF_P), LDP, (const float*)(ws + OFF_RSTD), LDP};
    g8::gemm_phase<g8::EpiScaleBf16, g8::DenseOrder, 0>((LAS unsigned char*)lds, 1024, DM, S, E); }
  { g8::DenseOrder S; S.init(memb, wm, 1024, NMEMROW, 1024, nblk, bid);
    g8::EpiMem E{(bf16_t*)(ws + OFF_MEMKV), (const float*)(ws + OFF_MRSTD)};
    g8::gemm_phase<g8::EpiMem, g8::DenseOrder, 0>((LAS unsigned char*)lds, 1024, DM, S, E); }
}
__device__ __forceinline__ void phase_gemm_inB(const Params& p, LAS char* lds, int bid, int nblk) {
  char* ws = p.ws;
  g8::DenseOrder S; S.init(ws + OFF_G + G_HB, ws + OFF_W + W_BIN, 1024, NTOK, NIN_B, nblk, bid);
  g8::EpiScaleBf16 E{(bf16_t*)(ws + OFF_P), LDP, (const float*)(ws + OFF_RSTD), LDP};
  g8::gemm_phase<g8::EpiScaleBf16, g8::DenseOrder, 0>((LAS unsigned char*)lds, 1024, DM, S, E);
}
__device__ __forceinline__ void phase_gemm_out(const Params& p, LAS char* lds, int bid, int nblk, int layer) {
  char* ws = p.ws;
  g8::DenseOrder S; S.init(ws + OFF_P, ws + OFF_W + (layer ? W_BOUT : W_AOUT), 1024, NTOK, 1024, nblk, bid);
  g8::EpiResidF32 E{p.out, layer ? (const float*)p.out : p.x};
  g8::gemm_phase<g8::EpiResidF32, g8::DenseOrder, 0>((LAS unsigned char*)lds, 1024, LDP, S, E);
}
__device__ __forceinline__ void phase_moe1(const Params& p, LAS char* lds, int bid, int nblk, int layer) {
  char* ws = p.ws;
  const unsigned* cnt = (const unsigned*)(ws + OFF_CTRL) + CTRL_CNT + layer * 16 * 64;
  g8::MoeOrder<2> S; S.A = ws + OFF_G + G_HB; S.Wt = ws + OFF_W + W_13 + (size_t)layer * 16 * 512 * 1024 * 2; S.lists = (const int*)(ws + OFF_LIST);
#pragma unroll
  for (int e = 0; e < 16; ++e) S.cn[e] = (int)cnt[e * 64];
  S.G = nblk; S.c = bid; S.wstride_e = (size_t)512 * 1024 * 2; S.wstride_pn = (size_t)256 * 1024 * 2;
  g8::EpiMoe1 E{(bf16_t*)(ws + OFF_P), (const float*)(ws + OFF_RSTD), (const float*)(ws + OFF_CW)};
  g8::gemm_phase<g8::EpiMoe1, g8::MoeOrder<2>, 1>((LAS unsigned char*)lds, 1024, DM, S, E);
}
__device__ __forceinline__ void phase_moe2(const Params& p, LAS char* lds, int bid, int nblk, int layer) {
  char* ws = p.ws;
  const unsigned* pcnt = (const unsigned*)(ws + OFF_CTRL) + CTRL_PCNT + layer * 24 * 64;
  g8::PairOrder S; S.A = ws + OFF_P; S.Wt = ws + OFF_W + W_2 + (size_t)layer * 16 * 1024 * 256 * 2; S.plist = (const int*)(ws + OFF_P + P_PLIST);
  LAS int* scn = (LAS int*)(lds + g8::STAGE_BYTES);
  __syncthreads();
  if (threadIdx.x < 24) scn[threadIdx.x] = (int)pcnt[threadIdx.x * 64];
  __syncthreads();
  S.cn = scn; S.G = nblk; S.c = bid;
  g8::EpiMoe2 E{(bf16_t*)(ws + OFF_G + G_MIX)};
  g8::gemm_phase<g8::EpiMoe2, g8::PairOrder, 0, true>((LAS unsigned char*)lds, 512, 512, S, E);
}


typedef float f32x2v __attribute__((ext_vector_type(2)));
__device__ __forceinline__ void phase_norm_route(const Params& p, LAS char* lds, int bid, int nblk, int layer) {
  char* ws = p.ws; const int tid = threadIdx.x, lane = tid & 63, r32 = lane & 31, hi = lane >> 5; const int w = __builtin_amdgcn_readfirstlane(tid >> 6);
  constexpr int WROW = 1028;
  LAS float* wl = (LAS float*)lds;
  LAS float* lgx = (LAS float*)(lds + 20 * WROW * 4);
  LAS float* ssx = lgx + 8 * 32 * 33;
  const float* wr = (const float*)(ws + OFF_WR) + (size_t)layer * 20480;
  __syncthreads();
  for (int i = tid; i < 20480 / 4; i += NTHR) { const int j = i >> 8, c = (i & 255) * 4; *(LAS f32x4*)(wl + j * WROW + c) = *(const f32x4*)(wr + j * 1024 + c); }
  __syncthreads();
  bf16_t* hb = (bf16_t*)(ws + OFF_G + G_HB); float* rstd = (float*)(ws + OFF_RSTD); float* cw = (float*)(ws + OFF_CW);
  unsigned* cnt = (unsigned*)(ws + OFF_CTRL) + CTRL_CNT + layer * 16 * 64; int* lists = (int*)(ws + OFF_LIST);
  unsigned* pcnt = (unsigned*)(ws + OFF_CTRL) + CTRL_PCNT + layer * 24 * 64; int* plist = (int*)(ws + OFF_P + P_PLIST);
  const float* bg = p.b_group + layer * 4; const float* br = p.b_router + layer * 16;
  const int nn = r32 < 20 ? r32 : 19;
  for (int base = bid * 4; base < NTOK / 32; base += nblk * 4) {
    const int tile = base + (w & 3), kh = w >> 2, t0 = tile * 32;
    const float* hrow = p.out + (size_t)(t0 + r32) * DM + kh * 512 + 4 * hi;
    bf16_t* hbrow = hb + (size_t)(t0 + r32) * DM + kh * 512 + 4 * hi;
    LAS const float* wrow = wl + nn * WROW + kh * 512 + 4 * hi;
    f32x16 acc = f32x16{}; float ss = 0.f;
    for (int j0 = 0; j0 < 64; j0 += 8) {
      f32x4 hv[8];
#pragma unroll
      for (int q = 0; q < 8; ++q) hv[q] = *(const f32x4*)(hrow + (j0 + q) * 8);
#pragma unroll
      for (int q = 0; q < 8; ++q) {
        const f32x4 wv = *(LAS const f32x4*)(wrow + (j0 + q) * 8);
        ss += hv[q][0] * hv[q][0] + hv[q][1] * hv[q][1] + hv[q][2] * hv[q][2] + hv[q][3] * hv[q][3];
        u32x2 o; o.x = cvt_pk_bf16(hv[q][0], hv[q][1]); o.y = cvt_pk_bf16(hv[q][2], hv[q][3]);
        *(u32x2*)(hbrow + (j0 + q) * 8) = o;
#pragma unroll
        for (int e = 0; e < 4; ++e) acc = __builtin_amdgcn_mfma_f32_32x32x2f32(wv[e], hv[q][e], acc, 0, 0, 0);
      }
    }
    { auto sw = __builtin_amdgcn_permlane32_swap(__float_as_uint(ss), __float_as_uint(ss), false, false); ss = __uint_as_float(sw[0]) + __uint_as_float(sw[1]); }
    LAS float* lg = lgx + w * 32 * 33;
#pragma unroll
    for (int r = 0; r < 16; ++r) { const int n = (r & 3) + 8 * (r >> 2) + 4 * hi; lg[r32 * 33 + n] = acc[r]; }
    if (hi == 0) ssx[w * 32 + r32] = ss;
    __syncthreads();
    if (w < 4 && hi == 0) {
      LAS const float* la = lgx + w * 32 * 33 + r32 * 33; LAS const float* lb = lgx + (w + 4) * 32 * 33 + r32 * 33;
      const int t = t0 + r32;
      const float rs = rsqrtf((ssx[w * 32 + r32] + ssx[(w + 4) * 32 + r32]) * (1.f / DM) + EPS);
      float lgt[20];
#pragma unroll
      for (int j = 0; j < 20; ++j) lgt[j] = (la[j] + lb[j]) * rs + (j < 4 ? bg[j] : br[j - 4]);
      int gs = 0; float gm = lgt[0];
#pragma unroll
      for (int j = 1; j < 4; ++j) if (lgt[j] > gm) { gm = lgt[j]; gs = j; }
      float den = 0.f;
#pragma unroll
      for (int j = 0; j < 4; ++j) den += __expf(lgt[j] - gm);
      const float pg = 1.f / den;
      float el[4];
#pragma unroll
      for (int j = 0; j < 4; ++j) el[j] = gs == 0 ? lgt[4 + j] : gs == 1 ? lgt[8 + j] : gs == 2 ? lgt[12 + j] : lgt[16 + j];
      int i1 = 0; float m1 = el[0];
#pragma unroll
      for (int j = 1; j < 4; ++j) if (el[j] > m1) { m1 = el[j]; i1 = j; }
      int i2 = -1; float m2 = -INFINITY;
#pragma unroll
      for (int j = 0; j < 4; ++j) if (j != i1 && el[j] > m2) { m2 = el[j]; i2 = j; }
      const float e2 = __expf(m2 - m1), p1 = 1.f / (1.f + e2), p2 = e2 * p1;
      const int ex1 = gs * 4 + i1, ex2 = gs * 4 + i2;
      unsigned myc = 0u; int rk1 = 0, rk2 = 0;
      const unsigned long long lt = (1ull << r32) - 1ull;
#pragma unroll
      for (int e = 0; e < 16; ++e) {
        const unsigned long long b1 = __ballot(ex1 == e), b2 = __ballot(ex2 == e);
        const int c1 = __popcll(b1), c2 = __popcll(b2);
        if (r32 == e) myc = (unsigned)(c1 + c2);
        if (ex1 == e) rk1 = __popcll(b1 & lt);
        if (ex2 == e) rk2 = c1 + __popcll(b2 & lt);
      }
      unsigned basev = 0u;
      if (r32 < 16 && myc) basev = atomicAdd(&cnt[r32 * 64], myc);
      const unsigned q1 = (unsigned)__shfl((int)basev, ex1) + (unsigned)rk1, q2 = (unsigned)__shfl((int)basev, ex2) + (unsigned)rk2;
      const int pos1 = ex1 < ex2 ? 0 : 1;
      lists[(size_t)ex1 * NTOK + q1] = t * 2 + pos1; lists[(size_t)ex2 * NTOK + q2] = t * 2 + (1 - pos1);
      cw[t * 2 + pos1] = pg * p1; cw[t * 2 + 1 - pos1] = pg * p2; rstd[t] = rs;
      const int xa = (pos1 ? i2 : i1), xb = (pos1 ? i1 : i2);
      const int pc = gs * 6 + (xa == 0 ? xb - 1 : xa == 1 ? xb + 1 : 5);
      unsigned myc2 = 0u; int rk = 0;
#pragma unroll
      for (int e = 0; e < 24; ++e) { const unsigned long long bb = __ballot(pc == e); if (r32 == e) myc2 = (unsigned)__popcll(bb); if (pc == e) rk = __popcll(bb & lt); }
      unsigned base2 = 0u;
      if (r32 < 24 && myc2) base2 = atomicAdd(&pcnt[r32 * 64], myc2);
      plist[(size_t)pc * NTOK + (unsigned)__shfl((int)base2, pc) + (unsigned)rk] = t;
    }
    __syncthreads();
  }
}

template <bool FINAL>
__device__ __forceinline__ void phase_combine(const Params& p, int bid, int nblk) {
  char* ws = p.ws; const int tid = threadIdx.x, lane = tid & 63, w = tid >> 6;
  const bf16_t* y = (const bf16_t*)(ws + OFF_G + G_MIX); bf16_t* hb = (bf16_t*)(ws + OFF_G + G_HB); float* rstd = (float*)(ws + OFF_RSTD);
  for (int t = bid * 8 + w; t < NTOK; t += nblk * 8) {
    float* hrow = p.out + (size_t)t * DM;
    f32x4 v[4]; float ss = 0.f;
#pragma unroll
    for (int i = 0; i < 4; ++i) { const int c = i * 256 + lane * 4; v[i] = *(const f32x4*)(hrow + c); const u32x2 a = *(const u32x2*)(y + (size_t)t * DM + c);
      v[i][0] += bflo(a.x); v[i][1] += bfhi(a.x); v[i][2] += bflo(a.y); v[i][3] += bfhi(a.y); ss += v[i][0] * v[i][0] + v[i][1] * v[i][1] + v[i][2] * v[i][2] + v[i][3] * v[i][3]; }
    ss = wave_sum(ss);
    const float rs = rsqrtf(ss * (1.f / DM) + EPS);
#pragma unroll
    for (int i = 0; i < 4; ++i) {
      const int c = i * 256 + lane * 4;
      if (FINAL) {
        const f32x4 g = *(const f32x4*)(p.final_norm + c);
        f32x4 o; o[0] = v[i][0] * rs * g[0]; o[1] = v[i][1] * rs * g[1]; o[2] = v[i][2] * rs * g[2]; o[3] = v[i][3] * rs * g[3];
        *(f32x4*)(hrow + c) = o;
      } else {
        *(f32x4*)(hrow + c) = v[i];
        u32x2 o; o.x = cvt_pk_bf16(v[i][0], v[i][1]); o.y = cvt_pk_bf16(v[i][2], v[i][3]);
        *(u32x2*)(hb + (size_t)t * DM + c) = o;
      }
    }
    if (!FINAL && lane == 0) rstd[t] = rs;
  }
}

namespace mem {
typedef short s16x4 __attribute__((ext_vector_type(4)));
constexpr int TILEB = 8192, LDS_K = 0, LDS_V = 4 * TILEB, LDS_WS = 8 * TILEB, LDS_OST = LDS_WS + 8 * 256;
__device__ __forceinline__ s16x4 vtr(LAS const char* p) { return __builtin_bit_cast(s16x4, __builtin_amdgcn_ds_read_tr16_b64_v4i16((LAS s16x4*)p)); }
__device__ __forceinline__ void unit(bf16_t* P, const bf16_t* mkv, int b, int hd, int qb, LAS char* lds) {
  const int tid = threadIdx.x, lane = tid & 63, r32 = lane & 31, hi = lane >> 5; const int wid = __builtin_amdgcn_readfirstlane(tid >> 6);
  const bf16_t* Kh = mkv + (size_t)b * 256 * 512 + hd * 64; const bf16_t* Vh = Kh + 256;
  bf16_t* Qw = P + ((size_t)b * SEQ + qb * 256 + wid * 32) * LDP + PC_MQ + hd * 64;
  const bf16_t* ksrc = Kh + (size_t)lane * 512 + wid * 8;
  const bf16_t* vsrc = Vh + (size_t)(16 * (wid & 3) + (lane >> 2)) * 512 + (wid >> 2) * 32 + (lane & 3) * 8;
#pragma unroll
  for (int t = 0; t < 4; ++t) {
    __builtin_amdgcn_global_load_lds((const unsigned*)(ksrc + (size_t)t * 64 * 512), (LAS unsigned*)(lds + LDS_K + t * TILEB + wid * 1024), 16, 0, 0);
    __builtin_amdgcn_global_load_lds((const unsigned*)(vsrc + (size_t)t * 64 * 512), (LAS unsigned*)(lds + LDS_V + t * TILEB + wid * 1024), 16, 0, 0);
  }
  bf16x8 qr[4];
#pragma unroll
  for (int d0 = 0; d0 < 4; ++d0) qr[d0] = *(const bf16x8*)(Qw + (size_t)r32 * LDP + d0 * 16 + hi * 8);
  asm volatile("s_waitcnt vmcnt(0) lgkmcnt(0)\n\ts_barrier" ::: "memory");
  LAS const char* kp0 = lds + LDS_K + hi * 1024 + r32 * 16;
  LAS const char* vp0 = lds + LDS_V + ((lane >> 4) & 1) * 32 + (lane & 3) * 8 + (4 * hi + ((lane & 15) >> 2)) * 64;
  float mx = -INFINITY;
#pragma unroll
  for (int t = 0; t < 4; ++t) {
    f32x16 p0 = f32x16{}, p1 = f32x16{};
#pragma unroll
    for (int d0 = 0; d0 < 4; ++d0) {
      const bf16x8 k0 = *(LAS const bf16x8*)(kp0 + t * TILEB + d0 * 2048), k1 = *(LAS const bf16x8*)(kp0 + t * TILEB + d0 * 2048 + 512);
      p0 = __builtin_amdgcn_mfma_f32_32x32x16_bf16(k0, qr[d0], p0, 0, 0, 0); p1 = __builtin_amdgcn_mfma_f32_32x32x16_bf16(k1, qr[d0], p1, 0, 0, 0);
    }
#pragma unroll
    for (int r = 0; r < 16; ++r) mx = fmaxf(mx, fmaxf(p0[r], p1[r]));
  }
  { auto sw = __builtin_amdgcn_permlane32_swap(__float_as_uint(mx), __float_as_uint(mx), false, false); mx = fmaxf(__uint_as_float(sw[0]), __uint_as_float(sw[1])); }
  f32x16 o[2]; o[0] = f32x16{}; o[1] = f32x16{};
  float lsum = 0.f;
#pragma unroll
  for (int t = 0; t < 4; ++t) {
    f32x16 p0 = f32x16{}, p1 = f32x16{};
#pragma unroll
    for (int d0 = 0; d0 < 4; ++d0) {
      const bf16x8 k0 = *(LAS const bf16x8*)(kp0 + t * TILEB + d0 * 2048), k1 = *(LAS const bf16x8*)(kp0 + t * TILEB + d0 * 2048 + 512);
      p0 = __builtin_amdgcn_mfma_f32_32x32x16_bf16(k0, qr[d0], p0, 0, 0, 0); p1 = __builtin_amdgcn_mfma_f32_32x32x16_bf16(k1, qr[d0], p1, 0, 0, 0);
    }
    float a[32];
#pragma unroll
    for (int r = 0; r < 16; ++r) { a[r] = __builtin_amdgcn_exp2f(p0[r] - mx); a[16 + r] = __builtin_amdgcn_exp2f(p1[r] - mx); lsum += a[r] + a[16 + r]; }
    u32x4 pw[4];
#pragma unroll
    for (int ks = 0; ks < 4; ++ks) { pw[ks].x = cvt_pk_bf16(a[8 * ks], a[8 * ks + 1]); pw[ks].y = cvt_pk_bf16(a[8 * ks + 2], a[8 * ks + 3]); pw[ks].z = cvt_pk_bf16(a[8 * ks + 4], a[8 * ks + 5]); pw[ks].w = cvt_pk_bf16(a[8 * ks + 6], a[8 * ks + 7]); }
    LAS const char* vp = vp0 + t * TILEB;
#pragma unroll
    for (int d0 = 0; d0 < 2; ++d0)
#pragma unroll
      for (int ks = 0; ks < 4; ++ks) {
        const s16x4 lo = vtr(vp + d0 * 4096 + ks * 1024), hh = vtr(vp + d0 * 4096 + ks * 1024 + 512);
        const bf16x8 vf = (bf16x8){lo[0], lo[1], lo[2], lo[3], hh[0], hh[1], hh[2], hh[3]};
        o[d0] = __builtin_amdgcn_mfma_f32_32x32x16_bf16(__builtin_bit_cast(bf16x8, pw[ks]), vf, o[d0], 0, 0, 0);
      }
  }
  { auto sw = __builtin_amdgcn_permlane32_swap(__float_as_uint(lsum), __float_as_uint(lsum), false, false); lsum = __uint_as_float(sw[0]) + __uint_as_float(sw[1]); }
  LAS float* wsf = (LAS float*)(lds + LDS_WS) + wid * 64;
  if (hi == 0) wsf[r32] = __builtin_amdgcn_rcpf(lsum);
  asm volatile("s_waitcnt lgkmcnt(0)" ::: "memory");
  LAS bf16_t* stg = (LAS bf16_t*)(lds + LDS_OST) + wid * 2048;
#pragma unroll
  for (int r = 0; r < 16; ++r) { const int orow = (r & 3) + 8 * (r >> 2) + 4 * hi; const float il = wsf[orow];
#pragma unroll
    for (int d0 = 0; d0 < 2; ++d0) stg[orow * 64 + d0 * 32 + r32] = f2bf(o[d0][r] * il); }
  asm volatile("s_waitcnt lgkmcnt(0)" ::: "memory");
#pragma unroll
  for (int i = 0; i < 4; ++i) { const int row = i * 8 + (lane >> 3), ch = lane & 7; const u32x4 v = *(LAS const u32x4*)(stg + row * 64 + ch * 8); *(u32x4*)(Qw + (size_t)row * LDP + ch * 8) = v; }
  asm volatile("s_waitcnt vmcnt(0) lgkmcnt(0)\n\ts_barrier" ::: "memory");
}
}
__device__ __forceinline__ void phase_memattn(const Params& p, LAS char* lds, int bid, int nblk, int layer) {
  char* ws = p.ws; bf16_t* P = (bf16_t*)(ws + OFF_P);
  const bf16_t* mkv = (const bf16_t*)(ws + OFF_MEMKV) + (size_t)layer * 2048 * 512;
  for (int u = bid; u < NBATCH * 4 * 16; u += nblk) { const int bh = u >> 4, qb = u & 15; mem::unit(P, mkv, bh >> 2, bh & 3, qb, lds); }
}

namespace sb {
typedef short s16x4 __attribute__((ext_vector_type(4)));
constexpr int SLOTB = 8192, LDS_K = 0, LDS_V = 3 * SLOTB, LDS_OST = 6 * SLOTB, LDS_FLAG = LDS_OST + 8 * 4096, LDS_BYTES_SB = LDS_FLAG + 64;
__device__ __forceinline__ s16x4 vtr(LAS const char* p) { return __builtin_bit_cast(s16x4, __builtin_amdgcn_ds_read_tr16_b64_v4i16((LAS s16x4*)p)); }

__device__ __forceinline__ void unit(const bf16_t* P, bf16_t* O, int ldo, int b, int h, int qb, LAS char* lds) {
  const int tid = threadIdx.x, lane = tid & 63, r32 = lane & 31, hi = lane >> 5; const int wid = __builtin_amdgcn_readfirstlane(tid >> 6);
  const size_t rowbase = (size_t)b * SEQ; const int q0 = qb * 256;
  const bf16_t* Kh = P + rowbase * LDP + PC_K + h * 64; const bf16_t* Vh = P + rowbase * LDP + PC_V + h * 64;
  const bf16_t* Qw = P + (rowbase + q0 + wid * 32) * LDP + PC_Q + h * 64;
  const bf16_t* ksrc = Kh + (size_t)lane * LDP + wid * 8;
  const bf16_t* vsrc = Vh + (size_t)(16 * (wid & 3) + (lane >> 2)) * LDP + (wid >> 2) * 32 + (lane & 3) * 8;
  LAS char* kdst = lds + LDS_K + wid * 1024; LAS char* vdst = lds + LDS_V + wid * 1024;
#define SB_DMA(t, slot) do { __builtin_amdgcn_global_load_lds((const unsigned*)(ksrc + (size_t)(t) * 64 * LDP), (LAS unsigned*)(kdst + (slot)), 16, 0, 0); \
                             __builtin_amdgcn_global_load_lds((const unsigned*)(vsrc + (size_t)(t) * 64 * LDP), (LAS unsigned*)(vdst + (slot)), 16, 0, 0); } while (0)
  const int NT = 4 * qb + 4;
  SB_DMA(NT - 1, 0);
  bf16x8 qr[4];
#pragma unroll
  for (int d0 = 0; d0 < 4; ++d0) qr[d0] = *(const bf16x8*)(Qw + (size_t)r32 * LDP + d0 * 16 + hi * 8);
  f32x16 o[2]; o[0] = f32x16{}; o[1] = f32x16{};
  float c = 1.f;
  const int qrel = wid * 32 + r32;
  LAS const char* kp0 = lds + LDS_K + hi * 1024 + r32 * 16;
  LAS const char* vp0 = lds + LDS_V + ((lane >> 4) & 1) * 32 + (lane & 3) * 8 + (4 * hi + ((lane & 15) >> 2)) * 64;
  int slot = 0; bool wave_alive = true;
  LAS unsigned* fl = (LAS unsigned*)(lds + LDS_FLAG);
  for (int i = 0; i < NT; ++i) {
    const int t = NT - 1 - i;
    const int nslot = (slot == 2 * SLOTB) ? 0 : slot + SLOTB;
    if (t > 0) { SB_DMA(t - 1, nslot); asm volatile("s_waitcnt vmcnt(2) lgkmcnt(0)\n\ts_barrier" ::: "memory"); }
    else { asm volatile("s_waitcnt vmcnt(0) lgkmcnt(0)\n\ts_barrier" ::: "memory"); }
    if (i > 0) { const u32x4 f0 = *(LAS const u32x4*)(fl + ((i - 1) & 1) * 8), f1 = *(LAS const u32x4*)(fl + ((i - 1) & 1) * 8 + 4);
      if (__builtin_amdgcn_readfirstlane((int)(f0.x | f0.y | f0.z | f0.w | f1.x | f1.y | f1.z | f1.w)) == 0) break; }
    const int jb = t - (NT - 4);
    if (!(jb >= 0 && 64 * jb > 32 * wid + 30) && wave_alive) {
      f32x16 p0 = f32x16{}, p1 = f32x16{};
#pragma unroll
      for (int d0 = 0; d0 < 4; ++d0) {
        const bf16x8 k0 = *(LAS const bf16x8*)(kp0 + slot + d0 * 2048), k1 = *(LAS const bf16x8*)(kp0 + slot + d0 * 2048 + 512);
        p0 = __builtin_amdgcn_mfma_f32_32x32x16_bf16(k0, qr[d0], p0, 0, 0, 0);
        p1 = __builtin_amdgcn_mfma_f32_32x32x16_bf16(k1, qr[d0], p1, 0, 0, 0);
      }
      if (jb >= 0) {
        const int kb = 64 * jb + 4 * hi;
#pragma unroll
        for (int r = 0; r < 16; ++r) { const int kv = kb + (r & 3) + 8 * (r >> 2); if (kv >= qrel) p0[r] = -INFINITY; if (kv + 32 >= qrel) p1[r] = -INFINITY; }
      }
      float rr[32], be[32];
#pragma unroll
      for (int r = 0; r < 16; ++r) {
        const float e0 = __builtin_amdgcn_exp2f(p0[r]), e1 = __builtin_amdgcn_exp2f(p1[r]);
        rr[r] = __builtin_amdgcn_rcpf(1.f + e0); rr[16 + r] = __builtin_amdgcn_rcpf(1.f + e1);
        be[r] = 1.f - rr[r]; be[16 + r] = 1.f - rr[16 + r];
      }
      float OS[9]; OS[8] = 1.f;
#pragma unroll
      for (int G = 7; G >= 0; --G) { const float gp = (rr[4 * G] * rr[4 * G + 1]) * (rr[4 * G + 2] * rr[4 * G + 3]); OS[G] = OS[G + 1] * gp; }
      float cE[8];
#pragma unroll
      for (int G = 0; G < 8; ++G) {
        const float X = hi ? OS[G] : OS[G + 1], Y = OS[G + 1];
        auto sw = __builtin_amdgcn_permlane32_swap(__float_as_uint(X), __float_as_uint(Y), false, false);
        cE[G] = c * (__uint_as_float(sw[0]) * __uint_as_float(sw[1]));
      }
      { auto sw = __builtin_amdgcn_permlane32_swap(__float_as_uint(OS[0]), __float_as_uint(OS[0]), false, false); c *= __uint_as_float(sw[0]) * __uint_as_float(sw[1]); }
      float a[32];
#pragma unroll
      for (int G = 0; G < 8; ++G) {
        const float t3 = cE[G], t2 = t3 * rr[4 * G + 3], t1 = t2 * rr[4 * G + 2], t0 = t1 * rr[4 * G + 1];
        a[4 * G + 3] = be[4 * G + 3] * t3; a[4 * G + 2] = be[4 * G + 2] * t2; a[4 * G + 1] = be[4 * G + 1] * t1; a[4 * G] = be[4 * G] * t0;
      }
      u32x4 pw[4];
#pragma unroll
      for (int ks = 0; ks < 4; ++ks) { pw[ks].x = cvt_pk_bf16(a[8 * ks], a[8 * ks + 1]); pw[ks].y = cvt_pk_bf16(a[8 * ks + 2], a[8 * ks + 3]); pw[ks].z = cvt_pk_bf16(a[8 * ks + 4], a[8 * ks + 5]); pw[ks].w = cvt_pk_bf16(a[8 * ks + 6], a[8 * ks + 7]); }
      LAS const char* vp = vp0 + slot;
#pragma unroll
      for (int d0 = 0; d0 < 2; ++d0)
#pragma unroll
        for (int ks = 0; ks < 4; ++ks) {
          const s16x4 lo = vtr(vp + d0 * 4096 + ks * 1024), hh = vtr(vp + d0 * 4096 + ks * 1024 + 512);
          const bf16x8 vf = (bf16x8){lo[0], lo[1], lo[2], lo[3], hh[0], hh[1], hh[2], hh[3]};
          o[d0] = __builtin_amdgcn_mfma_f32_32x32x16_bf16(__builtin_bit_cast(bf16x8, pw[ks]), vf, o[d0], 0, 0, 0);
        }
    }
    wave_alive = __any(c != 0.f);
    if (lane == 0) fl[(i & 1) * 8 + wid] = wave_alive ? 1u : 0u;
    slot = nslot;
  }
  bf16_t* Ow = O + (rowbase + q0 + wid * 32) * ldo + h * 64;
  LAS bf16_t* stg = (LAS bf16_t*)(lds + LDS_OST) + wid * 2048;
#pragma unroll
  for (int r = 0; r < 16; ++r) { const int orow = (r & 3) + 8 * (r >> 2) + 4 * hi;
#pragma unroll
    for (int d0 = 0; d0 < 2; ++d0) stg[orow * 64 + d0 * 32 + r32] = f2bf(o[d0][r]); }
  asm volatile("s_waitcnt lgkmcnt(0)" ::: "memory");
#pragma unroll
  for (int i = 0; i < 4; ++i) { const int row = i * 8 + (lane >> 3), ch = lane & 7; const u32x4 v = *(LAS const u32x4*)(stg + row * 64 + ch * 8); *(u32x4*)(Ow + (size_t)row * ldo + ch * 8) = v; }
  asm volatile("s_waitcnt vmcnt(0) lgkmcnt(0)\n\ts_barrier" ::: "memory");
#undef SB_DMA
}
}
__device__ __forceinline__ void phase_sb_attn(const Params& p, LAS char* lds, int bid, int nblk, bool dummy = false) {
  char* ws = p.ws;
  bf16_t* P = (bf16_t*)(ws + OFF_P); bf16_t* Od = dummy ? (bf16_t*)(ws + OFF_G + G_MIX) : P; const int ldo = dummy ? DM : LDP;
  const int vcu = (nblk % 8 == 0) ? (bid % 8) * (nblk / 8) + bid / 8 : bid;
  for (int pi = vcu; pi < 96 * 8; pi += nblk) {
    const int bh = pi >> 3, s = pi & 7, b = bh / 12, h = bh % 12;
    sb::unit(P, Od, ldo, b, h, 15 - s, lds);
    sb::unit(P, Od, ldo, b, h, s, lds);
  }
}

namespace gdn {
constexpr int RA_W = 0, RA_QG = 16384, RA_KT = 32768, RA_ATT = 49152, REC_A = 55296, REC_U = 16384, REC = REC_A + REC_U;
constexpr int HALF_LDS = 58368;
constexpr float QSCALE = 0.08838834764831845f;
__device__ __forceinline__ int crow(int r, int hi) { return (r & 3) + 8 * (r >> 2) + 4 * hi; }
}
__device__ __forceinline__ void phase_gdn_prep(const Params& p, LAS char* lds, int bid, int nblk) {
  using namespace gdn;
  char* ws = p.ws; const bf16_t* P = (const bf16_t*)(ws + OFF_P); char* G = ws + OFF_G; float* EGL = (float*)(ws + OFF_EGL);
  const int nrounds = (3072 + 2 * nblk - 1) / (2 * nblk);
  for (int rd = 0; rd < nrounds; ++rd) {
    int tl = threadIdx.x; asm volatile("" : "+v"(tl));
    const int tid = tl, hb = tid >> 8, ht = tid & 255, lane = tid & 63, r32 = lane & 31, hi = lane >> 5;
    const int hw = __builtin_amdgcn_readfirstlane(ht >> 6);
    LAS char* L = lds + hb * HALF_LDS;
    LAS float* sBeta = (LAS float*)(L + REC_A); LAS float* sGc = sBeta + 64; LAS float* sEgc = sGc + 64; LAS float* sRnK = sEgc + 64; LAS float* sRnQ = sRnK + 64;
    LAS char* sQ = L; LAS char* sK = L + 17408;
    LAS float* Amat = (LAS float*)(L + RA_W);
    const int u0 = (rd * nblk + bid) * 2 + hb; const bool valid = u0 < 3072; const int u = valid ? u0 : 0;
    const int bh = u >> 6, n = u & 63, b = bh / 6, h = bh % 6; const size_t row0 = (size_t)b * SEQ + (size_t)n * 64;
    char* rec = G + (size_t)u * REC;
    __syncthreads();
    if (hw == 0) {
      const bf16_t* pr = P + (row0 + lane) * LDP + PC_BA;
      const float braw = bf2f(pr[h]), araw = bf2f(pr[6 + h]);
      const float beta = sigmoidf_(braw), g = -__expf(p.a_log[h]) * softplusf_(araw + p.a_dt_bias[h]);
      float s = g;
#pragma unroll
      for (int o = 1; o < 64; o <<= 1) { const float t = __shfl_up(s, o); if (lane >= o) s += t; }
      sBeta[lane] = beta; sGc[lane] = s; sEgc[lane] = __expf(s);
    }
    for (int i = ht; i < 67 * 48; i += 256) {
      const int rr = i / 48, cc = i % 48, part = cc >> 4, c8 = (cc & 15) * 8;
      u32x4 v = (u32x4){0u, 0u, 0u, 0u};
      if (n > 0 || rr >= 3) v = *(const u32x4*)(P + (row0 + rr - 3) * LDP + (part == 0 ? PC_Q : part == 1 ? PC_K : PC_V) + h * 128 + c8);
      *(LAS u32x4*)(L + rr * 768 + cc * 16) = v;
    }
    __syncthreads();
    float x[64], xq[64];
    {
      const int c = ht & 127; const bool isk = ht >= 128;
      {
        const int ch = (isk ? 768 : 1536) + h * 128 + c;
        const float w0 = p.a_conv[ch], w1 = p.a_conv[2304 + ch], w2 = p.a_conv[2 * 2304 + ch], w3 = p.a_conv[3 * 2304 + ch];
        LAS const char* src = L + (isk ? 256 : 512) + c * 2;
        float r0 = bf2f(*(LAS const bf16_t*)(src)), r1 = bf2f(*(LAS const bf16_t*)(src + 768)), r2 = bf2f(*(LAS const bf16_t*)(src + 2 * 768));
#pragma unroll
        for (int i = 0; i < 64; ++i) { const float r3 = bf2f(*(LAS const bf16_t*)(src + (i + 3) * 768)); x[i] = siluf_(w0 * r0 + w1 * r1 + w2 * r2 + w3 * r3); r0 = r1; r1 = r2; r2 = r3; }
      }
      if (!isk) {
        const int ch = h * 128 + c;
        const float w0 = p.a_conv[ch], w1 = p.a_conv[2304 + ch], w2 = p.a_conv[2 * 2304 + ch], w3 = p.a_conv[3 * 2304 + ch];
        LAS const char* src = L + c * 2;
        float r0 = bf2f(*(LAS const bf16_t*)(src)), r1 = bf2f(*(LAS const bf16_t*)(src + 768)), r2 = bf2f(*(LAS const bf16_t*)(src + 2 * 768));
#pragma unroll
        for (int i = 0; i < 64; ++i) { const float r3 = bf2f(*(LAS const bf16_t*)(src + (i + 3) * 768)); xq[i] = siluf_(w0 * r0 + w1 * r1 + w2 * r2 + w3 * r3); r0 = r1; r1 = r2; r2 = r3; }
      } else {
#pragma unroll
        for (int i = 0; i < 64; ++i) xq[i] = x[i];
      }
    }
    __syncthreads();
    if (ht < 128) {
#pragma unroll
      for (int i = 0; i < 64; ++i) *(LAS bf16_t*)(sQ + i * 272 + ht * 2) = f2bf(xq[i]);
    } else {
#pragma unroll
      for (int i = 0; i < 64; ++i) *(LAS bf16_t*)(sK + i * 272 + (ht - 128) * 2) = f2bf(x[i]);
    }
    __syncthreads();
    const int it = hw >> 1, jt = hw & 1;
    f32x16 akk = f32x16{}, aqk = f32x16{};
    if (hw != 1) {
#pragma unroll
      for (int ks = 0; ks < 8; ++ks) {
        const bf16x8 ak = *(LAS const bf16x8*)(sK + (32 * it + r32) * 272 + ks * 32 + hi * 16), aq = *(LAS const bf16x8*)(sQ + (32 * it + r32) * 272 + ks * 32 + hi * 16);
        const bf16x8 bk = *(LAS const bf16x8*)(sK + (32 * jt + r32) * 272 + ks * 32 + hi * 16);
        akk = __builtin_amdgcn_mfma_f32_32x32x16_bf16(ak, bk, akk, 0, 0, 0); aqk = __builtin_amdgcn_mfma_f32_32x32x16_bf16(aq, bk, aqk, 0, 0, 0);
      }
    } else {
#pragma unroll
      for (int ks = 0; ks < 8; ++ks) {
        const bf16x8 a0 = *(LAS const bf16x8*)(sQ + r32 * 272 + ks * 32 + hi * 16), a1 = *(LAS const bf16x8*)(sQ + (32 + r32) * 272 + ks * 32 + hi * 16);
        akk = __builtin_amdgcn_mfma_f32_32x32x16_bf16(a0, a0, akk, 0, 0, 0); aqk = __builtin_amdgcn_mfma_f32_32x32x16_bf16(a1, a1, aqk, 0, 0, 0);
      }
    }
    {
      float d0 = 0.f, d1 = 0.f;
#pragma unroll
      for (int r = 0; r < 16; ++r) if (crow(r, hi) == r32) { d0 = akk[r]; d1 = aqk[r]; }
      const bool has = ((r32 >> 2) & 1) == hi;
      if (has && hw == 0) sRnK[r32] = rsqrtf(d0 + EPS);
      if (has && hw == 3) sRnK[32 + r32] = rsqrtf(d0 + EPS);
      if (has && hw == 1) { sRnQ[r32] = rsqrtf(d0 + EPS) * QSCALE; sRnQ[32 + r32] = rsqrtf(d1 + EPS) * QSCALE; }
    }
    __syncthreads();
    if (hw != 1) {
      const int j = 32 * jt + r32; const float rnkj = sRnK[j], gcj = sGc[j];
      const int ksj = 2 * jt + (r32 >> 4), jo = r32 & 15, hip = (jo >> 2) & 1, jp = (jo & 3) + 4 * (jo >> 3);
      LAS char* attf = L + RA_ATT + (it ? 2 + ksj : ksj) * 1024 + hip * 512 + jp * 2;
#pragma unroll
      for (int r = 0; r < 16; ++r) {
        const int il = crow(r, hi), i = 32 * it + il;
        const float dec = __expf(fminf(sGc[i] - gcj, 0.f));
        const float aval = (i > j) ? sBeta[i] * sRnK[i] * rnkj * akk[r] * dec : 0.f;
        const float tval = (i >= j) ? sRnQ[i] * rnkj * aqk[r] * dec : 0.f;
        Amat[i * 64 + j] = aval;
        *(LAS bf16_t*)(attf + il * 16) = f2bf(tval);
        if ((r & 3) == 3) asm volatile("" ::: "memory");
      }
    }
    __syncthreads();
    if (ht < 128) {
      const int c = ht;
      const int co = c & 15, hip = (co >> 2) & 1, jp = (co & 3) + 4 * (co >> 3);
      LAS char* qgf = L + RA_QG + (c >> 4) * 1024 + hip * 512 + jp * 2;
#pragma unroll
      for (int i = 0; i < 64; ++i) { *(LAS bf16_t*)(qgf + (i >> 5) * 8192 + (i & 31) * 16) = f2bf(xq[i] * sRnQ[i] * sEgc[i]); x[i] *= sBeta[i]; if ((i & 7) == 7) asm volatile("" ::: "memory"); }
    } else {
      const int c = ht - 128;
      const float gl = sGc[63];
      LAS char* ktf = L + RA_KT + (c >> 5) * 4096 + (c & 31) * 16;
#pragma unroll
      for (int ks = 0; ks < 4; ++ks)
#pragma unroll
        for (int hp = 0; hp < 2; ++hp) {
          float v[8];
#pragma unroll
          for (int jq = 0; jq < 8; ++jq) { const int i = 16 * ks + (jq & 3) + 8 * (jq >> 2) + 4 * hp; v[jq] = xq[i] * sRnK[i] * __expf(gl - sGc[i]); }
          u32x4 w; w.x = cvt_pk_bf16(v[0], v[1]); w.y = cvt_pk_bf16(v[2], v[3]); w.z = cvt_pk_bf16(v[4], v[5]); w.w = cvt_pk_bf16(v[6], v[7]);
          *(LAS u32x4*)(ktf + ks * 1024 + hp * 512) = w;
          asm volatile("" ::: "memory");
        }
#pragma unroll
      for (int i = 0; i < 64; ++i) { x[i] *= sBeta[i] * sEgc[i] * sRnK[i]; if ((i & 7) == 7) asm volatile("" ::: "memory"); }
    }
    asm volatile("" ::: "memory");
#pragma unroll
    for (int i = 1; i < 64; ++i) {
      float acc = x[i];
#pragma unroll
      for (int j4 = 0; j4 < (i + 3) / 4; ++j4) {
        const f32x4 a = *(LAS const f32x4*)(Amat + i * 64 + j4 * 4);
        acc -= a[0] * x[4 * j4]; acc -= a[1] * x[4 * j4 + 1]; acc -= a[2] * x[4 * j4 + 2]; acc -= a[3] * x[4 * j4 + 3];
      }
      x[i] = acc;
      if ((i & 3) == 3) asm volatile("" ::: "memory");
    }
    __syncthreads();
    if (ht < 128) {
      const int c = ht;
      if (valid) {
        char* ud = rec + REC_A + c * 128;
#pragma unroll
        for (int q = 0; q < 8; ++q) {
          const int ib = 32 * (q >> 2) + 4 * ((q >> 1) & 1) + 16 * (q & 1);
          u32x4 w; w.x = cvt_pk_bf16(x[ib], x[ib + 1]); w.y = cvt_pk_bf16(x[ib + 2], x[ib + 3]); w.z = cvt_pk_bf16(x[ib + 8], x[ib + 9]); w.w = cvt_pk_bf16(x[ib + 10], x[ib + 11]);
          *(u32x4*)(ud + q * 16) = w;
        }
      }
    } else {
      const int c = ht - 128;
      const int co = c & 15, hip = (co >> 2) & 1, jp = (co & 3) + 4 * (co >> 3);
      LAS char* wf = L + RA_W + (c >> 4) * 1024 + hip * 512 + jp * 2;
#pragma unroll
      for (int i = 0; i < 64; ++i) *(LAS bf16_t*)(wf + (i >> 5) * 8192 + (i & 31) * 16) = f2bf(-x[i]);
    }
    if (ht == 0 && valid) EGL[u] = __expf(sGc[63]);
    __syncthreads();
    if (valid) for (int o = ht * 16; o < REC_A; o += 4096) *(u32x4*)(rec + o) = *(LAS const u32x4*)(L + o);
  }
}

__device__ __forceinline__ void phase_gdn_scan(const Params& p, LAS char* lds, int bid, int nblk) {
  using namespace gdn;
  char* ws = p.ws; bf16_t* P = (bf16_t*)(ws + OFF_P); const char* G = ws + OFF_G; const float* EGL = (const float*)(ws + OFF_EGL);
  const int tid = threadIdx.x, lane = tid & 63, r32 = lane & 31, hi = lane >> 5; const int wid = __builtin_amdgcn_readfirstlane(tid >> 6);
  LAS char* OX = lds + 2 * REC_A;
  {
    const int u = bid; const int b = u / 6, h = u % 6; const size_t rowb = (size_t)b * SEQ; const char* recb = G + (size_t)u * 64 * REC;
    __syncthreads();
    if (wid >= 4) {
      const int j = wid - 4, row = 16 * j + (lane >> 2), cg = (lane & 3) * 32;
      if (j < 2) for (int f = j; f < 54; f += 2) __builtin_amdgcn_global_load_lds((const unsigned*)(recb + f * 1024 + lane * 16), (LAS unsigned*)(lds + f * 1024), 16, 0, 0);
      float gn[32];
#pragma unroll
      for (int q = 0; q < 8; ++q) { const f32x4 g = *(const f32x4*)(p.a_out_gain + cg + q * 4); gn[4 * q] = g[0]; gn[4 * q + 1] = g[1]; gn[4 * q + 2] = g[2]; gn[4 * q + 3] = g[3]; }
      float sg[32]; u32x4 gr[4];
#pragma unroll
      for (int q = 0; q < 4; ++q) gr[q] = (u32x4){0u, 0u, 0u, 0u};
      const bf16_t* gp0 = P + (rowb + row) * LDP + PC_GATE + h * 128 + cg;
      bf16_t* dp0 = P + (rowb + row) * LDP + PC_Q + h * 128 + cg;
      for (int c = 0; c <= 64; ++c) {
        asm volatile("s_waitcnt vmcnt(0) lgkmcnt(0)\n\ts_barrier" ::: "memory");
        if (j < 2 && c + 1 < 64) { const char* rn = recb + (size_t)(c + 1) * REC; LAS char* dst = lds + ((c + 1) & 1) * REC_A;
          for (int f = j; f < 54; f += 2) __builtin_amdgcn_global_load_lds((const unsigned*)(rn + f * 1024 + lane * 16), (LAS unsigned*)(dst + f * 1024), 16, 0, 0); }
        if (c >= 1) {
#pragma unroll
          for (int q = 0; q < 4; ++q) {
            sg[8 * q] = gn[8 * q] * siluf_(bflo(gr[q].x)); sg[8 * q + 1] = gn[8 * q + 1] * siluf_(bfhi(gr[q].x)); sg[8 * q + 2] = gn[8 * q + 2] * siluf_(bflo(gr[q].y)); sg[8 * q + 3] = gn[8 * q + 3] * siluf_(bfhi(gr[q].y));
            sg[8 * q + 4] = gn[8 * q + 4] * siluf_(bflo(gr[q].z)); sg[8 * q + 5] = gn[8 * q + 5] * siluf_(bfhi(gr[q].z)); sg[8 * q + 6] = gn[8 * q + 6] * siluf_(bflo(gr[q].w)); sg[8 * q + 7] = gn[8 * q + 7] * siluf_(bfhi(gr[q].w)); }
        }
        if (c < 64) {
#pragma unroll
          for (int q = 0; q < 4; ++q) gr[q] = *(const u32x4*)(gp0 + (size_t)c * 64 * LDP + q * 8);
        }
        if (c >= 1) {
          const int cc = c - 1;
          LAS const char* op = OX + (cc & 1) * 16384 + row * 256 + cg * 2;
          float ov[32]; float ss = 0.f;
#pragma unroll
          for (int q = 0; q < 4; ++q) { const u32x4 r = *(LAS const u32x4*)(op + q * 16);
            ov[8 * q] = bflo(r.x); ov[8 * q + 1] = bfhi(r.x); ov[8 * q + 2] = bflo(r.y); ov[8 * q + 3] = bfhi(r.y); ov[8 * q + 4] = bflo(r.z); ov[8 * q + 5] = bfhi(r.z); ov[8 * q + 6] = bflo(r.w); ov[8 * q + 7] = bfhi(r.w); }
#pragma unroll
          for (int q = 0; q < 32; ++q) ss += ov[q] * ov[q];
          ss += __shfl_xor(ss, 1); ss += __shfl_xor(ss, 2);
          const float sc = rsqrtf(ss * (1.f / 128.f) + EPS);
          bf16_t* dp = dp0 + (size_t)cc * 64 * LDP;
#pragma unroll
          for (int q = 0; q < 4; ++q) { u32x4 w;
            w.x = cvt_pk_bf16(ov[8 * q] * sc * sg[8 * q], ov[8 * q + 1] * sc * sg[8 * q + 1]); w.y = cvt_pk_bf16(ov[8 * q + 2] * sc * sg[8 * q + 2], ov[8 * q + 3] * sc * sg[8 * q + 3]);
            w.z = cvt_pk_bf16(ov[8 * q + 4] * sc * sg[8 * q + 4], ov[8 * q + 5] * sc * sg[8 * q + 5]); w.w = cvt_pk_bf16(ov[8 * q + 6] * sc * sg[8 * q + 6], ov[8 * q + 7] * sc * sg[8 * q + 7]);
            *(u32x4*)(dp + q * 8) = w; }
        }
      }
    } else {
      const int vs = wid;
      f32x16 S[4];
#pragma unroll
      for (int k = 0; k < 4; ++k) S[k] = f32x16{};
      const char* ub = recb + REC_A + (vs * 32 + r32) * 128 + hi * 32;
      u32x4 un[4];
#pragma unroll
      for (int q = 0; q < 4; ++q) un[q] = *(const u32x4*)(ub + (q >> 1) * 64 + (q & 1) * 16);
      float egn = EGL[u * 64];
      for (int c = 0; c <= 64; ++c) {
        asm volatile("s_waitcnt lgkmcnt(0)\n\ts_barrier" ::: "memory");
        if (c < 64) {
          LAS const char* R = lds + (c & 1) * REC_A + lane * 16;
          const float egl = egn; if (c + 1 < 64) egn = EGL[u * 64 + c + 1];
          u32x4 uc[4];
#pragma unroll
          for (int q = 0; q < 4; ++q) uc[q] = un[q];
          if (c + 1 < 64) {
#pragma unroll
            for (int q = 0; q < 4; ++q) un[q] = *(const u32x4*)(ub + (size_t)(c + 1) * REC + (q >> 1) * 64 + (q & 1) * 16);
          }
          bf16x8 Sb[8];
#pragma unroll
          for (int ks = 0; ks < 8; ++ks) { const int kt = ks >> 1, o = (ks & 1) * 8; u32x4 w;
            w.x = cvt_pk_bf16(S[kt][o], S[kt][o + 1]); w.y = cvt_pk_bf16(S[kt][o + 2], S[kt][o + 3]); w.z = cvt_pk_bf16(S[kt][o + 4], S[kt][o + 5]); w.w = cvt_pk_bf16(S[kt][o + 6], S[kt][o + 7]);
            Sb[ks] = __builtin_bit_cast(bf16x8, w); }
#define GB_LD(dst, off0, off1) do { _Pragma("unroll") for (int q_ = 0; q_ < 4; ++q_) { dst[q_] = *(LAS const bf16x8*)(R + (off0) + q_ * 1024); dst[4 + q_] = *(LAS const bf16x8*)(R + (off1) + q_ * 1024); } } while (0)
#define GB_SCHED __builtin_amdgcn_sched_barrier(0)
          bf16x8 fa[8], fb[8];
          GB_LD(fa, RA_W, RA_W + 8192);
          f32x16 vn[2];
#pragma unroll
          for (int t2 = 0; t2 < 2; ++t2)
#pragma unroll
            for (int q = 0; q < 2; ++q) { const u32x4 r = uc[2 * t2 + q];
              vn[t2][8 * q] = bflo(r.x); vn[t2][8 * q + 1] = bfhi(r.x); vn[t2][8 * q + 2] = bflo(r.y); vn[t2][8 * q + 3] = bfhi(r.y); vn[t2][8 * q + 4] = bflo(r.z); vn[t2][8 * q + 5] = bfhi(r.z); vn[t2][8 * q + 6] = bflo(r.w); vn[t2][8 * q + 7] = bfhi(r.w); }
          GB_LD(fb, RA_W + 4096, RA_W + 8192 + 4096); GB_SCHED;
#pragma unroll
          for (int ks = 0; ks < 4; ++ks) { vn[0] = __builtin_amdgcn_mfma_f32_32x32x16_bf16(fa[ks], Sb[ks], vn[0], 0, 0, 0); vn[1] = __builtin_amdgcn_mfma_f32_32x32x16_bf16(fa[4 + ks], Sb[ks], vn[1], 0, 0, 0); }
          GB_SCHED; GB_LD(fa, RA_KT, RA_KT + 4096); GB_SCHED;
#pragma unroll
          for (int ks = 0; ks < 4; ++ks) { vn[0] = __builtin_amdgcn_mfma_f32_32x32x16_bf16(fb[ks], Sb[4 + ks], vn[0], 0, 0, 0); vn[1] = __builtin_amdgcn_mfma_f32_32x32x16_bf16(fb[4 + ks], Sb[4 + ks], vn[1], 0, 0, 0); }
          bf16x8 vb[4];
#pragma unroll
          for (int ks = 0; ks < 4; ++ks) { const int t2 = ks >> 1, o = (ks & 1) * 8; u32x4 w;
            w.x = cvt_pk_bf16(vn[t2][o], vn[t2][o + 1]); w.y = cvt_pk_bf16(vn[t2][o + 2], vn[t2][o + 3]); w.z = cvt_pk_bf16(vn[t2][o + 4], vn[t2][o + 5]); w.w = cvt_pk_bf16(vn[t2][o + 6], vn[t2][o + 7]);
            vb[ks] = __builtin_bit_cast(bf16x8, w); }
          f32x16 oo[2]; oo[0] = f32x16{}; oo[1] = f32x16{};
          GB_SCHED; GB_LD(fb, RA_KT + 8192, RA_KT + 12288); GB_SCHED;
          S[0] = S[0] * egl; S[1] = S[1] * egl;
#pragma unroll
          for (int ks = 0; ks < 4; ++ks) { S[0] = __builtin_amdgcn_mfma_f32_32x32x16_bf16(fa[ks], vb[ks], S[0], 0, 0, 0); S[1] = __builtin_amdgcn_mfma_f32_32x32x16_bf16(fa[4 + ks], vb[ks], S[1], 0, 0, 0); }
          GB_SCHED; GB_LD(fa, RA_QG, RA_QG + 8192); GB_SCHED;
          S[2] = S[2] * egl; S[3] = S[3] * egl;
#pragma unroll
          for (int ks = 0; ks < 4; ++ks) { S[2] = __builtin_amdgcn_mfma_f32_32x32x16_bf16(fb[ks], vb[ks], S[2], 0, 0, 0); S[3] = __builtin_amdgcn_mfma_f32_32x32x16_bf16(fb[4 + ks], vb[ks], S[3], 0, 0, 0); }
          GB_SCHED; GB_LD(fb, RA_QG + 4096, RA_QG + 8192 + 4096); GB_SCHED;
#pragma unroll
          for (int ks = 0; ks < 4; ++ks) { oo[0] = __builtin_amdgcn_mfma_f32_32x32x16_bf16(fa[ks], Sb[ks], oo[0], 0, 0, 0); oo[1] = __builtin_amdgcn_mfma_f32_32x32x16_bf16(fa[4 + ks], Sb[ks], oo[1], 0, 0, 0); }
          GB_SCHED;
#pragma unroll
          for (int q = 0; q < 6; ++q) fa[q] = *(LAS const bf16x8*)(R + RA_ATT + q * 1024);
          GB_SCHED;
#pragma unroll
          for (int ks = 0; ks < 4; ++ks) { oo[0] = __builtin_amdgcn_mfma_f32_32x32x16_bf16(fb[ks], Sb[4 + ks], oo[0], 0, 0, 0); oo[1] = __builtin_amdgcn_mfma_f32_32x32x16_bf16(fb[4 + ks], Sb[4 + ks], oo[1], 0, 0, 0); }
          oo[0] = __builtin_amdgcn_mfma_f32_32x32x16_bf16(fa[0], vb[0], oo[0], 0, 0, 0); oo[1] = __builtin_amdgcn_mfma_f32_32x32x16_bf16(fa[2], vb[0], oo[1], 0, 0, 0);
          oo[0] = __builtin_amdgcn_mfma_f32_32x32x16_bf16(fa[1], vb[1], oo[0], 0, 0, 0); oo[1] = __builtin_amdgcn_mfma_f32_32x32x16_bf16(fa[3], vb[1], oo[1], 0, 0, 0);
          oo[1] = __builtin_amdgcn_mfma_f32_32x32x16_bf16(fa[4], vb[2], oo[1], 0, 0, 0); oo[1] = __builtin_amdgcn_mfma_f32_32x32x16_bf16(fa[5], vb[3], oo[1], 0, 0, 0);
#undef GB_LD
#undef GB_SCHED
          LAS char* ox = OX + (c & 1) * 16384 + (vs * 32 + r32) * 2;
#pragma unroll
          for (int t2 = 0; t2 < 2; ++t2)
#pragma unroll
            for (int r = 0; r < 16; ++r) *(LAS bf16_t*)(ox + (32 * t2 + crow(r, hi)) * 256) = f2bf(oo[t2][r]);
        }
      }
    }
  }
}

constexpr int NPHASE = 15;
__global__ void __launch_bounds__(NTHR, 2) yoco_fwd(Params p, int lo, int hi) {
  extern __shared__ __attribute__((aligned(16))) char smem_raw[];
  LAS char* lds = (LAS char*)smem_raw;
  const int bid = blockIdx.x, nblk = gridDim.x;
  LAS unsigned* xbw = (LAS unsigned*)(lds + LDS_BYTES - 16);
  if (threadIdx.x == 0) { xbw[0] = 0u; xbw[1] = 0u; xbw[2] = 0u; xbw[3] = 0u; }
  __syncthreads();
  XcdBarrier bar; bar.bar = (unsigned*)(p.ws + OFF_CTRL); bar.x = 0; bar.st = (volatile LAS unsigned*)xbw;
  if (hi - lo > 1) bar = xcd_barrier_post((unsigned*)(p.ws + OFF_CTRL), (volatile LAS unsigned*)xbw);
#ifndef PROBE_DOUBLE
#define PROBE_DOUBLE -1
#endif
#define PH(k) if (lo <= (k) && (k) < hi)
#define SEAM(k) if (lo <= (k) && (k) + 1 < hi) xcd_barrier(bar)
  PH(0) phase_prep<false>(p, bid, nblk);
#if PROBE_DOUBLE == 0
  PH(0) { __syncthreads(); phase_prep<false>(p, bid, nblk); }
#endif
  SEAM(0);
  PH(1) phase_gemm_inA(p, lds, bid, nblk);
#if PROBE_DOUBLE == 1
  PH(1) phase_gemm_inA(p, lds, bid, nblk);
#endif
  SEAM(1);
  PH(2) phase_gdn_prep(p, lds, bid, nblk);
#if PROBE_DOUBLE == 20
  PH(2) phase_gdn_prep(p, lds, bid, nblk);
#endif
  SEAM(2);
  PH(2) { if (bid < 48) phase_gdn_scan(p, lds, bid, nblk); else { phase_memattn(p, lds, bid - 48, nblk - 48, 0); phase_prep<true>(p, bid - 48, nblk - 48); } }
#if PROBE_DOUBLE == 21
  PH(2) { if (bid < 48) phase_gdn_scan(p, lds, bid, nblk); }
#endif
  SEAM(2);
  PH(3) phase_gemm_out(p, lds, bid, nblk, 0);
#if PROBE_DOUBLE == 3
  PH(3) phase_gemm_out(p, lds, bid, nblk, 0);
#endif
  SEAM(3);
  PH(4) phase_norm_route(p, lds, bid, nblk, 0);
  SEAM(4);
  PH(5) phase_moe1(p, lds, bid, nblk, 0);
#if PROBE_DOUBLE == 5
  PH(5) phase_moe1(p, lds, bid, nblk, 0);
#endif
  SEAM(5);
  PH(6) phase_moe2(p, lds, bid, nblk, 0);
#if PROBE_DOUBLE == 6
  PH(6) phase_moe2(p, lds, bid, nblk, 0);
#endif
  SEAM(6);
  PH(7) phase_combine<false>(p, bid, nblk);
  SEAM(7);
  PH(8) phase_gemm_inB(p, lds, bid, nblk);
#if PROBE_DOUBLE == 8
  PH(8) phase_gemm_inB(p, lds, bid, nblk);
#endif
  SEAM(8);
#if PROBE_DOUBLE == 9
  PH(9) { phase_sb_attn(p, lds, bid, nblk, true); }
#endif
  PH(9) { phase_sb_attn(p, lds, bid, nblk); phase_memattn(p, lds, bid, nblk, 1); }
#if PROBE_DOUBLE == 91
  PH(9) { phase_memattn(p, lds, bid, nblk, 1); }
#endif
  SEAM(9);
  PH(10) phase_gemm_out(p, lds, bid, nblk, 1);
  SEAM(10);
  PH(11) phase_norm_route(p, lds, bid, nblk, 1);
  SEAM(11);
  PH(12) phase_moe1(p, lds, bid, nblk, 1);
  SEAM(12);
  PH(13) phase_moe2(p, lds, bid, nblk, 1);
  SEAM(13);
  PH(14) phase_combine<true>(p, bid, nblk);
#undef PH
#undef SEAM
}

#ifndef N_LAUNCH_SPLIT
#define N_LAUNCH_SPLIT 0
#endif

extern "C" void kernel_launch(void* const* d_in, const int* in_sizes, int n_in, void* d_out, int out_size, void* d_ws, size_t ws_size, hipStream_t stream) {
  (void)in_sizes; (void)n_in; (void)out_size;
  if (ws_size < WS_NEED) return;
  static int grid = 0;
  if (!grid) {
    if (hipFuncSetAttribute((const void*)yoco_fwd, hipFuncAttributeMaxDynamicSharedMemorySize, LDS_BYTES) != hipSuccess) { grid = -1; return; }
    int dev = 0, cus = 0; hipGetDevice(&dev); hipDeviceGetAttribute(&cus, hipDeviceAttributeMultiprocessorCount, dev);
    int per_cu = 0; hipOccupancyMaxActiveBlocksPerMultiprocessor(&per_cu, (const void*)yoco_fwd, NTHR, LDS_BYTES);
    grid = (per_cu >= 1) ? cus : -1;
  }
  if (grid <= 0) return;
  Params p{};
  const float** pf = (const float**)&p;
  for (int i = 0; i < 25; ++i) pf[i] = (const float*)d_in[i];
  p.out = (float*)d_out; p.ws = (char*)d_ws;
  hipMemsetAsync(d_ws, 0, 65536, stream);
#if N_LAUNCH_SPLIT
  for (int k = 0; k < NPHASE; ++k) hipLaunchKernelGGL(yoco_fwd, dim3(grid), dim3(NTHR), LDS_BYTES, stream, p, k, k + 1);
#else
  hipLaunchKernelGGL(yoco_fwd, dim3(grid), dim3(NTHR), LDS_BYTES, stream, p, 0, NPHASE);
#endif
}
```

```cpp
#include <hip/hip_runtime.h>
#include <stdint.h>
#include <stddef.h>

#define LAS __attribute__((address_space(3)))
typedef unsigned short bf16_t;
typedef short bf16x8 __attribute__((ext_vector_type(8)));
typedef float f32x4 __attribute__((ext_vector_type(4)));
typedef float f32x16 __attribute__((ext_vector_type(16)));
typedef unsigned u32x4 __attribute__((ext_vector_type(4)));
typedef unsigned u32x2 __attribute__((ext_vector_type(2)));

constexpr int NTOK = 32768, DM = 1024, SEQ = 4096, NBATCH = 8, MEMLEN = 256, NMEMROW = NBATCH * MEMLEN;
constexpr int LDP = 3392;
constexpr int PC_Q = 0, PC_MQ = 768, PC_K = 1024, PC_V = 1792, PC_GATE = 2560, PC_BA = 3328;
constexpr int NIN_A = 3584;
constexpr int NIN_B = 2560;
constexpr float EPS = 1e-6f;
constexpr float LOG2E = 1.4426950408889634f;
constexpr int NTHR = 512;

constexpr size_t OFF_CTRL  = 0;
constexpr size_t CTRL_BYTES = 81920;
constexpr size_t OFF_RSTD  = CTRL_BYTES;
constexpr size_t OFF_MRSTD = OFF_RSTD + (size_t)NTOK * 4;
constexpr size_t OFF_CW    = OFF_MRSTD + 8192;
constexpr size_t OFF_LIST  = OFF_CW + 65536 * 4;
constexpr size_t OFF_MEMKV = OFF_LIST + (size_t)16 * NTOK * 4;
constexpr size_t OFF_WR    = OFF_MEMKV + (size_t)2 * 2048 * 512 * 2;
constexpr size_t OFF_EGL   = OFF_WR + (size_t)2 * 20 * 1024 * 4;
constexpr size_t OFF_W     = 8u << 20;
constexpr size_t W_AIN  = 0;
constexpr size_t W_AOUT = W_AIN + (size_t)NIN_A * 1024 * 2;
constexpr size_t W_BIN  = W_AOUT + (size_t)1024 * 1024 * 2;
constexpr size_t W_BOUT = W_BIN + (size_t)NIN_B * 1024 * 2;
constexpr size_t W_MEM  = W_BOUT + (size_t)1024 * 1024 * 2;
constexpr size_t W_13   = W_MEM + (size_t)2 * 512 * 1024 * 2;
constexpr size_t W_2    = W_13 + (size_t)32 * 512 * 1024 * 2;
constexpr size_t W_END  = W_2 + (size_t)32 * 1024 * 256 * 2;
constexpr size_t OFF_P  = OFF_W + W_END;
constexpr size_t OFF_G  = OFF_P + (size_t)NTOK * LDP * 2;
constexpr size_t G_MIX  = 0;
constexpr size_t G_HB   = (size_t)128 << 20;
constexpr size_t WS_NEED = OFF_G + ((size_t)216 << 20);
static_assert(OFF_EGL + 3072 * 128 <= OFF_W, "small region");
static_assert(WS_NEED <= ((size_t)512 << 20), "workspace");
constexpr int CTRL_CNT = 4096;
constexpr int CTRL_PCNT = 8192;
constexpr int CTRL_PROG = 12288;
constexpr int CTRL_XCC = 13312, CTRL_RANK = 13440;
constexpr int CTRL_MEMKV = 13056;
constexpr int CTRL_GFLAG = 16384;
constexpr int CTRL_EDONE = 6144;
constexpr size_t P_PLIST = (size_t)40 << 20;

constexpr int LDS_BYTES = 163840;

struct Params {
  const float *x, *mem, *a_norm, *a_w_in, *a_conv, *a_log, *a_dt_bias, *a_out_gain, *a_w_out, *kv_norm, *w_kv,
      *b_norm, *b_w_in, *b_w_out, *mem_norm, *w_mem_kv, *ffn_norm, *w_group, *b_group, *w_router, *b_router,
      *w1, *w3, *w2, *final_norm;
  float* out; char* ws;
};

typedef float f32x2_t __attribute__((ext_vector_type(2))); typedef __bf16 bf16x2_t __attribute__((ext_vector_type(2)));
__device__ __forceinline__ unsigned cvt_pk_bf16(float lo, float hi) { const f32x2_t v = {lo, hi}; const bf16x2_t b = __builtin_convertvector(v, bf16x2_t); return __builtin_bit_cast(unsigned, b); }
__device__ __forceinline__ bf16_t f2bf(float f) { return (bf16_t)(cvt_pk_bf16(f, 0.f) & 0xffffu); }
__device__ __forceinline__ float bf2f(bf16_t b) { return __uint_as_float(((unsigned)b) << 16); }
__device__ __forceinline__ float bflo(unsigned u) { return __uint_as_float(u << 16); }
__device__ __forceinline__ float bfhi(unsigned u) { return __uint_as_float(u & 0xffff0000u); }
__device__ __forceinline__ float wave_sum(float v) {
#pragma unroll
  for (int o = 32; o >= 1; o >>= 1) v += __shfl_xor(v, o);
  return v;
}
__device__ __forceinline__ float sigmoidf_(float x) { return __builtin_amdgcn_rcpf(1.f + __expf(-x)); }
__device__ __forceinline__ float siluf_(float x) { return x * __builtin_amdgcn_rcpf(1.f + __expf(-x)); }
__device__ __forceinline__ float softplusf_(float x) { return fmaxf(x, 0.f) + log1pf(__expf(-fabsf(x))); }

#define XB_TMO      128
#define XB_XCNT(j)  (256  + 64 * (j))
#define XB_XSUB(j)  (1280 + 64 * (j))
#define XB_XGEN(j)  (2304 + 64 * (j))
#define XB_TOP      3328
#define XB_TOPGEN   3392
#define XCD_BAR_WORDS 3456
#define XB_SPIN_CAP (1u << 22)
__device__ __forceinline__ unsigned xb_ld(unsigned* p)              { return __hip_atomic_load(p, __ATOMIC_RELAXED, __HIP_MEMORY_SCOPE_AGENT); }
__device__ __forceinline__ unsigned xb_add(unsigned* p, unsigned v) { return __hip_atomic_fetch_add(p, v, __ATOMIC_RELAXED, __HIP_MEMORY_SCOPE_AGENT); }
__device__ __forceinline__ unsigned xb_xcc_id() { return (unsigned)__builtin_amdgcn_s_getreg((3 << 11) | 20) & 0xFu; }
#define XB_SPIN(cond, bar) do { unsigned _sp = 0; while (cond) { __builtin_amdgcn_s_sleep(1); \
    if ((++_sp & 255u) == 0u) { if (xb_ld(&(bar)[XB_TMO])) break; if (_sp > XB_SPIN_CAP) { atomicAdd(&(bar)[XB_TMO], 1u); break; } } } } while (0)
struct XcdBarrier { unsigned* bar; unsigned x; volatile LAS unsigned* st; };
__device__ __forceinline__ XcdBarrier xcd_barrier_post(unsigned* bar, volatile LAS unsigned* st) {
    XcdBarrier b; b.bar = bar; b.x = xb_xcc_id(); b.st = st;
    if (threadIdx.x == 0) (void)xb_add(&bar[XB_XCNT(b.x)], 1u);
    return b;
}
__device__ __forceinline__ void xcd_barrier_complete(unsigned* bar, unsigned x, unsigned& nloc, unsigned& nx) {
    const unsigned G = gridDim.x * gridDim.y * gridDim.z;
    unsigned sum, cnt, mine, sp = 0u;
    for (;;) {
        sum = 0u; cnt = 0u; mine = 0u;
#pragma unroll
        for (unsigned j = 0; j < 16; ++j) { const unsigned c = xb_ld(&bar[XB_XCNT(j)]); sum += c; cnt += (c > 0u) ? 1u : 0u; mine = (j == x) ? c : mine; }
        if (sum == G) break;
        __builtin_amdgcn_s_sleep(1);
        if ((++sp & 255u) == 0u) { if (xb_ld(&bar[XB_TMO])) break; if (sp > XB_SPIN_CAP) { atomicAdd(&bar[XB_TMO], 1u); break; } }
    }
    nloc = mine > 0u ? mine : 1u; nx = cnt > 0u ? cnt : 1u;
}
__device__ __forceinline__ void xcd_barrier(const XcdBarrier& b) {
    asm volatile("s_waitcnt vmcnt(0)" ::: "memory");
    __syncthreads();
    if (threadIdx.x == 0) {
        unsigned* bar = b.bar;
        __builtin_amdgcn_s_waitcnt(0);
        unsigned nloc = b.st[0], nx = b.st[1];
        if (nloc == 0u) { xcd_barrier_complete(bar, b.x, nloc, nx); b.st[0] = nloc; b.st[1] = nx; }
        const unsigned old = xb_add(&bar[XB_XSUB(b.x)], 1u);
        const unsigned gen = old / nloc;
        if (old + 1u == (gen + 1u) * nloc) {
            __builtin_amdgcn_fence(__ATOMIC_RELEASE, "agent");
            asm volatile("s_waitcnt vmcnt(0)" ::: "memory");
            const unsigned og = xb_add(&bar[XB_TOP], 1u);
            const unsigned tg = og / nx;
            if (og + 1u == (tg + 1u) * nx) xb_add(&bar[XB_TOPGEN], 1u);
            else XB_SPIN(xb_ld(&bar[XB_TOPGEN]) == tg, bar);
            __builtin_amdgcn_fence(__ATOMIC_ACQUIRE, "agent");
            xb_add(&bar[XB_XGEN(b.x)], 1u);
            asm volatile("s_waitcnt vmcnt(0)" ::: "memory");
        } else {
            XB_SPIN(xb_ld(&bar[XB_XGEN(b.x)]) == gen, bar);
            __builtin_amdgcn_fence(__ATOMIC_ACQUIRE, "agent");
            asm volatile("s_waitcnt vmcnt(0)" ::: "memory");
        }
    }
    __syncthreads();
}

__device__ __forceinline__ void cvt_rows(bf16_t* dst, int nrows_dst, int K, const float* src, int src_ld, int col0, int nrows_src,
                         const float* gain, float scale, int gtid, int gthreads) {
  const int items = nrows_dst * (K >> 3);
  for (int it = gtid; it < items; it += gthreads) {
    const int r = it % nrows_dst, k8 = it / nrows_dst;
    float v[8];
#pragma unroll
    for (int j = 0; j < 8; ++j) {
      const int k = k8 * 8 + j;
      v[j] = (r < nrows_src) ? src[(size_t)k * src_ld + col0 + r] * (gain ? gain[k] : 1.f) * scale : 0.f;
    }
    u32x4 w; w.x = cvt_pk_bf16(v[0], v[1]); w.y = cvt_pk_bf16(v[2], v[3]); w.z = cvt_pk_bf16(v[4], v[5]); w.w = cvt_pk_bf16(v[6], v[7]);
    *(u32x4*)(dst + (size_t)r * K + k8 * 8) = w;
  }
}

__device__ __forceinline__ void rows_to_bf16(const float* src, bf16_t* dst, float* rstd, int nrows, int gwave, int nwaves, int lane) {
  for (int r = gwave; r < nrows; r += nwaves) {
    const float* s = src + (size_t)r * DM; float ss = 0.f;
#pragma unroll
    for (int i = 0; i < 4; ++i) {
      const f32x4 v = *(const f32x4*)(s + i * 256 + lane * 4);
      ss += v[0] * v[0] + v[1] * v[1] + v[2] * v[2] + v[3] * v[3];
      u32x2 w; w.x = cvt_pk_bf16(v[0], v[1]); w.y = cvt_pk_bf16(v[2], v[3]);
      *(u32x2*)(dst + (size_t)r * DM + i * 256 + lane * 4) = w;
    }
    ss = wave_sum(ss);
    if (lane == 0) rstd[r] = rsqrtf(ss * (1.f / DM) + EPS);
  }
}

template <bool LATE>
__device__ __forceinline__ void phase_prep(const Params& p, int bid, int nblk) {
  const int tid = threadIdx.x, gtid = bid * NTHR + tid, gthreads = nblk * NTHR, lane = tid & 63;
  char* ws = p.ws; bf16_t* W = (bf16_t*)(ws + OFF_W);
  if (!LATE) {
  bf16_t* wa = (bf16_t*)((char*)W + W_AIN);
  cvt_rows(wa + (size_t)PC_Q * 1024, 768, 1024, p.a_w_in, 3340, 0, 768, p.a_norm, 1.f, gtid, gthreads);
  cvt_rows(wa + (size_t)PC_MQ * 1024, 256, 1024, p.a_w_in, 3340, 3084, 256, p.a_norm, 0.125f * LOG2E, gtid, gthreads);
  cvt_rows(wa + (size_t)PC_K * 1024, 768, 1024, p.a_w_in, 3340, 768, 768, p.a_norm, 1.f, gtid, gthreads);
  cvt_rows(wa + (size_t)PC_V * 1024, 768, 1024, p.a_w_in, 3340, 1536, 768, p.a_norm, 1.f, gtid, gthreads);
  cvt_rows(wa + (size_t)PC_GATE * 1024, 768, 1024, p.a_w_in, 3340, 2304, 768, p.a_norm, 1.f, gtid, gthreads);
  cvt_rows(wa + (size_t)PC_BA * 1024, NIN_A - PC_BA, 1024, p.a_w_in, 3340, 3072, 12, p.a_norm, 1.f, gtid, gthreads);
  cvt_rows((bf16_t*)((char*)W + W_AOUT), 1024, 1024, p.a_w_out, 1024, 0, 1024, nullptr, 1.f, gtid, gthreads);
  for (int l = 0; l < 2; ++l)
    cvt_rows((bf16_t*)((char*)W + W_MEM) + (size_t)l * 512 * 1024, 512, 1024, p.w_mem_kv + (size_t)l * 1024 * 512, 512, 0, 512, p.mem_norm + l * 1024, 1.f, gtid, gthreads);
  } else {
  bf16_t* wb = (bf16_t*)((char*)W + W_BIN);
  cvt_rows(wb + (size_t)PC_Q * 1024, 768, 1024, p.b_w_in, 1024, 0, 768, p.b_norm, 0.125f * LOG2E, gtid, gthreads);
  cvt_rows(wb + (size_t)PC_MQ * 1024, 256, 1024, p.b_w_in, 1024, 768, 256, p.b_norm, 0.125f * LOG2E, gtid, gthreads);
  cvt_rows(wb + (size_t)PC_K * 1024, 768, 1024, p.w_kv, 1536, 0, 768, p.kv_norm, 1.f, gtid, gthreads);
  cvt_rows(wb + (size_t)PC_V * 1024, 768, 1024, p.w_kv, 1536, 768, 768, p.kv_norm, 1.f, gtid, gthreads);
  cvt_rows((bf16_t*)((char*)W + W_BOUT), 1024, 1024, p.b_w_out, 1024, 0, 1024, nullptr, 1.f, gtid, gthreads);
  {
    bf16_t* w13 = (bf16_t*)((char*)W + W_13);
    const int items = 32 * 512 * 128;
    for (int it = gtid; it < items; it += gthreads) {
      const int le = it >> 16, rem = it & 65535, r = rem & 511, k8 = rem >> 9;
      const int u = r >> 8, which = (r >> 7) & 1, j = r & 127, l = le >> 4;
      const float* src = (which ? p.w3 : p.w1) + (size_t)le * 1024 * 256 + u * 128 + j;
      const float* g = p.ffn_norm + l * 1024;
      float v[8];
#pragma unroll
      for (int q = 0; q < 8; ++q) { const int k = k8 * 8 + q; v[q] = src[(size_t)k * 256] * g[k]; }
      u32x4 w; w.x = cvt_pk_bf16(v[0], v[1]); w.y = cvt_pk_bf16(v[2], v[3]); w.z = cvt_pk_bf16(v[4], v[5]); w.w = cvt_pk_bf16(v[6], v[7]);
      *(u32x4*)(w13 + ((size_t)le * 512 + r) * 1024 + k8 * 8) = w;
    }
    bf16_t* w2t = (bf16_t*)((char*)W + W_2);
    const int items2 = 32 * 1024 * 32;
    for (int it = gtid; it < items2; it += gthreads) {
      const int le = it >> 15, rem = it & 32767, n = rem & 1023, k8 = rem >> 10;
      const float* src = p.w2 + (size_t)le * 256 * 1024 + n;
      float v[8];
#pragma unroll
      for (int q = 0; q < 8; ++q) v[q] = src[(size_t)(k8 * 8 + q) * 1024];
      u32x4 w; w.x = cvt_pk_bf16(v[0], v[1]); w.y = cvt_pk_bf16(v[2], v[3]); w.z = cvt_pk_bf16(v[4], v[5]); w.w = cvt_pk_bf16(v[6], v[7]);
      *(u32x4*)(w2t + ((size_t)le * 1024 + n) * 256 + k8 * 8) = w;
    }
  }
  }
  if (!LATE) {
  {
    float* wr = (float*)(ws + OFF_WR);
    for (int it = gtid; it < 2 * 20 * 1024; it += gthreads) {
      const int l = it / 20480, rem = it % 20480, j = rem >> 10, k = rem & 1023;
      const float w = (j < 4) ? p.w_group[((size_t)l * 1024 + k) * 4 + j] : p.w_router[((size_t)l * 1024 + k) * 16 + (j - 4)];
      wr[it] = w * p.ffn_norm[l * 1024 + k];
    }
  }
  const int gwave = gtid >> 6, nwaves = gthreads >> 6;
  rows_to_bf16(p.x, (bf16_t*)p.out, (float*)(ws + OFF_RSTD), NTOK, gwave, nwaves, lane);
  rows_to_bf16(p.mem, (bf16_t*)((char*)p.out + ((size_t)64 << 20)), (float*)(ws + OFF_MRSTD), NMEMROW, gwave, nwaves, lane);
  }
}

namespace g8 {
constexpr int BM = 256, BK = 64, HALF = 128, HTB = HALF * BK * 2, STAGE_BYTES = 8 * HTB, NXCD = 8, WGM = 8;
__host__ __device__ __forceinline__ int lds_byte(int r, int c) { const int st = (r >> 4) * 2 + (c >> 5), rr = r & 15, cc = c & 31, ob = rr * 64 + cc * 2; return st * 1024 + (ob ^ (((ob >> 9) & 1) << 5)); }
__host__ __device__ __forceinline__ void stage_rc(int b, int& R, int& C) { const int st = b / 1024, sb = b % 1024, swz = sb ^ (((sb >> 9) & 1) << 5); R = (st >> 1) * 16 + swz / 64; C = (st & 1) * 32 + (swz % 64) / 2; }
__host__ __device__ __forceinline__ int perm32(int rho) { const int n = rho >> 4, i = rho & 15; return 8 * (i >> 2) + 4 * n + (i & 3); }

struct Unit { const char* A; const char* B; const int* list; int row0, nvalid, pm, pn, aux; };

struct DenseOrder {
  const char* A; const char* Bt; int K; int nM, nN, nwg, G, c;
  __device__ __forceinline__ void init(const void* A_, const void* Bt_, int K_, int M, int N, int G_, int c_) { A = (const char*)A_; Bt = (const char*)Bt_; K = K_; nM = M / BM; nN = N / BM; nwg = nM * nN; G = G_; c = c_; }
  __device__ __forceinline__ bool next(int i, Unit& u) const {
    const long L = (long)i * G + c; if (L >= nwg) return false;
    int wgid = (int)L; { const int q = nwg / NXCD, r = nwg % NXCD, xcd = wgid % NXCD, off = wgid / NXCD; wgid = (xcd < r ? xcd * (q + 1) : r * (q + 1) + (xcd - r) * q) + off; }
    const int nig = WGM * nN, gid = wgid / nig, fm = gid * WGM, gsz = (nM - fm) < WGM ? (nM - fm) : WGM;
    u.pm = fm + ((wgid % nig) % gsz); u.pn = (wgid % nig) / gsz;
    u.A = A; u.B = Bt + (size_t)u.pn * BM * K * 2; u.list = nullptr; u.row0 = u.pm * BM; u.nvalid = BM; u.aux = 0; return true;
  }
  __device__ __forceinline__ void a_ready(const Unit&) const {}
  __device__ __forceinline__ void done(const Unit&) const {}
};

template <class Epi, class Sched, int SHIFT, bool SPLITB = false>
__device__ __forceinline__ void gemm_phase(LAS unsigned char* lds, const int K, const int lda, const Sched& S, const Epi& E) {
    const int tid = threadIdx.x, wid = __builtin_amdgcn_readfirstlane(tid >> 6), lane = tid & 63, wr = wid >> 2, wc = wid & 3, fr = lane & 15, fq = lane >> 4;
    const int nt = K / BK, nth = nt / 2, ldb = SPLITB ? K / 2 : K;
    int RA[2], CA[2]; unsigned voffB[2];
#pragma unroll
    for (int i = 0; i < 2; ++i) { int R, C; stage_rc(tid * 16 + i * 8192, R, C); const int Rb = Epi::PERM ? ((R & ~31) + perm32(R & 31)) : R;
        RA[i] = R; CA[i] = C; voffB[i] = (unsigned)(Rb * ldb + C) * 2u; }
    const size_t kstep = (size_t)(BK * 2);
    const size_t hstepB = (size_t)HALF * ldb * 2;
#define G8_BP(b_, d_, kt_) ((b_) + (size_t)(kt_) * kstep + ((SPLITB && (kt_) >= nth) ? (size_t)(d_) : (size_t)0))
    const unsigned ldsw = (unsigned)wid * 1024u;
    const int aoff = lds_byte(wr * 64 + fr, fq * 8), boff = lds_byte(wc * 32 + fr, fq * 8);
#define G8_AOFF(dst, u) do { _Pragma("unroll") for (int _h = 0; _h < 2; ++_h) _Pragma("unroll") for (int _i = 0; _i < 2; ++_i) { const int _r = _h * HALF + RA[_i]; int _ar; \
        if ((u).list) { const int _rr = _r < (u).nvalid ? _r : 0; _ar = (u).list[(u).row0 + _rr] >> SHIFT; } else _ar = (u).row0 + _r; \
        dst[_h][_i] = (unsigned)(_ar * lda + CA[_i]) * 2u; } } while (0)
#define G8_SA(b, h) (((b) * 2 + (h)) * HTB)
#define G8_SB(b, h) ((4 + (b) * 2 + (h)) * HTB)
#define G8_STAGEA(bufoff, gbase, vo, kb) do { _Pragma("unroll") for (int _i = 0; _i < 2; ++_i) \
        __builtin_amdgcn_global_load_lds((const unsigned*)((gbase) + (size_t)((vo)[_i] + (unsigned)(kb))), (LAS unsigned*)(lds + (bufoff) + ldsw + _i * 8192), 16, 0, 0); } while (0)
#define G8_STAGEB(bufoff, gbase) do { _Pragma("unroll") for (int _i = 0; _i < 2; ++_i) \
        __builtin_amdgcn_global_load_lds((const unsigned*)((const char*)(gbase) + voffB[_i]), (LAS unsigned*)(lds + (bufoff) + ldsw + _i * 8192), 16, 0, 0); } while (0)
#define G8_LDA(dst, b, h) do { _Pragma("unroll") for (int m = 0; m < 4; ++m) _Pragma("unroll") for (int k = 0; k < 2; ++k) dst[m][k] = *(const LAS bf16x8*)(lds + G8_SA(b, h) + aoff + m * 2048 + k * 1024); } while (0)
#define G8_LDB(dst, b, h) do { _Pragma("unroll") for (int n = 0; n < 2; ++n) _Pragma("unroll") for (int k = 0; k < 2; ++k) dst[n][k] = *(const LAS bf16x8*)(lds + G8_SB(b, h) + boff + n * 2048 + k * 1024); } while (0)
#define G8_MMA(ai, bj, At, Bt) do { __builtin_amdgcn_s_setprio(1); _Pragma("unroll") for (int m = 0; m < 4; ++m) _Pragma("unroll") for (int n = 0; n < 2; ++n) _Pragma("unroll") for (int k = 0; k < 2; ++k) \
        acc[ai][bj][m][n] = __builtin_amdgcn_mfma_f32_16x16x32_bf16(Bt[n][k], At[m][k], acc[ai][bj][m][n], 0, 0, 0); __builtin_amdgcn_s_setprio(0); } while (0)
#define G8_WAIT_V(n) asm volatile("s_waitcnt vmcnt(" #n ")" ::: "memory")
#define G8_WAIT_L(n) asm volatile("s_waitcnt lgkmcnt(" #n ")" ::: "memory")
#define G8_BAR __builtin_amdgcn_s_barrier()
#define G8_SCHED __builtin_amdgcn_sched_barrier(0)
    Unit cur, nxt; int ui = 0;
    if (!S.next(0, cur)) return;
    f32x4 acc[2][2][4][2];
#pragma unroll
    for (int a = 0; a < 2; ++a)
#pragma unroll
        for (int b = 0; b < 2; ++b)
#pragma unroll
            for (int m = 0; m < 4; ++m)
#pragma unroll
                for (int n = 0; n < 2; ++n) acc[a][b][m][n] = (f32x4){0.f, 0.f, 0.f, 0.f};
    bf16x8 At[4][2], B0[2][2], B1[2][2];
    unsigned aoC[2][2], aoN[2][2];
    G8_AOFF(aoC, cur);
    const char* cA = cur.A; const char* cB = cur.B; long cD = ((long)(cur.aux & 15) << 19) - (long)nth * (long)kstep;
    S.a_ready(cur);
    G8_STAGEB(G8_SB(0, 0), cB); G8_STAGEB(G8_SB(0, 1), cB + hstepB); G8_STAGEA(G8_SA(0, 0), cA, aoC[0], 0); G8_STAGEA(G8_SA(0, 1), cA, aoC[1], 0);
    if (wr == 1) G8_BAR;
    G8_WAIT_V(2); G8_BAR;
    G8_STAGEB(G8_SB(1, 0), cB + kstep); G8_STAGEA(G8_SA(1, 0), cA, aoC[0], kstep); G8_STAGEB(G8_SB(1, 1), cB + hstepB + kstep);
    G8_WAIT_V(6); G8_BAR;
    for (;;) {
        const bool has_next = S.next(ui + 1, nxt);
        const char* nA = has_next ? nxt.A : cA; const char* nB = has_next ? nxt.B : cB; const long nD = has_next ? ((long)(nxt.aux & 15) << 19) - (long)nth * (long)kstep : cD;
        if (has_next) { G8_AOFF(aoN, nxt); } else {
#pragma unroll
            for (int h = 0; h < 2; ++h)
#pragma unroll
                for (int i = 0; i < 2; ++i) aoN[h][i] = aoC[h][i]; }
        for (int t = 0; t < nt; t += 2) {
            const bool last = (t == nt - 2);
            if (last && has_next) S.a_ready(nxt);
            const unsigned k1 = (unsigned)((t + 1) * kstep);
            const char* a2b = last ? nA : cA; const unsigned k2 = last ? 0u : (unsigned)((t + 2) * kstep), k3 = k2 + (unsigned)kstep;
            const char* b2 = last ? nB : G8_BP(cB, cD, t + 2); const char* b3 = last ? nB + kstep : G8_BP(cB, cD, t + 3);
            unsigned ao2[2][2];
#pragma unroll
            for (int h = 0; h < 2; ++h)
#pragma unroll
                for (int i = 0; i < 2; ++i) ao2[h][i] = last ? aoN[h][i] : aoC[h][i];
            G8_LDB(B0, 0, 0); G8_LDB(B1, 0, 1); G8_SCHED; G8_LDA(At, 0, 0); G8_STAGEA(G8_SA(1, 1), cA, aoC[1], k1);
            G8_WAIT_V(8); G8_WAIT_L(0); G8_BAR; G8_MMA(0, 0, At, B0); G8_MMA(0, 1, At, B1); G8_BAR; G8_SCHED;
            G8_LDA(At, 0, 1); G8_STAGEB(G8_SB(0, 0), b2); G8_STAGEB(G8_SB(0, 1), b2 + hstepB); G8_STAGEA(G8_SA(0, 0), a2b, ao2[0], k2);
            G8_WAIT_V(8); G8_WAIT_L(0); G8_BAR; G8_MMA(1, 0, At, B0); G8_MMA(1, 1, At, B1); G8_BAR; G8_SCHED;
            G8_LDB(B0, 1, 0); G8_LDB(B1, 1, 1); G8_SCHED; G8_LDA(At, 1, 0); G8_STAGEA(G8_SA(0, 1), a2b, ao2[1], k2);
            G8_WAIT_V(8); G8_WAIT_L(0); G8_BAR; G8_MMA(0, 0, At, B0); G8_MMA(0, 1, At, B1); G8_BAR; G8_SCHED;
            G8_LDA(At, 1, 1); G8_STAGEB(G8_SB(1, 0), b3); G8_STAGEB(G8_SB(1, 1), b3 + hstepB); G8_STAGEA(G8_SA(1, 0), a2b, ao2[0], k3);
            G8_WAIT_V(8); G8_WAIT_L(0); G8_BAR; G8_MMA(1, 0, At, B0); G8_MMA(1, 1, At, B1); G8_BAR; G8_SCHED;
        }
        if (wr == 0) G8_BAR;
        E(acc, cur, wr, wc, fr, fq); S.done(cur);
        if (!has_next) break;
#pragma unroll
        for (int a = 0; a < 2; ++a)
#pragma unroll
            for (int b = 0; b < 2; ++b)
#pragma unroll
                for (int m = 0; m < 4; ++m)
#pragma unroll
                    for (int n = 0; n < 2; ++n) acc[a][b][m][n] = (f32x4){0.f, 0.f, 0.f, 0.f};
        cur = nxt; cA = nA; cB = nB; cD = nD; ++ui;
#pragma unroll
        for (int h = 0; h < 2; ++h)
#pragma unroll
            for (int i = 0; i < 2; ++i) aoC[h][i] = aoN[h][i];
        if (wr == 1) G8_BAR;
    }
    G8_WAIT_V(0);
    G8_BAR;
#undef G8_AOFF
#undef G8_SA
#undef G8_SB
#undef G8_STAGEA
#undef G8_STAGEB
#undef G8_BP
#undef G8_LDA
#undef G8_LDB
#undef G8_MMA
#undef G8_WAIT_V
#undef G8_WAIT_L
#undef G8_BAR
#undef G8_SCHED
}

struct EpiScaleBf16 {
  static constexpr bool PERM = true;
  bf16_t* C; int ldc; const float* rowscale; int ncol_store;
  __device__ __forceinline__ void operator()(const f32x4 (&acc)[2][2][4][2], const Unit& u, int wr, int wc, int fr, int fq) const {
    const int row0 = u.pm * BM + wr * 64 + fr, col0 = u.pn * BM + wc * 32 + 8 * fq;
#pragma unroll
    for (int ai = 0; ai < 2; ++ai)
#pragma unroll
      for (int m = 0; m < 4; ++m) { const int row = row0 + ai * HALF + m * 16; const float sc = rowscale[row]; bf16_t* rowp = C + (size_t)row * ldc + col0;
#pragma unroll
        for (int bj = 0; bj < 2; ++bj) { const f32x4 v0 = acc[ai][bj][m][0] * sc, v1 = acc[ai][bj][m][1] * sc;
          u32x4 w; w.x = cvt_pk_bf16(v0[0], v0[1]); w.y = cvt_pk_bf16(v0[2], v0[3]); w.z = cvt_pk_bf16(v1[0], v1[1]); w.w = cvt_pk_bf16(v1[2], v1[3]);
          if (col0 + bj * HALF < ncol_store) *(u32x4*)(rowp + bj * HALF) = w; } }
  }
};
struct EpiMem {
  static constexpr bool PERM = true; bf16_t* C; const float* rs;
  __device__ __forceinline__ void operator()(const f32x4 (&acc)[2][2][4][2], const Unit& u, int wr, int wc, int fr, int fq) const {
    const int l = u.pn >> 1; Unit v = u; v.pn = u.pn & 1;
    EpiScaleBf16 e{C + (size_t)l * 2048 * 512, 512, rs, 512}; e(acc, v, wr, wc, fr, fq); }
};
struct EpiResidBf16 {
  static constexpr bool PERM = true;
  bf16_t* out; const bf16_t* bres;
  __device__ __forceinline__ void operator()(const f32x4 (&acc)[2][2][4][2], const Unit& u, int wr, int wc, int fr, int fq) const {
    const int row0 = u.pm * BM + wr * 64 + fr, col0 = u.pn * BM + wc * 32 + 8 * fq;
#pragma unroll
    for (int ai = 0; ai < 2; ++ai)
#pragma unroll
      for (int m = 0; m < 4; ++m) { const size_t base = (size_t)(row0 + ai * HALF + m * 16) * DM + col0;
#pragma unroll
        for (int bj = 0; bj < 2; ++bj) { const size_t o = base + bj * HALF;
          const u32x4 rb = *(const u32x4*)(bres + o);
          const f32x4 v0 = (f32x4){bflo(rb.x), bfhi(rb.x), bflo(rb.y), bfhi(rb.y)} + acc[ai][bj][m][0], v1 = (f32x4){bflo(rb.z), bfhi(rb.z), bflo(rb.w), bfhi(rb.w)} + acc[ai][bj][m][1];
          u32x4 w; w.x = cvt_pk_bf16(v0[0], v0[1]); w.y = cvt_pk_bf16(v0[2], v0[3]); w.z = cvt_pk_bf16(v1[0], v1[1]); w.w = cvt_pk_bf16(v1[2], v1[3]);
          *(u32x4*)(out + o) = w; } }
  }
};
struct EpiMoe1 {
  static constexpr bool PERM = true;
  bf16_t* hid; const float* rstd; const float* cw;
  __device__ __forceinline__ void operator()(const f32x4 (&acc)[2][2][4][2], const Unit& u, int wr, int wc, int fr, int fq) const {
    const __amdgpu_buffer_rsrc_t hr = __builtin_amdgcn_make_buffer_rsrc((void*)hid, 0, 65536 * 256 * 2, 0x00020000);
#pragma unroll
    for (int ai = 0; ai < 2; ++ai)
#pragma unroll
      for (int m = 0; m < 4; ++m) { const int r = ai * HALF + wr * 64 + m * 16 + fr;
        if (r < u.nvalid) { const int slot = u.list[u.row0 + r]; const float rs = rstd[slot >> 1], cs = cw[slot] * rs;
          float h[8];
#pragma unroll
          for (int n = 0; n < 2; ++n)
#pragma unroll
            for (int j = 0; j < 4; ++j) { const float a = acc[ai][0][m][n][j] * rs, b = acc[ai][1][m][n][j] * cs; h[4 * n + j] = siluf_(a) * b; }
          u32x4 w; w.x = cvt_pk_bf16(h[0], h[1]); w.y = cvt_pk_bf16(h[2], h[3]); w.z = cvt_pk_bf16(h[4], h[5]); w.w = cvt_pk_bf16(h[6], h[7]);
          __builtin_amdgcn_raw_buffer_store_b128(w, hr, (slot * 256 + u.pn * 128 + wc * 32 + 8 * fq) * 2, 0, 16); } }
  }
};
struct EpiMoe2 {
  static constexpr bool PERM = true;
  bf16_t* y;
  __device__ __forceinline__ void operator()(const f32x4 (&acc)[2][2][4][2], const Unit& u, int wr, int wc, int fr, int fq) const {
#pragma unroll
    for (int ai = 0; ai < 2; ++ai)
#pragma unroll
      for (int m = 0; m < 4; ++m) { const int r = ai * HALF + wr * 64 + m * 16 + fr;
        if (r < u.nvalid) { const int tok = u.list[u.row0 + r];
          bf16_t* yp = y + (size_t)tok * DM + u.pn * BM + wc * 32 + 8 * fq;
#pragma unroll
          for (int bj = 0; bj < 2; ++bj) { const f32x4 v0 = acc[ai][bj][m][0], v1 = acc[ai][bj][m][1];
            u32x4 w; w.x = cvt_pk_bf16(v0[0], v0[1]); w.y = cvt_pk_bf16(v0[2], v0[3]); w.z = cvt_pk_bf16(v1[0], v1[1]); w.w = cvt_pk_bf16(v1[2], v1[3]);
            *(u32x4*)(yp + bj * HALF) = w; } } }
  }
};
struct PairOrder {
  const char* A; const char* Wt; const int* plist; LAS const int* cn; int G, c;
  unsigned* edone; unsigned* tmo; int r1;
  __device__ __forceinline__ bool next(int i, Unit& u) const {
    const int GA = G - r1;
    int L = (c >= r1) ? i * GA + (i > 0 ? (i - 1) * r1 : 0) + (c - r1) : (i + 2) * GA + i * r1 + c; bool found = false;
    for (int e = 0; e < 24; ++e) { const int cne = __builtin_amdgcn_readfirstlane(cn[e]); const int nu = ((cne + 255) >> 8) * 4;
      if (!found) { if (L < nu) { found = true; const int tile = L >> 2, pn = L & 3, g = e / 6, pr = e % 6;
          const int la = pr < 3 ? 0 : pr < 5 ? 1 : 2, lb = pr < 3 ? pr + 1 : pr < 5 ? pr - 1 : 3;
          u.pm = tile; u.pn = pn; u.aux = (lb - la) | ((g * 4 + la) << 4) | ((g * 4 + lb) << 8); u.A = A;
          u.B = Wt + ((size_t)(g * 4 + la) * 1024 + (size_t)pn * 256) * 256 * 2;
          u.list = plist + (size_t)e * NTOK; u.row0 = tile * 256; u.nvalid = (cne - tile * 256) < 256 ? (cne - tile * 256) : 256; } else L -= nu; } }
    return found;
  }
  __device__ __forceinline__ void a_ready(const Unit& u) const {
    if (threadIdx.x < 64) {
      const int ea = (u.aux >> 4) & 15, eb = (u.aux >> 8) & 15;
      const unsigned na = (unsigned)cn[32 + ea], nb = (unsigned)cn[32 + eb]; unsigned sp = 0u;
      while ((unsigned)__builtin_amdgcn_readfirstlane(xb_ld(edone + ea * 64)) < na || (unsigned)__builtin_amdgcn_readfirstlane(xb_ld(edone + eb * 64)) < nb) {
        __builtin_amdgcn_s_sleep(2);
        if ((++sp & 255u) == 0u) { if (xb_ld(tmo)) break; if (sp > XB_SPIN_CAP) { atomicAdd(tmo, 1u); break; } } }
      __builtin_amdgcn_fence(__ATOMIC_ACQUIRE, "agent");
      asm volatile("s_waitcnt vmcnt(0)" ::: "memory");
    }
    asm volatile("" ::: "memory"); __builtin_amdgcn_s_barrier(); asm volatile("" ::: "memory");
  }
  __device__ __forceinline__ void done(const Unit&) const {}
};
template <int NPN>
struct MoeOrder {
  const char* A; const char* Wt; const int* lists; int cn[16]; int G, c; size_t wstride_e, wstride_pn; unsigned* edone;
  __device__ __forceinline__ bool next(int i, Unit& u) const {
    int L = i * G + c; bool found = false;
#pragma unroll
    for (int e = 0; e < 16; ++e) { const int nu = ((cn[e] + 255) >> 8) * NPN;
      if (!found) { if (L < nu) { found = true; const int tile = L / NPN, pn = L % NPN; u.pm = tile; u.pn = pn; u.aux = e; u.A = A; u.B = Wt + (size_t)e * wstride_e + (size_t)pn * wstride_pn;
          u.list = lists + (size_t)e * NTOK; u.row0 = tile * 256; u.nvalid = (cn[e] - tile * 256) < 256 ? (cn[e] - tile * 256) : 256; } else L -= nu; } }
    return found;
  }
  __device__ __forceinline__ void a_ready(const Unit&) const {}
  __device__ __forceinline__ void done(const Unit& u) const {
    asm volatile("s_waitcnt vmcnt(0)" ::: "memory");
    if ((threadIdx.x & 63) == 0) (void)xb_add(edone + u.aux * 64, 1u);
  }
};
}

__device__ __forceinline__ void phase_gemm_inA(const Params& p, LAS char* lds, int bid, int nblk) {
  char* ws = p.ws;
  const bf16_t* hb = (const bf16_t*)p.out;
  const bf16_t* wa = (const bf16_t*)(ws + OFF_W + W_AIN);
  { g8::DenseOrder S; S.init(hb, wa, 1024, NTOK, NIN_A, nblk, bid);
    g8::EpiScaleBf16 E{(bf16_t*)(ws + OFF_P), LDP, (const float*)(ws + OFF_RSTD), LDP};
    g8::gemm_phase<g8::EpiScaleBf16, g8::DenseOrder, 0>((LAS unsigned char*)lds, 1024, DM, S, E); }
}
__device__ __forceinline__ void phase_gemm_memkv(const Params& p, LAS char* lds, int bid, int nblk) {
  char* ws = p.ws;
  const bf16_t* memb = (const bf16_t*)((char*)p.out + ((size_t)64 << 20)); const bf16_t* wm = (const bf16_t*)(ws + OFF_W + W_MEM);
  __syncthreads();
  g8::DenseOrder S; S.init(memb, wm, 1024, NMEMROW, 1024, nblk, bid);
  g8::EpiMem E{(bf16_t*)(ws + OFF_MEMKV), (const float*)(ws + OFF_MRSTD)};
  g8::gemm_phase<g8::EpiMem, g8::DenseOrder, 0>((LAS unsigned char*)lds, 1024, DM, S, E);
  if (threadIdx.x == 0) { __builtin_amdgcn_fence(__ATOMIC_RELEASE, "agent"); (void)xb_add((unsigned*)(ws + OFF_CTRL) + CTRL_MEMKV, 1u); }
}
__device__ __forceinline__ void wait_counter(unsigned* ctl, int word, unsigned need) {
  __syncthreads();
  if (threadIdx.x == 0) { unsigned sp = 0u;
    while (xb_ld(ctl + word) < need) { __builtin_amdgcn_s_sleep(2); if ((++sp & 255u) == 0u) { if (xb_ld(&ctl[XB_TMO])) break; if (sp > XB_SPIN_CAP) { atomicAdd(&ctl[XB_TMO], 1u); break; } } }
    __builtin_amdgcn_fence(__ATOMIC_ACQUIRE, "agent"); asm volatile("s_waitcnt vmcnt(0)" ::: "memory"); }
  __syncthreads();
}
__device__ __forceinline__ void phase_gemm_inB(const Params& p, LAS char* lds, int bid, int nblk) {
  char* ws = p.ws;
  g8::DenseOrder S; S.init(ws + OFF_G + G_HB, ws + OFF_W + W_BIN, 1024, NTOK, NIN_B, nblk, bid);
  g8::EpiScaleBf16 E{(bf16_t*)(ws + OFF_P), LDP, (const float*)(ws + OFF_RSTD), LDP};
  g8::gemm_phase<g8::EpiScaleBf16, g8::DenseOrder, 0>((LAS unsigned char*)lds, 1024, DM, S, E);
}
__device__ __forceinline__ void phase_gemm_out(const Params& p, LAS char* lds, int bid, int nblk, int layer) {
  char* ws = p.ws;
  g8::DenseOrder S; S.init(ws + OFF_P, ws + OFF_W + (layer ? W_BOUT : W_AOUT), 1024, NTOK, 1024, nblk, bid);
  bf16_t* hb = (bf16_t*)(ws + OFF_G + G_HB);
  g8::EpiResidBf16 E{hb, layer ? (const bf16_t*)hb : (const bf16_t*)p.out};
  g8::gemm_phase<g8::EpiResidBf16, g8::DenseOrder, 0>((LAS unsigned char*)lds, 1024, LDP, S, E);
}
__device__ __forceinline__ void phase_moe1(const Params& p, LAS char* lds, int bid, int nblk, int layer) {
  char* ws = p.ws;
  const unsigned* cnt = (const unsigned*)(ws + OFF_CTRL) + CTRL_CNT + layer * 16 * 64;
  g8::MoeOrder<2> S; S.A = ws + OFF_G + G_HB; S.Wt = ws + OFF_W + W_13 + (size_t)layer * 16 * 512 * 1024 * 2; S.lists = (const int*)(ws + OFF_LIST);
#pragma unroll
  for (int e = 0; e < 16; ++e) S.cn[e] = (int)cnt[e * 64];
  S.G = nblk; S.c = bid; S.wstride_e = (size_t)512 * 1024 * 2; S.wstride_pn = (size_t)256 * 1024 * 2; S.edone = (unsigned*)(ws + OFF_CTRL) + CTRL_EDONE + layer * 16 * 64;
  g8::EpiMoe1 E{(bf16_t*)(ws + OFF_P), (const float*)(ws + OFF_RSTD), (const float*)(ws + OFF_CW)};
  g8::gemm_phase<g8::EpiMoe1, g8::MoeOrder<2>, 1>((LAS unsigned char*)lds, 1024, DM, S, E);
}
__device__ __forceinline__ void phase_moe2(const Params& p, LAS char* lds, int bid, int nblk, int layer) {
  char* ws = p.ws;
  const unsigned* pcnt = (const unsigned*)(ws + OFF_CTRL) + CTRL_PCNT + layer * 24 * 64;
  g8::PairOrder S; S.A = ws + OFF_P; S.Wt = ws + OFF_W + W_2 + (size_t)layer * 16 * 1024 * 256 * 2; S.plist = (const int*)(ws + OFF_P + P_PLIST);
  const unsigned* cnt = (const unsigned*)(ws + OFF_CTRL) + CTRL_CNT + layer * 16 * 64;
  LAS int* scn = (LAS int*)(lds + g8::STAGE_BYTES);
  __syncthreads();
  if (threadIdx.x < 24) scn[threadIdx.x] = (int)pcnt[threadIdx.x * 64];
  if (threadIdx.x >= 32 && threadIdx.x < 48) scn[threadIdx.x] = (int)((cnt[(threadIdx.x - 32) * 64] + 255u) >> 8) * 16;
  __syncthreads();
  if (threadIdx.x == 0) { int n1 = 0;
#pragma unroll
    for (int e = 0; e < 16; ++e) n1 += scn[32 + e] >> 3;
    scn[48] = n1 % nblk; }
  __syncthreads();
  S.cn = scn; S.G = nblk; S.c = bid; S.r1 = __builtin_amdgcn_readfirstlane(scn[48]);
  S.edone = (unsigned*)(ws + OFF_CTRL) + CTRL_EDONE + layer * 16 * 64; S.tmo = (unsigned*)(ws + OFF_CTRL) + XB_TMO;
  g8::EpiMoe2 E{(bf16_t*)(ws + OFF_G + G_MIX)};
  g8::gemm_phase<g8::EpiMoe2, g8::PairOrder, 0, true>((LAS unsigned char*)lds, 512, 512, S, E);
}


typedef float f32x2v __attribute__((ext_vector_type(2)));
__device__ __forceinline__ void phase_norm_route(const Params& p, LAS char* lds, int bid, int nblk, int layer) {
  char* ws = p.ws; const int tid = threadIdx.x, lane = tid & 63, r32 = lane & 31, hi = lane >> 5; const int w = __builtin_amdgcn_readfirstlane(tid >> 6);
  constexpr int WROW = 1028;
  LAS float* wl = (LAS float*)lds;
  LAS float* lgx = (LAS float*)(lds + 20 * WROW * 4);
  LAS float* ssx = lgx + 8 * 32 * 33;
  const float* wr = (const float*)(ws + OFF_WR) + (size_t)layer * 20480;
  __syncthreads();
  { f32x4 wv[10];
#pragma unroll
    for (int k = 0; k < 10; ++k) { const int i = tid + k * NTHR; wv[k] = *(const f32x4*)(wr + (i >> 8) * 1024 + (i & 255) * 4); }
#pragma unroll
    for (int k = 0; k < 10; ++k) { const int i = tid + k * NTHR; *(LAS f32x4*)(wl + (i >> 8) * WROW + (i & 255) * 4) = wv[k]; } }
  __syncthreads();
  bf16_t* hb = (bf16_t*)(ws + OFF_G + G_HB); float* rstd = (float*)(ws + OFF_RSTD); float* cw = (float*)(ws + OFF_CW);
  unsigned* cnt = (unsigned*)(ws + OFF_CTRL) + CTRL_CNT + layer * 16 * 64; int* lists = (int*)(ws + OFF_LIST);
  unsigned* pcnt = (unsigned*)(ws + OFF_CTRL) + CTRL_PCNT + layer * 24 * 64; int* plist = (int*)(ws + OFF_P + P_PLIST);
  const float* bg = p.b_group + layer * 4; const float* br = p.b_router + layer * 16;
  const int nn = r32 < 20 ? r32 : 19;
  for (int base = bid * 4; base < NTOK / 32; base += nblk * 4) {
    const int tile = base + (w & 3), kh = w >> 2, t0 = tile * 32;
    const bf16_t* hbrow = hb + (size_t)(t0 + r32) * DM + kh * 512 + 4 * hi;
    LAS const float* wrow = wl + nn * WROW + kh * 512 + 4 * hi;
    f32x16 acc = f32x16{}; float ss = 0.f;
    for (int j0 = 0; j0 < 64; j0 += 8) {
      f32x4 hv[8];
#pragma unroll
      for (int q = 0; q < 8; ++q) { const u32x2 hr = *(const u32x2*)(hbrow + (j0 + q) * 8); hv[q] = (f32x4){bflo(hr.x), bfhi(hr.x), bflo(hr.y), bfhi(hr.y)}; }
#pragma unroll
      for (int q = 0; q < 8; ++q) {
        const f32x4 wv = *(LAS const f32x4*)(wrow + (j0 + q) * 8);
        ss += hv[q][0] * hv[q][0] + hv[q][1] * hv[q][1] + hv[q][2] * hv[q][2] + hv[q][3] * hv[q][3];
#pragma unroll
        for (int e = 0; e < 4; ++e) acc = __builtin_amdgcn_mfma_f32_32x32x2f32(wv[e], hv[q][e], acc, 0, 0, 0);
      }
    }
    { auto sw = __builtin_amdgcn_permlane32_swap(__float_as_uint(ss), __float_as_uint(ss), false, false); ss = __uint_as_float(sw[0]) + __uint_as_float(sw[1]); }
    LAS float* lg = lgx + w * 32 * 33;
#pragma unroll
    for (int r = 0; r < 16; ++r) { const int n = (r & 3) + 8 * (r >> 2) + 4 * hi; lg[r32 * 33 + n] = acc[r]; }
    if (hi == 0) ssx[w * 32 + r32] = ss;
    __syncthreads();
    if (w < 4 && hi == 0) {
      LAS const float* la = lgx + w * 32 * 33 + r32 * 33; LAS const float* lb = lgx + (w + 4) * 32 * 33 + r32 * 33;
      const int t = t0 + r32;
      const float rs = rsqrtf((ssx[w * 32 + r32] + ssx[(w + 4) * 32 + r32]) * (1.f / DM) + EPS);
      float lgt[20];
#pragma unroll
      for (int j = 0; j < 20; ++j) lgt[j] = (la[j] + lb[j]) * rs + (j < 4 ? bg[j] : br[j - 4]);
      int gs = 0; float gm = lgt[0];
#pragma unroll
      for (int j = 1; j < 4; ++j) if (lgt[j] > gm) { gm = lgt[j]; gs = j; }
      float den = 0.f;
#pragma unroll
      for (int j = 0; j < 4; ++j) den += __expf(lgt[j] - gm);
      const float pg = 1.f / den;
      float el[4];
#pragma unroll
      for (int j = 0; j < 4; ++j) el[j] = gs == 0 ? lgt[4 + j] : gs == 1 ? lgt[8 + j] : gs == 2 ? lgt[12 + j] : lgt[16 + j];
      int i1 = 0; float m1 = el[0];
#pragma unroll
      for (int j = 1; j < 4; ++j) if (el[j] > m1) { m1 = el[j]; i1 = j; }
      int i2 = -1; float m2 = -INFINITY;
#pragma unroll
      for (int j = 0; j < 4; ++j) if (j != i1 && el[j] > m2) { m2 = el[j]; i2 = j; }
      const float e2 = __expf(m2 - m1), p1 = 1.f / (1.f + e2), p2 = e2 * p1;
      const int ex1 = gs * 4 + i1, ex2 = gs * 4 + i2;
      unsigned myc = 0u; int rk1 = 0, rk2 = 0;
      const unsigned long long lt = (1ull << r32) - 1ull;
#pragma unroll
      for (int e = 0; e < 16; ++e) {
        const unsigned long long b1 = __ballot(ex1 == e), b2 = __ballot(ex2 == e);
        const int c1 = __popcll(b1), c2 = __popcll(b2);
        if (r32 == e) myc = (unsigned)(c1 + c2);
        if (ex1 == e) rk1 = __popcll(b1 & lt);
        if (ex2 == e) rk2 = c1 + __popcll(b2 & lt);
      }
      unsigned basev = 0u;
      if (r32 < 16 && myc) basev = atomicAdd(&cnt[r32 * 64], myc);
      const unsigned q1 = (unsigned)__shfl((int)basev, ex1) + (unsigned)rk1, q2 = (unsigned)__shfl((int)basev, ex2) + (unsigned)rk2;
      const int pos1 = ex1 < ex2 ? 0 : 1;
      lists[(size_t)ex1 * NTOK + q1] = t * 2 + pos1; lists[(size_t)ex2 * NTOK + q2] = t * 2 + (1 - pos1);
      cw[t * 2 + pos1] = pg * p1; cw[t * 2 + 1 - pos1] = pg * p2; rstd[t] = rs;
      const int xa = (pos1 ? i2 : i1), xb = (pos1 ? i1 : i2);
      const int pc = gs * 6 + (xa == 0 ? xb - 1 : xa == 1 ? xb + 1 : 5);
      unsigned myc2 = 0u; int rk = 0;
#pragma unroll
      for (int e = 0; e < 24; ++e) { const unsigned long long bb = __ballot(pc == e); if (r32 == e) myc2 = (unsigned)__popcll(bb); if (pc == e) rk = __popcll(bb & lt); }
      unsigned base2 = 0u;
      if (r32 < 24 && myc2) base2 = atomicAdd(&pcnt[r32 * 64], myc2);
      plist[(size_t)pc * NTOK + (unsigned)__shfl((int)base2, pc) + (unsigned)rk] = t;
    }
    __syncthreads();
  }
}

template <bool FINAL>
__device__ __forceinline__ void phase_combine(const Params& p, int bid, int nblk) {
  char* ws = p.ws; const int tid = threadIdx.x, lane = tid & 63, w = tid >> 6;
  const bf16_t* y = (const bf16_t*)(ws + OFF_G + G_MIX); bf16_t* hb = (bf16_t*)(ws + OFF_G + G_HB); float* rstd = (float*)(ws + OFF_RSTD);
  for (int t = bid * 8 + w; t < NTOK; t += nblk * 8) {
    float v[16]; float ss = 0.f;
#pragma unroll
    for (int i = 0; i < 2; ++i) { const int c = i * 512 + lane * 8; const u32x4 a = *(const u32x4*)(hb + (size_t)t * DM + c), d = *(const u32x4*)(y + (size_t)t * DM + c);
      v[8 * i] = bflo(a.x) + bflo(d.x); v[8 * i + 1] = bfhi(a.x) + bfhi(d.x); v[8 * i + 2] = bflo(a.y) + bflo(d.y); v[8 * i + 3] = bfhi(a.y) + bfhi(d.y);
      v[8 * i + 4] = bflo(a.z) + bflo(d.z); v[8 * i + 5] = bfhi(a.z) + bfhi(d.z); v[8 * i + 6] = bflo(a.w) + bflo(d.w); v[8 * i + 7] = bfhi(a.w) + bfhi(d.w); }
#pragma unroll
    for (int k = 0; k < 16; ++k) ss += v[k] * v[k];
    ss = wave_sum(ss);
    const float rs = rsqrtf(ss * (1.f / DM) + EPS);
#pragma unroll
    for (int i = 0; i < 2; ++i) { const int c = i * 512 + lane * 8;
      if (FINAL) {
        const f32x4 g0 = *(const f32x4*)(p.final_norm + c), g1 = *(const f32x4*)(p.final_norm + c + 4);
        *(f32x4*)(p.out + (size_t)t * DM + c) = (f32x4){v[8 * i] * rs * g0[0], v[8 * i + 1] * rs * g0[1], v[8 * i + 2] * rs * g0[2], v[8 * i + 3] * rs * g0[3]};
        *(f32x4*)(p.out + (size_t)t * DM + c + 4) = (f32x4){v[8 * i + 4] * rs * g1[0], v[8 * i + 5] * rs * g1[1], v[8 * i + 6] * rs * g1[2], v[8 * i + 7] * rs * g1[3]};
      } else {
        u32x4 o; o.x = cvt_pk_bf16(v[8 * i], v[8 * i + 1]); o.y = cvt_pk_bf16(v[8 * i + 2], v[8 * i + 3]); o.z = cvt_pk_bf16(v[8 * i + 4], v[8 * i + 5]); o.w = cvt_pk_bf16(v[8 * i + 6], v[8 * i + 7]);
        *(u32x4*)(hb + (size_t)t * DM + c) = o;
      }
    }
    if (!FINAL && lane == 0) rstd[t] = rs;
  }
}

namespace mem {
typedef short s16x4 __attribute__((ext_vector_type(4)));
constexpr int TILEB = 8192, LDS_K = 0, LDS_V = 4 * TILEB, LDS_WS = 8 * TILEB, LDS_OST = LDS_WS + 8 * 256;
__device__ __forceinline__ s16x4 vtr(LAS const char* p) { return __builtin_bit_cast(s16x4, __builtin_amdgcn_ds_read_tr16_b64_v4i16((LAS s16x4*)p)); }
__device__ __forceinline__ void unit(bf16_t* P, const bf16_t* mkv, int b, int hd, int qb, LAS char* lds) {
  const int tid = threadIdx.x, lane = tid & 63, r32 = lane & 31, hi = lane >> 5; const int wid = __builtin_amdgcn_readfirstlane(tid >> 6);
  const bf16_t* Kh = mkv + (size_t)b * 256 * 512 + hd * 64; const bf16_t* Vh = Kh + 256;
  bf16_t* Qw = P + ((size_t)b * SEQ + qb * 256 + wid * 32) * LDP + PC_MQ + hd * 64;
  const bf16_t* ksrc = Kh + (size_t)lane * 512 + wid * 8;
  const bf16_t* vsrc = Vh + (size_t)(16 * (wid & 3) + (lane >> 2)) * 512 + (wid >> 2) * 32 + (lane & 3) * 8;
#pragma unroll
  for (int t = 0; t < 4; ++t) {
    __builtin_amdgcn_global_load_lds((const unsigned*)(ksrc + (size_t)t * 64 * 512), (LAS unsigned*)(lds + LDS_K + t * TILEB + wid * 1024), 16, 0, 0);
    __builtin_amdgcn_global_load_lds((const unsigned*)(vsrc + (size_t)t * 64 * 512), (LAS unsigned*)(lds + LDS_V + t * TILEB + wid * 1024), 16, 0, 0);
  }
  bf16x8 qr[4];
#pragma unroll
  for (int d0 = 0; d0 < 4; ++d0) qr[d0] = *(const bf16x8*)(Qw + (size_t)r32 * LDP + d0 * 16 + hi * 8);
  asm volatile("s_waitcnt vmcnt(0) lgkmcnt(0)\n\ts_barrier" ::: "memory");
  LAS const char* kp0 = lds + LDS_K + hi * 1024 + r32 * 16;
  LAS const char* vp0 = lds + LDS_V + ((lane >> 4) & 1) * 32 + (lane & 3) * 8 + (4 * hi + ((lane & 15) >> 2)) * 64;
  float mx = -INFINITY;
#pragma unroll
  for (int t = 0; t < 4; ++t) {
    f32x16 p0 = f32x16{}, p1 = f32x16{};
#pragma unroll
    for (int d0 = 0; d0 < 4; ++d0) {
      const bf16x8 k0 = *(LAS const bf16x8*)(kp0 + t * TILEB + d0 * 2048), k1 = *(LAS const bf16x8*)(kp0 + t * TILEB + d0 * 2048 + 512);
      p0 = __builtin_amdgcn_mfma_f32_32x32x16_bf16(k0, qr[d0], p0, 0, 0, 0); p1 = __builtin_amdgcn_mfma_f32_32x32x16_bf16(k1, qr[d0], p1, 0, 0, 0);
    }
#pragma unroll
    for (int r = 0; r < 16; ++r) mx = fmaxf(mx, fmaxf(p0[r], p1[r]));
  }
  { auto sw = __builtin_amdgcn_permlane32_swap(__float_as_uint(mx), __float_as_uint(mx), false, false); mx = fmaxf(__uint_as_float(sw[0]), __uint_as_float(sw[1])); }
  f32x16 o[2]; o[0] = f32x16{}; o[1] = f32x16{};
  float lsum = 0.f;
#pragma unroll
  for (int t = 0; t < 4; ++t) {
    f32x16 p0 = f32x16{}, p1 = f32x16{};
#pragma unroll
    for (int d0 = 0; d0 < 4; ++d0) {
      const bf16x8 k0 = *(LAS const bf16x8*)(kp0 + t * TILEB + d0 * 2048), k1 = *(LAS const bf16x8*)(kp0 + t * TILEB + d0 * 2048 + 512);
      p0 = __builtin_amdgcn_mfma_f32_32x32x16_bf16(k0, qr[d0], p0, 0, 0, 0); p1 = __builtin_amdgcn_mfma_f32_32x32x16_bf16(k1, qr[d0], p1, 0, 0, 0);
    }
    float a[32];
#pragma unroll
    for (int r = 0; r < 16; ++r) { a[r] = __builtin_amdgcn_exp2f(p0[r] - mx); a[16 + r] = __builtin_amdgcn_exp2f(p1[r] - mx); lsum += a[r] + a[16 + r]; }
    u32x4 pw[4];
#pragma unroll
    for (int ks = 0; ks < 4; ++ks) { pw[ks].x = cvt_pk_bf16(a[8 * ks], a[8 * ks + 1]); pw[ks].y = cvt_pk_bf16(a[8 * ks + 2], a[8 * ks + 3]); pw[ks].z = cvt_pk_bf16(a[8 * ks + 4], a[8 * ks + 5]); pw[ks].w = cvt_pk_bf16(a[8 * ks + 6], a[8 * ks + 7]); }
    LAS const char* vp = vp0 + t * TILEB;
#pragma unroll
    for (int d0 = 0; d0 < 2; ++d0)
#pragma unroll
      for (int ks = 0; ks < 4; ++ks) {
        const s16x4 lo = vtr(vp + d0 * 4096 + ks * 1024), hh = vtr(vp + d0 * 4096 + ks * 1024 + 512);
        const bf16x8 vf = (bf16x8){lo[0], lo[1], lo[2], lo[3], hh[0], hh[1], hh[2], hh[3]};
        o[d0] = __builtin_amdgcn_mfma_f32_32x32x16_bf16(__builtin_bit_cast(bf16x8, pw[ks]), vf, o[d0], 0, 0, 0);
      }
  }
  { auto sw = __builtin_amdgcn_permlane32_swap(__float_as_uint(lsum), __float_as_uint(lsum), false, false); lsum = __uint_as_float(sw[0]) + __uint_as_float(sw[1]); }
  LAS float* wsf = (LAS float*)(lds + LDS_WS) + wid * 64;
  if (hi == 0) wsf[r32] = __builtin_amdgcn_rcpf(lsum);
  asm volatile("s_waitcnt lgkmcnt(0)" ::: "memory");
  LAS bf16_t* stg = (LAS bf16_t*)(lds + LDS_OST) + wid * 2048;
#pragma unroll
  for (int r = 0; r < 16; ++r) { const int orow = (r & 3) + 8 * (r >> 2) + 4 * hi; const float il = wsf[orow];
#pragma unroll
    for (int d0 = 0; d0 < 2; ++d0) stg[orow * 64 + d0 * 32 + r32] = f2bf(o[d0][r] * il); }
  asm volatile("s_waitcnt lgkmcnt(0)" ::: "memory");
#pragma unroll
  for (int i = 0; i < 4; ++i) { const int row = i * 8 + (lane >> 3), ch = lane & 7; const u32x4 v = *(LAS const u32x4*)(stg + row * 64 + ch * 8); *(u32x4*)(Qw + (size_t)row * LDP + ch * 8) = v; }
  asm volatile("s_waitcnt vmcnt(0) lgkmcnt(0)\n\ts_barrier" ::: "memory");
}
}
__device__ __forceinline__ void phase_memattn(const Params& p, LAS char* lds, int bid, int nblk, int layer) {
  char* ws = p.ws; bf16_t* P = (bf16_t*)(ws + OFF_P);
  const bf16_t* mkv = (const bf16_t*)(ws + OFF_MEMKV) + (size_t)layer * 2048 * 512;
  for (int u = bid; u < NBATCH * 4 * 16; u += nblk) { const int bh = u >> 4, qb = u & 15; mem::unit(P, mkv, bh >> 2, bh & 3, qb, lds); }
}

namespace sb {
typedef short s16x4 __attribute__((ext_vector_type(4)));
constexpr int SLOTB = 8192, NSLOT = 4, LDS_K = 0, LDS_V = NSLOT * SLOTB, LDS_OST = 2 * NSLOT * SLOTB, LDS_FLAG = LDS_OST + 8 * 4096, LDS_BYTES_SB = LDS_FLAG + 64;
__device__ __forceinline__ s16x4 vtr(LAS const char* p) { return __builtin_bit_cast(s16x4, __builtin_amdgcn_ds_read_tr16_b64_v4i16((LAS s16x4*)p)); }

__device__ __forceinline__ void unit(const bf16_t* P, bf16_t* O, int ldo, int b, int h, int qb, LAS char* lds) {
  const int tid = threadIdx.x, lane = tid & 63, r32 = lane & 31, hi = lane >> 5; const int wid = __builtin_amdgcn_readfirstlane(tid >> 6);
  const size_t rowbase = (size_t)b * SEQ; const int q0 = qb * 256;
  const bf16_t* Kh = P + rowbase * LDP + PC_K + h * 64; const bf16_t* Vh = P + rowbase * LDP + PC_V + h * 64;
  const bf16_t* Qw = P + (rowbase + q0 + wid * 32) * LDP + PC_Q + h * 64;
  const bf16_t* ksrc = Kh + (size_t)lane * LDP + wid * 8;
  const bf16_t* vsrc = Vh + (size_t)(16 * (wid & 3) + (lane >> 2)) * LDP + (wid >> 2) * 32 + (lane & 3) * 8;
  LAS char* kdst = lds + LDS_K + wid * 1024; LAS char* vdst = lds + LDS_V + wid * 1024;
#define SB_DMA(t, slot) do { __builtin_amdgcn_global_load_lds((const unsigned*)(ksrc + (size_t)(t) * 64 * LDP), (LAS unsigned*)(kdst + (slot)), 16, 0, 0); \
                             __builtin_amdgcn_global_load_lds((const unsigned*)(vsrc + (size_t)(t) * 64 * LDP), (LAS unsigned*)(vdst + (slot)), 16, 0, 0); } while (0)
  const int NT = 4 * qb + 4;
  bf16x8 qr[4];
#pragma unroll
  for (int d0 = 0; d0 < 4; ++d0) qr[d0] = *(const bf16x8*)(Qw + (size_t)r32 * LDP + d0 * 16 + hi * 8);
  asm volatile("" ::: "memory");
  SB_DMA(NT - 1, 0); SB_DMA(NT - 2, SLOTB); SB_DMA(NT - 3, 2 * SLOTB);
  f32x16 o[2]; o[0] = f32x16{}; o[1] = f32x16{};
  float c = 1.f;
  const int qrel = wid * 32 + r32;
  LAS const char* kp0 = lds + LDS_K + hi * 1024 + r32 * 16;
  LAS const char* vp0 = lds + LDS_V + ((lane >> 4) & 1) * 32 + (lane & 3) * 8 + (4 * hi + ((lane & 15) >> 2)) * 64;
  int slot = 0; bool wave_alive = true;
  LAS unsigned* fl = (LAS unsigned*)(lds + LDS_FLAG);
  for (int i = 0; i < NT; ++i) {
    const int t = NT - 1 - i;
    const int nslot = (slot == (NSLOT - 1) * SLOTB) ? 0 : slot + SLOTB;
    if (t > 1) { asm volatile("s_waitcnt vmcnt(4) lgkmcnt(0)\n\ts_barrier" ::: "memory"); }
    else if (t == 1) { asm volatile("s_waitcnt vmcnt(2) lgkmcnt(0)\n\ts_barrier" ::: "memory"); }
    else { asm volatile("s_waitcnt vmcnt(0) lgkmcnt(0)\n\ts_barrier" ::: "memory"); }
    if (t > 2) { const int pslot = (slot == 0) ? (NSLOT - 1) * SLOTB : slot - SLOTB; SB_DMA(t - 3, pslot); }
    if (i > 0) { const u32x4 f0 = *(LAS const u32x4*)(fl + ((i - 1) & 1) * 8), f1 = *(LAS const u32x4*)(fl + ((i - 1) & 1) * 8 + 4);
      if (__builtin_amdgcn_readfirstlane((int)(f0.x | f0.y | f0.z | f0.w | f1.x | f1.y | f1.z | f1.w)) == 0) break; }
    const int jb = t - (NT - 4);
    if (!(jb >= 0 && 64 * jb > 32 * wid + 30) && wave_alive) {
      f32x16 p0 = f32x16{}, p1 = f32x16{};
#pragma unroll
      for (int d0 = 0; d0 < 4; ++d0) {
        const bf16x8 k0 = *(LAS const bf16x8*)(kp0 + slot + d0 * 2048), k1 = *(LAS const bf16x8*)(kp0 + slot + d0 * 2048 + 512);
        p0 = __builtin_amdgcn_mfma_f32_32x32x16_bf16(k0, qr[d0], p0, 0, 0, 0);
        p1 = __builtin_amdgcn_mfma_f32_32x32x16_bf16(k1, qr[d0], p1, 0, 0, 0);
      }
      if (jb >= 0) {
        const int kb = 64 * jb + 4 * hi;
#pragma unroll
        for (int r = 0; r < 16; ++r) { const int kv = kb + (r & 3) + 8 * (r >> 2); if (kv >= qrel) p0[r] = -INFINITY; if (kv + 32 >= qrel) p1[r] = -INFINITY; }
      }
      float rr[32], be[32];
#pragma unroll
      for (int r = 0; r < 16; ++r) {
        const float e0 = __builtin_amdgcn_exp2f(p0[r]), e1 = __builtin_amdgcn_exp2f(p1[r]);
        rr[r] = __builtin_amdgcn_rcpf(1.f + e0); rr[16 + r] = __builtin_amdgcn_rcpf(1.f + e1);
        be[r] = 1.f - rr[r]; be[16 + r] = 1.f - rr[16 + r];
      }
      float OS[9]; OS[8] = 1.f;
#pragma unroll
      for (int G = 7; G >= 0; --G) { const float gp = (rr[4 * G] * rr[4 * G + 1]) * (rr[4 * G + 2] * rr[4 * G + 3]); OS[G] = OS[G + 1] * gp; }
      float cE[8];
#pragma unroll
      for (int G = 0; G < 8; ++G) {
        const float X = hi ? OS[G] : OS[G + 1], Y = OS[G + 1];
        auto sw = __builtin_amdgcn_permlane32_swap(__float_as_uint(X), __float_as_uint(Y), false, false);
        cE[G] = c * (__uint_as_float(sw[0]) * __uint_as_float(sw[1]));
      }
      { auto sw = __builtin_amdgcn_permlane32_swap(__float_as_uint(OS[0]), __float_as_uint(OS[0]), false, false); c *= __uint_as_float(sw[0]) * __uint_as_float(sw[1]); }
      float a[32];
#pragma unroll
      for (int G = 0; G < 8; ++G) {
        const float t3 = cE[G], t2 = t3 * rr[4 * G + 3], t1 = t2 * rr[4 * G + 2], t0 = t1 * rr[4 * G + 1];
        a[4 * G + 3] = be[4 * G + 3] * t3; a[4 * G + 2] = be[4 * G + 2] * t2; a[4 * G + 1] = be[4 * G + 1] * t1; a[4 * G] = be[4 * G] * t0;
      }
      u32x4 pw[4];
#pragma unroll
      for (int ks = 0; ks < 4; ++ks) { pw[ks].x = cvt_pk_bf16(a[8 * ks], a[8 * ks + 1]); pw[ks].y = cvt_pk_bf16(a[8 * ks + 2], a[8 * ks + 3]); pw[ks].z = cvt_pk_bf16(a[8 * ks + 4], a[8 * ks + 5]); pw[ks].w = cvt_pk_bf16(a[8 * ks + 6], a[8 * ks + 7]); }
      LAS const char* vp = vp0 + slot;
#pragma unroll
      for (int d0 = 0; d0 < 2; ++d0)
#pragma unroll
        for (int ks = 0; ks < 4; ++ks) {
          const s16x4 lo = vtr(vp + d0 * 4096 + ks * 1024), hh = vtr(vp + d0 * 4096 + ks * 1024 + 512);
          const bf16x8 vf = (bf16x8){lo[0], lo[1], lo[2], lo[3], hh[0], hh[1], hh[2], hh[3]};
          o[d0] = __builtin_amdgcn_mfma_f32_32x32x16_bf16(__builtin_bit_cast(bf16x8, pw[ks]), vf, o[d0], 0, 0, 0);
        }
    }
    wave_alive = __any(c != 0.f);
    if (lane == 0) fl[(i & 1) * 8 + wid] = wave_alive ? 1u : 0u;
    slot = nslot;
  }
  bf16_t* Ow = O + (rowbase + q0 + wid * 32) * ldo + h * 64;
  LAS bf16_t* stg = (LAS bf16_t*)(lds + LDS_OST) + wid * 2048;
#pragma unroll
  for (int r = 0; r < 16; ++r) { const int orow = (r & 3) + 8 * (r >> 2) + 4 * hi;
#pragma unroll
    for (int d0 = 0; d0 < 2; ++d0) stg[orow * 64 + d0 * 32 + r32] = f2bf(o[d0][r]); }
  asm volatile("s_waitcnt lgkmcnt(0)" ::: "memory");
#pragma unroll
  for (int i = 0; i < 4; ++i) { const int row = i * 8 + (lane >> 3), ch = lane & 7; const u32x4 v = *(LAS const u32x4*)(stg + row * 64 + ch * 8); *(u32x4*)(Ow + (size_t)row * ldo + ch * 8) = v; }
  asm volatile("s_waitcnt vmcnt(0) lgkmcnt(0)\n\ts_barrier" ::: "memory");
#undef SB_DMA
}
}
__device__ __forceinline__ void phase_sb_attn(const Params& p, LAS char* lds, int bid, int nblk, bool dummy = false) {
  char* ws = p.ws;
  bf16_t* P = (bf16_t*)(ws + OFF_P); bf16_t* Od = dummy ? (bf16_t*)(ws + OFF_G + G_MIX) : P; const int ldo = dummy ? DM : LDP;
  const int vcu = (nblk % 8 == 0) ? (bid % 8) * (nblk / 8) + bid / 8 : bid;
  for (int pi = vcu; pi < 96 * 8; pi += nblk) {
    const int bh = pi >> 3, s = pi & 7, b = bh / 12, h = bh % 12;
    sb::unit(P, Od, ldo, b, h, 15 - s, lds);
    sb::unit(P, Od, ldo, b, h, s, lds);
  }
}

namespace gdn {
constexpr int RA_W = 0, RA_QG = 16384, RA_KT = 32768, RA_ATT = 49152, REC_A = 55296, REC_U = 16384, REC = REC_A + REC_U;
constexpr int HALF_LDS = 78848;
constexpr int GA_TM = 57344, GA_YM = GA_TM + 64 * 68 * 4, GA_RB = RA_QG;
constexpr float QSCALE = 0.08838834764831845f;
__device__ __forceinline__ int crow(int r, int hi) { return (r & 3) + 8 * (r >> 2) + 4 * hi; }
}
__device__ __forceinline__ void phase_gdn_prep(const Params& p, LAS char* lds, int bid, int nblk, int ubase, int nunits) {
  using namespace gdn;
  char* ws = p.ws; const bf16_t* P = (const bf16_t*)(ws + OFF_P); char* G = ws + OFF_G; float* EGL = (float*)(ws + OFF_EGL);
  const int nrounds = (nunits + 2 * nblk - 1) / (2 * nblk);
  const __amdgpu_buffer_rsrc_t gr_ = __builtin_amdgcn_make_buffer_rsrc((void*)G, 0, (int)((size_t)216 << 20), 0x00020000);
  unsigned* gflag = (unsigned*)(ws + OFF_CTRL) + CTRL_GFLAG;
  for (int rd = 0; rd < nrounds; ++rd) {
    int tl = threadIdx.x; asm volatile("" : "+v"(tl));
    const int tid = tl, hb = tid >> 8, ht = tid & 255, lane = tid & 63, r32 = lane & 31, hi = lane >> 5;
    const int hw = __builtin_amdgcn_readfirstlane(ht >> 6);
    LAS char* L = lds + hb * HALF_LDS;
    LAS float* sBeta = (LAS float*)(L + REC_A); LAS float* sGc = sBeta + 64; LAS float* sEgc = sGc + 64; LAS float* sRnK = sEgc + 64; LAS float* sRnQ = sRnK + 64;
    LAS char* sQ = L; LAS char* sK = L + 17408;
    LAS float* Amat = (LAS float*)(L + RA_W);
    const int u0 = (rd * nblk + bid) * 2 + hb; const bool valid = u0 < nunits; const int uq = ubase + (valid ? u0 : 0);
    const int bh = uq % 48, n = uq / 48, u = bh * 64 + n, b = bh / 6, h = bh % 6; const size_t row0 = (size_t)b * SEQ + (size_t)n * 64;
    const unsigned reco = (unsigned)u * (unsigned)REC;
    __syncthreads();
    if (hw == 0) {
      const bf16_t* pr = P + (row0 + lane) * LDP + PC_BA;
      const float braw = bf2f(pr[h]), araw = bf2f(pr[6 + h]);
      const float beta = sigmoidf_(braw), g = -__expf(p.a_log[h]) * softplusf_(araw + p.a_dt_bias[h]);
      float s = g;
#pragma unroll
      for (int o = 1; o < 64; o <<= 1) { const float t = __shfl_up(s, o); if (lane >= o) s += t; }
      sBeta[lane] = beta; sGc[lane] = s; sEgc[lane] = __expf(s);
    }
    {
      u32x4 rv[13];
#pragma unroll
      for (int k = 0; k < 13; ++k) { const int i = ht + k * 256, ic = i < 67 * 48 ? i : 67 * 48 - 1, rr = ic / 48, cc = ic % 48, part = cc >> 4, c8 = (cc & 15) * 8;
        const int rsrc = (n > 0 || rr >= 3) ? rr - 3 : 0;
        rv[k] = *(const u32x4*)(P + (row0 + rsrc) * LDP + (part == 0 ? PC_Q : part == 1 ? PC_K : PC_V) + h * 128 + c8); }
#pragma unroll
      for (int k = 0; k < 13; ++k) { const int i = ht + k * 256, rr = i / 48, cc = i % 48;
        if (i < 67 * 48) *(LAS u32x4*)(L + rr * 768 + cc * 16) = (n > 0 || rr >= 3) ? rv[k] : (u32x4){0u, 0u, 0u, 0u}; }
    }
    __syncthreads();
    float x[64], xq[64];
    {
      const int c = ht & 127; const bool isk = ht >= 128;
      {
        const int ch = (isk ? 768 : 1536) + h * 128 + c;
        const float w0 = p.a_conv[ch], w1 = p.a_conv[2304 + ch], w2 = p.a_conv[2 * 2304 + ch], w3 = p.a_conv[3 * 2304 + ch];
        LAS const char* src = L + (isk ? 256 : 512) + c * 2;
        float r0 = bf2f(*(LAS const bf16_t*)(src)), r1 = bf2f(*(LAS const bf16_t*)(src + 768)), r2 = bf2f(*(LAS const bf16_t*)(src + 2 * 768));
#pragma unroll
        for (int i = 0; i < 64; ++i) { const float r3 = bf2f(*(LAS const bf16_t*)(src + (i + 3) * 768)); x[i] = siluf_(w0 * r0 + w1 * r1 + w2 * r2 + w3 * r3); r0 = r1; r1 = r2; r2 = r3; }
      }
      if (!isk) {
        const int ch = h * 128 + c;
        const float w0 = p.a_conv[ch], w1 = p.a_conv[2304 + ch], w2 = p.a_conv[2 * 2304 + ch], w3 = p.a_conv[3 * 2304 + ch];
        LAS const char* src = L + c * 2;
        float r0 = bf2f(*(LAS const bf16_t*)(src)), r1 = bf2f(*(LAS const bf16_t*)(src + 768)), r2 = bf2f(*(LAS const bf16_t*)(src + 2 * 768));
#pragma unroll
        for (int i = 0; i < 64; ++i) { const float r3 = bf2f(*(LAS const bf16_t*)(src + (i + 3) * 768)); xq[i] = siluf_(w0 * r0 + w1 * r1 + w2 * r2 + w3 * r3); r0 = r1; r1 = r2; r2 = r3; }
      } else {
#pragma unroll
        for (int i = 0; i < 64; ++i) xq[i] = x[i];
      }
    }
    __syncthreads();
    if (ht < 128) {
#pragma unroll
      for (int i = 0; i < 64; ++i) *(LAS bf16_t*)(sQ + i * 272 + ht * 2) = f2bf(xq[i]);
    } else {
#pragma unroll
      for (int i = 0; i < 64; ++i) *(LAS bf16_t*)(sK + i * 272 + (ht - 128) * 2) = f2bf(x[i]);
    }
    __syncthreads();
    const int it = hw >> 1, jt = hw & 1;
    f32x16 akk = f32x16{}, aqk = f32x16{};
    if (hw != 1) {
#pragma unroll
      for (int ks = 0; ks < 8; ++ks) {
        const bf16x8 ak = *(LAS const bf16x8*)(sK + (32 * it + r32) * 272 + ks * 32 + hi * 16), aq = *(LAS const bf16x8*)(sQ + (32 * it + r32) * 272 + ks * 32 + hi * 16);
        const bf16x8 bk = *(LAS const bf16x8*)(sK + (32 * jt + r32) * 272 + ks * 32 + hi * 16);
        akk = __builtin_amdgcn_mfma_f32_32x32x16_bf16(ak, bk, akk, 0, 0, 0); aqk = __builtin_amdgcn_mfma_f32_32x32x16_bf16(aq, bk, aqk, 0, 0, 0);
      }
    } else {
#pragma unroll
      for (int ks = 0; ks < 8; ++ks) {
        const bf16x8 a0 = *(LAS const bf16x8*)(sQ + r32 * 272 + ks * 32 + hi * 16), a1 = *(LAS const bf16x8*)(sQ + (32 + r32) * 272 + ks * 32 + hi * 16);
        akk = __builtin_amdgcn_mfma_f32_32x32x16_bf16(a0, a0, akk, 0, 0, 0); aqk = __builtin_amdgcn_mfma_f32_32x32x16_bf16(a1, a1, aqk, 0, 0, 0);
      }
    }
    {
      float d0 = 0.f, d1 = 0.f;
#pragma unroll
      for (int r = 0; r < 16; ++r) if (crow(r, hi) == r32) { d0 = akk[r]; d1 = aqk[r]; }
      const bool has = ((r32 >> 2) & 1) == hi;
      if (has && hw == 0) sRnK[r32] = rsqrtf(d0 + EPS);
      if (has && hw == 3) sRnK[32 + r32] = rsqrtf(d0 + EPS);
      if (has && hw == 1) { sRnQ[r32] = rsqrtf(d0 + EPS) * QSCALE; sRnQ[32 + r32] = rsqrtf(d1 + EPS) * QSCALE; }
    }
    __syncthreads();
    if (hw != 1) {
      const int j = 32 * jt + r32; const float rnkj = sRnK[j], gcj = sGc[j];
      const int ksj = 2 * jt + (r32 >> 4), jo = r32 & 15, hip = (jo >> 2) & 1, jp = (jo & 3) + 4 * (jo >> 3);
      LAS char* attf = L + RA_ATT + (it ? 2 + ksj : ksj) * 1024 + hip * 512 + jp * 2;
#pragma unroll
      for (int r = 0; r < 16; ++r) {
        const int il = crow(r, hi), i = 32 * it + il;
        const float dec = __expf(fminf(sGc[i] - gcj, 0.f));
        const float aval = (i > j) ? sBeta[i] * sRnK[i] * rnkj * akk[r] * dec : 0.f;
        const float tval = (i >= j) ? sRnQ[i] * rnkj * aqk[r] * dec : 0.f;
        Amat[i * 64 + j] = aval;
        *(LAS bf16_t*)(attf + il * 16) = f2bf(tval);
        if ((r & 3) == 3) asm volatile("" ::: "memory");
      }
    }
    __syncthreads();
    LAS float* Tm = (LAS float*)(L + GA_TM); LAS float* Ym = (LAS float*)(L + GA_YM); LAS char* RB = L + GA_RB;
    {
      LAS char* rc = RB + ht * 128;
#pragma unroll
      for (int q = 0; q < 8; ++q) { float v[8];
#pragma unroll
        for (int e = 0; e < 8; ++e) { const int i = 8 * q + e; v[e] = x[i] * (ht < 128 ? sBeta[i] : sBeta[i] * sEgc[i] * sRnK[i]); }
        u32x4 w; w.x = cvt_pk_bf16(v[0], v[1]); w.y = cvt_pk_bf16(v[2], v[3]); w.z = cvt_pk_bf16(v[4], v[5]); w.w = cvt_pk_bf16(v[6], v[7]);
        *(LAS u32x4*)(rc + ((q ^ (ht & 7)) * 16)) = w; asm volatile("" ::: "memory"); }
    }
    if (hw == 0) {
      const int blk = hi, c = r32;
      LAS const float* Ab = Amat + (32 * blk) * 64 + 32 * blk;
      float t[32];
#pragma unroll
      for (int i = 0; i < 32; ++i) t[i] = (i == c) ? 1.f : 0.f;
#pragma unroll
      for (int i = 1; i < 32; ++i) {
        float a0 = 0.f, a1 = 0.f, a2 = 0.f, a3 = 0.f;
#pragma unroll
        for (int m4 = 0; m4 < (i + 3) / 4; ++m4) { const f32x4 a = *(LAS const f32x4*)(Ab + i * 64 + m4 * 4); a0 += a[0] * t[4 * m4]; a1 += a[1] * t[4 * m4 + 1]; a2 += a[2] * t[4 * m4 + 2]; a3 += a[3] * t[4 * m4 + 3]; }
        t[i] -= (a0 + a1) + (a2 + a3);
        if ((i & 3) == 3) asm volatile("" ::: "memory");
      }
#pragma unroll
      for (int k = 0; k < 32; ++k) Tm[(32 * blk + k) * 68 + 32 * blk + c] = t[k];
      asm volatile("s_waitcnt lgkmcnt(0)" ::: "memory");
      f32x16 acc = f32x16{};
      {
#pragma unroll
        for (int q = 0; q < 8; ++q) { const f32x4 a = *(LAS const f32x4*)(Amat + (32 + r32) * 64 + q * 4);
          const float av0 = hi ? a[1] : a[0], av1 = hi ? a[3] : a[2]; const float bv0 = Tm[(4 * q + hi) * 68 + r32], bv1 = Tm[(4 * q + 2 + hi) * 68 + r32];
          acc = __builtin_amdgcn_mfma_f32_32x32x2f32(av0, bv0, acc, 0, 0, 0); acc = __builtin_amdgcn_mfma_f32_32x32x2f32(av1, bv1, acc, 0, 0, 0);
          if (q & 1) asm volatile("" ::: "memory"); }
      }
#pragma unroll
      for (int r = 0; r < 16; ++r) Ym[crow(r, hi) * 32 + r32] = acc[r];
      asm volatile("s_waitcnt lgkmcnt(0)" ::: "memory");
      acc = f32x16{};
      {
#pragma unroll
        for (int q = 0; q < 8; ++q) { const f32x4 a = *(LAS const f32x4*)(Tm + (32 + r32) * 68 + 32 + q * 4);
          const float av0 = hi ? a[1] : a[0], av1 = hi ? a[3] : a[2]; const float bv0 = Ym[(4 * q + hi) * 32 + r32], bv1 = Ym[(4 * q + 2 + hi) * 32 + r32];
          acc = __builtin_amdgcn_mfma_f32_32x32x2f32(av0, bv0, acc, 0, 0, 0); acc = __builtin_amdgcn_mfma_f32_32x32x2f32(av1, bv1, acc, 0, 0, 0);
          if (q & 1) asm volatile("" ::: "memory"); }
      }
#pragma unroll
      for (int r = 0; r < 16; ++r) Tm[(32 + crow(r, hi)) * 68 + r32] = -acc[r];
    }
    __syncthreads();
    {
      f32x16 xa[2][2];
#pragma unroll
      for (int mt = 0; mt < 2; ++mt)
#pragma unroll
        for (int nl = 0; nl < 2; ++nl) xa[mt][nl] = f32x16{};
#pragma unroll
      for (int ks = 0; ks < 4; ++ks) {
        bf16x8 bfr[2];
#pragma unroll
        for (int nl = 0; nl < 2; ++nl) { const int col = 64 * hw + 32 * nl + r32; bfr[nl] = *(LAS const bf16x8*)(RB + col * 128 + (((2 * ks + hi) ^ (col & 7)) * 16)); }
#pragma unroll
        for (int mt = 0; mt < 2; ++mt) {
          if (mt == 0 && ks >= 2) continue;
          LAS const float* tp = Tm + (32 * mt + r32) * 68 + 16 * ks + 8 * hi;
          const f32x4 t0 = *(LAS const f32x4*)tp, t1 = *(LAS const f32x4*)(tp + 4);
          u32x4 w; w.x = cvt_pk_bf16(t0[0], t0[1]); w.y = cvt_pk_bf16(t0[2], t0[3]); w.z = cvt_pk_bf16(t1[0], t1[1]); w.w = cvt_pk_bf16(t1[2], t1[3]);
          const bf16x8 af = __builtin_bit_cast(bf16x8, w);
#pragma unroll
          for (int nl = 0; nl < 2; ++nl) xa[mt][nl] = __builtin_amdgcn_mfma_f32_32x32x16_bf16(af, bfr[nl], xa[mt][nl], 0, 0, 0);
        }
      }
      if (hw < 2) {
        if (valid) {
#pragma unroll
          for (int nl = 0; nl < 2; ++nl) { const unsigned ud = reco + (unsigned)(REC_A + (64 * hw + 32 * nl + r32) * 128 + hi * 32);
#pragma unroll
            for (int mt = 0; mt < 2; ++mt)
#pragma unroll
              for (int q = 0; q < 2; ++q) { u32x4 w; w.x = cvt_pk_bf16(xa[mt][nl][8 * q], xa[mt][nl][8 * q + 1]); w.y = cvt_pk_bf16(xa[mt][nl][8 * q + 2], xa[mt][nl][8 * q + 3]);
                w.z = cvt_pk_bf16(xa[mt][nl][8 * q + 4], xa[mt][nl][8 * q + 5]); w.w = cvt_pk_bf16(xa[mt][nl][8 * q + 6], xa[mt][nl][8 * q + 7]); __builtin_amdgcn_raw_buffer_store_b128(w, gr_, ud + mt * 64 + q * 16, 0, 16); } }
        }
      } else {
#pragma unroll
        for (int nl = 0; nl < 2; ++nl) { const int cp = 64 * (hw - 2) + 32 * nl + r32, co = cp & 15, hip = (co >> 2) & 1, jp = (co & 3) + 4 * (co >> 3);
          LAS char* wf = L + RA_W + (cp >> 4) * 1024 + hip * 512 + jp * 2;
#pragma unroll
          for (int mt = 0; mt < 2; ++mt)
#pragma unroll
            for (int r = 0; r < 16; ++r) *(LAS bf16_t*)(wf + mt * 8192 + crow(r, hi) * 16) = f2bf(-xa[mt][nl][r]); }
      }
    }
    __syncthreads();
    if (ht < 128) {
      const int c = ht;
      const int co = c & 15, hip = (co >> 2) & 1, jp = (co & 3) + 4 * (co >> 3);
      LAS char* qgf = L + RA_QG + (c >> 4) * 1024 + hip * 512 + jp * 2;
#pragma unroll
      for (int i = 0; i < 64; ++i) { *(LAS bf16_t*)(qgf + (i >> 5) * 8192 + (i & 31) * 16) = f2bf(xq[i] * sRnQ[i] * sEgc[i]); if ((i & 7) == 7) asm volatile("" ::: "memory"); }
    } else {
      const int c = ht - 128;
      const float gl = sGc[63];
      LAS char* ktf = L + RA_KT + (c >> 5) * 4096 + (c & 31) * 16;
#pragma unroll
      for (int ks = 0; ks < 4; ++ks)
#pragma unroll
        for (int hp = 0; hp < 2; ++hp) {
          float v[8];
#pragma unroll
          for (int jq = 0; jq < 8; ++jq) { const int i = 16 * ks + (jq & 3) + 8 * (jq >> 2) + 4 * hp; v[jq] = xq[i] * sRnK[i] * __expf(gl - sGc[i]); }
          u32x4 w; w.x = cvt_pk_bf16(v[0], v[1]); w.y = cvt_pk_bf16(v[2], v[3]); w.z = cvt_pk_bf16(v[4], v[5]); w.w = cvt_pk_bf16(v[6], v[7]);
          *(LAS u32x4*)(ktf + ks * 1024 + hp * 512) = w;
          asm volatile("" ::: "memory");
        }
    }
    if (ht == 0 && valid) __hip_atomic_store(EGL + u * 32, __expf(sGc[63]), __ATOMIC_RELAXED, __HIP_MEMORY_SCOPE_AGENT);
    __syncthreads();
    if (valid) for (int o = ht * 16; o < REC_A; o += 4096) __builtin_amdgcn_raw_buffer_store_b128(*(LAS const u32x4*)(L + o), gr_, reco + (unsigned)o, 0, 16);
    asm volatile("s_waitcnt vmcnt(0)" ::: "memory");
    if (valid && lane == 0) (void)xb_add(gflag + u, 1u);
  }
}

__device__ __forceinline__ void phase_gdn_scan(const Params& p, LAS char* lds, int bid) {
  constexpr int c0 = 0, cend = 64;
  using namespace gdn;
  char* ws = p.ws; bf16_t* P = (bf16_t*)(ws + OFF_P); const char* G = ws + OFF_G; const float* EGL = (const float*)(ws + OFF_EGL);
  const int tid = threadIdx.x, lane = tid & 63, r32 = lane & 31, hi = lane >> 5; const int wid = __builtin_amdgcn_readfirstlane(tid >> 6);
  constexpr int RBUF = 57344;
  LAS char* OX = lds + 2 * RBUF;
  {
    const int u = bid; const int b = u / 6, h = u % 6; const size_t rowb = (size_t)b * SEQ; const char* recb = G + (size_t)u * 64 * REC;
    __syncthreads();
    unsigned* ctl = (unsigned*)(ws + OFF_CTRL);
    if (wid >= 4) {
      const int j = wid - 4, row = 16 * j + (lane >> 2), cg = (lane & 3) * 32;
      const char* recl = recb + j * 1024 + lane * 16;
      u32x4 R0[14], R1[14];
#define GH_LOAD(RS, r_) do { const int rr_ = (r_) < cend - 1 ? (r_) : cend - 1; const char* rp_ = recl + (size_t)rr_ * REC; _Pragma("unroll") for (int i_ = 0; i_ < 14; ++i_) RS[i_] = *(const u32x4*)(rp_ + i_ * 4096); } while (0)
#define GH_WRITE(RS, r_) do { LAS char* dp_ = lds + ((r_) & 1) * RBUF + j * 1024 + lane * 16; _Pragma("unroll") for (int i_ = 0; i_ < 14; ++i_) *(LAS u32x4*)(dp_ + i_ * 4096) = RS[i_]; } while (0)
      LAS float* gnl = (LAS float*)(lds + 2 * RBUF + 32768);
      if (j == 0) { gnl[lane] = p.a_out_gain[lane]; gnl[64 + lane] = p.a_out_gain[64 + lane]; }
      LAS const float* gnp = gnl + cg;
      const bf16_t* gp0 = P + (rowb + row) * LDP + PC_GATE + h * 128 + cg;
      bf16_t* dp0 = P + (rowb + row) * LDP + PC_Q + h * 128 + cg;
      u32x4 gr[4];
#pragma unroll
      for (int q = 0; q < 4; ++q) gr[q] = *(const u32x4*)(gp0 + (size_t)c0 * 64 * LDP + q * 8);
      asm volatile("" ::: "memory");
      GH_LOAD(R0, c0); GH_WRITE(R0, c0); GH_LOAD(R1, c0 + 1); GH_LOAD(R0, c0 + 2);
#define GH_STEP(c_, RS) do { const int c = (c_); \
        asm volatile("s_waitcnt lgkmcnt(0)\n\ts_barrier" ::: "memory"); \
        GH_WRITE(RS, c + 1); GH_LOAD(RS, c + 3);        \
        if (c >= c0 + 1 && c <= cend) { const int cc = c - 1; \
          LAS const char* op = OX + (cc & 1) * 16384 + row * 256 + cg * 2; \
          float ss = 0.f; \
          _Pragma("unroll") for (int q = 0; q < 4; ++q) { const u32x4 r = *(LAS const u32x4*)(op + q * 16); \
            const float o0 = bflo(r.x), o1 = bfhi(r.x), o2 = bflo(r.y), o3 = bfhi(r.y), o4 = bflo(r.z), o5 = bfhi(r.z), o6 = bflo(r.w), o7 = bfhi(r.w); \
            ss += (o0 * o0 + o1 * o1) + (o2 * o2 + o3 * o3) + (o4 * o4 + o5 * o5) + (o6 * o6 + o7 * o7); } \
          ss += __shfl_xor(ss, 1); ss += __shfl_xor(ss, 2); \
          const float sc = rsqrtf(ss * (1.f / 128.f) + EPS); \
          bf16_t* dp = dp0 + (size_t)cc * 64 * LDP; \
          _Pragma("unroll") for (int q = 0; q < 4; ++q) { u32x4 w; const u32x4 gg = gr[q]; const u32x4 r = *(LAS const u32x4*)(op + q * 16);        \
            const f32x4 g0 = *(LAS const f32x4*)(gnp + 8 * q), g1 = *(LAS const f32x4*)(gnp + 8 * q + 4); \
            w.x = cvt_pk_bf16(bflo(r.x) * sc * g0[0] * siluf_(bflo(gg.x)), bfhi(r.x) * sc * g0[1] * siluf_(bfhi(gg.x))); w.y = cvt_pk_bf16(bflo(r.y) * sc * g0[2] * siluf_(bflo(gg.y)), bfhi(r.y) * sc * g0[3] * siluf_(bfhi(gg.y))); \
            w.z = cvt_pk_bf16(bflo(r.z) * sc * g1[0] * siluf_(bflo(gg.z)), bfhi(r.z) * sc * g1[1] * siluf_(bfhi(gg.z))); w.w = cvt_pk_bf16(bflo(r.w) * sc * g1[2] * siluf_(bflo(gg.w)), bfhi(r.w) * sc * g1[3] * siluf_(bfhi(gg.w))); \
            *(u32x4*)(dp + q * 8) = w; } \
          { const int cn_ = c < cend - 1 ? c : cend - 1; _Pragma("unroll") for (int q = 0; q < 4; ++q) gr[q] = *(const u32x4*)(gp0 + (size_t)cn_ * 64 * LDP + q * 8); } \
        } \
      } while (0)
      for (int c2 = c0; c2 <= cend; c2 += 2) { GH_STEP(c2, R1); GH_STEP(c2 + 1, R0); }
#undef GH_STEP
#undef GH_LOAD
#undef GH_WRITE
    } else {
      const int vs = wid;
      f32x16 S[4];
#pragma unroll
      for (int k = 0; k < 4; ++k)
#pragma unroll
        for (int r = 0; r < 16; ++r) S[k][r] = 0.f;
      const char* ub = recb + REC_A + (vs * 32 + r32) * 128 + hi * 32;
      u32x4 un[4];
#pragma unroll
      for (int q = 0; q < 4; ++q) un[q] = *(const u32x4*)(ub + (size_t)c0 * REC + (q >> 1) * 64 + (q & 1) * 16);
      const float* egp = EGL + (size_t)u * 64 * 32;
      float egn = egp[0];
      unsigned* gfl = ctl + CTRL_GFLAG + u * 64;
      for (int c = c0; c <= cend + 1; ++c) {
        asm volatile("s_waitcnt lgkmcnt(0)\n\ts_barrier" ::: "memory");
        if (c < cend) {
          unsigned fl = 4u;
          if (vs == 0) fl = xb_ld(gfl + (c + 4 < cend ? c + 4 : cend - 1));
          LAS const char* R = lds + (c & 1) * RBUF + lane * 16;
          const float egl = egn;
          u32x4 uc[4];
#pragma unroll
          for (int q = 0; q < 4; ++q) uc[q] = un[q];
          { const int cu = c + 1 < cend ? c + 1 : cend - 1;
#pragma unroll
            for (int q = 0; q < 4; ++q) un[q] = *(const u32x4*)(ub + (size_t)cu * REC + (q >> 1) * 64 + (q & 1) * 16);
            egn = egp[cu * 32]; }
          bf16x8 Sb[8];
#pragma unroll
          for (int ks = 0; ks < 8; ++ks) { const int kt = ks >> 1, o = (ks & 1) * 8; u32x4 w;
            w.x = cvt_pk_bf16(S[kt][o], S[kt][o + 1]); w.y = cvt_pk_bf16(S[kt][o + 2], S[kt][o + 3]); w.z = cvt_pk_bf16(S[kt][o + 4], S[kt][o + 5]); w.w = cvt_pk_bf16(S[kt][o + 6], S[kt][o + 7]);
            Sb[ks] = __builtin_bit_cast(bf16x8, w); }
#define GB_LD(dst, off0, off1) do { _Pragma("unroll") for (int q_ = 0; q_ < 4; ++q_) { dst[q_] = *(LAS const bf16x8*)(R + (off0) + q_ * 1024); dst[4 + q_] = *(LAS const bf16x8*)(R + (off1) + q_ * 1024); } } while (0)
#define GB_SCHED __builtin_amdgcn_sched_barrier(0)
          bf16x8 fa[8];
          GB_LD(fa, RA_W, RA_W + 8192);
          f32x16 vn[2];
#pragma unroll
          for (int t2 = 0; t2 < 2; ++t2)
#pragma unroll
            for (int q = 0; q < 2; ++q) { const u32x4 r = uc[2 * t2 + q];
              vn[t2][8 * q] = bflo(r.x); vn[t2][8 * q + 1] = bfhi(r.x); vn[t2][8 * q + 2] = bflo(r.y); vn[t2][8 * q + 3] = bfhi(r.y); vn[t2][8 * q + 4] = bflo(r.z); vn[t2][8 * q + 5] = bfhi(r.z); vn[t2][8 * q + 6] = bflo(r.w); vn[t2][8 * q + 7] = bfhi(r.w); }
          GB_SCHED;
#pragma unroll
          for (int ks = 0; ks < 4; ++ks) { vn[0] = __builtin_amdgcn_mfma_f32_32x32x16_bf16(fa[ks], Sb[ks], vn[0], 0, 0, 0); vn[1] = __builtin_amdgcn_mfma_f32_32x32x16_bf16(fa[4 + ks], Sb[ks], vn[1], 0, 0, 0); }
          GB_SCHED; GB_LD(fa, RA_W + 4096, RA_W + 8192 + 4096); GB_SCHED;
#pragma unroll
          for (int ks = 0; ks < 4; ++ks) { vn[0] = __builtin_amdgcn_mfma_f32_32x32x16_bf16(fa[ks], Sb[4 + ks], vn[0], 0, 0, 0); vn[1] = __builtin_amdgcn_mfma_f32_32x32x16_bf16(fa[4 + ks], Sb[4 + ks], vn[1], 0, 0, 0); }
          GB_SCHED; GB_LD(fa, RA_KT, RA_KT + 4096); GB_SCHED;
          bf16x8 vb[4];
#pragma unroll
          for (int ks = 0; ks < 4; ++ks) { const int t2 = ks >> 1, o = (ks & 1) * 8; u32x4 w;
            w.x = cvt_pk_bf16(vn[t2][o], vn[t2][o + 1]); w.y = cvt_pk_bf16(vn[t2][o + 2], vn[t2][o + 3]); w.z = cvt_pk_bf16(vn[t2][o + 4], vn[t2][o + 5]); w.w = cvt_pk_bf16(vn[t2][o + 6], vn[t2][o + 7]);
            vb[ks] = __builtin_bit_cast(bf16x8, w); }
          f32x16 oo[2]; oo[0] = f32x16{}; oo[1] = f32x16{};
          S[0] = S[0] * egl; S[1] = S[1] * egl;
#pragma unroll
          for (int ks = 0; ks < 4; ++ks) { S[0] = __builtin_amdgcn_mfma_f32_32x32x16_bf16(fa[ks], vb[ks], S[0], 0, 0, 0); S[1] = __builtin_amdgcn_mfma_f32_32x32x16_bf16(fa[4 + ks], vb[ks], S[1], 0, 0, 0); }
          GB_SCHED; GB_LD(fa, RA_KT + 8192, RA_KT + 12288); GB_SCHED;
          S[2] = S[2] * egl; S[3] = S[3] * egl;
#pragma unroll
          for (int ks = 0; ks < 4; ++ks) { S[2] = __builtin_amdgcn_mfma_f32_32x32x16_bf16(fa[ks], vb[ks], S[2], 0, 0, 0); S[3] = __builtin_amdgcn_mfma_f32_32x32x16_bf16(fa[4 + ks], vb[ks], S[3], 0, 0, 0); }
          GB_SCHED; GB_LD(fa, RA_QG, RA_QG + 8192); GB_SCHED;
#pragma unroll
          for (int ks = 0; ks < 4; ++ks) { oo[0] = __builtin_amdgcn_mfma_f32_32x32x16_bf16(fa[ks], Sb[ks], oo[0], 0, 0, 0); oo[1] = __builtin_amdgcn_mfma_f32_32x32x16_bf16(fa[4 + ks], Sb[ks], oo[1], 0, 0, 0); }
          GB_SCHED; GB_LD(fa, RA_QG + 4096, RA_QG + 8192 + 4096); GB_SCHED;
#pragma unroll
          for (int ks = 0; ks < 4; ++ks) { oo[0] = __builtin_amdgcn_mfma_f32_32x32x16_bf16(fa[ks], Sb[4 + ks], oo[0], 0, 0, 0); oo[1] = __builtin_amdgcn_mfma_f32_32x32x16_bf16(fa[4 + ks], Sb[4 + ks], oo[1], 0, 0, 0); }
          GB_SCHED;
#pragma unroll
          for (int q = 0; q < 6; ++q) fa[q] = *(LAS const bf16x8*)(R + RA_ATT + q * 1024);
          GB_SCHED;
          oo[0] = __builtin_amdgcn_mfma_f32_32x32x16_bf16(fa[0], vb[0], oo[0], 0, 0, 0); oo[1] = __builtin_amdgcn_mfma_f32_32x32x16_bf16(fa[2], vb[0], oo[1], 0, 0, 0);
          oo[0] = __builtin_amdgcn_mfma_f32_32x32x16_bf16(fa[1], vb[1], oo[0], 0, 0, 0); oo[1] = __builtin_amdgcn_mfma_f32_32x32x16_bf16(fa[3], vb[1], oo[1], 0, 0, 0);
          oo[1] = __builtin_amdgcn_mfma_f32_32x32x16_bf16(fa[4], vb[2], oo[1], 0, 0, 0); oo[1] = __builtin_amdgcn_mfma_f32_32x32x16_bf16(fa[5], vb[3], oo[1], 0, 0, 0);
#undef GB_LD
#undef GB_SCHED
          LAS char* ox = OX + (c & 1) * 16384 + (vs * 32 + r32) * 2;
#pragma unroll
          for (int t2 = 0; t2 < 2; ++t2)
#pragma unroll
            for (int r = 0; r < 16; ++r) *(LAS bf16_t*)(ox + (32 * t2 + crow(r, hi)) * 256) = f2bf(oo[t2][r]);
          if (vs == 0) {
            unsigned sp = 0u;
            while ((unsigned)__builtin_amdgcn_readfirstlane(fl) < 4u) { __builtin_amdgcn_s_sleep(2);
              if ((++sp & 255u) == 0u) { if (xb_ld(&ctl[XB_TMO])) break; if (sp > XB_SPIN_CAP) { atomicAdd(&ctl[XB_TMO], 1u); break; } }
              fl = xb_ld(gfl + (c + 4 < cend ? c + 4 : cend - 1)); }
            __builtin_amdgcn_fence(__ATOMIC_ACQUIRE, "agent");
          }
        }
      }
    }
  }
}


__device__ __forceinline__ void phase_l2_stream(const Params& p, LAS char* lds) {
  char* ws = p.ws; unsigned* ctl = (unsigned*)(ws + OFF_CTRL); const char* G = ws + OFF_G; const bf16_t* P = (const bf16_t*)(ws + OFF_P);
  const int tid = threadIdx.x;
  LAS int* sh = (LAS int*)lds;
  __syncthreads();
  if (tid == 0) {
    const unsigned x = xb_xcc_id();
    int n = 0;
    for (int s_ = 0; s_ < 48; ++s_) { const unsigned v = __hip_atomic_load(&ctl[CTRL_XCC + s_], __ATOMIC_RELAXED, __HIP_MEMORY_SCOPE_AGENT); if (v == x + 1u && n < 8) { sh[8 + n] = s_; ++n; } }
    const unsigned rank = n ? __hip_atomic_fetch_add(&ctl[CTRL_RANK + x * 16], 1u, __ATOMIC_RELAXED, __HIP_MEMORY_SCOPE_AGENT) : 0u;
    sh[0] = n ? sh[8 + (int)(rank % (unsigned)n)] : -1;
    sh[1] = n ? (int)(rank / (unsigned)n) : 0;
  }
  __syncthreads();
  const int sbh = sh[0], q = sh[1];
  if (sbh < 0 || q >= 4) return;
  const int b = sbh / 6, h = sbh % 6; const char* recb = G + (size_t)sbh * 64 * gdn::REC; const size_t rowb = (size_t)b * SEQ;
  const unsigned long long t0 = wall_clock64();
  unsigned acc = 0u; int next = 0;
  while (next < 64) {
    const unsigned done = __builtin_amdgcn_readfirstlane(__hip_atomic_load(&ctl[CTRL_PROG + sbh * 16], __ATOMIC_RELAXED, __HIP_MEMORY_SCOPE_AGENT));
    if (wall_clock64() - t0 > 60000ull) break;
    const int lim = (int)done + 5 < 64 ? (int)done + 5 : 64;
    if (next >= lim) { __builtin_amdgcn_s_sleep(16); continue; }
    for (; next < lim; ++next) {
      if (next < (int)done + 1) continue;
      const char* rec = recb + (size_t)next * gdn::REC;
      for (int o = (q * 512 + tid) * 16; o < gdn::REC; o += 4 * 512 * 16) acc ^= (*(const u32x4*)(rec + o)).x;
      if (q == 0) { const int r = tid >> 3, ch = tid & 7; acc ^= (*(const u32x4*)(P + (rowb + (size_t)next * 64 + r) * LDP + PC_GATE + h * 128 + ch * 16)).x; }
    }
  }
  if (acc == 0x9E3779B9u && tid == 1023) ctl[CTRL_RANK + 15 * 16 + 1] = acc;
}

constexpr int NPHASE = 15;
__global__ void __launch_bounds__(NTHR, 2) yoco_fwd(Params p, int lo, int hi) {
  extern __shared__ __attribute__((aligned(16))) char smem_raw[];
  LAS char* lds = (LAS char*)smem_raw;
  const int bid = blockIdx.x, nblk = gridDim.x;
  LAS unsigned* xbw = (LAS unsigned*)(lds + LDS_BYTES - 16);
  if (threadIdx.x == 0) { xbw[0] = 0u; xbw[1] = 0u; xbw[2] = 0u; xbw[3] = 0u; }
  __syncthreads();
  XcdBarrier bar; bar.bar = (unsigned*)(p.ws + OFF_CTRL); bar.x = 0; bar.st = (volatile LAS unsigned*)xbw;
  if (hi - lo > 1) bar = xcd_barrier_post((unsigned*)(p.ws + OFF_CTRL), (volatile LAS unsigned*)xbw);
#ifndef PROBE_DOUBLE
#define PROBE_DOUBLE -1
#endif
#define PH(k) if (lo <= (k) && (k) < hi)
#ifndef PROBE_AMP
#define PROBE_AMP -1
#endif
#ifndef PROBE_BLK
#define PROBE_BLK 0
#endif
#if PROBE_AMP >= 0
  unsigned long long tph = wall_clock64();
#define SEAM_ID(id, k) do { if ((id) == PROBE_AMP && bid == PROBE_BLK && threadIdx.x == 0) { const unsigned long long dt_ = wall_clock64() - tph, t1_ = wall_clock64(); while (wall_clock64() - t1_ < 16ull * dt_) __builtin_amdgcn_s_sleep(8); } \
    if (lo <= (k) && (k) + 1 < hi) xcd_barrier(bar); tph = wall_clock64(); } while (0)
#else
#define SEAM_ID(id, k) do { if (lo <= (k) && (k) + 1 < hi) xcd_barrier(bar); } while (0)
#endif
  PH(0) phase_prep<false>(p, bid, nblk);
#if PROBE_DOUBLE == 0
  PH(0) { __syncthreads(); phase_prep<false>(p, bid, nblk); }
#endif
  SEAM_ID(0, 0);
  PH(1) phase_gemm_inA(p, lds, bid, nblk);
#if PROBE_DOUBLE == 1
  PH(1) phase_gemm_inA(p, lds, bid, nblk);
#endif
  SEAM_ID(1, 1);
  PH(2) phase_gdn_prep(p, lds, bid, nblk, 0, 2 * nblk);
  SEAM_ID(2, 2);
  PH(2) { if (bid < 48) phase_gdn_scan(p, lds, bid);
          else { phase_gdn_prep(p, lds, bid - 48, nblk - 48, 2 * nblk, 3072 - 2 * nblk); if (bid >= nblk - 32) phase_gemm_memkv(p, lds, bid - (nblk - 32), 32);
                 phase_prep<true>(p, bid - 48, nblk - 48); wait_counter((unsigned*)(p.ws + OFF_CTRL), CTRL_MEMKV, 32u); phase_memattn(p, lds, bid - 48, nblk - 48, 0); } }
  SEAM_ID(3, 2);
  PH(3) phase_gemm_out(p, lds, bid, nblk, 0);
#if PROBE_DOUBLE == 3
  PH(3) phase_gemm_out(p, lds, bid, nblk, 0);
#endif
  SEAM_ID(4, 3);
  PH(4) phase_norm_route(p, lds, bid, nblk, 0);
  SEAM_ID(5, 4);
  PH(5) phase_moe1(p, lds, bid, nblk, 0);
#if PROBE_DOUBLE == 5
  PH(5) phase_moe1(p, lds, bid, nblk, 0);
#endif
  PH(6) phase_moe2(p, lds, bid, nblk, 0);
#if PROBE_DOUBLE == 6
  PH(6) phase_moe2(p, lds, bid, nblk, 0);
#endif
  SEAM_ID(7, 6);
  PH(7) phase_combine<false>(p, bid, nblk);
  SEAM_ID(8, 7);
  PH(8) phase_gemm_inB(p, lds, bid, nblk);
#if PROBE_DOUBLE == 8
  PH(8) phase_gemm_inB(p, lds, bid, nblk);
#endif
  SEAM_ID(9, 8);
#if PROBE_DOUBLE == 9
  PH(9) { phase_sb_attn(p, lds, bid, nblk, true); }
#endif
  PH(9) { phase_sb_attn(p, lds, bid, nblk); phase_memattn(p, lds, bid, nblk, 1); }
#if PROBE_DOUBLE == 91
  PH(9) { phase_memattn(p, lds, bid, nblk, 1); }
#endif
  SEAM_ID(10, 9);
  PH(10) phase_gemm_out(p, lds, bid, nblk, 1);
  SEAM_ID(11, 10);
  PH(11) phase_norm_route(p, lds, bid, nblk, 1);
  SEAM_ID(12, 11);
  PH(12) phase_moe1(p, lds, bid, nblk, 1);
  PH(13) phase_moe2(p, lds, bid, nblk, 1);
  SEAM_ID(14, 13);
  PH(14) phase_combine<true>(p, bid, nblk);
#if PROBE_AMP == 15
  if (bid == PROBE_BLK && threadIdx.x == 0) { const unsigned long long dt_ = wall_clock64() - tph, t1_ = wall_clock64(); while (wall_clock64() - t1_ < 16ull * dt_) __builtin_amdgcn_s_sleep(8); }
#endif
#undef PH
#undef SEAM_ID
}

#ifndef N_LAUNCH_SPLIT
#define N_LAUNCH_SPLIT 0
#endif

extern "C" void kernel_launch(void* const* d_in, const int* in_sizes, int n_in, void* d_out, int out_size, void* d_ws, size_t ws_size, hipStream_t stream) {
  (void)in_sizes; (void)n_in; (void)out_size;
  if (ws_size < WS_NEED) return;
  static int grid = 0;
  if (!grid) {
    if (hipFuncSetAttribute((const void*)yoco_fwd, hipFuncAttributeMaxDynamicSharedMemorySize, LDS_BYTES) != hipSuccess) { grid = -1; return; }
    int dev = 0, cus = 0; hipGetDevice(&dev); hipDeviceGetAttribute(&cus, hipDeviceAttributeMultiprocessorCount, dev);
    int per_cu = 0; hipOccupancyMaxActiveBlocksPerMultiprocessor(&per_cu, (const void*)yoco_fwd, NTHR, LDS_BYTES);
    grid = (per_cu >= 1) ? cus : -1;
  }
  if (grid <= 0) return;
  Params p{};
  const float** pf = (const float**)&p;
  for (int i = 0; i < 25; ++i) pf[i] = (const float*)d_in[i];
  p.out = (float*)d_out; p.ws = (char*)d_ws;
  hipMemsetAsync(d_ws, 0, CTRL_BYTES, stream);
#if N_LAUNCH_SPLIT
  for (int k = 0; k < NPHASE; ++k) hipLaunchKernelGGL(yoco_fwd, dim3(grid), dim3(NTHR), LDS_BYTES, stream, p, k, k + 1);
#else
  hipLaunchKernelGGL(yoco_fwd, dim3(grid), dim3(NTHR), LDS_BYTES, stream, p, 0, NPHASE);
#endif
}
```

```cpp
#include <hip/hip_runtime.h>
#include <stdint.h>
#include <stddef.h>

#define LAS __attribute__((address_space(3)))
typedef unsigned short bf16_t;
typedef short bf16x8 __attribute__((ext_vector_type(8)));
typedef float f32x4 __attribute__((ext_vector_type(4)));
typedef float f32x16 __attribute__((ext_vector_type(16)));
typedef unsigned u32x4 __attribute__((ext_vector_type(4)));
typedef unsigned u32x2 __attribute__((ext_vector_type(2)));

constexpr int NTOK = 32768, DM = 1024, SEQ = 4096, NBATCH = 8, MEMLEN = 256, NMEMROW = NBATCH * MEMLEN;
constexpr int LDP = 3392;
constexpr int PC_Q = 0, PC_MQ = 768, PC_K = 1024, PC_V = 1792, PC_GATE = 2560, PC_BA = 3328;
constexpr int NIN_A = 3584;
constexpr int NIN_B = 2560;
constexpr float EPS = 1e-6f;
constexpr float LOG2E = 1.4426950408889634f;
constexpr int NTHR = 512;

constexpr size_t OFF_CTRL  = 0;
constexpr size_t CTRL_BYTES = 81920;
constexpr size_t OFF_RSTD  = CTRL_BYTES;
constexpr size_t OFF_MRSTD = OFF_RSTD + (size_t)NTOK * 4;
constexpr size_t OFF_CW    = OFF_MRSTD + 8192;
constexpr size_t OFF_LIST  = OFF_CW + 65536 * 4;
constexpr size_t OFF_MEMKV = OFF_LIST + (size_t)16 * NTOK * 4;
constexpr size_t OFF_WR    = OFF_MEMKV + (size_t)2 * 2048 * 512 * 2;
constexpr size_t OFF_EGL   = OFF_WR + (size_t)2 * 20 * 1024 * 4;
constexpr size_t OFF_W     = 8u << 20;
constexpr size_t W_AIN  = 0;
constexpr size_t W_AOUT = W_AIN + (size_t)NIN_A * 1024 * 2;
constexpr size_t W_BIN  = W_AOUT + (size_t)1024 * 1024 * 2;
constexpr size_t W_BOUT = W_BIN + (size_t)NIN_B * 1024 * 2;
constexpr size_t W_MEM  = W_BOUT + (size_t)1024 * 1024 * 2;
constexpr size_t W_13   = W_MEM + (size_t)2 * 512 * 1024 * 2;
constexpr size_t W_2    = W_13 + (size_t)32 * 512 * 1024 * 2;
constexpr size_t W_END  = W_2 + (size_t)32 * 1024 * 256 * 2;
constexpr size_t OFF_P  = OFF_W + W_END;
constexpr size_t OFF_G  = OFF_P + (size_t)NTOK * LDP * 2;
constexpr size_t G_MIX  = 0;
constexpr size_t G_HB   = (size_t)128 << 20;
constexpr size_t WS_NEED = OFF_G + ((size_t)216 << 20);
static_assert(OFF_EGL + 3072 * 128 <= OFF_W, "small region");
static_assert(WS_NEED <= ((size_t)512 << 20), "workspace");
constexpr int CTRL_CNT = 4096;
constexpr int CTRL_PCNT = 8192;
constexpr int CTRL_PROG = 12288;
constexpr int CTRL_XCC = 13312, CTRL_RANK = 13440;
constexpr int CTRL_MEMKV = 13056;
constexpr int CTRL_GFLAG = 16384;
constexpr int CTRL_EDONE = 6144;
constexpr size_t P_PLIST = (size_t)40 << 20;

constexpr int LDS_BYTES = 163840;

struct Params {
  const float *x, *mem, *a_norm, *a_w_in, *a_conv, *a_log, *a_dt_bias, *a_out_gain, *a_w_out, *kv_norm, *w_kv,
      *b_norm, *b_w_in, *b_w_out, *mem_norm, *w_mem_kv, *ffn_norm, *w_group, *b_group, *w_router, *b_router,
      *w1, *w3, *w2, *final_norm;
  float* out; char* ws;
};

typedef float f32x2_t __attribute__((ext_vector_type(2))); typedef __bf16 bf16x2_t __attribute__((ext_vector_type(2)));
__device__ __forceinline__ unsigned cvt_pk_bf16(float lo, float hi) { const f32x2_t v = {lo, hi}; const bf16x2_t b = __builtin_convertvector(v, bf16x2_t); return __builtin_bit_cast(unsigned, b); }
__device__ __forceinline__ bf16_t f2bf(float f) { return (bf16_t)(cvt_pk_bf16(f, 0.f) & 0xffffu); }
__device__ __forceinline__ float bf2f(bf16_t b) { return __uint_as_float(((unsigned)b) << 16); }
__device__ __forceinline__ float bflo(unsigned u) { return __uint_as_float(u << 16); }
__device__ __forceinline__ float bfhi(unsigned u) { return __uint_as_float(u & 0xffff0000u); }
__device__ __forceinline__ float wave_sum(float v) {
#pragma unroll
  for (int o = 32; o >= 1; o >>= 1) v += __shfl_xor(v, o);
  return v;
}
__device__ __forceinline__ float sigmoidf_(float x) { return __builtin_amdgcn_rcpf(1.f + __expf(-x)); }
__device__ __forceinline__ float siluf_(float x) { return x * __builtin_amdgcn_rcpf(1.f + __expf(-x)); }
__device__ __forceinline__ float softplusf_(float x) { return fmaxf(x, 0.f) + log1pf(__expf(-fabsf(x))); }

#define XB_TMO      128
#define XB_XCNT(j)  (256  + 64 * (j))
#define XB_XSUB(j)  (1280 + 64 * (j))
#define XB_XGEN(j)  (2304 + 64 * (j))
#define XB_TOP      3328
#define XB_TOPGEN   3392
#define XCD_BAR_WORDS 3456
#define XB_SPIN_CAP (1u << 22)
__device__ __forceinline__ unsigned xb_ld(unsigned* p)              { return __hip_atomic_load(p, __ATOMIC_RELAXED, __HIP_MEMORY_SCOPE_AGENT); }
__device__ __forceinline__ unsigned xb_add(unsigned* p, unsigned v) { return __hip_atomic_fetch_add(p, v, __ATOMIC_RELAXED, __HIP_MEMORY_SCOPE_AGENT); }
__device__ __forceinline__ unsigned xb_xcc_id() { return (unsigned)__builtin_amdgcn_s_getreg((3 << 11) | 20) & 0xFu; }
#define XB_SPIN(cond, bar) do { unsigned _sp = 0; while (cond) { __builtin_amdgcn_s_sleep(1); \
    if ((++_sp & 255u) == 0u) { if (xb_ld(&(bar)[XB_TMO])) break; if (_sp > XB_SPIN_CAP) { atomicAdd(&(bar)[XB_TMO], 1u); break; } } } } while (0)
struct XcdBarrier { unsigned* bar; unsigned x; volatile LAS unsigned* st; };
__device__ __forceinline__ XcdBarrier xcd_barrier_post(unsigned* bar, volatile LAS unsigned* st) {
    XcdBarrier b; b.bar = bar; b.x = xb_xcc_id(); b.st = st;
    if (threadIdx.x == 0) (void)xb_add(&bar[XB_XCNT(b.x)], 1u);
    return b;
}
__device__ __forceinline__ void xcd_barrier_complete(unsigned* bar, unsigned x, unsigned& nloc, unsigned& nx) {
    const unsigned G = gridDim.x * gridDim.y * gridDim.z;
    unsigned sum, cnt, mine, sp = 0u;
    for (;;) {
        sum = 0u; cnt = 0u; mine = 0u;
#pragma unroll
        for (unsigned j = 0; j < 16; ++j) { const unsigned c = xb_ld(&bar[XB_XCNT(j)]); sum += c; cnt += (c > 0u) ? 1u : 0u; mine = (j == x) ? c : mine; }
        if (sum == G) break;
        __builtin_amdgcn_s_sleep(1);
        if ((++sp & 255u) == 0u) { if (xb_ld(&bar[XB_TMO])) break; if (sp > XB_SPIN_CAP) { atomicAdd(&bar[XB_TMO], 1u); break; } }
    }
    nloc = mine > 0u ? mine : 1u; nx = cnt > 0u ? cnt : 1u;
}
__device__ __forceinline__ void xcd_barrier(const XcdBarrier& b) {
    asm volatile("s_waitcnt vmcnt(0)" ::: "memory");
    __syncthreads();
    if (threadIdx.x == 0) {
        unsigned* bar = b.bar;
        __builtin_amdgcn_s_waitcnt(0);
        unsigned nloc = b.st[0], nx = b.st[1];
        if (nloc == 0u) { xcd_barrier_complete(bar, b.x, nloc, nx); b.st[0] = nloc; b.st[1] = nx; }
        const unsigned old = xb_add(&bar[XB_XSUB(b.x)], 1u);
        const unsigned gen = old / nloc;
        if (old + 1u == (gen + 1u) * nloc) {
            __builtin_amdgcn_fence(__ATOMIC_RELEASE, "agent");
            asm volatile("s_waitcnt vmcnt(0)" ::: "memory");
            const unsigned og = xb_add(&bar[XB_TOP], 1u);
            const unsigned tg = og / nx;
            if (og + 1u == (tg + 1u) * nx) xb_add(&bar[XB_TOPGEN], 1u);
            else XB_SPIN(xb_ld(&bar[XB_TOPGEN]) == tg, bar);
            __builtin_amdgcn_fence(__ATOMIC_ACQUIRE, "agent");
            xb_add(&bar[XB_XGEN(b.x)], 1u);
            asm volatile("s_waitcnt vmcnt(0)" ::: "memory");
        } else {
            XB_SPIN(xb_ld(&bar[XB_XGEN(b.x)]) == gen, bar);
            __builtin_amdgcn_fence(__ATOMIC_ACQUIRE, "agent");
            asm volatile("s_waitcnt vmcnt(0)" ::: "memory");
        }
    }
    __syncthreads();
}

__device__ __forceinline__ void cvt_rows(bf16_t* dst, int nrows_dst, int K, const float* src, int src_ld, int col0, int nrows_src,
                         const float* gain, float scale, int gtid, int gthreads) {
  const int items = nrows_dst * (K >> 3);
  for (int it = gtid; it < items; it += gthreads) {
    const int r = it % nrows_dst, k8 = it / nrows_dst;
    float v[8];
#pragma unroll
    for (int j = 0; j < 8; ++j) {
      const int k = k8 * 8 + j;
      v[j] = (r < nrows_src) ? src[(size_t)k * src_ld + col0 + r] * (gain ? gain[k] : 1.f) * scale : 0.f;
    }
    u32x4 w; w.x = cvt_pk_bf16(v[0], v[1]); w.y = cvt_pk_bf16(v[2], v[3]); w.z = cvt_pk_bf16(v[4], v[5]); w.w = cvt_pk_bf16(v[6], v[7]);
    *(u32x4*)(dst + (size_t)r * K + k8 * 8) = w;
  }
}

__device__ __forceinline__ void rows_to_bf16(const float* src, bf16_t* dst, float* rstd, int nrows, int gwave, int nwaves, int lane) {
  for (int r = gwave; r < nrows; r += nwaves) {
    const float* s = src + (size_t)r * DM; float ss = 0.f;
#pragma unroll
    for (int i = 0; i < 4; ++i) {
      const f32x4 v = *(const f32x4*)(s + i * 256 + lane * 4);
      ss += v[0] * v[0] + v[1] * v[1] + v[2] * v[2] + v[3] * v[3];
      u32x2 w; w.x = cvt_pk_bf16(v[0], v[1]); w.y = cvt_pk_bf16(v[2], v[3]);
      *(u32x2*)(dst + (size_t)r * DM + i * 256 + lane * 4) = w;
    }
    ss = wave_sum(ss);
    if (lane == 0) rstd[r] = rsqrtf(ss * (1.f / DM) + EPS);
  }
}

template <bool LATE>
__device__ __forceinline__ void phase_prep(const Params& p, int bid, int nblk, int nshare = 1) {
  const int tid = threadIdx.x, gthreads = nblk * NTHR, lane = tid & 63;
  char* ws = p.ws; bf16_t* W = (bf16_t*)(ws + OFF_W);
  for (int vv = 0; vv < nshare; ++vv) {
  const int gtid = (bid + vv) * NTHR + tid;
  if (!LATE) {
  bf16_t* wa = (bf16_t*)((char*)W + W_AIN);
  cvt_rows(wa + (size_t)PC_Q * 1024, 768, 1024, p.a_w_in, 3340, 0, 768, p.a_norm, 1.f, gtid, gthreads);
  cvt_rows(wa + (size_t)PC_MQ * 1024, 256, 1024, p.a_w_in, 3340, 3084, 256, p.a_norm, 0.125f * LOG2E, gtid, gthreads);
  cvt_rows(wa + (size_t)PC_K * 1024, 768, 1024, p.a_w_in, 3340, 768, 768, p.a_norm, 1.f, gtid, gthreads);
  cvt_rows(wa + (size_t)PC_V * 1024, 768, 1024, p.a_w_in, 3340, 1536, 768, p.a_norm, 1.f, gtid, gthreads);
  cvt_rows(wa + (size_t)PC_GATE * 1024, 768, 1024, p.a_w_in, 3340, 2304, 768, p.a_norm, 1.f, gtid, gthreads);
  cvt_rows(wa + (size_t)PC_BA * 1024, NIN_A - PC_BA, 1024, p.a_w_in, 3340, 3072, 12, p.a_norm, 1.f, gtid, gthreads);
  cvt_rows((bf16_t*)((char*)W + W_AOUT), 1024, 1024, p.a_w_out, 1024, 0, 1024, nullptr, 1.f, gtid, gthreads);
  for (int l = 0; l < 2; ++l)
    cvt_rows((bf16_t*)((char*)W + W_MEM) + (size_t)l * 512 * 1024, 512, 1024, p.w_mem_kv + (size_t)l * 1024 * 512, 512, 0, 512, p.mem_norm + l * 1024, 1.f, gtid, gthreads);
  } else {
  bf16_t* wb = (bf16_t*)((char*)W + W_BIN);
  cvt_rows(wb + (size_t)PC_Q * 1024, 768, 1024, p.b_w_in, 1024, 0, 768, p.b_norm, 0.125f * LOG2E, gtid, gthreads);
  cvt_rows(wb + (size_t)PC_MQ * 1024, 256, 1024, p.b_w_in, 1024, 768, 256, p.b_norm, 0.125f * LOG2E, gtid, gthreads);
  cvt_rows(wb + (size_t)PC_K * 1024, 768, 1024, p.w_kv, 1536, 0, 768, p.kv_norm, 1.f, gtid, gthreads);
  cvt_rows(wb + (size_t)PC_V * 1024, 768, 1024, p.w_kv, 1536, 768, 768, p.kv_norm, 1.f, gtid, gthreads);
  cvt_rows((bf16_t*)((char*)W + W_BOUT), 1024, 1024, p.b_w_out, 1024, 0, 1024, nullptr, 1.f, gtid, gthreads);
  {
    bf16_t* w13 = (bf16_t*)((char*)W + W_13);
    const int items = 32 * 512 * 128;
    for (int it0 = gtid; it0 < items; it0 += 4 * gthreads) {
      float v[4][8];
#pragma unroll
      for (int s_ = 0; s_ < 4; ++s_) { const int itx = it0 + s_ * gthreads, it = itx < items ? itx : items - 1;
        const int le = it >> 16, rem = it & 65535, r = rem & 511, k8 = rem >> 9;
        const int u = r >> 8, which = (r >> 7) & 1, j = r & 127, l = le >> 4;
        const float* src = (which ? p.w3 : p.w1) + (size_t)le * 1024 * 256 + u * 128 + j;
        const float* g = p.ffn_norm + l * 1024;
#pragma unroll
        for (int q = 0; q < 8; ++q) { const int k = k8 * 8 + q; v[s_][q] = src[(size_t)k * 256] * g[k]; } }
#pragma unroll
      for (int s_ = 0; s_ < 4; ++s_) { const int it = it0 + s_ * gthreads;
        if (it < items) { const int le = it >> 16, rem = it & 65535, r = rem & 511, k8 = rem >> 9;
          u32x4 w; w.x = cvt_pk_bf16(v[s_][0], v[s_][1]); w.y = cvt_pk_bf16(v[s_][2], v[s_][3]); w.z = cvt_pk_bf16(v[s_][4], v[s_][5]); w.w = cvt_pk_bf16(v[s_][6], v[s_][7]);
          *(u32x4*)(w13 + ((size_t)le * 512 + r) * 1024 + k8 * 8) = w; } }
    }
    bf16_t* w2t = (bf16_t*)((char*)W + W_2);
    const int items2 = 32 * 1024 * 32;
    for (int it0 = gtid; it0 < items2; it0 += 4 * gthreads) {
      float v[4][8];
#pragma unroll
      for (int s_ = 0; s_ < 4; ++s_) { const int itx = it0 + s_ * gthreads, it = itx < items2 ? itx : items2 - 1;
        const int le = it >> 15, rem = it & 32767, n = rem & 1023, k8 = rem >> 10;
        const float* src = p.w2 + (size_t)le * 256 * 1024 + n;
#pragma unroll
        for (int q = 0; q < 8; ++q) v[s_][q] = src[(size_t)(k8 * 8 + q) * 1024]; }
#pragma unroll
      for (int s_ = 0; s_ < 4; ++s_) { const int it = it0 + s_ * gthreads;
        if (it < items2) { const int le = it >> 15, rem = it & 32767, n = rem & 1023, k8 = rem >> 10;
          u32x4 w; w.x = cvt_pk_bf16(v[s_][0], v[s_][1]); w.y = cvt_pk_bf16(v[s_][2], v[s_][3]); w.z = cvt_pk_bf16(v[s_][4], v[s_][5]); w.w = cvt_pk_bf16(v[s_][6], v[s_][7]);
          *(u32x4*)(w2t + ((size_t)le * 1024 + n) * 256 + k8 * 8) = w; } }
    }
  }
  }
  if (!LATE) {
  {
    float* wr = (float*)(ws + OFF_WR);
    for (int it = gtid; it < 2 * 20 * 1024; it += gthreads) {
      const int l = it / 20480, rem = it % 20480, j = rem >> 10, k = rem & 1023;
      const float w = (j < 4) ? p.w_group[((size_t)l * 1024 + k) * 4 + j] : p.w_router[((size_t)l * 1024 + k) * 16 + (j - 4)];
      wr[it] = w * p.ffn_norm[l * 1024 + k];
    }
  }
  const int gwave = gtid >> 6, nwaves = gthreads >> 6;
  rows_to_bf16(p.x, (bf16_t*)p.out, (float*)(ws + OFF_RSTD), NTOK, gwave, nwaves, lane);
  rows_to_bf16(p.mem, (bf16_t*)((char*)p.out + ((size_t)64 << 20)), (float*)(ws + OFF_MRSTD), NMEMROW, gwave, nwaves, lane);
  }
  }
}

namespace g8 {
constexpr int BM = 256, BK = 64, HALF = 128, HTB = HALF * BK * 2, STAGE_BYTES = 8 * HTB, NXCD = 8, WGM = 8;
__host__ __device__ __forceinline__ int lds_byte(int r, int c) { const int st = (r >> 4) * 2 + (c >> 5), rr = r & 15, cc = c & 31, ob = rr * 64 + cc * 2; return st * 1024 + (ob ^ (((ob >> 9) & 1) << 5)); }
__host__ __device__ __forceinline__ void stage_rc(int b, int& R, int& C) { const int st = b / 1024, sb = b % 1024, swz = sb ^ (((sb >> 9) & 1) << 5); R = (st >> 1) * 16 + swz / 64; C = (st & 1) * 32 + (swz % 64) / 2; }
__host__ __device__ __forceinline__ int perm32(int rho) { const int n = rho >> 4, i = rho & 15; return 8 * (i >> 2) + 4 * n + (i & 3); }

struct Unit { const char* A; const char* B; const int* list; int row0, nvalid, pm, pn, aux; };

struct DenseOrder {
  const char* A; const char* Bt; int K; int nM, nN, nwg, G, c;
  __device__ __forceinline__ void init(const void* A_, const void* Bt_, int K_, int M, int N, int G_, int c_) { A = (const char*)A_; Bt = (const char*)Bt_; K = K_; nM = M / BM; nN = N / BM; nwg = nM * nN; G = G_; c = c_; }
  __device__ __forceinline__ bool next(int i, Unit& u) const {
    const long L = (long)i * G + c; if (L >= nwg) return false;
    int wgid = (int)L; { const int q = nwg / NXCD, r = nwg % NXCD, xcd = wgid % NXCD, off = wgid / NXCD; wgid = (xcd < r ? xcd * (q + 1) : r * (q + 1) + (xcd - r) * q) + off; }
    const int nig = WGM * nN, gid = wgid / nig, fm = gid * WGM, gsz = (nM - fm) < WGM ? (nM - fm) : WGM;
    u.pm = fm + ((wgid % nig) % gsz); u.pn = (wgid % nig) / gsz;
    u.A = A; u.B = Bt + (size_t)u.pn * BM * K * 2; u.list = nullptr; u.row0 = u.pm * BM; u.nvalid = BM; u.aux = 0; return true;
  }
  __device__ __forceinline__ void a_ready(const Unit&) const {}
  __device__ __forceinline__ void done(const Unit&) const {}
};

template <class Epi, class Sched, int SHIFT, bool SPLITB = false>
__device__ __forceinline__ void gemm_phase(LAS unsigned char* lds, const int K, const int lda, const Sched& S, const Epi& E) {
    const int tid = threadIdx.x, wid = __builtin_amdgcn_readfirstlane(tid >> 6), lane = tid & 63, wr = wid >> 2, wc = wid & 3, fr = lane & 15, fq = lane >> 4;
    const int nt = K / BK, nth = nt / 2, ldb = SPLITB ? K / 2 : K;
    int RA[2], CA[2]; unsigned voffB[2];
#pragma unroll
    for (int i = 0; i < 2; ++i) { int R, C; stage_rc(tid * 16 + i * 8192, R, C); const int Rb = Epi::PERM ? ((R & ~31) + perm32(R & 31)) : R;
        RA[i] = R; CA[i] = C; voffB[i] = (unsigned)(Rb * ldb + C) * 2u; }
    const size_t kstep = (size_t)(BK * 2);
    const size_t hstepB = (size_t)HALF * ldb * 2;
#define G8_BP(b_, d_, kt_) ((b_) + (size_t)(kt_) * kstep + ((SPLITB && (kt_) >= nth) ? (size_t)(d_) : (size_t)0))
    const unsigned ldsw = (unsigned)wid * 1024u;
    const int aoff = lds_byte(wr * 64 + fr, fq * 8), boff = lds_byte(wc * 32 + fr, fq * 8);
#define G8_AOFF(dst, u) do { _Pragma("unroll") for (int _h = 0; _h < 2; ++_h) _Pragma("unroll") for (int _i = 0; _i < 2; ++_i) { const int _r = _h * HALF + RA[_i]; int _ar; \
        if ((u).list) { const int _rr = _r < (u).nvalid ? _r : 0; _ar = (u).list[(u).row0 + _rr] >> SHIFT; } else _ar = (u).row0 + _r; \
        dst[_h][_i] = (unsigned)(_ar * lda + CA[_i]) * 2u; } } while (0)
#define G8_SA(b, h) (((b) * 2 + (h)) * HTB)
#define G8_SB(b, h) ((4 + (b) * 2 + (h)) * HTB)
#define G8_STAGEA(bufoff, gbase, vo, kb) do { _Pragma("unroll") for (int _i = 0; _i < 2; ++_i) \
        __builtin_amdgcn_global_load_lds((const unsigned*)((gbase) + (size_t)((vo)[_i] + (unsigned)(kb))), (LAS unsigned*)(lds + (bufoff) + ldsw + _i * 8192), 16, 0, 0); } while (0)
#define G8_STAGEB(bufoff, gbase) do { _Pragma("unroll") for (int _i = 0; _i < 2; ++_i) \
        __builtin_amdgcn_global_load_lds((const unsigned*)((const char*)(gbase) + voffB[_i]), (LAS unsigned*)(lds + (bufoff) + ldsw + _i * 8192), 16, 0, 0); } while (0)
#define G8_LDA(dst, b, h) do { _Pragma("unroll") for (int m = 0; m < 4; ++m) _Pragma("unroll") for (int k = 0; k < 2; ++k) dst[m][k] = *(const LAS bf16x8*)(lds + G8_SA(b, h) + aoff + m * 2048 + k * 1024); } while (0)
#define G8_LDB(dst, b, h) do { _Pragma("unroll") for (int n = 0; n < 2; ++n) _Pragma("unroll") for (int k = 0; k < 2; ++k) dst[n][k] = *(const LAS bf16x8*)(lds + G8_SB(b, h) + boff + n * 2048 + k * 1024); } while (0)
#define G8_MMA(ai, bj, At, Bt) do { __builtin_amdgcn_s_setprio(1); _Pragma("unroll") for (int m = 0; m < 4; ++m) _Pragma("unroll") for (int n = 0; n < 2; ++n) _Pragma("unroll") for (int k = 0; k < 2; ++k) \
        acc[ai][bj][m][n] = __builtin_amdgcn_mfma_f32_16x16x32_bf16(Bt[n][k], At[m][k], acc[ai][bj][m][n], 0, 0, 0); __builtin_amdgcn_s_setprio(0); } while (0)
#define G8_WAIT_V(n) asm volatile("s_waitcnt vmcnt(" #n ")" ::: "memory")
#define G8_WAIT_L(n) asm volatile("s_waitcnt lgkmcnt(" #n ")" ::: "memory")
#define G8_BAR __builtin_amdgcn_s_barrier()
#define G8_SCHED __builtin_amdgcn_sched_barrier(0)
    Unit cur, nxt; int ui = 0;
    if (!S.next(0, cur)) return;
    f32x4 acc[2][2][4][2];
#pragma unroll
    for (int a = 0; a < 2; ++a)
#pragma unroll
        for (int b = 0; b < 2; ++b)
#pragma unroll
            for (int m = 0; m < 4; ++m)
#pragma unroll
                for (int n = 0; n < 2; ++n) acc[a][b][m][n] = (f32x4){0.f, 0.f, 0.f, 0.f};
    bf16x8 At[4][2], B0[2][2], B1[2][2];
    unsigned aoC[2][2], aoN[2][2];
    G8_AOFF(aoC, cur);
    const char* cA = cur.A; const char* cB = cur.B; long cD = ((long)(cur.aux & 15) << 19) - (long)nth * (long)kstep;
    S.a_ready(cur);
    G8_STAGEB(G8_SB(0, 0), cB); G8_STAGEB(G8_SB(0, 1), cB + hstepB); G8_STAGEA(G8_SA(0, 0), cA, aoC[0], 0); G8_STAGEA(G8_SA(0, 1), cA, aoC[1], 0);
    if (wr == 1) G8_BAR;
    G8_WAIT_V(2); G8_BAR;
    G8_STAGEB(G8_SB(1, 0), cB + kstep); G8_STAGEA(G8_SA(1, 0), cA, aoC[0], kstep); G8_STAGEB(G8_SB(1, 1), cB + hstepB + kstep);
    G8_WAIT_V(6); G8_BAR;
    for (;;) {
        const bool has_next = S.next(ui + 1, nxt);
        const char* nA = has_next ? nxt.A : cA; const char* nB = has_next ? nxt.B : cB; const long nD = has_next ? ((long)(nxt.aux & 15) << 19) - (long)nth * (long)kstep : cD;
        if (has_next) { G8_AOFF(aoN, nxt); } else {
#pragma unroll
            for (int h = 0; h < 2; ++h)
#pragma unroll
                for (int i = 0; i < 2; ++i) aoN[h][i] = aoC[h][i]; }
        for (int t = 0; t < nt; t += 2) {
            const bool last = (t == nt - 2);
            if (last && has_next) S.a_ready(nxt);
            const unsigned k1 = (unsigned)((t + 1) * kstep);
            const char* a2b = last ? nA : cA; const unsigned k2 = last ? 0u : (unsigned)((t + 2) * kstep), k3 = k2 + (unsigned)kstep;
            const char* b2 = last ? nB : G8_BP(cB, cD, t + 2); const char* b3 = last ? nB + kstep : G8_BP(cB, cD, t + 3);
            unsigned ao2[2][2];
#pragma unroll
            for (int h = 0; h < 2; ++h)
#pragma unroll
                for (int i = 0; i < 2; ++i) ao2[h][i] = last ? aoN[h][i] : aoC[h][i];
            G8_LDB(B0, 0, 0); G8_LDB(B1, 0, 1); G8_SCHED; G8_LDA(At, 0, 0); G8_STAGEA(G8_SA(1, 1), cA, aoC[1], k1);
            G8_WAIT_V(8); G8_WAIT_L(0); G8_BAR; G8_MMA(0, 0, At, B0); G8_MMA(0, 1, At, B1); G8_BAR; G8_SCHED;
            G8_LDA(At, 0, 1); G8_STAGEB(G8_SB(0, 0), b2); G8_STAGEB(G8_SB(0, 1), b2 + hstepB); G8_STAGEA(G8_SA(0, 0), a2b, ao2[0], k2);
            G8_WAIT_V(8); G8_WAIT_L(0); G8_BAR; G8_MMA(1, 0, At, B0); G8_MMA(1, 1, At, B1); G8_BAR; G8_SCHED;
            G8_LDB(B0, 1, 0); G8_LDB(B1, 1, 1); G8_SCHED; G8_LDA(At, 1, 0); G8_STAGEA(G8_SA(0, 1), a2b, ao2[1], k2);
            G8_WAIT_V(8); G8_WAIT_L(0); G8_BAR; G8_MMA(0, 0, At, B0); G8_MMA(0, 1, At, B1); G8_BAR; G8_SCHED;
            G8_LDA(At, 1, 1); G8_STAGEB(G8_SB(1, 0), b3); G8_STAGEB(G8_SB(1, 1), b3 + hstepB); G8_STAGEA(G8_SA(1, 0), a2b, ao2[0], k3);
            G8_WAIT_V(8); G8_WAIT_L(0); G8_BAR; G8_MMA(1, 0, At, B0); G8_MMA(1, 1, At, B1); G8_BAR; G8_SCHED;
        }
        if (wr == 0) G8_BAR;
        E(acc, cur, wr, wc, fr, fq); S.done(cur);
        if (!has_next) break;
#pragma unroll
        for (int a = 0; a < 2; ++a)
#pragma unroll
            for (int b = 0; b < 2; ++b)
#pragma unroll
                for (int m = 0; m < 4; ++m)
#pragma unroll
                    for (int n = 0; n < 2; ++n) acc[a][b][m][n] = (f32x4){0.f, 0.f, 0.f, 0.f};
        cur = nxt; cA = nA; cB = nB; cD = nD; ++ui;
#pragma unroll
        for (int h = 0; h < 2; ++h)
#pragma unroll
            for (int i = 0; i < 2; ++i) aoC[h][i] = aoN[h][i];
        if (wr == 1) G8_BAR;
    }
    G8_WAIT_V(0);
    G8_BAR;
#undef G8_AOFF
#undef G8_SA
#undef G8_SB
#undef G8_STAGEA
#undef G8_STAGEB
#undef G8_BP
#undef G8_LDA
#undef G8_LDB
#undef G8_MMA
#undef G8_WAIT_V
#undef G8_WAIT_L
#undef G8_BAR
#undef G8_SCHED
}

struct EpiScaleBf16 {
  static constexpr bool PERM = true;
  bf16_t* C; int ldc; const float* rowscale; int ncol_store;
  __device__ __forceinline__ void operator()(const f32x4 (&acc)[2][2][4][2], const Unit& u, int wr, int wc, int fr, int fq) const {
    const int row0 = u.pm * BM + wr * 64 + fr, col0 = u.pn * BM + wc * 32 + 8 * fq;
#pragma unroll
    for (int ai = 0; ai < 2; ++ai)
#pragma unroll
      for (int m = 0; m < 4; ++m) { const int row = row0 + ai * HALF + m * 16; const float sc = rowscale[row]; bf16_t* rowp = C + (size_t)row * ldc + col0;
#pragma unroll
        for (int bj = 0; bj < 2; ++bj) { const f32x4 v0 = acc[ai][bj][m][0] * sc, v1 = acc[ai][bj][m][1] * sc;
          u32x4 w; w.x = cvt_pk_bf16(v0[0], v0[1]); w.y = cvt_pk_bf16(v0[2], v0[3]); w.z = cvt_pk_bf16(v1[0], v1[1]); w.w = cvt_pk_bf16(v1[2], v1[3]);
          if (col0 + bj * HALF < ncol_store) *(u32x4*)(rowp + bj * HALF) = w; } }
  }
};
struct EpiMem {
  static constexpr bool PERM = true; bf16_t* C; const float* rs;
  __device__ __forceinline__ void operator()(const f32x4 (&acc)[2][2][4][2], const Unit& u, int wr, int wc, int fr, int fq) const {
    const int l = u.pn >> 1; Unit v = u; v.pn = u.pn & 1;
    EpiScaleBf16 e{C + (size_t)l * 2048 * 512, 512, rs, 512}; e(acc, v, wr, wc, fr, fq); }
};
struct EpiResidBf16 {
  static constexpr bool PERM = true;
  bf16_t* out; const bf16_t* bres;
  __device__ __forceinline__ void operator()(const f32x4 (&acc)[2][2][4][2], const Unit& u, int wr, int wc, int fr, int fq) const {
    const int row0 = u.pm * BM + wr * 64 + fr, col0 = u.pn * BM + wc * 32 + 8 * fq;
#pragma unroll
    for (int ai = 0; ai < 2; ++ai)
#pragma unroll
      for (int m = 0; m < 4; ++m) { const size_t base = (size_t)(row0 + ai * HALF + m * 16) * DM + col0;
#pragma unroll
        for (int bj = 0; bj < 2; ++bj) { const size_t o = base + bj * HALF;
          const u32x4 rb = *(const u32x4*)(bres + o);
          const f32x4 v0 = (f32x4){bflo(rb.x), bfhi(rb.x), bflo(rb.y), bfhi(rb.y)} + acc[ai][bj][m][0], v1 = (f32x4){bflo(rb.z), bfhi(rb.z), bflo(rb.w), bfhi(rb.w)} + acc[ai][bj][m][1];
          u32x4 w; w.x = cvt_pk_bf16(v0[0], v0[1]); w.y = cvt_pk_bf16(v0[2], v0[3]); w.z = cvt_pk_bf16(v1[0], v1[1]); w.w = cvt_pk_bf16(v1[2], v1[3]);
          *(u32x4*)(out + o) = w; } }
  }
};
struct EpiMoe1 {
  static constexpr bool PERM = true;
  bf16_t* hid; const float* rstd; const float* cw;
  __device__ __forceinline__ void operator()(const f32x4 (&acc)[2][2][4][2], const Unit& u, int wr, int wc, int fr, int fq) const {
    const __amdgpu_buffer_rsrc_t hr = __builtin_amdgcn_make_buffer_rsrc((void*)hid, 0, 65536 * 256 * 2, 0x00020000);
#pragma unroll
    for (int ai = 0; ai < 2; ++ai)
#pragma unroll
      for (int m = 0; m < 4; ++m) { const int r = ai * HALF + wr * 64 + m * 16 + fr;
        if (r < u.nvalid) { const int slot = u.list[u.row0 + r]; const float rs = rstd[slot >> 1], cs = cw[slot] * rs;
          float h[8];
#pragma unroll
          for (int n = 0; n < 2; ++n)
#pragma unroll
            for (int j = 0; j < 4; ++j) { const float a = acc[ai][0][m][n][j] * rs, b = acc[ai][1][m][n][j] * cs; h[4 * n + j] = siluf_(a) * b; }
          u32x4 w; w.x = cvt_pk_bf16(h[0], h[1]); w.y = cvt_pk_bf16(h[2], h[3]); w.z = cvt_pk_bf16(h[4], h[5]); w.w = cvt_pk_bf16(h[6], h[7]);
          __builtin_amdgcn_raw_buffer_store_b128(w, hr, (slot * 256 + u.pn * 128 + wc * 32 + 8 * fq) * 2, 0, 16); } }
  }
};
struct EpiMoe2 {
  static constexpr bool PERM = true;
  bf16_t* y;
  __device__ __forceinline__ void operator()(const f32x4 (&acc)[2][2][4][2], const Unit& u, int wr, int wc, int fr, int fq) const {
#pragma unroll
    for (int ai = 0; ai < 2; ++ai)
#pragma unroll
      for (int m = 0; m < 4; ++m) { const int r = ai * HALF + wr * 64 + m * 16 + fr;
        if (r < u.nvalid) { const int tok = u.list[u.row0 + r];
          bf16_t* yp = y + (size_t)tok * DM + u.pn * BM + wc * 32 + 8 * fq;
#pragma unroll
          for (int bj = 0; bj < 2; ++bj) { const f32x4 v0 = acc[ai][bj][m][0], v1 = acc[ai][bj][m][1];
            u32x4 w; w.x = cvt_pk_bf16(v0[0], v0[1]); w.y = cvt_pk_bf16(v0[2], v0[3]); w.z = cvt_pk_bf16(v1[0], v1[1]); w.w = cvt_pk_bf16(v1[2], v1[3]);
            *(u32x4*)(yp + bj * HALF) = w; } } }
  }
};
struct PairOrder {
  const char* A; const char* Wt; const int* plist; LAS const int* cn; int G, c;
  unsigned* edone; unsigned* tmo; int r1;
  __device__ __forceinline__ bool next(int i, Unit& u) const {
    const int GA = G - r1;
    int L = (c >= r1) ? i * GA + (i > 0 ? (i - 1) * r1 : 0) + (c - r1) : (i + 2) * GA + i * r1 + c; bool found = false;
    for (int e = 0; e < 24; ++e) { const int cne = __builtin_amdgcn_readfirstlane(cn[e]); const int nu = ((cne + 255) >> 8) * 4;
      if (!found) { if (L < nu) { found = true; const int tile = L >> 2, pn = L & 3, g = e / 6, pr = e % 6;
          const int la = pr < 3 ? 0 : pr < 5 ? 1 : 2, lb = pr < 3 ? pr + 1 : pr < 5 ? pr - 1 : 3;
          u.pm = tile; u.pn = pn; u.aux = (lb - la) | ((g * 4 + la) << 4) | ((g * 4 + lb) << 8); u.A = A;
          u.B = Wt + ((size_t)(g * 4 + la) * 1024 + (size_t)pn * 256) * 256 * 2;
          u.list = plist + (size_t)e * NTOK; u.row0 = tile * 256; u.nvalid = (cne - tile * 256) < 256 ? (cne - tile * 256) : 256; } else L -= nu; } }
    return found;
  }
  __device__ __forceinline__ void a_ready(const Unit& u) const {
    if (threadIdx.x < 64) {
      const int ea = (u.aux >> 4) & 15, eb = (u.aux >> 8) & 15;
      const unsigned na = (unsigned)cn[32 + ea], nb = (unsigned)cn[32 + eb]; unsigned sp = 0u;
      while ((unsigned)__builtin_amdgcn_readfirstlane(xb_ld(edone + ea * 64)) < na || (unsigned)__builtin_amdgcn_readfirstlane(xb_ld(edone + eb * 64)) < nb) {
        __builtin_amdgcn_s_sleep(2);
        if ((++sp & 255u) == 0u) { if (xb_ld(tmo)) break; if (sp > XB_SPIN_CAP) { atomicAdd(tmo, 1u); break; } } }
      __builtin_amdgcn_fence(__ATOMIC_ACQUIRE, "agent");
      asm volatile("s_waitcnt vmcnt(0)" ::: "memory");
    }
    asm volatile("" ::: "memory"); __builtin_amdgcn_s_barrier(); asm volatile("" ::: "memory");
  }
  __device__ __forceinline__ void done(const Unit&) const {}
};
template <int NPN>
struct MoeOrder {
  const char* A; const char* Wt; const int* lists; int cn[16]; int G, c; size_t wstride_e, wstride_pn; unsigned* edone;
  __device__ __forceinline__ bool next(int i, Unit& u) const {
    int L = i * G + c; bool found = false;
#pragma unroll
    for (int e = 0; e < 16; ++e) { const int nu = ((cn[e] + 255) >> 8) * NPN;
      if (!found) { if (L < nu) { found = true; const int tile = L / NPN, pn = L % NPN; u.pm = tile; u.pn = pn; u.aux = e; u.A = A; u.B = Wt + (size_t)e * wstride_e + (size_t)pn * wstride_pn;
          u.list = lists + (size_t)e * NTOK; u.row0 = tile * 256; u.nvalid = (cn[e] - tile * 256) < 256 ? (cn[e] - tile * 256) : 256; } else L -= nu; } }
    return found;
  }
  __device__ __forceinline__ void a_ready(const Unit&) const {}
  __device__ __forceinline__ void done(const Unit& u) const {
    asm volatile("s_waitcnt vmcnt(0)" ::: "memory");
    if ((threadIdx.x & 63) == 0) (void)xb_add(edone + u.aux * 64, 1u);
  }
};
}

__device__ __forceinline__ void phase_gemm_inA(const Params& p, LAS char* lds, int bid, int nblk) {
  char* ws = p.ws;
  const bf16_t* hb = (const bf16_t*)p.out;
  const bf16_t* wa = (const bf16_t*)(ws + OFF_W + W_AIN);
  { g8::DenseOrder S; S.init(hb, wa, 1024, NTOK, NIN_A, nblk, bid);
    g8::EpiScaleBf16 E{(bf16_t*)(ws + OFF_P), LDP, (const float*)(ws + OFF_RSTD), LDP};
    g8::gemm_phase<g8::EpiScaleBf16, g8::DenseOrder, 0>((LAS unsigned char*)lds, 1024, DM, S, E); }
}
__device__ __forceinline__ void phase_gemm_memkv(const Params& p, LAS char* lds, int bid, int nblk) {
  char* ws = p.ws;
  const bf16_t* memb = (const bf16_t*)((char*)p.out + ((size_t)64 << 20)); const bf16_t* wm = (const bf16_t*)(ws + OFF_W + W_MEM);
  __syncthreads();
  g8::DenseOrder S; S.init(memb, wm, 1024, NMEMROW, 1024, nblk, bid);
  g8::EpiMem E{(bf16_t*)(ws + OFF_MEMKV), (const float*)(ws + OFF_MRSTD)};
  g8::gemm_phase<g8::EpiMem, g8::DenseOrder, 0>((LAS unsigned char*)lds, 1024, DM, S, E);
  if (threadIdx.x == 0) { __builtin_amdgcn_fence(__ATOMIC_RELEASE, "agent"); (void)xb_add((unsigned*)(ws + OFF_CTRL) + CTRL_MEMKV, 1u); }
}
__device__ __forceinline__ void wait_counter(unsigned* ctl, int word, unsigned need) {
  __syncthreads();
  if (threadIdx.x == 0) { unsigned sp = 0u;
    while (xb_ld(ctl + word) < need) { __builtin_amdgcn_s_sleep(2); if ((++sp & 255u) == 0u) { if (xb_ld(&ctl[XB_TMO])) break; if (sp > XB_SPIN_CAP) { atomicAdd(&ctl[XB_TMO], 1u); break; } } }
    __builtin_amdgcn_fence(__ATOMIC_ACQUIRE, "agent"); asm volatile("s_waitcnt vmcnt(0)" ::: "memory"); }
  __syncthreads();
}
__device__ __forceinline__ void phase_gemm_inB(const Params& p, LAS char* lds, int bid, int nblk) {
  char* ws = p.ws;
  g8::DenseOrder S; S.init(ws + OFF_G + G_HB, ws + OFF_W + W_BIN, 1024, NTOK, NIN_B, nblk, bid);
  g8::EpiScaleBf16 E{(bf16_t*)(ws + OFF_P), LDP, (const float*)(ws + OFF_RSTD), LDP};
  g8::gemm_phase<g8::EpiScaleBf16, g8::DenseOrder, 0>((LAS unsigned char*)lds, 1024, DM, S, E);
}
__device__ __forceinline__ void phase_gemm_out(const Params& p, LAS char* lds, int bid, int nblk, int layer) {
  char* ws = p.ws;
  g8::DenseOrder S; S.init(ws + OFF_P, ws + OFF_W + (layer ? W_BOUT : W_AOUT), 1024, NTOK, 1024, nblk, bid);
  bf16_t* hb = (bf16_t*)(ws + OFF_G + G_HB);
  g8::EpiResidBf16 E{hb, layer ? (const bf16_t*)hb : (const bf16_t*)p.out};
  g8::gemm_phase<g8::EpiResidBf16, g8::DenseOrder, 0>((LAS unsigned char*)lds, 1024, LDP, S, E);
}
__device__ __forceinline__ void phase_moe1(const Params& p, LAS char* lds, int bid, int nblk, int layer) {
  char* ws = p.ws;
  const unsigned* cnt = (const unsigned*)(ws + OFF_CTRL) + CTRL_CNT + layer * 16 * 64;
  g8::MoeOrder<2> S; S.A = ws + OFF_G + G_HB; S.Wt = ws + OFF_W + W_13 + (size_t)layer * 16 * 512 * 1024 * 2; S.lists = (const int*)(ws + OFF_LIST);
#pragma unroll
  for (int e = 0; e < 16; ++e) S.cn[e] = (int)cnt[e * 64];
  S.G = nblk; S.c = bid; S.wstride_e = (size_t)512 * 1024 * 2; S.wstride_pn = (size_t)256 * 1024 * 2; S.edone = (unsigned*)(ws + OFF_CTRL) + CTRL_EDONE + layer * 16 * 64;
  g8::EpiMoe1 E{(bf16_t*)(ws + OFF_P), (const float*)(ws + OFF_RSTD), (const float*)(ws + OFF_CW)};
  g8::gemm_phase<g8::EpiMoe1, g8::MoeOrder<2>, 1>((LAS unsigned char*)lds, 1024, DM, S, E);
}
__device__ __forceinline__ void phase_moe2(const Params& p, LAS char* lds, int bid, int nblk, int layer) {
  char* ws = p.ws;
  const unsigned* pcnt = (const unsigned*)(ws + OFF_CTRL) + CTRL_PCNT + layer * 24 * 64;
  g8::PairOrder S; S.A = ws + OFF_P; S.Wt = ws + OFF_W + W_2 + (size_t)layer * 16 * 1024 * 256 * 2; S.plist = (const int*)(ws + OFF_P + P_PLIST);
  const unsigned* cnt = (const unsigned*)(ws + OFF_CTRL) + CTRL_CNT + layer * 16 * 64;
  LAS int* scn = (LAS int*)(lds + g8::STAGE_BYTES);
  __syncthreads();
  if (threadIdx.x < 24) scn[threadIdx.x] = (int)pcnt[threadIdx.x * 64];
  if (threadIdx.x >= 32 && threadIdx.x < 48) scn[threadIdx.x] = (int)((cnt[(threadIdx.x - 32) * 64] + 255u) >> 8) * 16;
  __syncthreads();
  if (threadIdx.x == 0) { int n1 = 0;
#pragma unroll
    for (int e = 0; e < 16; ++e) n1 += scn[32 + e] >> 3;
    scn[48] = n1 % nblk; }
  __syncthreads();
  S.cn = scn; S.G = nblk; S.c = bid; S.r1 = __builtin_amdgcn_readfirstlane(scn[48]);
  S.edone = (unsigned*)(ws + OFF_CTRL) + CTRL_EDONE + layer * 16 * 64; S.tmo = (unsigned*)(ws + OFF_CTRL) + XB_TMO;
  g8::EpiMoe2 E{(bf16_t*)(ws + OFF_G + G_MIX)};
  g8::gemm_phase<g8::EpiMoe2, g8::PairOrder, 0, true>((LAS unsigned char*)lds, 512, 512, S, E);
}


typedef float f32x2v __attribute__((ext_vector_type(2)));
__device__ __forceinline__ void phase_norm_route(const Params& p, LAS char* lds, int bid, int nblk, int layer) {
  char* ws = p.ws; const int tid = threadIdx.x, lane = tid & 63, r32 = lane & 31, hi = lane >> 5; const int w = __builtin_amdgcn_readfirstlane(tid >> 6);
  constexpr int WROW = 1028;
  LAS float* wl = (LAS float*)lds;
  LAS float* lgx = (LAS float*)(lds + 20 * WROW * 4);
  LAS float* ssx = lgx + 8 * 32 * 33;
  const float* wr = (const float*)(ws + OFF_WR) + (size_t)layer * 20480;
  __syncthreads();
  { f32x4 wv[10];
#pragma unroll
    for (int k = 0; k < 10; ++k) { const int i = tid + k * NTHR; wv[k] = *(const f32x4*)(wr + (i >> 8) * 1024 + (i & 255) * 4); }
#pragma unroll
    for (int k = 0; k < 10; ++k) { const int i = tid + k * NTHR; *(LAS f32x4*)(wl + (i >> 8) * WROW + (i & 255) * 4) = wv[k]; } }
  __syncthreads();
  bf16_t* hb = (bf16_t*)(ws + OFF_G + G_HB); float* rstd = (float*)(ws + OFF_RSTD); float* cw = (float*)(ws + OFF_CW);
  unsigned* cnt = (unsigned*)(ws + OFF_CTRL) + CTRL_CNT + layer * 16 * 64; int* lists = (int*)(ws + OFF_LIST);
  unsigned* pcnt = (unsigned*)(ws + OFF_CTRL) + CTRL_PCNT + layer * 24 * 64; int* plist = (int*)(ws + OFF_P + P_PLIST);
  const float* bg = p.b_group + layer * 4; const float* br = p.b_router + layer * 16;
  const int nn = r32 < 20 ? r32 : 19;
  for (int base = bid * 4; base < NTOK / 32; base += nblk * 4) {
    const int tile = base + (w & 3), kh = w >> 2, t0 = tile * 32;
    const bf16_t* hbrow = hb + (size_t)(t0 + r32) * DM + kh * 512 + 4 * hi;
    LAS const float* wrow = wl + nn * WROW + kh * 512 + 4 * hi;
    f32x16 acc = f32x16{}; float ss = 0.f;
    for (int j0 = 0; j0 < 64; j0 += 8) {
      f32x4 hv[8];
#pragma unroll
      for (int q = 0; q < 8; ++q) { const u32x2 hr = *(const u32x2*)(hbrow + (j0 + q) * 8); hv[q] = (f32x4){bflo(hr.x), bfhi(hr.x), bflo(hr.y), bfhi(hr.y)}; }
#pragma unroll
      for (int q = 0; q < 8; ++q) {
        const f32x4 wv = *(LAS const f32x4*)(wrow + (j0 + q) * 8);
        ss += hv[q][0] * hv[q][0] + hv[q][1] * hv[q][1] + hv[q][2] * hv[q][2] + hv[q][3] * hv[q][3];
#pragma unroll
        for (int e = 0; e < 4; ++e) acc = __builtin_amdgcn_mfma_f32_32x32x2f32(wv[e], hv[q][e], acc, 0, 0, 0);
      }
    }
    { auto sw = __builtin_amdgcn_permlane32_swap(__float_as_uint(ss), __float_as_uint(ss), false, false); ss = __uint_as_float(sw[0]) + __uint_as_float(sw[1]); }
    LAS float* lg = lgx + w * 32 * 33;
#pragma unroll
    for (int r = 0; r < 16; ++r) { const int n = (r & 3) + 8 * (r >> 2) + 4 * hi; lg[r32 * 33 + n] = acc[r]; }
    if (hi == 0) ssx[w * 32 + r32] = ss;
    __syncthreads();
    if (w < 4 && hi == 0) {
      LAS const float* la = lgx + w * 32 * 33 + r32 * 33; LAS const float* lb = lgx + (w + 4) * 32 * 33 + r32 * 33;
      const int t = t0 + r32;
      const float rs = rsqrtf((ssx[w * 32 + r32] + ssx[(w + 4) * 32 + r32]) * (1.f / DM) + EPS);
      float lgt[20];
#pragma unroll
      for (int j = 0; j < 20; ++j) lgt[j] = (la[j] + lb[j]) * rs + (j < 4 ? bg[j] : br[j - 4]);
      int gs = 0; float gm = lgt[0];
#pragma unroll
      for (int j = 1; j < 4; ++j) if (lgt[j] > gm) { gm = lgt[j]; gs = j; }
      float den = 0.f;
#pragma unroll
      for (int j = 0; j < 4; ++j) den += __expf(lgt[j] - gm);
      const float pg = 1.f / den;
      float el[4];
#pragma unroll
      for (int j = 0; j < 4; ++j) el[j] = gs == 0 ? lgt[4 + j] : gs == 1 ? lgt[8 + j] : gs == 2 ? lgt[12 + j] : lgt[16 + j];
      int i1 = 0; float m1 = el[0];
#pragma unroll
      for (int j = 1; j < 4; ++j) if (el[j] > m1) { m1 = el[j]; i1 = j; }
      int i2 = -1; float m2 = -INFINITY;
#pragma unroll
      for (int j = 0; j < 4; ++j) if (j != i1 && el[j] > m2) { m2 = el[j]; i2 = j; }
      const float e2 = __expf(m2 - m1), p1 = 1.f / (1.f + e2), p2 = e2 * p1;
      const int ex1 = gs * 4 + i1, ex2 = gs * 4 + i2;
      unsigned myc = 0u; int rk1 = 0, rk2 = 0;
      const unsigned long long lt = (1ull << r32) - 1ull;
#pragma unroll
      for (int e = 0; e < 16; ++e) {
        const unsigned long long b1 = __ballot(ex1 == e), b2 = __ballot(ex2 == e);
        const int c1 = __popcll(b1), c2 = __popcll(b2);
        if (r32 == e) myc = (unsigned)(c1 + c2);
        if (ex1 == e) rk1 = __popcll(b1 & lt);
        if (ex2 == e) rk2 = c1 + __popcll(b2 & lt);
      }
      unsigned basev = 0u;
      if (r32 < 16 && myc) basev = atomicAdd(&cnt[r32 * 64], myc);
      const unsigned q1 = (unsigned)__shfl((int)basev, ex1) + (unsigned)rk1, q2 = (unsigned)__shfl((int)basev, ex2) + (unsigned)rk2;
      const int pos1 = ex1 < ex2 ? 0 : 1;
      lists[(size_t)ex1 * NTOK + q1] = t * 2 + pos1; lists[(size_t)ex2 * NTOK + q2] = t * 2 + (1 - pos1);
      cw[t * 2 + pos1] = pg * p1; cw[t * 2 + 1 - pos1] = pg * p2; rstd[t] = rs;
      const int xa = (pos1 ? i2 : i1), xb = (pos1 ? i1 : i2);
      const int pc = gs * 6 + (xa == 0 ? xb - 1 : xa == 1 ? xb + 1 : 5);
      unsigned myc2 = 0u; int rk = 0;
#pragma unroll
      for (int e = 0; e < 24; ++e) { const unsigned long long bb = __ballot(pc == e); if (r32 == e) myc2 = (unsigned)__popcll(bb); if (pc == e) rk = __popcll(bb & lt); }
      unsigned base2 = 0u;
      if (r32 < 24 && myc2) base2 = atomicAdd(&pcnt[r32 * 64], myc2);
      plist[(size_t)pc * NTOK + (unsigned)__shfl((int)base2, pc) + (unsigned)rk] = t;
    }
    __syncthreads();
  }
}

template <bool FINAL>
__device__ __forceinline__ void phase_combine(const Params& p, int bid, int nblk) {
  char* ws = p.ws; const int tid = threadIdx.x, lane = tid & 63, w = tid >> 6;
  const bf16_t* y = (const bf16_t*)(ws + OFF_G + G_MIX); bf16_t* hb = (bf16_t*)(ws + OFF_G + G_HB); float* rstd = (float*)(ws + OFF_RSTD);
  for (int t = bid * 8 + w; t < NTOK; t += nblk * 8) {
    float v[16]; float ss = 0.f;
#pragma unroll
    for (int i = 0; i < 2; ++i) { const int c = i * 512 + lane * 8; const u32x4 a = *(const u32x4*)(hb + (size_t)t * DM + c), d = *(const u32x4*)(y + (size_t)t * DM + c);
      v[8 * i] = bflo(a.x) + bflo(d.x); v[8 * i + 1] = bfhi(a.x) + bfhi(d.x); v[8 * i + 2] = bflo(a.y) + bflo(d.y); v[8 * i + 3] = bfhi(a.y) + bfhi(d.y);
      v[8 * i + 4] = bflo(a.z) + bflo(d.z); v[8 * i + 5] = bfhi(a.z) + bfhi(d.z); v[8 * i + 6] = bflo(a.w) + bflo(d.w); v[8 * i + 7] = bfhi(a.w) + bfhi(d.w); }
#pragma unroll
    for (int k = 0; k < 16; ++k) ss += v[k] * v[k];
    ss = wave_sum(ss);
    const float rs = rsqrtf(ss * (1.f / DM) + EPS);
#pragma unroll
    for (int i = 0; i < 2; ++i) { const int c = i * 512 + lane * 8;
      if (FINAL) {
        const f32x4 g0 = *(const f32x4*)(p.final_norm + c), g1 = *(const f32x4*)(p.final_norm + c + 4);
        *(f32x4*)(p.out + (size_t)t * DM + c) = (f32x4){v[8 * i] * rs * g0[0], v[8 * i + 1] * rs * g0[1], v[8 * i + 2] * rs * g0[2], v[8 * i + 3] * rs * g0[3]};
        *(f32x4*)(p.out + (size_t)t * DM + c + 4) = (f32x4){v[8 * i + 4] * rs * g1[0], v[8 * i + 5] * rs * g1[1], v[8 * i + 6] * rs * g1[2], v[8 * i + 7] * rs * g1[3]};
      } else {
        u32x4 o; o.x = cvt_pk_bf16(v[8 * i], v[8 * i + 1]); o.y = cvt_pk_bf16(v[8 * i + 2], v[8 * i + 3]); o.z = cvt_pk_bf16(v[8 * i + 4], v[8 * i + 5]); o.w = cvt_pk_bf16(v[8 * i + 6], v[8 * i + 7]);
        *(u32x4*)(hb + (size_t)t * DM + c) = o;
      }
    }
    if (!FINAL && lane == 0) rstd[t] = rs;
  }
}

namespace mem {
typedef short s16x4 __attribute__((ext_vector_type(4)));
constexpr int TILEB = 8192, LDS_K = 0, LDS_V = 4 * TILEB, LDS_WS = 8 * TILEB, LDS_OST = LDS_WS + 8 * 256;
__device__ __forceinline__ s16x4 vtr(LAS const char* p) { return __builtin_bit_cast(s16x4, __builtin_amdgcn_ds_read_tr16_b64_v4i16((LAS s16x4*)p)); }
__device__ __forceinline__ void unit(bf16_t* P, const bf16_t* mkv, int b, int hd, int qb, LAS char* lds) {
  const int tid = threadIdx.x, lane = tid & 63, r32 = lane & 31, hi = lane >> 5; const int wid = __builtin_amdgcn_readfirstlane(tid >> 6);
  const bf16_t* Kh = mkv + (size_t)b * 256 * 512 + hd * 64; const bf16_t* Vh = Kh + 256;
  bf16_t* Qw = P + ((size_t)b * SEQ + qb * 256 + wid * 32) * LDP + PC_MQ + hd * 64;
  const bf16_t* ksrc = Kh + (size_t)lane * 512 + wid * 8;
  const bf16_t* vsrc = Vh + (size_t)(16 * (wid & 3) + (lane >> 2)) * 512 + (wid >> 2) * 32 + (lane & 3) * 8;
#pragma unroll
  for (int t = 0; t < 4; ++t) {
    __builtin_amdgcn_global_load_lds((const unsigned*)(ksrc + (size_t)t * 64 * 512), (LAS unsigned*)(lds + LDS_K + t * TILEB + wid * 1024), 16, 0, 0);
    __builtin_amdgcn_global_load_lds((const unsigned*)(vsrc + (size_t)t * 64 * 512), (LAS unsigned*)(lds + LDS_V + t * TILEB + wid * 1024), 16, 0, 0);
  }
  bf16x8 qr[4];
#pragma unroll
  for (int d0 = 0; d0 < 4; ++d0) qr[d0] = *(const bf16x8*)(Qw + (size_t)r32 * LDP + d0 * 16 + hi * 8);
  asm volatile("s_waitcnt vmcnt(0) lgkmcnt(0)\n\ts_barrier" ::: "memory");
  LAS const char* kp0 = lds + LDS_K + hi * 1024 + r32 * 16;
  LAS const char* vp0 = lds + LDS_V + ((lane >> 4) & 1) * 32 + (lane & 3) * 8 + (4 * hi + ((lane & 15) >> 2)) * 64;
  float mx = -INFINITY;
#pragma unroll
  for (int t = 0; t < 4; ++t) {
    f32x16 p0 = f32x16{}, p1 = f32x16{};
#pragma unroll
    for (int d0 = 0; d0 < 4; ++d0) {
      const bf16x8 k0 = *(LAS const bf16x8*)(kp0 + t * TILEB + d0 * 2048), k1 = *(LAS const bf16x8*)(kp0 + t * TILEB + d0 * 2048 + 512);
      p0 = __builtin_amdgcn_mfma_f32_32x32x16_bf16(k0, qr[d0], p0, 0, 0, 0); p1 = __builtin_amdgcn_mfma_f32_32x32x16_bf16(k1, qr[d0], p1, 0, 0, 0);
    }
#pragma unroll
    for (int r = 0; r < 16; ++r) mx = fmaxf(mx, fmaxf(p0[r], p1[r]));
  }
  { auto sw = __builtin_amdgcn_permlane32_swap(__float_as_uint(mx), __float_as_uint(mx), false, false); mx = fmaxf(__uint_as_float(sw[0]), __uint_as_float(sw[1])); }
  f32x16 o[2]; o[0] = f32x16{}; o[1] = f32x16{};
  float lsum = 0.f;
#pragma unroll
  for (int t = 0; t < 4; ++t) {
    f32x16 p0 = f32x16{}, p1 = f32x16{};
#pragma unroll
    for (int d0 = 0; d0 < 4; ++d0) {
      const bf16x8 k0 = *(LAS const bf16x8*)(kp0 + t * TILEB + d0 * 2048), k1 = *(LAS const bf16x8*)(kp0 + t * TILEB + d0 * 2048 + 512);
      p0 = __builtin_amdgcn_mfma_f32_32x32x16_bf16(k0, qr[d0], p0, 0, 0, 0); p1 = __builtin_amdgcn_mfma_f32_32x32x16_bf16(k1, qr[d0], p1, 0, 0, 0);
    }
    float a[32];
#pragma unroll
    for (int r = 0; r < 16; ++r) { a[r] = __builtin_amdgcn_exp2f(p0[r] - mx); a[16 + r] = __builtin_amdgcn_exp2f(p1[r] - mx); lsum += a[r] + a[16 + r]; }
    u32x4 pw[4];
#pragma unroll
    for (int ks = 0; ks < 4; ++ks) { pw[ks].x = cvt_pk_bf16(a[8 * ks], a[8 * ks + 1]); pw[ks].y = cvt_pk_bf16(a[8 * ks + 2], a[8 * ks + 3]); pw[ks].z = cvt_pk_bf16(a[8 * ks + 4], a[8 * ks + 5]); pw[ks].w = cvt_pk_bf16(a[8 * ks + 6], a[8 * ks + 7]); }
    LAS const char* vp = vp0 + t * TILEB;
#pragma unroll
    for (int d0 = 0; d0 < 2; ++d0)
#pragma unroll
      for (int ks = 0; ks < 4; ++ks) {
        const s16x4 lo = vtr(vp + d0 * 4096 + ks * 1024), hh = vtr(vp + d0 * 4096 + ks * 1024 + 512);
        const bf16x8 vf = (bf16x8){lo[0], lo[1], lo[2], lo[3], hh[0], hh[1], hh[2], hh[3]};
        o[d0] = __builtin_amdgcn_mfma_f32_32x32x16_bf16(__builtin_bit_cast(bf16x8, pw[ks]), vf, o[d0], 0, 0, 0);
      }
  }
  { auto sw = __builtin_amdgcn_permlane32_swap(__float_as_uint(lsum), __float_as_uint(lsum), false, false); lsum = __uint_as_float(sw[0]) + __uint_as_float(sw[1]); }
  LAS float* wsf = (LAS float*)(lds + LDS_WS) + wid * 64;
  if (hi == 0) wsf[r32] = __builtin_amdgcn_rcpf(lsum);
  asm volatile("s_waitcnt lgkmcnt(0)" ::: "memory");
  LAS bf16_t* stg = (LAS bf16_t*)(lds + LDS_OST) + wid * 2048;
#pragma unroll
  for (int r = 0; r < 16; ++r) { const int orow = (r & 3) + 8 * (r >> 2) + 4 * hi; const float il = wsf[orow];
#pragma unroll
    for (int d0 = 0; d0 < 2; ++d0) stg[orow * 64 + d0 * 32 + r32] = f2bf(o[d0][r] * il); }
  asm volatile("s_waitcnt lgkmcnt(0)" ::: "memory");
#pragma unroll
  for (int i = 0; i < 4; ++i) { const int row = i * 8 + (lane >> 3), ch = lane & 7; const u32x4 v = *(LAS const u32x4*)(stg + row * 64 + ch * 8); *(u32x4*)(Qw + (size_t)row * LDP + ch * 8) = v; }
  asm volatile("s_waitcnt vmcnt(0) lgkmcnt(0)\n\ts_barrier" ::: "memory");
}
}
__device__ __forceinline__ void phase_memattn(const Params& p, LAS char* lds, int bid, int nblk, int layer) {
  char* ws = p.ws; bf16_t* P = (bf16_t*)(ws + OFF_P);
  const bf16_t* mkv = (const bf16_t*)(ws + OFF_MEMKV) + (size_t)layer * 2048 * 512;
  for (int u = bid; u < NBATCH * 4 * 16; u += nblk) { const int bh = u >> 4, qb = u & 15; mem::unit(P, mkv, bh >> 2, bh & 3, qb, lds); }
}

namespace sb {
typedef short s16x4 __attribute__((ext_vector_type(4)));
constexpr int SLOTB = 8192, NSLOT = 4, LDS_K = 0, LDS_V = NSLOT * SLOTB, LDS_OST = 2 * NSLOT * SLOTB, LDS_FLAG = LDS_OST + 8 * 4096, LDS_BYTES_SB = LDS_FLAG + 64;
__device__ __forceinline__ s16x4 vtr(LAS const char* p) { return __builtin_bit_cast(s16x4, __builtin_amdgcn_ds_read_tr16_b64_v4i16((LAS s16x4*)p)); }

__device__ __forceinline__ void unit(const bf16_t* P, bf16_t* O, int ldo, int b, int h, int qb, LAS char* lds) {
  const int tid = threadIdx.x, lane = tid & 63, r32 = lane & 31, hi = lane >> 5; const int wid = __builtin_amdgcn_readfirstlane(tid >> 6);
  const size_t rowbase = (size_t)b * SEQ; const int q0 = qb * 256;
  const bf16_t* Kh = P + rowbase * LDP + PC_K + h * 64; const bf16_t* Vh = P + rowbase * LDP + PC_V + h * 64;
  const bf16_t* Qw = P + (rowbase + q0 + wid * 32) * LDP + PC_Q + h * 64;
  const bf16_t* ksrc = Kh + (size_t)lane * LDP + wid * 8;
  const bf16_t* vsrc = Vh + (size_t)(16 * (wid & 3) + (lane >> 2)) * LDP + (wid >> 2) * 32 + (lane & 3) * 8;
  LAS char* kdst = lds + LDS_K + wid * 1024; LAS char* vdst = lds + LDS_V + wid * 1024;
#define SB_DMA(t, slot) do { __builtin_amdgcn_global_load_lds((const unsigned*)(ksrc + (size_t)(t) * 64 * LDP), (LAS unsigned*)(kdst + (slot)), 16, 0, 0); \
                             __builtin_amdgcn_global_load_lds((const unsigned*)(vsrc + (size_t)(t) * 64 * LDP), (LAS unsigned*)(vdst + (slot)), 16, 0, 0); } while (0)
  const int NT = 4 * qb + 4;
  bf16x8 qr[4];
#pragma unroll
  for (int d0 = 0; d0 < 4; ++d0) qr[d0] = *(const bf16x8*)(Qw + (size_t)r32 * LDP + d0 * 16 + hi * 8);
  asm volatile("" ::: "memory");
  SB_DMA(NT - 1, 0); SB_DMA(NT - 2, SLOTB); SB_DMA(NT - 3, 2 * SLOTB);
  f32x16 o[2]; o[0] = f32x16{}; o[1] = f32x16{};
  float c = 1.f;
  const int qrel = wid * 32 + r32;
  LAS const char* kp0 = lds + LDS_K + hi * 1024 + r32 * 16;
  LAS const char* vp0 = lds + LDS_V + ((lane >> 4) & 1) * 32 + (lane & 3) * 8 + (4 * hi + ((lane & 15) >> 2)) * 64;
  int slot = 0; bool wave_alive = true;
  LAS unsigned* fl = (LAS unsigned*)(lds + LDS_FLAG);
  for (int i = 0; i < NT; ++i) {
    const int t = NT - 1 - i;
    const int nslot = (slot == (NSLOT - 1) * SLOTB) ? 0 : slot + SLOTB;
    if (t > 1) { asm volatile("s_waitcnt vmcnt(4) lgkmcnt(0)\n\ts_barrier" ::: "memory"); }
    else if (t == 1) { asm volatile("s_waitcnt vmcnt(2) lgkmcnt(0)\n\ts_barrier" ::: "memory"); }
    else { asm volatile("s_waitcnt vmcnt(0) lgkmcnt(0)\n\ts_barrier" ::: "memory"); }
    if (t > 2) { const int pslot = (slot == 0) ? (NSLOT - 1) * SLOTB : slot - SLOTB; SB_DMA(t - 3, pslot); }
    if (i > 0) { const u32x4 f0 = *(LAS const u32x4*)(fl + ((i - 1) & 1) * 8), f1 = *(LAS const u32x4*)(fl + ((i - 1) & 1) * 8 + 4);
      if (__builtin_amdgcn_readfirstlane((int)(f0.x | f0.y | f0.z | f0.w | f1.x | f1.y | f1.z | f1.w)) == 0) break; }
    const int jb = t - (NT - 4);
    if (!(jb >= 0 && 64 * jb > 32 * wid + 30) && wave_alive) {
      f32x16 p0 = f32x16{}, p1 = f32x16{};
#pragma unroll
      for (int d0 = 0; d0 < 4; ++d0) {
        const bf16x8 k0 = *(LAS const bf16x8*)(kp0 + slot + d0 * 2048), k1 = *(LAS const bf16x8*)(kp0 + slot + d0 * 2048 + 512);
        p0 = __builtin_amdgcn_mfma_f32_32x32x16_bf16(k0, qr[d0], p0, 0, 0, 0);
        p1 = __builtin_amdgcn_mfma_f32_32x32x16_bf16(k1, qr[d0], p1, 0, 0, 0);
      }
      if (jb >= 0) {
        const int kb = 64 * jb + 4 * hi;
#pragma unroll
        for (int r = 0; r < 16; ++r) { const int kv = kb + (r & 3) + 8 * (r >> 2); if (kv >= qrel) p0[r] = -INFINITY; if (kv + 32 >= qrel) p1[r] = -INFINITY; }
      }
      float rr[32], be[32];
#pragma unroll
      for (int r = 0; r < 16; ++r) {
        const float e0 = __builtin_amdgcn_exp2f(p0[r]), e1 = __builtin_amdgcn_exp2f(p1[r]);
        rr[r] = __builtin_amdgcn_rcpf(1.f + e0); rr[16 + r] = __builtin_amdgcn_rcpf(1.f + e1);
        be[r] = 1.f - rr[r]; be[16 + r] = 1.f - rr[16 + r];
      }
      float OS[9]; OS[8] = 1.f;
#pragma unroll
      for (int G = 7; G >= 0; --G) { const float gp = (rr[4 * G] * rr[4 * G + 1]) * (rr[4 * G + 2] * rr[4 * G + 3]); OS[G] = OS[G + 1] * gp; }
      float cE[8];
#pragma unroll
      for (int G = 0; G < 8; ++G) {
        const float X = hi ? OS[G] : OS[G + 1], Y = OS[G + 1];
        auto sw = __builtin_amdgcn_permlane32_swap(__float_as_uint(X), __float_as_uint(Y), false, false);
        cE[G] = c * (__uint_as_float(sw[0]) * __uint_as_float(sw[1]));
      }
      { auto sw = __builtin_amdgcn_permlane32_swap(__float_as_uint(OS[0]), __float_as_uint(OS[0]), false, false); c *= __uint_as_float(sw[0]) * __uint_as_float(sw[1]); }
      float a[32];
#pragma unroll
      for (int G = 0; G < 8; ++G) {
        const float t3 = cE[G], t2 = t3 * rr[4 * G + 3], t1 = t2 * rr[4 * G + 2], t0 = t1 * rr[4 * G + 1];
        a[4 * G + 3] = be[4 * G + 3] * t3; a[4 * G + 2] = be[4 * G + 2] * t2; a[4 * G + 1] = be[4 * G + 1] * t1; a[4 * G] = be[4 * G] * t0;
      }
      u32x4 pw[4];
#pragma unroll
      for (int ks = 0; ks < 4; ++ks) { pw[ks].x = cvt_pk_bf16(a[8 * ks], a[8 * ks + 1]); pw[ks].y = cvt_pk_bf16(a[8 * ks + 2], a[8 * ks + 3]); pw[ks].z = cvt_pk_bf16(a[8 * ks + 4], a[8 * ks + 5]); pw[ks].w = cvt_pk_bf16(a[8 * ks + 6], a[8 * ks + 7]); }
      LAS const char* vp = vp0 + slot;
#pragma unroll
      for (int d0 = 0; d0 < 2; ++d0)
#pragma unroll
        for (int ks = 0; ks < 4; ++ks) {
          const s16x4 lo = vtr(vp + d0 * 4096 + ks * 1024), hh = vtr(vp + d0 * 4096 + ks * 1024 + 512);
          const bf16x8 vf = (bf16x8){lo[0], lo[1], lo[2], lo[3], hh[0], hh[1], hh[2], hh[3]};
          o[d0] = __builtin_amdgcn_mfma_f32_32x32x16_bf16(__builtin_bit_cast(bf16x8, pw[ks]), vf, o[d0], 0, 0, 0);
        }
    }
    wave_alive = __any(c != 0.f);
    if (lane == 0) fl[(i & 1) * 8 + wid] = wave_alive ? 1u : 0u;
    slot = nslot;
  }
  bf16_t* Ow = O + (rowbase + q0 + wid * 32) * ldo + h * 64;
  LAS bf16_t* stg = (LAS bf16_t*)(lds + LDS_OST) + wid * 2048;
#pragma unroll
  for (int r = 0; r < 16; ++r) { const int orow = (r & 3) + 8 * (r >> 2) + 4 * hi;
#pragma unroll
    for (int d0 = 0; d0 < 2; ++d0) stg[orow * 64 + d0 * 32 + r32] = f2bf(o[d0][r]); }
  asm volatile("s_waitcnt lgkmcnt(0)" ::: "memory");
#pragma unroll
  for (int i = 0; i < 4; ++i) { const int row = i * 8 + (lane >> 3), ch = lane & 7; const u32x4 v = *(LAS const u32x4*)(stg + row * 64 + ch * 8); *(u32x4*)(Ow + (size_t)row * ldo + ch * 8) = v; }
  asm volatile("s_waitcnt vmcnt(0) lgkmcnt(0)\n\ts_barrier" ::: "memory");
#undef SB_DMA
}
}
__device__ __forceinline__ void phase_sb_attn(const Params& p, LAS char* lds, int bid, int nblk, bool dummy = false) {
  char* ws = p.ws;
  bf16_t* P = (bf16_t*)(ws + OFF_P); bf16_t* Od = dummy ? (bf16_t*)(ws + OFF_G + G_MIX) : P; const int ldo = dummy ? DM : LDP;
  const int vcu = (nblk % 8 == 0) ? (bid % 8) * (nblk / 8) + bid / 8 : bid;
  for (int pi = vcu; pi < 96 * 8; pi += nblk) {
    const int bh = pi >> 3, s = pi & 7, b = bh / 12, h = bh % 12;
    sb::unit(P, Od, ldo, b, h, 15 - s, lds);
    sb::unit(P, Od, ldo, b, h, s, lds);
  }
}

namespace gdn {
constexpr int RA_W = 0, RA_QG = 16384, RA_KT = 32768, RA_ATT = 49152, REC_A = 55296, REC_U = 16384, REC = REC_A + REC_U;
constexpr int HALF_LDS = 78848;
constexpr int GA_TM = 57344, GA_YM = GA_TM + 64 * 68 * 4, GA_RB = RA_QG;
constexpr float QSCALE = 0.08838834764831845f;
__device__ __forceinline__ int crow(int r, int hi) { return (r & 3) + 8 * (r >> 2) + 4 * hi; }
}
__device__ __forceinline__ void phase_gdn_prep(const Params& p, LAS char* lds, int bid, int nblk, int ubase, int nunits) {
  using namespace gdn;
  char* ws = p.ws; const bf16_t* P = (const bf16_t*)(ws + OFF_P); char* G = ws + OFF_G; float* EGL = (float*)(ws + OFF_EGL);
  const int nrounds = (nunits + 2 * nblk - 1) / (2 * nblk);
  const __amdgpu_buffer_rsrc_t gr_ = __builtin_amdgcn_make_buffer_rsrc((void*)G, 0, (int)((size_t)216 << 20), 0x00020000);
  unsigned* gflag = (unsigned*)(ws + OFF_CTRL) + CTRL_GFLAG;
  for (int rd = 0; rd < nrounds; ++rd) {
    int tl = threadIdx.x; asm volatile("" : "+v"(tl));
    const int tid = tl, hb = tid >> 8, ht = tid & 255, lane = tid & 63, r32 = lane & 31, hi = lane >> 5;
    const int hw = __builtin_amdgcn_readfirstlane(ht >> 6);
    LAS char* L = lds + hb * HALF_LDS;
    LAS float* sBeta = (LAS float*)(L + REC_A); LAS float* sGc = sBeta + 64; LAS float* sEgc = sGc + 64; LAS float* sRnK = sEgc + 64; LAS float* sRnQ = sRnK + 64;
    LAS char* sQ = L; LAS char* sK = L + 17408;
    LAS float* Amat = (LAS float*)(L + RA_W);
    const int u0 = (rd * nblk + bid) * 2 + hb; const bool valid = u0 < nunits; const int uq = ubase + (valid ? u0 : 0);
    const int bh = uq % 48, n = uq / 48, u = bh * 64 + n, b = bh / 6, h = bh % 6; const size_t row0 = (size_t)b * SEQ + (size_t)n * 64;
    const unsigned reco = (unsigned)u * (unsigned)REC;
    __syncthreads();
    if (hw == 0) {
      const bf16_t* pr = P + (row0 + lane) * LDP + PC_BA;
      const float braw = bf2f(pr[h]), araw = bf2f(pr[6 + h]);
      const float beta = sigmoidf_(braw), g = -__expf(p.a_log[h]) * softplusf_(araw + p.a_dt_bias[h]);
      float s = g;
#pragma unroll
      for (int o = 1; o < 64; o <<= 1) { const float t = __shfl_up(s, o); if (lane >= o) s += t; }
      sBeta[lane] = beta; sGc[lane] = s; sEgc[lane] = __expf(s);
    }
    {
      u32x4 rv[13];
#pragma unroll
      for (int k = 0; k < 13; ++k) { const int i = ht + k * 256, ic = i < 67 * 48 ? i : 67 * 48 - 1, rr = ic / 48, cc = ic % 48, part = cc >> 4, c8 = (cc & 15) * 8;
        const int rsrc = (n > 0 || rr >= 3) ? rr - 3 : 0;
        rv[k] = *(const u32x4*)(P + (row0 + rsrc) * LDP + (part == 0 ? PC_Q : part == 1 ? PC_K : PC_V) + h * 128 + c8); }
#pragma unroll
      for (int k = 0; k < 13; ++k) { const int i = ht + k * 256, rr = i / 48, cc = i % 48;
        if (i < 67 * 48) *(LAS u32x4*)(L + rr * 768 + cc * 16) = (n > 0 || rr >= 3) ? rv[k] : (u32x4){0u, 0u, 0u, 0u}; }
    }
    __syncthreads();
    float x[64], xq[64];
    {
      const int c = ht & 127; const bool isk = ht >= 128;
      {
        const int ch = (isk ? 768 : 1536) + h * 128 + c;
        const float w0 = p.a_conv[ch], w1 = p.a_conv[2304 + ch], w2 = p.a_conv[2 * 2304 + ch], w3 = p.a_conv[3 * 2304 + ch];
        LAS const char* src = L + (isk ? 256 : 512) + c * 2;
        float r0 = bf2f(*(LAS const bf16_t*)(src)), r1 = bf2f(*(LAS const bf16_t*)(src + 768)), r2 = bf2f(*(LAS const bf16_t*)(src + 2 * 768));
#pragma unroll
        for (int i = 0; i < 64; ++i) { const float r3 = bf2f(*(LAS const bf16_t*)(src + (i + 3) * 768)); x[i] = siluf_(w0 * r0 + w1 * r1 + w2 * r2 + w3 * r3); r0 = r1; r1 = r2; r2 = r3; }
      }
      if (!isk) {
        const int ch = h * 128 + c;
        const float w0 = p.a_conv[ch], w1 = p.a_conv[2304 + ch], w2 = p.a_conv[2 * 2304 + ch], w3 = p.a_conv[3 * 2304 + ch];
        LAS const char* src = L + c * 2;
        float r0 = bf2f(*(LAS const bf16_t*)(src)), r1 = bf2f(*(LAS const bf16_t*)(src + 768)), r2 = bf2f(*(LAS const bf16_t*)(src + 2 * 768));
#pragma unroll
        for (int i = 0; i < 64; ++i) { const float r3 = bf2f(*(LAS const bf16_t*)(src + (i + 3) * 768)); xq[i] = siluf_(w0 * r0 + w1 * r1 + w2 * r2 + w3 * r3); r0 = r1; r1 = r2; r2 = r3; }
      } else {
#pragma unroll
        for (int i = 0; i < 64; ++i) xq[i] = x[i];
      }
    }
    __syncthreads();
    if (ht < 128) {
#pragma unroll
      for (int i = 0; i < 64; ++i) *(LAS bf16_t*)(sQ + i * 272 + ht * 2) = f2bf(xq[i]);
    } else {
#pragma unroll
      for (int i = 0; i < 64; ++i) *(LAS bf16_t*)(sK + i * 272 + (ht - 128) * 2) = f2bf(x[i]);
    }
    __syncthreads();
    const int it = hw >> 1, jt = hw & 1;
    f32x16 akk = f32x16{}, aqk = f32x16{};
    if (hw != 1) {
#pragma unroll
      for (int ks = 0; ks < 8; ++ks) {
        const bf16x8 ak = *(LAS const bf16x8*)(sK + (32 * it + r32) * 272 + ks * 32 + hi * 16), aq = *(LAS const bf16x8*)(sQ + (32 * it + r32) * 272 + ks * 32 + hi * 16);
        const bf16x8 bk = *(LAS const bf16x8*)(sK + (32 * jt + r32) * 272 + ks * 32 + hi * 16);
        akk = __builtin_amdgcn_mfma_f32_32x32x16_bf16(ak, bk, akk, 0, 0, 0); aqk = __builtin_amdgcn_mfma_f32_32x32x16_bf16(aq, bk, aqk, 0, 0, 0);
      }
    } else {
#pragma unroll
      for (int ks = 0; ks < 8; ++ks) {
        const bf16x8 a0 = *(LAS const bf16x8*)(sQ + r32 * 272 + ks * 32 + hi * 16), a1 = *(LAS const bf16x8*)(sQ + (32 + r32) * 272 + ks * 32 + hi * 16);
        akk = __builtin_amdgcn_mfma_f32_32x32x16_bf16(a0, a0, akk, 0, 0, 0); aqk = __builtin_amdgcn_mfma_f32_32x32x16_bf16(a1, a1, aqk, 0, 0, 0);
      }
    }
    {
      float d0 = 0.f, d1 = 0.f;
#pragma unroll
      for (int r = 0; r < 16; ++r) if (crow(r, hi) == r32) { d0 = akk[r]; d1 = aqk[r]; }
      const bool has = ((r32 >> 2) & 1) == hi;
      if (has && hw == 0) sRnK[r32] = rsqrtf(d0 + EPS);
      if (has && hw == 3) sRnK[32 + r32] = rsqrtf(d0 + EPS);
      if (has && hw == 1) { sRnQ[r32] = rsqrtf(d0 + EPS) * QSCALE; sRnQ[32 + r32] = rsqrtf(d1 + EPS) * QSCALE; }
    }
    __syncthreads();
    if (hw != 1) {
      const int j = 32 * jt + r32; const float rnkj = sRnK[j], gcj = sGc[j];
      const int ksj = 2 * jt + (r32 >> 4), jo = r32 & 15, hip = (jo >> 2) & 1, jp = (jo & 3) + 4 * (jo >> 3);
      LAS char* attf = L + RA_ATT + (it ? 2 + ksj : ksj) * 1024 + hip * 512 + jp * 2;
#pragma unroll
      for (int r = 0; r < 16; ++r) {
        const int il = crow(r, hi), i = 32 * it + il;
        const float dec = __expf(fminf(sGc[i] - gcj, 0.f));
        const float aval = (i > j) ? sBeta[i] * sRnK[i] * rnkj * akk[r] * dec : 0.f;
        const float tval = (i >= j) ? sRnQ[i] * rnkj * aqk[r] * dec : 0.f;
        Amat[i * 64 + j] = aval;
        *(LAS bf16_t*)(attf + il * 16) = f2bf(tval);
        if ((r & 3) == 3) asm volatile("" ::: "memory");
      }
    }
    __syncthreads();
    LAS float* Tm = (LAS float*)(L + GA_TM); LAS float* Ym = (LAS float*)(L + GA_YM); LAS char* RB = L + GA_RB;
    {
      LAS char* rc = RB + ht * 128;
#pragma unroll
      for (int q = 0; q < 8; ++q) { float v[8];
#pragma unroll
        for (int e = 0; e < 8; ++e) { const int i = 8 * q + e; v[e] = x[i] * (ht < 128 ? sBeta[i] : sBeta[i] * sEgc[i] * sRnK[i]); }
        u32x4 w; w.x = cvt_pk_bf16(v[0], v[1]); w.y = cvt_pk_bf16(v[2], v[3]); w.z = cvt_pk_bf16(v[4], v[5]); w.w = cvt_pk_bf16(v[6], v[7]);
        *(LAS u32x4*)(rc + ((q ^ (ht & 7)) * 16)) = w; asm volatile("" ::: "memory"); }
    }
    if (hw == 0) {
      const int blk = hi, c = r32;
      LAS const float* Ab = Amat + (32 * blk) * 64 + 32 * blk;
      float t[32];
#pragma unroll
      for (int i = 0; i < 32; ++i) t[i] = (i == c) ? 1.f : 0.f;
#pragma unroll
      for (int i = 1; i < 32; ++i) {
        float a0 = 0.f, a1 = 0.f, a2 = 0.f, a3 = 0.f;
#pragma unroll
        for (int m4 = 0; m4 < (i + 3) / 4; ++m4) { const f32x4 a = *(LAS const f32x4*)(Ab + i * 64 + m4 * 4); a0 += a[0] * t[4 * m4]; a1 += a[1] * t[4 * m4 + 1]; a2 += a[2] * t[4 * m4 + 2]; a3 += a[3] * t[4 * m4 + 3]; }
        t[i] -= (a0 + a1) + (a2 + a3);
        if ((i & 3) == 3) asm volatile("" ::: "memory");
      }
#pragma unroll
      for (int k = 0; k < 32; ++k) Tm[(32 * blk + k) * 68 + 32 * blk + c] = t[k];
      asm volatile("s_waitcnt lgkmcnt(0)" ::: "memory");
      f32x16 acc = f32x16{};
      {
#pragma unroll
        for (int q = 0; q < 8; ++q) { const f32x4 a = *(LAS const f32x4*)(Amat + (32 + r32) * 64 + q * 4);
          const float av0 = hi ? a[1] : a[0], av1 = hi ? a[3] : a[2]; const float bv0 = Tm[(4 * q + hi) * 68 + r32], bv1 = Tm[(4 * q + 2 + hi) * 68 + r32];
          acc = __builtin_amdgcn_mfma_f32_32x32x2f32(av0, bv0, acc, 0, 0, 0); acc = __builtin_amdgcn_mfma_f32_32x32x2f32(av1, bv1, acc, 0, 0, 0);
          if (q & 1) asm volatile("" ::: "memory"); }
      }
#pragma unroll
      for (int r = 0; r < 16; ++r) Ym[crow(r, hi) * 32 + r32] = acc[r];
      asm volatile("s_waitcnt lgkmcnt(0)" ::: "memory");
      acc = f32x16{};
      {
#pragma unroll
        for (int q = 0; q < 8; ++q) { const f32x4 a = *(LAS const f32x4*)(Tm + (32 + r32) * 68 + 32 + q * 4);
          const float av0 = hi ? a[1] : a[0], av1 = hi ? a[3] : a[2]; const float bv0 = Ym[(4 * q + hi) * 32 + r32], bv1 = Ym[(4 * q + 2 + hi) * 32 + r32];
          acc = __builtin_amdgcn_mfma_f32_32x32x2f32(av0, bv0, acc, 0, 0, 0); acc = __builtin_amdgcn_mfma_f32_32x32x2f32(av1, bv1, acc, 0, 0, 0);
          if (q & 1) asm volatile("" ::: "memory"); }
      }
#pragma unroll
      for (int r = 0; r < 16; ++r) Tm[(32 + crow(r, hi)) * 68 + r32] = -acc[r];
    }
    __syncthreads();
    {
      f32x16 xa[2][2];
#pragma unroll
      for (int mt = 0; mt < 2; ++mt)
#pragma unroll
        for (int nl = 0; nl < 2; ++nl) xa[mt][nl] = f32x16{};
#pragma unroll
      for (int ks = 0; ks < 4; ++ks) {
        bf16x8 bfr[2];
#pragma unroll
        for (int nl = 0; nl < 2; ++nl) { const int col = 64 * hw + 32 * nl + r32; bfr[nl] = *(LAS const bf16x8*)(RB + col * 128 + (((2 * ks + hi) ^ (col & 7)) * 16)); }
#pragma unroll
        for (int mt = 0; mt < 2; ++mt) {
          if (mt == 0 && ks >= 2) continue;
          LAS const float* tp = Tm + (32 * mt + r32) * 68 + 16 * ks + 8 * hi;
          const f32x4 t0 = *(LAS const f32x4*)tp, t1 = *(LAS const f32x4*)(tp + 4);
          u32x4 w; w.x = cvt_pk_bf16(t0[0], t0[1]); w.y = cvt_pk_bf16(t0[2], t0[3]); w.z = cvt_pk_bf16(t1[0], t1[1]); w.w = cvt_pk_bf16(t1[2], t1[3]);
          const bf16x8 af = __builtin_bit_cast(bf16x8, w);
#pragma unroll
          for (int nl = 0; nl < 2; ++nl) xa[mt][nl] = __builtin_amdgcn_mfma_f32_32x32x16_bf16(af, bfr[nl], xa[mt][nl], 0, 0, 0);
        }
      }
      if (hw < 2) {
        if (valid) {
#pragma unroll
          for (int nl = 0; nl < 2; ++nl) { const unsigned ud = reco + (unsigned)(REC_A + (64 * hw + 32 * nl + r32) * 128 + hi * 32);
#pragma unroll
            for (int mt = 0; mt < 2; ++mt)
#pragma unroll
              for (int q = 0; q < 2; ++q) { u32x4 w; w.x = cvt_pk_bf16(xa[mt][nl][8 * q], xa[mt][nl][8 * q + 1]); w.y = cvt_pk_bf16(xa[mt][nl][8 * q + 2], xa[mt][nl][8 * q + 3]);
                w.z = cvt_pk_bf16(xa[mt][nl][8 * q + 4], xa[mt][nl][8 * q + 5]); w.w = cvt_pk_bf16(xa[mt][nl][8 * q + 6], xa[mt][nl][8 * q + 7]); __builtin_amdgcn_raw_buffer_store_b128(w, gr_, ud + mt * 64 + q * 16, 0, 16); } }
        }
      } else {
#pragma unroll
        for (int nl = 0; nl < 2; ++nl) { const int cp = 64 * (hw - 2) + 32 * nl + r32, co = cp & 15, hip = (co >> 2) & 1, jp = (co & 3) + 4 * (co >> 3);
          LAS char* wf = L + RA_W + (cp >> 4) * 1024 + hip * 512 + jp * 2;
#pragma unroll
          for (int mt = 0; mt < 2; ++mt)
#pragma unroll
            for (int r = 0; r < 16; ++r) *(LAS bf16_t*)(wf + mt * 8192 + crow(r, hi) * 16) = f2bf(-xa[mt][nl][r]); }
      }
    }
    __syncthreads();
    if (ht < 128) {
      const int c = ht;
      const int co = c & 15, hip = (co >> 2) & 1, jp = (co & 3) + 4 * (co >> 3);
      LAS char* qgf = L + RA_QG + (c >> 4) * 1024 + hip * 512 + jp * 2;
#pragma unroll
      for (int i = 0; i < 64; ++i) { *(LAS bf16_t*)(qgf + (i >> 5) * 8192 + (i & 31) * 16) = f2bf(xq[i] * sRnQ[i] * sEgc[i]); if ((i & 7) == 7) asm volatile("" ::: "memory"); }
    } else {
      const int c = ht - 128;
      const float gl = sGc[63];
      LAS char* ktf = L + RA_KT + (c >> 5) * 4096 + (c & 31) * 16;
#pragma unroll
      for (int ks = 0; ks < 4; ++ks)
#pragma unroll
        for (int hp = 0; hp < 2; ++hp) {
          float v[8];
#pragma unroll
          for (int jq = 0; jq < 8; ++jq) { const int i = 16 * ks + (jq & 3) + 8 * (jq >> 2) + 4 * hp; v[jq] = xq[i] * sRnK[i] * __expf(gl - sGc[i]); }
          u32x4 w; w.x = cvt_pk_bf16(v[0], v[1]); w.y = cvt_pk_bf16(v[2], v[3]); w.z = cvt_pk_bf16(v[4], v[5]); w.w = cvt_pk_bf16(v[6], v[7]);
          *(LAS u32x4*)(ktf + ks * 1024 + hp * 512) = w;
          asm volatile("" ::: "memory");
        }
    }
    if (ht == 0 && valid) __hip_atomic_store(EGL + u * 32, __expf(sGc[63]), __ATOMIC_RELAXED, __HIP_MEMORY_SCOPE_AGENT);
    __syncthreads();
    if (valid) for (int o = ht * 16; o < REC_A; o += 4096) __builtin_amdgcn_raw_buffer_store_b128(*(LAS const u32x4*)(L + o), gr_, reco + (unsigned)o, 0, 16);
    asm volatile("s_waitcnt vmcnt(0)" ::: "memory");
    if (valid && lane == 0) (void)xb_add(gflag + u, 1u);
  }
}

__device__ __forceinline__ void phase_gdn_scan(const Params& p, LAS char* lds, int bid) {
  constexpr int c0 = 0, cend = 64;
  using namespace gdn;
  char* ws = p.ws; bf16_t* P = (bf16_t*)(ws + OFF_P); const char* G = ws + OFF_G; const float* EGL = (const float*)(ws + OFF_EGL);
  const int tid = threadIdx.x, lane = tid & 63, r32 = lane & 31, hi = lane >> 5; const int wid = __builtin_amdgcn_readfirstlane(tid >> 6);
  constexpr int RBUF = 57344;
  LAS char* OX = lds + 2 * RBUF;
  {
    const int u = bid; const int b = u / 6, h = u % 6; const size_t rowb = (size_t)b * SEQ; const char* recb = G + (size_t)u * 64 * REC;
    __syncthreads();
    unsigned* ctl = (unsigned*)(ws + OFF_CTRL);
    if (wid >= 4) {
      const int j = wid - 4, row = 16 * j + (lane >> 2), cg = (lane & 3) * 32;
      const char* recl = recb + j * 1024 + lane * 16;
      u32x4 R0[14], R1[14];
#define GH_LOAD(RS, r_) do { const int rr_ = (r_) < cend - 1 ? (r_) : cend - 1; const char* rp_ = recl + (size_t)rr_ * REC; _Pragma("unroll") for (int i_ = 0; i_ < 14; ++i_) RS[i_] = *(const u32x4*)(rp_ + i_ * 4096); } while (0)
#define GH_WRITE(RS, r_) do { LAS char* dp_ = lds + ((r_) & 1) * RBUF + j * 1024 + lane * 16; _Pragma("unroll") for (int i_ = 0; i_ < 14; ++i_) *(LAS u32x4*)(dp_ + i_ * 4096) = RS[i_]; } while (0)
      LAS float* gnl = (LAS float*)(lds + 2 * RBUF + 32768);
      if (j == 0) { gnl[lane] = p.a_out_gain[lane]; gnl[64 + lane] = p.a_out_gain[64 + lane]; }
      LAS const float* gnp = gnl + cg;
      const bf16_t* gp0 = P + (rowb + row) * LDP + PC_GATE + h * 128 + cg;
      bf16_t* dp0 = P + (rowb + row) * LDP + PC_Q + h * 128 + cg;
      u32x4 gr[4];
#pragma unroll
      for (int q = 0; q < 4; ++q) gr[q] = *(const u32x4*)(gp0 + (size_t)c0 * 64 * LDP + q * 8);
      asm volatile("" ::: "memory");
      GH_LOAD(R0, c0); GH_WRITE(R0, c0); GH_LOAD(R1, c0 + 1); GH_LOAD(R0, c0 + 2);
#define GH_STEP(c_, RS) do { const int c = (c_); \
        asm volatile("s_waitcnt lgkmcnt(0)\n\ts_barrier" ::: "memory"); \
        GH_WRITE(RS, c + 1); GH_LOAD(RS, c + 3);        \
        if (c >= c0 + 1 && c <= cend) { const int cc = c - 1; \
          LAS const char* op = OX + (cc & 1) * 16384 + row * 256 + cg * 2; \
          float ss = 0.f; \
          _Pragma("unroll") for (int q = 0; q < 4; ++q) { const u32x4 r = *(LAS const u32x4*)(op + q * 16); \
            const float o0 = bflo(r.x), o1 = bfhi(r.x), o2 = bflo(r.y), o3 = bfhi(r.y), o4 = bflo(r.z), o5 = bfhi(r.z), o6 = bflo(r.w), o7 = bfhi(r.w); \
            ss += (o0 * o0 + o1 * o1) + (o2 * o2 + o3 * o3) + (o4 * o4 + o5 * o5) + (o6 * o6 + o7 * o7); } \
          ss += __shfl_xor(ss, 1); ss += __shfl_xor(ss, 2); \
          const float sc = rsqrtf(ss * (1.f / 128.f) + EPS); \
          bf16_t* dp = dp0 + (size_t)cc * 64 * LDP; \
          _Pragma("unroll") for (int q = 0; q < 4; ++q) { u32x4 w; const u32x4 gg = gr[q]; const u32x4 r = *(LAS const u32x4*)(op + q * 16);        \
            const f32x4 g0 = *(LAS const f32x4*)(gnp + 8 * q), g1 = *(LAS const f32x4*)(gnp + 8 * q + 4); \
            w.x = cvt_pk_bf16(bflo(r.x) * sc * g0[0] * siluf_(bflo(gg.x)), bfhi(r.x) * sc * g0[1] * siluf_(bfhi(gg.x))); w.y = cvt_pk_bf16(bflo(r.y) * sc * g0[2] * siluf_(bflo(gg.y)), bfhi(r.y) * sc * g0[3] * siluf_(bfhi(gg.y))); \
            w.z = cvt_pk_bf16(bflo(r.z) * sc * g1[0] * siluf_(bflo(gg.z)), bfhi(r.z) * sc * g1[1] * siluf_(bfhi(gg.z))); w.w = cvt_pk_bf16(bflo(r.w) * sc * g1[2] * siluf_(bflo(gg.w)), bfhi(r.w) * sc * g1[3] * siluf_(bfhi(gg.w))); \
            *(u32x4*)(dp + q * 8) = w; } \
          { const int cn_ = c < cend - 1 ? c : cend - 1; _Pragma("unroll") for (int q = 0; q < 4; ++q) gr[q] = *(const u32x4*)(gp0 + (size_t)cn_ * 64 * LDP + q * 8); } \
        } \
      } while (0)
      for (int c2 = c0; c2 <= cend; c2 += 2) { GH_STEP(c2, R1); GH_STEP(c2 + 1, R0); }
#undef GH_STEP
#undef GH_LOAD
#undef GH_WRITE
    } else {
      const int vs = wid;
      f32x16 S[4];
#pragma unroll
      for (int k = 0; k < 4; ++k)
#pragma unroll
        for (int r = 0; r < 16; ++r) S[k][r] = 0.f;
      const char* ub = recb + REC_A + (vs * 32 + r32) * 128 + hi * 32;
      u32x4 un[4];
#pragma unroll
      for (int q = 0; q < 4; ++q) un[q] = *(const u32x4*)(ub + (size_t)c0 * REC + (q >> 1) * 64 + (q & 1) * 16);
      const float* egp = EGL + (size_t)u * 64 * 32;
      float egn = egp[0];
      unsigned* gfl = ctl + CTRL_GFLAG + u * 64;
      for (int c = c0; c <= cend + 1; ++c) {
        asm volatile("s_waitcnt lgkmcnt(0)\n\ts_barrier" ::: "memory");
        if (c < cend) {
          unsigned fl = 4u;
          if (vs == 0) fl = xb_ld(gfl + (c + 4 < cend ? c + 4 : cend - 1));
          LAS const char* R = lds + (c & 1) * RBUF + lane * 16;
          const float egl = egn;
          u32x4 uc[4];
#pragma unroll
          for (int q = 0; q < 4; ++q) uc[q] = un[q];
          { const int cu = c + 1 < cend ? c + 1 : cend - 1;
#pragma unroll
            for (int q = 0; q < 4; ++q) un[q] = *(const u32x4*)(ub + (size_t)cu * REC + (q >> 1) * 64 + (q & 1) * 16);
            egn = egp[cu * 32]; }
          bf16x8 Sb[8];
#pragma unroll
          for (int ks = 0; ks < 8; ++ks) { const int kt = ks >> 1, o = (ks & 1) * 8; u32x4 w;
            w.x = cvt_pk_bf16(S[kt][o], S[kt][o + 1]); w.y = cvt_pk_bf16(S[kt][o + 2], S[kt][o + 3]); w.z = cvt_pk_bf16(S[kt][o + 4], S[kt][o + 5]); w.w = cvt_pk_bf16(S[kt][o + 6], S[kt][o + 7]);
            Sb[ks] = __builtin_bit_cast(bf16x8, w); }
#define GB_LD(dst, off0, off1) do { _Pragma("unroll") for (int q_ = 0; q_ < 4; ++q_) { dst[q_] = *(LAS const bf16x8*)(R + (off0) + q_ * 1024); dst[4 + q_] = *(LAS const bf16x8*)(R + (off1) + q_ * 1024); } } while (0)
#define GB_SCHED __builtin_amdgcn_sched_barrier(0)
          bf16x8 fa[8];
          GB_LD(fa, RA_W, RA_W + 8192);
          f32x16 vn[2];
#pragma unroll
          for (int t2 = 0; t2 < 2; ++t2)
#pragma unroll
            for (int q = 0; q < 2; ++q) { const u32x4 r = uc[2 * t2 + q];
              vn[t2][8 * q] = bflo(r.x); vn[t2][8 * q + 1] = bfhi(r.x); vn[t2][8 * q + 2] = bflo(r.y); vn[t2][8 * q + 3] = bfhi(r.y); vn[t2][8 * q + 4] = bflo(r.z); vn[t2][8 * q + 5] = bfhi(r.z); vn[t2][8 * q + 6] = bflo(r.w); vn[t2][8 * q + 7] = bfhi(r.w); }
          GB_SCHED;
#pragma unroll
          for (int ks = 0; ks < 4; ++ks) { vn[0] = __builtin_amdgcn_mfma_f32_32x32x16_bf16(fa[ks], Sb[ks], vn[0], 0, 0, 0); vn[1] = __builtin_amdgcn_mfma_f32_32x32x16_bf16(fa[4 + ks], Sb[ks], vn[1], 0, 0, 0); }
          GB_SCHED; GB_LD(fa, RA_W + 4096, RA_W + 8192 + 4096); GB_SCHED;
#pragma unroll
          for (int ks = 0; ks < 4; ++ks) { vn[0] = __builtin_amdgcn_mfma_f32_32x32x16_bf16(fa[ks], Sb[4 + ks], vn[0], 0, 0, 0); vn[1] = __builtin_amdgcn_mfma_f32_32x32x16_bf16(fa[4 + ks], Sb[4 + ks], vn[1], 0, 0, 0); }
          GB_SCHED; GB_LD(fa, RA_KT, RA_KT + 4096); GB_SCHED;
          bf16x8 vb[4];
#pragma unroll
          for (int ks = 0; ks < 4; ++ks) { const int t2 = ks >> 1, o = (ks & 1) * 8; u32x4 w;
            w.x = cvt_pk_bf16(vn[t2][o], vn[t2][o + 1]); w.y = cvt_pk_bf16(vn[t2][o + 2], vn[t2][o + 3]); w.z = cvt_pk_bf16(vn[t2][o + 4], vn[t2][o + 5]); w.w = cvt_pk_bf16(vn[t2][o + 6], vn[t2][o + 7]);
            vb[ks] = __builtin_bit_cast(bf16x8, w); }
          f32x16 oo[2]; oo[0] = f32x16{}; oo[1] = f32x16{};
          S[0] = S[0] * egl; S[1] = S[1] * egl;
#pragma unroll
          for (int ks = 0; ks < 4; ++ks) { S[0] = __builtin_amdgcn_mfma_f32_32x32x16_bf16(fa[ks], vb[ks], S[0], 0, 0, 0); S[1] = __builtin_amdgcn_mfma_f32_32x32x16_bf16(fa[4 + ks], vb[ks], S[1], 0, 0, 0); }
          GB_SCHED; GB_LD(fa, RA_KT + 8192, RA_KT + 12288); GB_SCHED;
          S[2] = S[2] * egl; S[3] = S[3] * egl;
#pragma unroll
          for (int ks = 0; ks < 4; ++ks) { S[2] = __builtin_amdgcn_mfma_f32_32x32x16_bf16(fa[ks], vb[ks], S[2], 0, 0, 0); S[3] = __builtin_amdgcn_mfma_f32_32x32x16_bf16(fa[4 + ks], vb[ks], S[3], 0, 0, 0); }
          GB_SCHED; GB_LD(fa, RA_QG, RA_QG + 8192); GB_SCHED;
#pragma unroll
          for (int ks = 0; ks < 4; ++ks) { oo[0] = __builtin_amdgcn_mfma_f32_32x32x16_bf16(fa[ks], Sb[ks], oo[0], 0, 0, 0); oo[1] = __builtin_amdgcn_mfma_f32_32x32x16_bf16(fa[4 + ks], Sb[ks], oo[1], 0, 0, 0); }
          GB_SCHED; GB_LD(fa, RA_QG + 4096, RA_QG + 8192 + 4096); GB_SCHED;
#pragma unroll
          for (int ks = 0; ks < 4; ++ks) { oo[0] = __builtin_amdgcn_mfma_f32_32x32x16_bf16(fa[ks], Sb[4 + ks], oo[0], 0, 0, 0); oo[1] = __builtin_amdgcn_mfma_f32_32x32x16_bf16(fa[4 + ks], Sb[4 + ks], oo[1], 0, 0, 0); }
          GB_SCHED;
#pragma unroll
          for (int q = 0; q < 6; ++q) fa[q] = *(LAS const bf16x8*)(R + RA_ATT + q * 1024);
          GB_SCHED;
          oo[0] = __builtin_amdgcn_mfma_f32_32x32x16_bf16(fa[0], vb[0], oo[0], 0, 0, 0); oo[1] = __builtin_amdgcn_mfma_f32_32x32x16_bf16(fa[2], vb[0], oo[1], 0, 0, 0);
          oo[0] = __builtin_amdgcn_mfma_f32_32x32x16_bf16(fa[1], vb[1], oo[0], 0, 0, 0); oo[1] = __builtin_amdgcn_mfma_f32_32x32x16_bf16(fa[3], vb[1], oo[1], 0, 0, 0);
          oo[1] = __builtin_amdgcn_mfma_f32_32x32x16_bf16(fa[4], vb[2], oo[1], 0, 0, 0); oo[1] = __builtin_amdgcn_mfma_f32_32x32x16_bf16(fa[5], vb[3], oo[1], 0, 0, 0);
#undef GB_LD
#undef GB_SCHED
          LAS char* ox = OX + (c & 1) * 16384 + (vs * 32 + r32) * 2;
#pragma unroll
          for (int t2 = 0; t2 < 2; ++t2)
#pragma unroll
            for (int r = 0; r < 16; ++r) *(LAS bf16_t*)(ox + (32 * t2 + crow(r, hi)) * 256) = f2bf(oo[t2][r]);
          if (vs == 0) {
            unsigned sp = 0u;
            while ((unsigned)__builtin_amdgcn_readfirstlane(fl) < 4u) { __builtin_amdgcn_s_sleep(2);
              if ((++sp & 255u) == 0u) { if (xb_ld(&ctl[XB_TMO])) break; if (sp > XB_SPIN_CAP) { atomicAdd(&ctl[XB_TMO], 1u); break; } }
              fl = xb_ld(gfl + (c + 4 < cend ? c + 4 : cend - 1)); }
            __builtin_amdgcn_fence(__ATOMIC_ACQUIRE, "agent");
          }
        }
      }
    }
  }
}


__device__ __forceinline__ void phase_l2_stream(const Params& p, LAS char* lds) {
  char* ws = p.ws; unsigned* ctl = (unsigned*)(ws + OFF_CTRL); const char* G = ws + OFF_G; const bf16_t* P = (const bf16_t*)(ws + OFF_P);
  const int tid = threadIdx.x;
  LAS int* sh = (LAS int*)lds;
  __syncthreads();
  if (tid == 0) {
    const unsigned x = xb_xcc_id();
    int n = 0;
    for (int s_ = 0; s_ < 48; ++s_) { const unsigned v = __hip_atomic_load(&ctl[CTRL_XCC + s_], __ATOMIC_RELAXED, __HIP_MEMORY_SCOPE_AGENT); if (v == x + 1u && n < 8) { sh[8 + n] = s_; ++n; } }
    const unsigned rank = n ? __hip_atomic_fetch_add(&ctl[CTRL_RANK + x * 16], 1u, __ATOMIC_RELAXED, __HIP_MEMORY_SCOPE_AGENT) : 0u;
    sh[0] = n ? sh[8 + (int)(rank % (unsigned)n)] : -1;
    sh[1] = n ? (int)(rank / (unsigned)n) : 0;
  }
  __syncthreads();
  const int sbh = sh[0], q = sh[1];
  if (sbh < 0 || q >= 4) return;
  const int b = sbh / 6, h = sbh % 6; const char* recb = G + (size_t)sbh * 64 * gdn::REC; const size_t rowb = (size_t)b * SEQ;
  const unsigned long long t0 = wall_clock64();
  unsigned acc = 0u; int next = 0;
  while (next < 64) {
    const unsigned done = __builtin_amdgcn_readfirstlane(__hip_atomic_load(&ctl[CTRL_PROG + sbh * 16], __ATOMIC_RELAXED, __HIP_MEMORY_SCOPE_AGENT));
    if (wall_clock64() - t0 > 60000ull) break;
    const int lim = (int)done + 5 < 64 ? (int)done + 5 : 64;
    if (next >= lim) { __builtin_amdgcn_s_sleep(16); continue; }
    for (; next < lim; ++next) {
      if (next < (int)done + 1) continue;
      const char* rec = recb + (size_t)next * gdn::REC;
      for (int o = (q * 512 + tid) * 16; o < gdn::REC; o += 4 * 512 * 16) acc ^= (*(const u32x4*)(rec + o)).x;
      if (q == 0) { const int r = tid >> 3, ch = tid & 7; acc ^= (*(const u32x4*)(P + (rowb + (size_t)next * 64 + r) * LDP + PC_GATE + h * 128 + ch * 16)).x; }
    }
  }
  if (acc == 0x9E3779B9u && tid == 1023) ctl[CTRL_RANK + 15 * 16 + 1] = acc;
}

constexpr int NPHASE = 15;
__global__ void __launch_bounds__(NTHR, 2) yoco_fwd(Params p, int lo, int hi) {
  extern __shared__ __attribute__((aligned(16))) char smem_raw[];
  LAS char* lds = (LAS char*)smem_raw;
  const int bid = blockIdx.x, nblk = gridDim.x;
  LAS unsigned* xbw = (LAS unsigned*)(lds + LDS_BYTES - 16);
  if (threadIdx.x == 0) { xbw[0] = 0u; xbw[1] = 0u; xbw[2] = 0u; xbw[3] = 0u; }
  __syncthreads();
  XcdBarrier bar; bar.bar = (unsigned*)(p.ws + OFF_CTRL); bar.x = 0; bar.st = (volatile LAS unsigned*)xbw;
  if (hi - lo > 1) bar = xcd_barrier_post((unsigned*)(p.ws + OFF_CTRL), (volatile LAS unsigned*)xbw);
#ifndef PROBE_DOUBLE
#define PROBE_DOUBLE -1
#endif
#define PH(k) if (lo <= (k) && (k) < hi)
#ifndef PROBE_AMP
#define PROBE_AMP -1
#endif
#ifndef PROBE_BLK
#define PROBE_BLK 0
#endif
#if PROBE_AMP >= 0
  unsigned long long tph = wall_clock64();
#define SEAM_ID(id, k) do { if ((id) == PROBE_AMP && bid == PROBE_BLK && threadIdx.x == 0) { const unsigned long long dt_ = wall_clock64() - tph, t1_ = wall_clock64(); while (wall_clock64() - t1_ < 16ull * dt_) __builtin_amdgcn_s_sleep(8); } \
    if (lo <= (k) && (k) + 1 < hi) xcd_barrier(bar); tph = wall_clock64(); } while (0)
#else
#define SEAM_ID(id, k) do { if (lo <= (k) && (k) + 1 < hi) xcd_barrier(bar); } while (0)
#endif
  PH(0) phase_prep<false>(p, bid, nblk);
#if PROBE_DOUBLE == 0
  PH(0) { __syncthreads(); phase_prep<false>(p, bid, nblk); }
#endif
  SEAM_ID(0, 0);
  PH(1) phase_gemm_inA(p, lds, bid, nblk);
#if PROBE_DOUBLE == 1
  PH(1) phase_gemm_inA(p, lds, bid, nblk);
#endif
  SEAM_ID(1, 1);
  PH(2) phase_gdn_prep(p, lds, bid, nblk, 0, 2 * nblk);
  SEAM_ID(2, 2);
  PH(2) { if (bid < 48) phase_gdn_scan(p, lds, bid);
          else {
#ifdef PROBE_SUB
#define PSUB_T0() unsigned long long ts_ = wall_clock64()
#define PSUB(k) do { if (PROBE_SUB == (k) && bid == PROBE_BLK && threadIdx.x == 0) { const unsigned long long dt_ = wall_clock64() - ts_, t1_ = wall_clock64(); while (wall_clock64() - t1_ < 16ull * dt_) __builtin_amdgcn_s_sleep(8); } __syncthreads(); ts_ = wall_clock64(); } while (0)
#else
#define PSUB_T0() do {} while (0)
#define PSUB(k) do {} while (0)
#endif
                 PSUB_T0();
                 phase_gdn_prep(p, lds, bid - 48, nblk - 48, 2 * nblk, 3072 - 2 * nblk); PSUB(0); if (bid >= nblk - 32) phase_gemm_memkv(p, lds, bid - (nblk - 32), 32);
                 { const int ns = nblk - 48, g = bid - 48, nu2 = 3072 - 2 * nblk, nlast = (nu2 - ((nu2 + 2 * ns - 1) / (2 * ns) - 1) * 2 * ns + 1) / 2;
                   const int npl = ns - 32 - nlast;
                   const int vb = g < nlast ? g : g < ns - 32 ? nlast + 2 * (g - nlast) : nlast + 2 * npl + (g - (ns - 32));
                   phase_prep<true>(p, vb, nlast + 2 * npl + 32, (g >= nlast && g < ns - 32) ? 2 : 1); } PSUB(1); wait_counter((unsigned*)(p.ws + OFF_CTRL), CTRL_MEMKV, 32u); phase_memattn(p, lds, bid - 48, nblk - 48, 0); PSUB(2); } }
  SEAM_ID(3, 2);
  PH(3) phase_gemm_out(p, lds, bid, nblk, 0);
#if PROBE_DOUBLE == 3
  PH(3) phase_gemm_out(p, lds, bid, nblk, 0);
#endif
  SEAM_ID(4, 3);
  PH(4) phase_norm_route(p, lds, bid, nblk, 0);
  SEAM_ID(5, 4);
  PH(5) phase_moe1(p, lds, bid, nblk, 0);
#if PROBE_DOUBLE == 5
  PH(5) phase_moe1(p, lds, bid, nblk, 0);
#endif
  PH(6) phase_moe2(p, lds, bid, nblk, 0);
#if PROBE_DOUBLE == 6
  PH(6) phase_moe2(p, lds, bid, nblk, 0);
#endif
  SEAM_ID(7, 6);
  PH(7) phase_combine<false>(p, bid, nblk);
  SEAM_ID(8, 7);
  PH(8) phase_gemm_inB(p, lds, bid, nblk);
#if PROBE_DOUBLE == 8
  PH(8) phase_gemm_inB(p, lds, bid, nblk);
#endif
  SEAM_ID(9, 8);
#if PROBE_DOUBLE == 9
  PH(9) { phase_sb_attn(p, lds, bid, nblk, true); }
#endif
  PH(9) { phase_sb_attn(p, lds, bid, nblk); phase_memattn(p, lds, bid, nblk, 1); }
#if PROBE_DOUBLE == 91
  PH(9) { phase_memattn(p, lds, bid, nblk, 1); }
#endif
  SEAM_ID(10, 9);
  PH(10) phase_gemm_out(p, lds, bid, nblk, 1);
  SEAM_ID(11, 10);
  PH(11) phase_norm_route(p, lds, bid, nblk, 1);
  SEAM_ID(12, 11);
  PH(12) phase_moe1(p, lds, bid, nblk, 1);
  PH(13) phase_moe2(p, lds, bid, nblk, 1);
  SEAM_ID(14, 13);
  PH(14) phase_combine<true>(p, bid, nblk);
#if PROBE_AMP == 15
  if (bid == PROBE_BLK && threadIdx.x == 0) { const unsigned long long dt_ = wall_clock64() - tph, t1_ = wall_clock64(); while (wall_clock64() - t1_ < 16ull * dt_) __builtin_amdgcn_s_sleep(8); }
#endif
#undef PH
#undef SEAM_ID
}

#ifndef N_LAUNCH_SPLIT
#define N_LAUNCH_SPLIT 0
#endif

extern "C" void kernel_launch(void* const* d_in, const int* in_sizes, int n_in, void* d_out, int out_size, void* d_ws, size_t ws_size, hipStream_t stream) {
  (void)in_sizes; (void)n_in; (void)out_size;
  if (ws_size < WS_NEED) return;
  static int grid = 0;
  if (!grid) {
    if (hipFuncSetAttribute((const void*)yoco_fwd, hipFuncAttributeMaxDynamicSharedMemorySize, LDS_BYTES) != hipSuccess) { grid = -1; return; }
    int dev = 0, cus = 0; hipGetDevice(&dev); hipDeviceGetAttribute(&cus, hipDeviceAttributeMultiprocessorCount, dev);
    int per_cu = 0; hipOccupancyMaxActiveBlocksPerMultiprocessor(&per_cu, (const void*)yoco_fwd, NTHR, LDS_BYTES);
    grid = (per_cu >= 1) ? cus : -1;
  }
  if (grid <= 0) return;
  Params p{};
  const float** pf = (const float**)&p;
  for (int i = 0; i < 25; ++i) pf[i] = (const float*)d_in[i];
  p.out = (float*)d_out; p.ws = (char*)d_ws;
  hipMemsetAsync(d_ws, 0, CTRL_BYTES, stream);
#if N_LAUNCH_SPLIT
  for (int k = 0; k < NPHASE; ++k) hipLaunchKernelGGL(yoco_fwd, dim3(grid), dim3(NTHR), LDS_BYTES, stream, p, k, k + 1);
#else
  hipLaunchKernelGGL(yoco_fwd, dim3(grid), dim3(NTHR), LDS_BYTES, stream, p, 0, NPHASE);
#endif
}
```

```cpp
#include <hip/hip_runtime.h>
#include <stdint.h>
#include <stddef.h>

#define LAS __attribute__((address_space(3)))
typedef unsigned short bf16_t;
typedef short bf16x8 __attribute__((ext_vector_type(8)));
typedef float f32x4 __attribute__((ext_vector_type(4)));
typedef float f32x16 __attribute__((ext_vector_type(16)));
typedef unsigned u32x4 __attribute__((ext_vector_type(4)));
typedef unsigned u32x2 __attribute__((ext_vector_type(2)));

constexpr int NTOK = 32768, DM = 1024, SEQ = 4096, NBATCH = 8, MEMLEN = 256, NMEMROW = NBATCH * MEMLEN;
constexpr int LDP = 3392;
constexpr int PC_Q = 0, PC_MQ = 768, PC_K = 1024, PC_V = 1792, PC_GATE = 2560, PC_BA = 3328;
constexpr int NIN_A = 3584;
constexpr int NIN_B = 2560;
constexpr float EPS = 1e-6f;
constexpr float LOG2E = 1.4426950408889634f;
constexpr int NTHR = 512;

constexpr size_t OFF_CTRL  = 0;
constexpr size_t CTRL_BYTES = 98304;
constexpr size_t OFF_RSTD  = CTRL_BYTES;
constexpr size_t OFF_MRSTD = OFF_RSTD + (size_t)NTOK * 4;
constexpr size_t OFF_CW    = OFF_MRSTD + 8192;
constexpr size_t OFF_LIST  = OFF_CW + 65536 * 4;
constexpr size_t OFF_MEMKV = OFF_LIST + (size_t)16 * NTOK * 4;
constexpr size_t OFF_WR    = OFF_MEMKV + (size_t)2 * 2048 * 512 * 2;
constexpr size_t OFF_EGL   = OFF_WR + (size_t)2 * 3 * 20 * 1024 * 2;
constexpr size_t OFF_W     = 8u << 20;
constexpr size_t W_AIN  = 0;
constexpr size_t W_AOUT = W_AIN + (size_t)NIN_A * 1024 * 2;
constexpr size_t W_BIN  = W_AOUT + (size_t)1024 * 1024 * 2;
constexpr size_t W_BOUT = W_BIN + (size_t)NIN_B * 1024 * 2;
constexpr size_t W_MEM  = W_BOUT + (size_t)1024 * 1024 * 2;
constexpr size_t W_13   = W_MEM + (size_t)2 * 512 * 1024 * 2;
constexpr size_t W_2    = W_13 + (size_t)32 * 512 * 1024 * 2;
constexpr size_t W_END  = W_2 + (size_t)32 * 1024 * 256 * 2;
constexpr size_t OFF_P  = OFF_W + W_END;
constexpr size_t OFF_G  = OFF_P + (size_t)NTOK * LDP * 2;
constexpr size_t G_MIX  = 0;
constexpr size_t G_HB   = (size_t)128 << 20;
constexpr size_t WS_NEED = OFF_G + ((size_t)216 << 20);
static_assert(OFF_EGL + 3072 * 128 <= OFF_W, "small region");
static_assert(WS_NEED <= ((size_t)512 << 20), "workspace");
constexpr int CTRL_CNT = 4096;
constexpr int CTRL_PCNT = 8192;
constexpr int CTRL_PROG = 12288;
constexpr int CTRL_XCC = 13312, CTRL_RANK = 13440;
constexpr int CTRL_QUEUE2 = 13184;
constexpr int CTRL_QUEUE = 13120;
constexpr int CTRL_MEMKV = 13056;
constexpr int CTRL_PANEL = 20480;
constexpr int CTRL_GFLAG = 16384;
constexpr int CTRL_EDONE = 6144;
constexpr size_t P_PLIST = (size_t)40 << 20;

constexpr int LDS_BYTES = 163840;

struct Params {
  const float *x, *mem, *a_norm, *a_w_in, *a_conv, *a_log, *a_dt_bias, *a_out_gain, *a_w_out, *kv_norm, *w_kv,
      *b_norm, *b_w_in, *b_w_out, *mem_norm, *w_mem_kv, *ffn_norm, *w_group, *b_group, *w_router, *b_router,
      *w1, *w3, *w2, *final_norm;
  float* out; char* ws;
};

typedef float f32x2_t __attribute__((ext_vector_type(2))); typedef __bf16 bf16x2_t __attribute__((ext_vector_type(2)));
__device__ __forceinline__ unsigned cvt_pk_bf16(float lo, float hi) { const f32x2_t v = {lo, hi}; const bf16x2_t b = __builtin_convertvector(v, bf16x2_t); return __builtin_bit_cast(unsigned, b); }
__device__ __forceinline__ bf16_t f2bf(float f) { return (bf16_t)(cvt_pk_bf16(f, 0.f) & 0xffffu); }
__device__ __forceinline__ float bf2f(bf16_t b) { return __uint_as_float(((unsigned)b) << 16); }
__device__ __forceinline__ float bflo(unsigned u) { return __uint_as_float(u << 16); }
__device__ __forceinline__ float bfhi(unsigned u) { return __uint_as_float(u & 0xffff0000u); }
__device__ __forceinline__ float wave_sum(float v) {
#pragma unroll
  for (int o = 32; o >= 1; o >>= 1) v += __shfl_xor(v, o);
  return v;
}
__device__ __forceinline__ float sigmoidf_(float x) { return __builtin_amdgcn_rcpf(1.f + __expf(-x)); }
__device__ __forceinline__ float siluf_(float x) { return x * __builtin_amdgcn_rcpf(1.f + __expf(-x)); }
__device__ __forceinline__ float softplusf_(float x) { return fmaxf(x, 0.f) + log1pf(__expf(-fabsf(x))); }

#define XB_TMO      128
#define XB_XCNT(j)  (256  + 64 * (j))
#define XB_XSUB(j)  (1280 + 64 * (j))
#define XB_XGEN(j)  (2304 + 64 * (j))
#define XB_TOP      3328
#define XB_TOPGEN   3392
#define XCD_BAR_WORDS 3456
#define XB_SPIN_CAP (1u << 22)
__device__ __forceinline__ unsigned xb_ld(unsigned* p)              { return __hip_atomic_load(p, __ATOMIC_RELAXED, __HIP_MEMORY_SCOPE_AGENT); }
__device__ __forceinline__ unsigned xb_add(unsigned* p, unsigned v) { return __hip_atomic_fetch_add(p, v, __ATOMIC_RELAXED, __HIP_MEMORY_SCOPE_AGENT); }
__device__ __forceinline__ unsigned xb_xcc_id() { return (unsigned)__builtin_amdgcn_s_getreg((3 << 11) | 20) & 0xFu; }
#define XB_SPIN(cond, bar) do { unsigned _sp = 0; while (cond) { __builtin_amdgcn_s_sleep(1); \
    if ((++_sp & 255u) == 0u) { if (xb_ld(&(bar)[XB_TMO])) break; if (_sp > XB_SPIN_CAP) { atomicAdd(&(bar)[XB_TMO], 1u); break; } } } } while (0)
struct XcdBarrier { unsigned* bar; unsigned x; volatile LAS unsigned* st; };
__device__ __forceinline__ XcdBarrier xcd_barrier_post(unsigned* bar, volatile LAS unsigned* st) {
    XcdBarrier b; b.bar = bar; b.x = xb_xcc_id(); b.st = st;
    if (threadIdx.x == 0) (void)xb_add(&bar[XB_XCNT(b.x)], 1u);
    return b;
}
__device__ __forceinline__ void xcd_barrier_complete(unsigned* bar, unsigned x, unsigned& nloc, unsigned& nx) {
    const unsigned G = gridDim.x * gridDim.y * gridDim.z;
    unsigned sum, cnt, mine, sp = 0u;
    for (;;) {
        sum = 0u; cnt = 0u; mine = 0u;
#pragma unroll
        for (unsigned j = 0; j < 16; ++j) { const unsigned c = xb_ld(&bar[XB_XCNT(j)]); sum += c; cnt += (c > 0u) ? 1u : 0u; mine = (j == x) ? c : mine; }
        if (sum == G) break;
        __builtin_amdgcn_s_sleep(1);
        if ((++sp & 255u) == 0u) { if (xb_ld(&bar[XB_TMO])) break; if (sp > XB_SPIN_CAP) { atomicAdd(&bar[XB_TMO], 1u); break; } }
    }
    nloc = mine > 0u ? mine : 1u; nx = cnt > 0u ? cnt : 1u;
}
__device__ __forceinline__ void xcd_barrier(const XcdBarrier& b) {
    asm volatile("s_waitcnt vmcnt(0)" ::: "memory");
    __syncthreads();
    if (threadIdx.x == 0) {
        unsigned* bar = b.bar;
        __builtin_amdgcn_s_waitcnt(0);
        unsigned nloc = b.st[0], nx = b.st[1];
        if (nloc == 0u) { xcd_barrier_complete(bar, b.x, nloc, nx); b.st[0] = nloc; b.st[1] = nx; }
        const unsigned old = xb_add(&bar[XB_XSUB(b.x)], 1u);
        const unsigned gen = old / nloc;
        if (old + 1u == (gen + 1u) * nloc) {
            __builtin_amdgcn_fence(__ATOMIC_RELEASE, "agent");
            asm volatile("s_waitcnt vmcnt(0)" ::: "memory");
            const unsigned og = xb_add(&bar[XB_TOP], 1u);
            const unsigned tg = og / nx;
            if (og + 1u == (tg + 1u) * nx) xb_add(&bar[XB_TOPGEN], 1u);
            else XB_SPIN(xb_ld(&bar[XB_TOPGEN]) == tg, bar);
            __builtin_amdgcn_fence(__ATOMIC_ACQUIRE, "agent");
            xb_add(&bar[XB_XGEN(b.x)], 1u);
            asm volatile("s_waitcnt vmcnt(0)" ::: "memory");
        } else {
            XB_SPIN(xb_ld(&bar[XB_XGEN(b.x)]) == gen, bar);
            __builtin_amdgcn_fence(__ATOMIC_ACQUIRE, "agent");
            asm volatile("s_waitcnt vmcnt(0)" ::: "memory");
        }
    }
    __syncthreads();
}

__device__ __forceinline__ void cvt_rows(bf16_t* dst, int nrows_dst, int K, const float* src, int src_ld, int col0, int nrows_src,
                         const float* gain, float scale, int gtid, int gthreads) {
  const int items = nrows_dst * (K >> 3);
  for (int it = gtid; it < items; it += gthreads) {
    const int r = it % nrows_dst, k8 = it / nrows_dst;
    float v[8];
#pragma unroll
    for (int j = 0; j < 8; ++j) {
      const int k = k8 * 8 + j;
      v[j] = (r < nrows_src) ? src[(size_t)k * src_ld + col0 + r] * (gain ? gain[k] : 1.f) * scale : 0.f;
    }
    u32x4 w; w.x = cvt_pk_bf16(v[0], v[1]); w.y = cvt_pk_bf16(v[2], v[3]); w.z = cvt_pk_bf16(v[4], v[5]); w.w = cvt_pk_bf16(v[6], v[7]);
    *(u32x4*)(dst + (size_t)r * K + k8 * 8) = w;
  }
}

__device__ __forceinline__ void rows_to_bf16(const float* src, bf16_t* dst, float* rstd, int nrows, int gwave, int nwaves, int lane) {
  for (int r = gwave; r < nrows; r += nwaves) {
    const float* s = src + (size_t)r * DM; float ss = 0.f;
#pragma unroll
    for (int i = 0; i < 4; ++i) {
      const f32x4 v = __builtin_nontemporal_load((const f32x4*)(s + i * 256 + lane * 4));
      ss += v[0] * v[0] + v[1] * v[1] + v[2] * v[2] + v[3] * v[3];
      u32x2 w; w.x = cvt_pk_bf16(v[0], v[1]); w.y = cvt_pk_bf16(v[2], v[3]);
      *(u32x2*)(dst + (size_t)r * DM + i * 256 + lane * 4) = w;
    }
    ss = wave_sum(ss);
    if (lane == 0) rstd[r] = rsqrtf(ss * (1.f / DM) + EPS);
  }
}

__device__ __forceinline__ void rows_to_bf16x4(const float* src, bf16_t* dst, float* rstd, int nrows, int gwave, int nwaves, int lane) {
  const __amdgpu_buffer_rsrc_t drc = __builtin_amdgcn_make_buffer_rsrc((void*)dst, 0, NTOK * DM * 2, 0x00020000);
  for (int r0 = gwave * 8; r0 < nrows; r0 += nwaves * 8) {
    f32x4 v[8][4];
#pragma unroll
    for (int j = 0; j < 8; ++j)
#pragma unroll
      for (int i = 0; i < 4; ++i) v[j][i] = __builtin_nontemporal_load((const f32x4*)(src + (size_t)(r0 + j) * DM + i * 256 + lane * 4));
#pragma unroll
    for (int j = 0; j < 8; ++j) { float ss = 0.f;
#pragma unroll
      for (int i = 0; i < 4; ++i) { const f32x4 x = v[j][i];
        ss += x[0] * x[0] + x[1] * x[1] + x[2] * x[2] + x[3] * x[3];
        u32x2 w; w.x = cvt_pk_bf16(x[0], x[1]); w.y = cvt_pk_bf16(x[2], x[3]);
        __builtin_amdgcn_raw_buffer_store_b64(w, drc, (unsigned)(((size_t)(r0 + j) * DM + i * 256 + lane * 4) * 2), 0, 16); }
      ss = wave_sum(ss);
      if (lane == 0) rstd[r0 + j] = rsqrtf(ss * (1.f / DM) + EPS); }
  }
}

template <bool LATE>
__device__ __forceinline__ void phase_prep(const Params& p, int bid, int nblk) {
  const int tid = threadIdx.x, gtid = bid * NTHR + tid, gthreads = nblk * NTHR, lane = tid & 63;
  char* ws = p.ws; bf16_t* W = (bf16_t*)(ws + OFF_W);
  if (!LATE) {
  {
    bf16_t* wa = (bf16_t*)((char*)W + W_AIN); bf16_t* wo = (bf16_t*)((char*)W + W_AOUT); bf16_t* wm = (bf16_t*)((char*)W + W_MEM);
    constexpr int U = 8, IA = NIN_A * 128, IB = IA + 131072, I = IB + 131072;
    for (int it0 = gtid; it0 < I; it0 += U * gthreads) {
      float v[U][8];
#pragma unroll
      for (int s_ = 0; s_ < U; ++s_) { const int itx = it0 + s_ * gthreads, it = itx < I ? itx : I - 1;
        const int m = it < IA ? 0 : it < IB ? 1 : 2, li = it - (m == 0 ? 0 : m == 1 ? IA : IB);
        const int d0 = li % NIN_A, col = d0 < 768 ? d0 : d0 < 1024 ? 3084 + (d0 - 768) : d0 < PC_BA ? d0 - 256 : 3072 + (d0 - PC_BA); const bool ok0 = d0 < PC_BA + 12;
        const int l2 = li >> 16, d2 = li & 511;
        const float* src = m == 0 ? p.a_w_in + (ok0 ? col : 0) : m == 1 ? p.a_w_out + (li & 1023) : p.w_mem_kv + (size_t)l2 * 1024 * 512 + d2;
        const int ld = m == 0 ? 3340 : m == 1 ? 1024 : 512, k8 = m == 0 ? li / NIN_A : m == 1 ? li >> 10 : (li & 65535) >> 9;
        const float* gn = m == 2 ? p.mem_norm + l2 * 1024 : p.a_norm;
        const float sc = m == 0 ? (!ok0 ? 0.f : (d0 >= 768 && d0 < 1024) ? 0.125f * LOG2E : 1.f) : 1.f;
#pragma unroll
        for (int q = 0; q < 8; ++q) { const int k = k8 * 8 + q; const float g = gn[k]; v[s_][q] = __builtin_nontemporal_load(src + (size_t)k * ld) * (m == 1 ? 1.f : g * sc); } }
#pragma unroll
      for (int s_ = 0; s_ < U; ++s_) { const int it = it0 + s_ * gthreads;
        if (it < I) { const int m = it < IA ? 0 : it < IB ? 1 : 2, li = it - (m == 0 ? 0 : m == 1 ? IA : IB);
          bf16_t* dst = m == 0 ? wa + (size_t)(li % NIN_A) * 1024 + (li / NIN_A) * 8 : m == 1 ? wo + (size_t)(li & 1023) * 1024 + (li >> 10) * 8
                                                                                          : wm + ((size_t)(li >> 16) * 512 + (li & 511)) * 1024 + ((li & 65535) >> 9) * 8;
          u32x4 w; w.x = cvt_pk_bf16(v[s_][0], v[s_][1]); w.y = cvt_pk_bf16(v[s_][2], v[s_][3]); w.z = cvt_pk_bf16(v[s_][4], v[s_][5]); w.w = cvt_pk_bf16(v[s_][6], v[s_][7]);
          *(u32x4*)dst = w; } }
    }
  }
  } else {
  bf16_t* wb = (bf16_t*)((char*)W + W_BIN);
  cvt_rows(wb + (size_t)PC_Q * 1024, 768, 1024, p.b_w_in, 1024, 0, 768, p.b_norm, 0.125f * LOG2E, gtid, gthreads);
  cvt_rows(wb + (size_t)PC_MQ * 1024, 256, 1024, p.b_w_in, 1024, 768, 256, p.b_norm, 0.125f * LOG2E, gtid, gthreads);
  cvt_rows(wb + (size_t)PC_K * 1024, 768, 1024, p.w_kv, 1536, 0, 768, p.kv_norm, 1.f, gtid, gthreads);
  cvt_rows(wb + (size_t)PC_V * 1024, 768, 1024, p.w_kv, 1536, 768, 768, p.kv_norm, 1.f, gtid, gthreads);
  cvt_rows((bf16_t*)((char*)W + W_BOUT), 1024, 1024, p.b_w_out, 1024, 0, 1024, nullptr, 1.f, gtid, gthreads);
  {
    bf16_t* w13 = (bf16_t*)((char*)W + W_13);
    const int items = 32 * 512 * 128;
    for (int it0 = gtid; it0 < items; it0 += 4 * gthreads) {
      float v[4][8];
#pragma unroll
      for (int s_ = 0; s_ < 4; ++s_) { const int itx = it0 + s_ * gthreads, it = itx < items ? itx : items - 1;
        const int le = it >> 16, rem = it & 65535, r = rem & 511, k8 = rem >> 9;
        const int u = r >> 8, which = (r >> 7) & 1, j = r & 127, l = le >> 4;
        const float* src = (which ? p.w3 : p.w1) + (size_t)le * 1024 * 256 + u * 128 + j;
        const float* g = p.ffn_norm + l * 1024;
#pragma unroll
        for (int q = 0; q < 8; ++q) { const int k = k8 * 8 + q; v[s_][q] = src[(size_t)k * 256] * g[k]; } }
#pragma unroll
      for (int s_ = 0; s_ < 4; ++s_) { const int it = it0 + s_ * gthreads;
        if (it < items) { const int le = it >> 16, rem = it & 65535, r = rem & 511, k8 = rem >> 9;
          u32x4 w; w.x = cvt_pk_bf16(v[s_][0], v[s_][1]); w.y = cvt_pk_bf16(v[s_][2], v[s_][3]); w.z = cvt_pk_bf16(v[s_][4], v[s_][5]); w.w = cvt_pk_bf16(v[s_][6], v[s_][7]);
          *(u32x4*)(w13 + ((size_t)le * 512 + r) * 1024 + k8 * 8) = w; } }
    }
    bf16_t* w2t = (bf16_t*)((char*)W + W_2);
    const int items2 = 32 * 1024 * 32;
    for (int it0 = gtid; it0 < items2; it0 += 4 * gthreads) {
      float v[4][8];
#pragma unroll
      for (int s_ = 0; s_ < 4; ++s_) { const int itx = it0 + s_ * gthreads, it = itx < items2 ? itx : items2 - 1;
        const int le = it >> 15, rem = it & 32767, n = rem & 1023, k8 = rem >> 10;
        const float* src = p.w2 + (size_t)le * 256 * 1024 + n;
#pragma unroll
        for (int q = 0; q < 8; ++q) v[s_][q] = src[(size_t)(k8 * 8 + q) * 1024]; }
#pragma unroll
      for (int s_ = 0; s_ < 4; ++s_) { const int it = it0 + s_ * gthreads;
        if (it < items2) { const int le = it >> 15, rem = it & 32767, n = rem & 1023, k8 = rem >> 10;
          u32x4 w; w.x = cvt_pk_bf16(v[s_][0], v[s_][1]); w.y = cvt_pk_bf16(v[s_][2], v[s_][3]); w.z = cvt_pk_bf16(v[s_][4], v[s_][5]); w.w = cvt_pk_bf16(v[s_][6], v[s_][7]);
          *(u32x4*)(w2t + ((size_t)le * 1024 + n) * 256 + k8 * 8) = w; } }
    }
  }
  }
  if (!LATE) {
  {
    bf16_t* wr = (bf16_t*)(ws + OFF_WR);
    for (int it = gtid; it < 2 * 20 * 1024; it += gthreads) {
      const int l = it / 20480, rem = it % 20480, j = rem >> 10, k = rem & 1023;
      const float w0 = (j < 4) ? p.w_group[((size_t)l * 1024 + k) * 4 + j] : p.w_router[((size_t)l * 1024 + k) * 16 + (j - 4)];
      const float w = w0 * p.ffn_norm[l * 1024 + k];
      const bf16_t h_ = f2bf(w); const float r1 = w - bf2f(h_); const bf16_t m_ = f2bf(r1); const float r2 = r1 - bf2f(m_); const bf16_t l_ = f2bf(r2);
      bf16_t* d = wr + (size_t)l * 3 * 20480 + j * 1024 + k;
      d[0] = h_; d[20480] = m_; d[2 * 20480] = l_;
    }
  }
  const int gwave = gtid >> 6, nwaves = gthreads >> 6;
  rows_to_bf16x4(p.x, (bf16_t*)p.out, (float*)(ws + OFF_RSTD), NTOK, gwave, nwaves, lane);
  rows_to_bf16(p.mem, (bf16_t*)((char*)p.out + ((size_t)64 << 20)), (float*)(ws + OFF_MRSTD), NMEMROW, gwave, nwaves, lane);
  }
}

template <int U>
__device__ __forceinline__ void cvt_w13(const Params& p, bf16_t* w13, int st, int en, int tid) {
  for (int it0 = st + tid; it0 < en; it0 += U * NTHR) {
    float v[U][8];
#pragma unroll
    for (int s_ = 0; s_ < U; ++s_) { const int itx = it0 + s_ * NTHR, it = itx < en ? itx : en - 1;
      const int le = it >> 16, rem = it & 65535, r = rem & 511, k8 = rem >> 9;
      const int u = r >> 8, which = (r >> 7) & 1, j = r & 127, l = le >> 4;
      const float* src = (which ? p.w3 : p.w1) + (size_t)le * 1024 * 256 + u * 128 + j;
      const float* g = p.ffn_norm + l * 1024;
#pragma unroll
      for (int q = 0; q < 8; ++q) { const int k = k8 * 8 + q; v[s_][q] = __builtin_nontemporal_load(src + (size_t)k * 256) * g[k]; } }
#pragma unroll
    for (int s_ = 0; s_ < U; ++s_) { const int it = it0 + s_ * NTHR;
      if (it < en) { const int le = it >> 16, rem = it & 65535, r = rem & 511, k8 = rem >> 9;
        u32x4 w; w.x = cvt_pk_bf16(v[s_][0], v[s_][1]); w.y = cvt_pk_bf16(v[s_][2], v[s_][3]); w.z = cvt_pk_bf16(v[s_][4], v[s_][5]); w.w = cvt_pk_bf16(v[s_][6], v[s_][7]);
        *(u32x4*)(w13 + ((size_t)le * 512 + r) * 1024 + k8 * 8) = w; } }
  }
}
template <int U>
__device__ __forceinline__ void cvt_w2(const Params& p, bf16_t* w2t, int st, int en, int tid) {
  for (int it0 = st + tid; it0 < en; it0 += U * NTHR) {
    float v[U][8];
#pragma unroll
    for (int s_ = 0; s_ < U; ++s_) { const int itx = it0 + s_ * NTHR, it = itx < en ? itx : en - 1;
      const int le = it >> 15, rem = it & 32767, n = rem & 1023, k8 = rem >> 10;
      const float* src = p.w2 + (size_t)le * 256 * 1024 + n;
#pragma unroll
      for (int q = 0; q < 8; ++q) v[s_][q] = __builtin_nontemporal_load(src + (size_t)(k8 * 8 + q) * 1024); }
#pragma unroll
    for (int s_ = 0; s_ < U; ++s_) { const int it = it0 + s_ * NTHR;
      if (it < en) { const int le = it >> 15, rem = it & 32767, n = rem & 1023, k8 = rem >> 10;
        u32x4 w; w.x = cvt_pk_bf16(v[s_][0], v[s_][1]); w.y = cvt_pk_bf16(v[s_][2], v[s_][3]); w.z = cvt_pk_bf16(v[s_][4], v[s_][5]); w.w = cvt_pk_bf16(v[s_][6], v[s_][7]);
        *(u32x4*)(w2t + ((size_t)le * 1024 + n) * 256 + k8 * 8) = w; } }
  }
}
template <int U>
__device__ __forceinline__ void cvt_proj1(const Params& p, int st, int en, int tid) {
  char* ws = p.ws; bf16_t* wb = (bf16_t*)(ws + OFF_W + W_BIN); bf16_t* wo = (bf16_t*)(ws + OFF_W + W_BOUT);
  for (int it0 = st + tid; it0 < en; it0 += U * NTHR) {
    float v[U][8];
#pragma unroll
    for (int s_ = 0; s_ < U; ++s_) { const int itx = it0 + s_ * NTHR, it = itx < en ? itx : en - 1;
      const int m = it < 131072 ? 0 : it < 327680 ? 1 : 2, li = it - (m == 0 ? 0 : m == 1 ? 131072 : 327680), nr = m == 1 ? 1536 : 1024, r = li % nr, k8 = li / nr;
      const float* src = (m == 0 ? p.b_w_in : m == 1 ? p.w_kv : p.b_w_out) + r; const float* gn = m == 1 ? p.kv_norm : p.b_norm; const float sc = m == 0 ? 0.125f * LOG2E : 1.f;
#pragma unroll
      for (int q = 0; q < 8; ++q) { const int k = k8 * 8 + q; const float g = gn[k]; v[s_][q] = __builtin_nontemporal_load(src + (size_t)k * nr) * (m == 2 ? 1.f : g * sc); } }
#pragma unroll
    for (int s_ = 0; s_ < U; ++s_) { const int it = it0 + s_ * NTHR;
      if (it < en) { const int m = it < 131072 ? 0 : it < 327680 ? 1 : 2, li = it - (m == 0 ? 0 : m == 1 ? 131072 : 327680), nr = m == 1 ? 1536 : 1024, r = li % nr, k8 = li / nr;
        bf16_t* dst = (m == 0 ? wb : m == 1 ? wb + (size_t)1024 * 1024 : wo) + (size_t)r * 1024 + k8 * 8;
        u32x4 w; w.x = cvt_pk_bf16(v[s_][0], v[s_][1]); w.y = cvt_pk_bf16(v[s_][2], v[s_][3]); w.z = cvt_pk_bf16(v[s_][4], v[s_][5]); w.w = cvt_pk_bf16(v[s_][6], v[s_][7]);
        *(u32x4*)dst = w; } }
  }
}
constexpr int NCHUNK0 = 256 + 128;
__device__ __forceinline__ void prep_late0_chunk(const Params& p, int c) {
  const int tid = threadIdx.x; char* ws = p.ws;
  if (c < 256) cvt_w13<8>(p, (bf16_t*)(ws + OFF_W + W_13), c * 4096, c * 4096 + 4096, tid);
  else cvt_w2<8>(p, (bf16_t*)(ws + OFF_W + W_2), (c - 256) * 4096, (c - 256) * 4096 + 4096, tid);
}
constexpr int NCHUNK1 = 112 + 256 + 128;
__device__ __forceinline__ void prep_late1_chunk(const Params& p, int c) {
  const int tid = threadIdx.x; char* ws = p.ws;
  if (c < 112) cvt_proj1<8>(p, c * 4096, c * 4096 + 4096, tid);
  else if (c < 368) { const int st = 16 * 512 * 128 + (c - 112) * 4096; cvt_w13<8>(p, (bf16_t*)(ws + OFF_W + W_13), st, st + 4096, tid); }
  else { const int st = 16 * 1024 * 32 + (c - 368) * 4096; cvt_w2<8>(p, (bf16_t*)(ws + OFF_W + W_2), st, st + 4096, tid); }
}
__device__ __forceinline__ void phase_prep_late1_queue(const Params& p, LAS char* lds) {
  unsigned* q = (unsigned*)(p.ws + OFF_CTRL) + CTRL_QUEUE; LAS int* sh = (LAS int*)lds;
  for (int guard = 0; guard < NCHUNK1 + 1; ++guard) {
    __syncthreads();
    if (threadIdx.x == 0) sh[0] = (int)xb_add(q, 1u);
    __syncthreads();
    const int c = sh[0];
    if (c >= NCHUNK1) break;
    prep_late1_chunk(p, c);
  }
}

namespace g8 {
constexpr int BM = 256, BK = 64, HALF = 128, HTB = HALF * BK * 2, STAGE_BYTES = 8 * HTB, NXCD = 8, WGM = 8;
__host__ __device__ __forceinline__ int lds_byte(int r, int c) { const int st = (r >> 4) * 2 + (c >> 5), rr = r & 15, cc = c & 31, ob = rr * 64 + cc * 2; return st * 1024 + (ob ^ (((ob >> 9) & 1) << 5)); }
__host__ __device__ __forceinline__ void stage_rc(int b, int& R, int& C) { const int st = b / 1024, sb = b % 1024, swz = sb ^ (((sb >> 9) & 1) << 5); R = (st >> 1) * 16 + swz / 64; C = (st & 1) * 32 + (swz % 64) / 2; }
__host__ __device__ __forceinline__ int perm32(int rho) { const int n = rho >> 4, i = rho & 15; return 8 * (i >> 2) + 4 * n + (i & 3); }

struct Unit { const char* A; const char* B; const int* list; int row0, nvalid, pm, pn, aux; };

struct DenseOrder {
  const char* A; const char* Bt; int K; int nM, nN, nwg, G, c;
  __device__ __forceinline__ void init(const void* A_, const void* Bt_, int K_, int M, int N, int G_, int c_) { A = (const char*)A_; Bt = (const char*)Bt_; K = K_; nM = M / BM; nN = N / BM; nwg = nM * nN; G = G_; c = c_; }
  __device__ __forceinline__ bool next(int i, Unit& u) const {
    const long L = (long)i * G + c; if (L >= nwg) return false;
    int wgid = (int)L; { const int q = nwg / NXCD, r = nwg % NXCD, xcd = wgid % NXCD, off = wgid / NXCD; wgid = (xcd < r ? xcd * (q + 1) : r * (q + 1) + (xcd - r) * q) + off; }
    const int nig = WGM * nN, gid = wgid / nig, fm = gid * WGM, gsz = (nM - fm) < WGM ? (nM - fm) : WGM;
    u.pm = fm + ((wgid % nig) % gsz); u.pn = (wgid % nig) / gsz;
    u.A = A; u.B = Bt + (size_t)u.pn * BM * K * 2; u.list = nullptr; u.row0 = u.pm * BM; u.nvalid = BM; u.aux = 0; return true;
  }
  __device__ __forceinline__ void a_ready(const Unit&) const {}
  __device__ __forceinline__ void done(const Unit&) const {}
};

struct DensePubOrder : DenseOrder {
  unsigned* pcnt; mutable int pend[4]; mutable int np;
  __device__ __forceinline__ void done(const Unit& u) const {
    if (np < 4) { if (np == 0) pend[0] = u.pm; else if (np == 1) pend[1] = u.pm; else if (np == 2) pend[2] = u.pm; else pend[3] = u.pm; ++np; }
    else { asm volatile("s_waitcnt vmcnt(0)" ::: "memory"); if ((threadIdx.x & 63) == 0) (void)xb_add(pcnt + u.pm * 16, 1u); } }
  __device__ __forceinline__ void flush() const {
    if ((threadIdx.x & 63) == 0) { if (np > 0) (void)xb_add(pcnt + pend[0] * 16, 1u); if (np > 1) (void)xb_add(pcnt + pend[1] * 16, 1u); if (np > 2) (void)xb_add(pcnt + pend[2] * 16, 1u); if (np > 3) (void)xb_add(pcnt + pend[3] * 16, 1u); }
    np = 0; }
};
template <class Epi, class Sched, int SHIFT, bool SPLITB = false>
__device__ __forceinline__ void gemm_phase(LAS unsigned char* lds, const int K, const int lda, const Sched& S, const Epi& E) {
    const int tid = threadIdx.x, wid = __builtin_amdgcn_readfirstlane(tid >> 6), lane = tid & 63, wr = wid >> 2, wc = wid & 3, fr = lane & 15, fq = lane >> 4;
    const int nt = K / BK, nth = nt / 2, ldb = SPLITB ? K / 2 : K;
    int RA[2], CA[2]; unsigned voffB[2];
#pragma unroll
    for (int i = 0; i < 2; ++i) { int R, C; stage_rc(tid * 16 + i * 8192, R, C); const int Rb = Epi::PERM ? ((R & ~31) + perm32(R & 31)) : R;
        RA[i] = R; CA[i] = C; voffB[i] = (unsigned)(Rb * ldb + C) * 2u; }
    const size_t kstep = (size_t)(BK * 2);
    const size_t hstepB = (size_t)HALF * ldb * 2;
#define G8_BP(b_, d_, kt_) ((b_) + (size_t)(kt_) * kstep + ((SPLITB && (kt_) >= nth) ? (size_t)(d_) : (size_t)0))
    const unsigned ldsw = (unsigned)wid * 1024u;
    const int aoff = lds_byte(wr * 64 + fr, fq * 8), boff = lds_byte(wc * 32 + fr, fq * 8);
#define G8_AOFF(dst, u) do { _Pragma("unroll") for (int _h = 0; _h < 2; ++_h) _Pragma("unroll") for (int _i = 0; _i < 2; ++_i) { const int _r = _h * HALF + RA[_i]; int _ar; \
        if ((u).list) { const int _rr = _r < (u).nvalid ? _r : 0; _ar = (u).list[(u).row0 + _rr] >> SHIFT; } else _ar = (u).row0 + _r; \
        dst[_h][_i] = (unsigned)(_ar * lda + CA[_i]) * 2u; } } while (0)
#define G8_SA(b, h) (((b) * 2 + (h)) * HTB)
#define G8_SB(b, h) ((4 + (b) * 2 + (h)) * HTB)
#define G8_STAGEA(bufoff, gbase, vo, kb) do { _Pragma("unroll") for (int _i = 0; _i < 2; ++_i) \
        __builtin_amdgcn_global_load_lds((const unsigned*)((gbase) + (size_t)((vo)[_i] + (unsigned)(kb))), (LAS unsigned*)(lds + (bufoff) + ldsw + _i * 8192), 16, 0, 0); } while (0)
#define G8_STAGEB(bufoff, gbase) do { _Pragma("unroll") for (int _i = 0; _i < 2; ++_i) \
        __builtin_amdgcn_global_load_lds((const unsigned*)((const char*)(gbase) + voffB[_i]), (LAS unsigned*)(lds + (bufoff) + ldsw + _i * 8192), 16, 0, 0); } while (0)
#define G8_LDA(dst, b, h) do { _Pragma("unroll") for (int m = 0; m < 4; ++m) _Pragma("unroll") for (int k = 0; k < 2; ++k) dst[m][k] = *(const LAS bf16x8*)(lds + G8_SA(b, h) + aoff + m * 2048 + k * 1024); } while (0)
#define G8_LDB(dst, b, h) do { _Pragma("unroll") for (int n = 0; n < 2; ++n) _Pragma("unroll") for (int k = 0; k < 2; ++k) dst[n][k] = *(const LAS bf16x8*)(lds + G8_SB(b, h) + boff + n * 2048 + k * 1024); } while (0)
#define G8_MMA(ai, bj, At, Bt) do { __builtin_amdgcn_s_setprio(1); _Pragma("unroll") for (int m = 0; m < 4; ++m) _Pragma("unroll") for (int n = 0; n < 2; ++n) _Pragma("unroll") for (int k = 0; k < 2; ++k) \
        acc[ai][bj][m][n] = __builtin_amdgcn_mfma_f32_16x16x32_bf16(Bt[n][k], At[m][k], acc[ai][bj][m][n], 0, 0, 0); __builtin_amdgcn_s_setprio(0); } while (0)
#define G8_WAIT_V(n) asm volatile("s_waitcnt vmcnt(" #n ")" ::: "memory")
#define G8_WAIT_L(n) asm volatile("s_waitcnt lgkmcnt(" #n ")" ::: "memory")
#define G8_BAR __builtin_amdgcn_s_barrier()
#define G8_SCHED __builtin_amdgcn_sched_barrier(0)
    Unit cur, nxt; int ui = 0;
    if (!S.next(0, cur)) return;
    f32x4 acc[2][2][4][2];
#pragma unroll
    for (int a = 0; a < 2; ++a)
#pragma unroll
        for (int b = 0; b < 2; ++b)
#pragma unroll
            for (int m = 0; m < 4; ++m)
#pragma unroll
                for (int n = 0; n < 2; ++n) acc[a][b][m][n] = (f32x4){0.f, 0.f, 0.f, 0.f};
    bf16x8 At[4][2], B0[2][2], B1[2][2];
    unsigned aoC[2][2], aoN[2][2];
    G8_AOFF(aoC, cur);
    const char* cA = cur.A; const char* cB = cur.B; long cD = ((long)(cur.aux & 15) << 19) - (long)nth * (long)kstep;
    S.a_ready(cur);
    G8_STAGEB(G8_SB(0, 0), cB); G8_STAGEB(G8_SB(0, 1), cB + hstepB); G8_STAGEA(G8_SA(0, 0), cA, aoC[0], 0); G8_STAGEA(G8_SA(0, 1), cA, aoC[1], 0);
    if (wr == 1) G8_BAR;
    G8_WAIT_V(2); G8_BAR;
    G8_STAGEB(G8_SB(1, 0), cB + kstep); G8_STAGEA(G8_SA(1, 0), cA, aoC[0], kstep); G8_STAGEB(G8_SB(1, 1), cB + hstepB + kstep);
    G8_WAIT_V(6); G8_BAR;
    for (;;) {
        const bool has_next = S.next(ui + 1, nxt);
        E.pre(cur);
        const char* nA = has_next ? nxt.A : cA; const char* nB = has_next ? nxt.B : cB; const long nD = has_next ? ((long)(nxt.aux & 15) << 19) - (long)nth * (long)kstep : cD;
        if (has_next) { G8_AOFF(aoN, nxt); } else {
#pragma unroll
            for (int h = 0; h < 2; ++h)
#pragma unroll
                for (int i = 0; i < 2; ++i) aoN[h][i] = aoC[h][i]; }
        for (int t = 0; t < nt; t += 2) {
            const bool last = (t == nt - 2);
            if (last && has_next) S.a_ready(nxt);
            const unsigned k1 = (unsigned)((t + 1) * kstep);
            const char* a2b = last ? nA : cA; const unsigned k2 = last ? 0u : (unsigned)((t + 2) * kstep), k3 = k2 + (unsigned)kstep;
            const char* b2 = last ? nB : G8_BP(cB, cD, t + 2); const char* b3 = last ? nB + kstep : G8_BP(cB, cD, t + 3);
            unsigned ao2[2][2];
#pragma unroll
            for (int h = 0; h < 2; ++h)
#pragma unroll
                for (int i = 0; i < 2; ++i) ao2[h][i] = last ? aoN[h][i] : aoC[h][i];
            G8_LDB(B0, 0, 0); G8_LDB(B1, 0, 1); G8_SCHED; G8_LDA(At, 0, 0); G8_STAGEA(G8_SA(1, 1), cA, aoC[1], k1);
            G8_WAIT_V(8); G8_WAIT_L(0); G8_BAR; G8_MMA(0, 0, At, B0); G8_MMA(0, 1, At, B1); G8_BAR; G8_SCHED;
            G8_LDA(At, 0, 1); G8_STAGEB(G8_SB(0, 0), b2); G8_STAGEB(G8_SB(0, 1), b2 + hstepB); G8_STAGEA(G8_SA(0, 0), a2b, ao2[0], k2);
            G8_WAIT_V(8); G8_WAIT_L(0); G8_BAR; G8_MMA(1, 0, At, B0); G8_MMA(1, 1, At, B1); G8_BAR; G8_SCHED;
            G8_LDB(B0, 1, 0); G8_LDB(B1, 1, 1); G8_SCHED; G8_LDA(At, 1, 0); G8_STAGEA(G8_SA(0, 1), a2b, ao2[1], k2);
            G8_WAIT_V(8); G8_WAIT_L(0); G8_BAR; G8_MMA(0, 0, At, B0); G8_MMA(0, 1, At, B1); G8_BAR; G8_SCHED;
            G8_LDA(At, 1, 1); G8_STAGEB(G8_SB(1, 0), b3); G8_STAGEB(G8_SB(1, 1), b3 + hstepB); G8_STAGEA(G8_SA(1, 0), a2b, ao2[0], k3);
            G8_WAIT_V(8); G8_WAIT_L(0); G8_BAR; G8_MMA(1, 0, At, B0); G8_MMA(1, 1, At, B1); G8_BAR; G8_SCHED;
        }
        if (wr == 0) G8_BAR;
        E(acc, cur, wr, wc, fr, fq); S.done(cur);
        if (!has_next) break;
#pragma unroll
        for (int a = 0; a < 2; ++a)
#pragma unroll
            for (int b = 0; b < 2; ++b)
#pragma unroll
                for (int m = 0; m < 4; ++m)
#pragma unroll
                    for (int n = 0; n < 2; ++n) acc[a][b][m][n] = (f32x4){0.f, 0.f, 0.f, 0.f};
        cur = nxt; cA = nA; cB = nB; cD = nD; ++ui;
#pragma unroll
        for (int h = 0; h < 2; ++h)
#pragma unroll
            for (int i = 0; i < 2; ++i) aoC[h][i] = aoN[h][i];
        if (wr == 1) G8_BAR;
    }
    G8_WAIT_V(0);
    G8_BAR;
#undef G8_AOFF
#undef G8_SA
#undef G8_SB
#undef G8_STAGEA
#undef G8_STAGEB
#undef G8_BP
#undef G8_LDA
#undef G8_LDB
#undef G8_MMA
#undef G8_WAIT_V
#undef G8_WAIT_L
#undef G8_BAR
#undef G8_SCHED
}

struct EpiScaleBf16 {
  static constexpr bool PERM = true;
  bf16_t* C; int ldc; const float* rowscale; int ncol_store;
  __device__ __forceinline__ void pre(const Unit&) const {}
  __device__ __forceinline__ void operator()(const f32x4 (&acc)[2][2][4][2], const Unit& u, int wr, int wc, int fr, int fq) const {
    const int row0 = u.pm * BM + wr * 64 + fr, col0 = u.pn * BM + wc * 32 + 8 * fq;
#pragma unroll
    for (int ai = 0; ai < 2; ++ai)
#pragma unroll
      for (int m = 0; m < 4; ++m) { const int row = row0 + ai * HALF + m * 16; const float sc = rowscale[row]; bf16_t* rowp = C + (size_t)row * ldc + col0;
#pragma unroll
        for (int bj = 0; bj < 2; ++bj) { const f32x4 v0 = acc[ai][bj][m][0] * sc, v1 = acc[ai][bj][m][1] * sc;
          u32x4 w; w.x = cvt_pk_bf16(v0[0], v0[1]); w.y = cvt_pk_bf16(v0[2], v0[3]); w.z = cvt_pk_bf16(v1[0], v1[1]); w.w = cvt_pk_bf16(v1[2], v1[3]);
          if (col0 + bj * HALF < ncol_store) *(u32x4*)(rowp + bj * HALF) = w; } }
  }
};
struct EpiScaleBf16L {
  static constexpr bool PERM = true;
  bf16_t* C; int ldc; const float* rowscale; int ncol_store; LAS float* sbuf; mutable int par;
  __device__ __forceinline__ void pre(const Unit& u) const {
    if (threadIdx.x < 64) __builtin_amdgcn_global_load_lds((const unsigned*)(rowscale + u.pm * BM + threadIdx.x * 4), (LAS unsigned*)(sbuf + par * 256), 16, 0, 0);
  }
  __device__ __forceinline__ void operator()(const f32x4 (&acc)[2][2][4][2], const Unit& u, int wr, int wc, int fr, int fq) const {
    const int rl0 = wr * 64 + fr, row0 = u.pm * BM + rl0, col0 = u.pn * BM + wc * 32 + 8 * fq;
    LAS const float* sp = sbuf + par * 256 + rl0;
    const __amdgpu_buffer_rsrc_t crc = __builtin_amdgcn_make_buffer_rsrc((void*)C, 0, NTOK * LDP * 2, 0x00020000);
#pragma unroll
    for (int ai = 0; ai < 2; ++ai)
#pragma unroll
      for (int m = 0; m < 4; ++m) { const int row = row0 + ai * HALF + m * 16; const float sc = sp[ai * HALF + m * 16]; bf16_t* rowp = C + (size_t)row * ldc + col0;
#pragma unroll
        for (int bj = 0; bj < 2; ++bj) { const f32x4 v0 = acc[ai][bj][m][0] * sc, v1 = acc[ai][bj][m][1] * sc;
          u32x4 w; w.x = cvt_pk_bf16(v0[0], v0[1]); w.y = cvt_pk_bf16(v0[2], v0[3]); w.z = cvt_pk_bf16(v1[0], v1[1]); w.w = cvt_pk_bf16(v1[2], v1[3]);
          if (col0 + bj * HALF < ncol_store) __builtin_amdgcn_raw_buffer_store_b128(w, crc, (unsigned)(((size_t)row * ldc + col0 + bj * HALF) * 2), 0, 16); } }
    par ^= 1;
  }
};
struct EpiMem {
  static constexpr bool PERM = true; bf16_t* C; const float* rs;
  __device__ __forceinline__ void pre(const Unit&) const {}
  __device__ __forceinline__ void operator()(const f32x4 (&acc)[2][2][4][2], const Unit& u, int wr, int wc, int fr, int fq) const {
    const int l = u.pn >> 1; Unit v = u; v.pn = u.pn & 1;
    EpiScaleBf16 e{C + (size_t)l * 2048 * 512, 512, rs, 512}; e(acc, v, wr, wc, fr, fq); }
};
struct EpiResidBf16 {
  static constexpr bool PERM = true;
  bf16_t* out; const bf16_t* bres;
  __device__ __forceinline__ void pre(const Unit&) const {}
  __device__ __forceinline__ void operator()(const f32x4 (&acc)[2][2][4][2], const Unit& u, int wr, int wc, int fr, int fq) const {
    const int row0 = u.pm * BM + wr * 64 + fr, col0 = u.pn * BM + wc * 32 + 8 * fq;
    const __amdgpu_buffer_rsrc_t orc = __builtin_amdgcn_make_buffer_rsrc((void*)out, 0, NTOK * DM * 2, 0x00020000);
    u32x4 rb[2][4][2];
#pragma unroll
    for (int ai = 0; ai < 2; ++ai)
#pragma unroll
      for (int m = 0; m < 4; ++m)
#pragma unroll
        for (int bj = 0; bj < 2; ++bj) rb[ai][m][bj] = *(const u32x4*)(bres + (size_t)(row0 + ai * HALF + m * 16) * DM + col0 + bj * HALF);
#pragma unroll
    for (int ai = 0; ai < 2; ++ai)
#pragma unroll
      for (int m = 0; m < 4; ++m) { const size_t base = (size_t)(row0 + ai * HALF + m * 16) * DM + col0;
#pragma unroll
        for (int bj = 0; bj < 2; ++bj) { const size_t o = base + bj * HALF;
          const u32x4 r_ = rb[ai][m][bj];
          const f32x4 v0 = (f32x4){bflo(r_.x), bfhi(r_.x), bflo(r_.y), bfhi(r_.y)} + acc[ai][bj][m][0], v1 = (f32x4){bflo(r_.z), bfhi(r_.z), bflo(r_.w), bfhi(r_.w)} + acc[ai][bj][m][1];
          u32x4 w; w.x = cvt_pk_bf16(v0[0], v0[1]); w.y = cvt_pk_bf16(v0[2], v0[3]); w.z = cvt_pk_bf16(v1[0], v1[1]); w.w = cvt_pk_bf16(v1[2], v1[3]);
          __builtin_amdgcn_raw_buffer_store_b128(w, orc, (unsigned)(o * 2), 0, 16); } }
  }
};
struct EpiMoe1 {
  static constexpr bool PERM = true;
  bf16_t* hid; const float* rstd; const float* cw; LAS int* sbuf; mutable int par;
  __device__ __forceinline__ void pre(const Unit& u) const {
    if (threadIdx.x < 64) __builtin_amdgcn_global_load_lds((const unsigned*)(u.list + u.row0 + threadIdx.x * 4), (LAS unsigned*)(sbuf + par * 256), 16, 0, 0); }
  __device__ __forceinline__ void operator()(const f32x4 (&acc)[2][2][4][2], const Unit& u, int wr, int wc, int fr, int fq) const {
    const __amdgpu_buffer_rsrc_t hr = __builtin_amdgcn_make_buffer_rsrc((void*)hid, 0, 65536 * 256 * 2, 0x00020000);
#pragma unroll
    for (int ai = 0; ai < 2; ++ai)
#pragma unroll
      for (int m = 0; m < 4; ++m) { const int r = ai * HALF + wr * 64 + m * 16 + fr;
        if (r < u.nvalid) { const int slot = sbuf[par * 256 + r]; const float rs = rstd[slot >> 1], cs = cw[slot] * rs;
          float h[8];
#pragma unroll
          for (int n = 0; n < 2; ++n)
#pragma unroll
            for (int j = 0; j < 4; ++j) { const float a = acc[ai][0][m][n][j] * rs, b = acc[ai][1][m][n][j] * cs; h[4 * n + j] = siluf_(a) * b; }
          u32x4 w; w.x = cvt_pk_bf16(h[0], h[1]); w.y = cvt_pk_bf16(h[2], h[3]); w.z = cvt_pk_bf16(h[4], h[5]); w.w = cvt_pk_bf16(h[6], h[7]);
          __builtin_amdgcn_raw_buffer_store_b128(w, hr, (slot * 256 + u.pn * 128 + wc * 32 + 8 * fq) * 2, 0, 16); } }
    par ^= 1;
  }
};
struct EpiMoe2 {
  static constexpr bool PERM = true;
  bf16_t* y; LAS int* sbuf; mutable int par;
  __device__ __forceinline__ void pre(const Unit& u) const {
    if (threadIdx.x < 64) __builtin_amdgcn_global_load_lds((const unsigned*)(u.list + u.row0 + threadIdx.x * 4), (LAS unsigned*)(sbuf + par * 256), 16, 0, 0); }
  __device__ __forceinline__ void operator()(const f32x4 (&acc)[2][2][4][2], const Unit& u, int wr, int wc, int fr, int fq) const {
#pragma unroll
    for (int ai = 0; ai < 2; ++ai)
#pragma unroll
      for (int m = 0; m < 4; ++m) { const int r = ai * HALF + wr * 64 + m * 16 + fr;
        if (r < u.nvalid) { const int tok = sbuf[par * 256 + r];
          bf16_t* yp = y + (size_t)tok * DM + u.pn * BM + wc * 32 + 8 * fq;
#pragma unroll
          for (int bj = 0; bj < 2; ++bj) { const f32x4 v0 = acc[ai][bj][m][0], v1 = acc[ai][bj][m][1];
            u32x4 w; w.x = cvt_pk_bf16(v0[0], v0[1]); w.y = cvt_pk_bf16(v0[2], v0[3]); w.z = cvt_pk_bf16(v1[0], v1[1]); w.w = cvt_pk_bf16(v1[2], v1[3]);
            *(u32x4*)(yp + bj * HALF) = w; } } }
    par ^= 1;
  }
};
struct PairOrder {
  const char* A; const char* Wt; const int* plist; LAS const int* cn; int G, c;
  unsigned* edone; unsigned* tmo; int r1; mutable int acquired;
  __device__ __forceinline__ bool next(int i, Unit& u) const {
    const int GA = G - r1;
    int L = (c >= r1) ? i * GA + (i > 0 ? (i - 1) * r1 : 0) + (c - r1) : (i + 2) * GA + i * r1 + c; bool found = false;
    for (int e = 0; e < 24; ++e) { const int cne = __builtin_amdgcn_readfirstlane(cn[e]); const int nu = ((cne + 255) >> 8) * 4;
      if (!found) { if (L < nu) { found = true; const int tile = L >> 2, pn = L & 3, g = e / 6, pr = e % 6;
          const int la = pr < 3 ? 0 : pr < 5 ? 1 : 2, lb = pr < 3 ? pr + 1 : pr < 5 ? pr - 1 : 3;
          u.pm = tile; u.pn = pn; u.aux = (lb - la) | ((g * 4 + la) << 4) | ((g * 4 + lb) << 8); u.A = A;
          u.B = Wt + ((size_t)(g * 4 + la) * 1024 + (size_t)pn * 256) * 256 * 2;
          u.list = plist + (size_t)e * NTOK; u.row0 = tile * 256; u.nvalid = (cne - tile * 256) < 256 ? (cne - tile * 256) : 256; } else L -= nu; } }
    return found;
  }
  __device__ __forceinline__ void a_ready(const Unit& u) const {
    if (threadIdx.x < 64) {
      const int ea = (u.aux >> 4) & 15, eb = (u.aux >> 8) & 15;
      const unsigned na = (unsigned)cn[32 + ea], nb = (unsigned)cn[32 + eb]; unsigned sp = 0u;
      while ((unsigned)__builtin_amdgcn_readfirstlane(xb_ld(edone + ea * 64)) < na || (unsigned)__builtin_amdgcn_readfirstlane(xb_ld(edone + eb * 64)) < nb) {
        __builtin_amdgcn_s_sleep(2);
        if ((++sp & 255u) == 0u) { if (xb_ld(tmo)) break; if (sp > XB_SPIN_CAP) { atomicAdd(tmo, 1u); break; } } }
      if (!acquired) { __builtin_amdgcn_fence(__ATOMIC_ACQUIRE, "agent"); asm volatile("s_waitcnt vmcnt(0)" ::: "memory"); }
    }
    acquired = 1;
    asm volatile("" ::: "memory"); __builtin_amdgcn_s_barrier(); asm volatile("" ::: "memory");
  }
  __device__ __forceinline__ void done(const Unit&) const {}
};
template <int NPN>
struct MoeOrder {
  const char* A; const char* Wt; const int* lists; int cn[16]; int G, c; size_t wstride_e, wstride_pn; unsigned* edone;
  __device__ __forceinline__ bool next(int i, Unit& u) const {
    int L = i * G + c; bool found = false;
#pragma unroll
    for (int e = 0; e < 16; ++e) { const int nu = ((cn[e] + 255) >> 8) * NPN;
      if (!found) { if (L < nu) { found = true; const int tile = L / NPN, pn = L % NPN; u.pm = tile; u.pn = pn; u.aux = e; u.A = A; u.B = Wt + (size_t)e * wstride_e + (size_t)pn * wstride_pn;
          u.list = lists + (size_t)e * NTOK; u.row0 = tile * 256; u.nvalid = (cn[e] - tile * 256) < 256 ? (cn[e] - tile * 256) : 256; } else L -= nu; } }
    return found;
  }
  __device__ __forceinline__ void a_ready(const Unit&) const {}
  __device__ __forceinline__ void done(const Unit& u) const {
    asm volatile("s_waitcnt vmcnt(0)" ::: "memory");
    if ((threadIdx.x & 63) == 0) (void)xb_add(edone + u.aux * 64, 1u);
  }
};
}

__device__ __forceinline__ void phase_gemm_inA(const Params& p, LAS char* lds, int bid, int nblk) {
  char* ws = p.ws;
  const bf16_t* hb = (const bf16_t*)p.out;
  const bf16_t* wa = (const bf16_t*)(ws + OFF_W + W_AIN);
  { g8::DenseOrder S; S.init(hb, wa, 1024, NTOK, NIN_A, nblk, bid);
    g8::EpiScaleBf16L E{(bf16_t*)(ws + OFF_P), LDP, (const float*)(ws + OFF_RSTD), LDP, (LAS float*)(lds + g8::STAGE_BYTES + 1024), 0};
    g8::gemm_phase<g8::EpiScaleBf16L, g8::DenseOrder, 0>((LAS unsigned char*)lds, 1024, DM, S, E); }
}
__device__ __forceinline__ void phase_gemm_memkv(const Params& p, LAS char* lds, int bid, int nblk) {
  char* ws = p.ws;
  const bf16_t* memb = (const bf16_t*)((char*)p.out + ((size_t)64 << 20)); const bf16_t* wm = (const bf16_t*)(ws + OFF_W + W_MEM);
  __syncthreads();
  g8::DenseOrder S; S.init(memb, wm, 1024, NMEMROW, 1024, nblk, bid);
  g8::EpiMem E{(bf16_t*)(ws + OFF_MEMKV), (const float*)(ws + OFF_MRSTD)};
  g8::gemm_phase<g8::EpiMem, g8::DenseOrder, 0>((LAS unsigned char*)lds, 1024, DM, S, E);
  if (threadIdx.x == 0) { __builtin_amdgcn_fence(__ATOMIC_RELEASE, "agent"); (void)xb_add((unsigned*)(ws + OFF_CTRL) + CTRL_MEMKV, 1u); }
}
__device__ __forceinline__ void wait_counter(unsigned* ctl, int word, unsigned need) {
  __syncthreads();
  if (threadIdx.x == 0) { unsigned sp = 0u;
    while (xb_ld(ctl + word) < need) { __builtin_amdgcn_s_sleep(2); if ((++sp & 255u) == 0u) { if (xb_ld(&ctl[XB_TMO])) break; if (sp > XB_SPIN_CAP) { atomicAdd(&ctl[XB_TMO], 1u); break; } } }
    __builtin_amdgcn_fence(__ATOMIC_ACQUIRE, "agent"); asm volatile("s_waitcnt vmcnt(0)" ::: "memory"); }
  __syncthreads();
}
__device__ __forceinline__ void phase_gemm_inB(const Params& p, LAS char* lds, int bid, int nblk) {
  char* ws = p.ws;
  g8::DenseOrder S; S.init(ws + OFF_G + G_HB, ws + OFF_W + W_BIN, 1024, NTOK, NIN_B, nblk, bid);
  g8::EpiScaleBf16L E{(bf16_t*)(ws + OFF_P), LDP, (const float*)(ws + OFF_RSTD), LDP, (LAS float*)(lds + g8::STAGE_BYTES + 1024), 0};
  g8::gemm_phase<g8::EpiScaleBf16L, g8::DenseOrder, 0>((LAS unsigned char*)lds, 1024, DM, S, E);
}
__device__ __forceinline__ void phase_gemm_out(const Params& p, LAS char* lds, int bid, int nblk, int layer) {
  char* ws = p.ws;
  g8::DensePubOrder S; S.init(ws + OFF_P, ws + OFF_W + (layer ? W_BOUT : W_AOUT), 1024, NTOK, 1024, nblk, bid); S.pcnt = (unsigned*)(ws + OFF_CTRL) + CTRL_PANEL + layer * 128 * 16; S.np = 0; S.pend[0] = S.pend[1] = S.pend[2] = S.pend[3] = 0;
  bf16_t* hb = (bf16_t*)(ws + OFF_G + G_HB);
  g8::EpiResidBf16 E{hb, layer ? (const bf16_t*)hb : (const bf16_t*)p.out};
  g8::gemm_phase<g8::EpiResidBf16, g8::DensePubOrder, 0>((LAS unsigned char*)lds, 1024, LDP, S, E);
  S.flush();
}
__device__ __forceinline__ void phase_moe1(const Params& p, LAS char* lds, int bid, int nblk, int layer) {
  char* ws = p.ws;
  const unsigned* cnt = (const unsigned*)(ws + OFF_CTRL) + CTRL_CNT + layer * 16 * 64;
  g8::MoeOrder<2> S; S.A = ws + OFF_G + G_HB; S.Wt = ws + OFF_W + W_13 + (size_t)layer * 16 * 512 * 1024 * 2; S.lists = (const int*)(ws + OFF_LIST);
#pragma unroll
  for (int e = 0; e < 16; ++e) S.cn[e] = (int)cnt[e * 64];
  S.G = nblk; S.c = bid; S.wstride_e = (size_t)512 * 1024 * 2; S.wstride_pn = (size_t)256 * 1024 * 2; S.edone = (unsigned*)(ws + OFF_CTRL) + CTRL_EDONE + layer * 16 * 64;
  g8::EpiMoe1 E{(bf16_t*)(ws + OFF_P), (const float*)(ws + OFF_RSTD), (const float*)(ws + OFF_CW), (LAS int*)(lds + g8::STAGE_BYTES + 1024), 0};
  g8::gemm_phase<g8::EpiMoe1, g8::MoeOrder<2>, 1>((LAS unsigned char*)lds, 1024, DM, S, E);
}
__device__ __forceinline__ void phase_moe2(const Params& p, LAS char* lds, int bid, int nblk, int layer) {
  char* ws = p.ws;
  const unsigned* pcnt = (const unsigned*)(ws + OFF_CTRL) + CTRL_PCNT + layer * 24 * 64;
  g8::PairOrder S; S.A = ws + OFF_P; S.Wt = ws + OFF_W + W_2 + (size_t)layer * 16 * 1024 * 256 * 2; S.plist = (const int*)(ws + OFF_P + P_PLIST);
  const unsigned* cnt = (const unsigned*)(ws + OFF_CTRL) + CTRL_CNT + layer * 16 * 64;
  LAS int* scn = (LAS int*)(lds + g8::STAGE_BYTES);
  __syncthreads();
  if (threadIdx.x < 24) scn[threadIdx.x] = (int)pcnt[threadIdx.x * 64];
  if (threadIdx.x >= 32 && threadIdx.x < 48) scn[threadIdx.x] = (int)((cnt[(threadIdx.x - 32) * 64] + 255u) >> 8) * 16;
  __syncthreads();
  if (threadIdx.x == 0) { int n1 = 0;
#pragma unroll
    for (int e = 0; e < 16; ++e) n1 += scn[32 + e] >> 3;
    scn[48] = n1 % nblk; }
  __syncthreads();
  S.cn = scn; S.G = nblk; S.c = bid; S.r1 = __builtin_amdgcn_readfirstlane(scn[48]); S.acquired = 0;
  S.edone = (unsigned*)(ws + OFF_CTRL) + CTRL_EDONE + layer * 16 * 64; S.tmo = (unsigned*)(ws + OFF_CTRL) + XB_TMO;
  g8::EpiMoe2 E{(bf16_t*)(ws + OFF_G + G_MIX), (LAS int*)(lds + g8::STAGE_BYTES + 1024), 0};
  g8::gemm_phase<g8::EpiMoe2, g8::PairOrder, 0, true>((LAS unsigned char*)lds, 512, 512, S, E);
}


typedef float f32x2v __attribute__((ext_vector_type(2)));
__device__ __forceinline__ void phase_norm_route(const Params& p, LAS char* lds, int bid, int nblk, int layer) {
  char* ws = p.ws; const int tid = threadIdx.x, lane = tid & 63, r32 = lane & 31, hi = lane >> 5; const int w = __builtin_amdgcn_readfirstlane(tid >> 6);
  constexpr int WROWB = 2064;
  LAS char* wl = lds;
  LAS float* lgx = (LAS float*)(lds + 60 * WROWB);
  LAS float* ssx = lgx + 8 * 32 * 33;
  const bf16_t* wr = (const bf16_t*)(ws + OFF_WR) + (size_t)layer * 3 * 20480;
  __syncthreads();
  { u32x4 wv[15];
#pragma unroll
    for (int k = 0; k < 15; ++k) { const int i = tid + k * NTHR; wv[k] = *(const u32x4*)(wr + (size_t)i * 8); }
    if (bid * 4 < NTOK / 32) wait_counter((unsigned*)(ws + OFF_CTRL), CTRL_PANEL + layer * 128 * 16 + ((bid * 4) >> 3) * 16, 32u);
#pragma unroll
    for (int k = 0; k < 15; ++k) { const int i = tid + k * NTHR; *(LAS u32x4*)(wl + (i >> 7) * WROWB + (i & 127) * 16) = wv[k]; } }
  __syncthreads();
  bf16_t* hb = (bf16_t*)(ws + OFF_G + G_HB); float* rstd = (float*)(ws + OFF_RSTD); float* cw = (float*)(ws + OFF_CW);
  unsigned* cnt = (unsigned*)(ws + OFF_CTRL) + CTRL_CNT + layer * 16 * 64; int* lists = (int*)(ws + OFF_LIST);
  unsigned* pcnt = (unsigned*)(ws + OFF_CTRL) + CTRL_PCNT + layer * 24 * 64; int* plist = (int*)(ws + OFF_P + P_PLIST);
  const float* bg = p.b_group + layer * 4; const float* br = p.b_router + layer * 16;
  float bias[20];
#pragma unroll
  for (int j = 0; j < 20; ++j) bias[j] = j < 4 ? bg[j] : br[j - 4];
  const int nn = r32 < 20 ? r32 : 19;
  for (int base = bid * 4; base < NTOK / 32; base += nblk * 4) {
    if (base != bid * 4) wait_counter((unsigned*)(ws + OFF_CTRL), CTRL_PANEL + layer * 128 * 16 + (base >> 3) * 16, 32u);
    const int tile = base + (w & 3), kh = w >> 2, t0 = tile * 32;
    const bf16_t* hbrow = hb + (size_t)(t0 + r32) * DM + kh * 512 + 8 * hi;
    LAS const char* wrow = wl + nn * WROWB + (kh * 512 + 8 * hi) * 2;
    f32x16 acc = f32x16{}; float ss = 0.f;
    for (int j0 = 0; j0 < 32; j0 += 16) {
      u32x4 hr[16];
#pragma unroll
      for (int q = 0; q < 16; ++q) hr[q] = *(const u32x4*)(hbrow + (j0 + q) * 16);
#pragma unroll
      for (int q = 0; q < 16; ++q) {
        const u32x4 r = hr[q];
        const float h0 = bflo(r.x), h1 = bfhi(r.x), h2 = bflo(r.y), h3 = bfhi(r.y), h4 = bflo(r.z), h5 = bfhi(r.z), h6 = bflo(r.w), h7 = bfhi(r.w);
        ss += (h0 * h0 + h1 * h1) + (h2 * h2 + h3 * h3) + (h4 * h4 + h5 * h5) + (h6 * h6 + h7 * h7);
        const bf16x8 bfr = __builtin_bit_cast(bf16x8, r);
#pragma unroll
        for (int pc = 0; pc < 3; ++pc) { const bf16x8 afr = *(LAS const bf16x8*)(wrow + pc * 20 * WROWB + (j0 + q) * 32);
          acc = __builtin_amdgcn_mfma_f32_32x32x16_bf16(afr, bfr, acc, 0, 0, 0); }
      }
    }
    { auto sw = __builtin_amdgcn_permlane32_swap(__float_as_uint(ss), __float_as_uint(ss), false, false); ss = __uint_as_float(sw[0]) + __uint_as_float(sw[1]); }
    LAS float* lg = lgx + w * 32 * 33;
#pragma unroll
    for (int r = 0; r < 16; ++r) { const int n = (r & 3) + 8 * (r >> 2) + 4 * hi; lg[r32 * 33 + n] = acc[r]; }
    if (hi == 0) ssx[w * 32 + r32] = ss;
    __syncthreads();
    if (w < 4 && hi == 0) {
      LAS const float* la = lgx + w * 32 * 33 + r32 * 33; LAS const float* lb = lgx + (w + 4) * 32 * 33 + r32 * 33;
      const int t = t0 + r32;
      const float rs = rsqrtf((ssx[w * 32 + r32] + ssx[(w + 4) * 32 + r32]) * (1.f / DM) + EPS);
      float lgt[20];
#pragma unroll
      for (int j = 0; j < 20; ++j) lgt[j] = (la[j] + lb[j]) * rs + bias[j];
      int gs = 0; float gm = lgt[0];
#pragma unroll
      for (int j = 1; j < 4; ++j) if (lgt[j] > gm) { gm = lgt[j]; gs = j; }
      float den = 0.f;
#pragma unroll
      for (int j = 0; j < 4; ++j) den += __expf(lgt[j] - gm);
      const float pg = 1.f / den;
      float el[4];
#pragma unroll
      for (int j = 0; j < 4; ++j) el[j] = gs == 0 ? lgt[4 + j] : gs == 1 ? lgt[8 + j] : gs == 2 ? lgt[12 + j] : lgt[16 + j];
      int i1 = 0; float m1 = el[0];
#pragma unroll
      for (int j = 1; j < 4; ++j) if (el[j] > m1) { m1 = el[j]; i1 = j; }
      int i2 = -1; float m2 = -INFINITY;
#pragma unroll
      for (int j = 0; j < 4; ++j) if (j != i1 && el[j] > m2) { m2 = el[j]; i2 = j; }
      const float e2 = __expf(m2 - m1), p1 = 1.f / (1.f + e2), p2 = e2 * p1;
      const int ex1 = gs * 4 + i1, ex2 = gs * 4 + i2;
      unsigned myc = 0u; int rk1 = 0, rk2 = 0;
      const unsigned long long lt = (1ull << r32) - 1ull;
#pragma unroll
      for (int e = 0; e < 16; ++e) {
        const unsigned long long b1 = __ballot(ex1 == e), b2 = __ballot(ex2 == e);
        const int c1 = __popcll(b1), c2 = __popcll(b2);
        if (r32 == e) myc = (unsigned)(c1 + c2);
        if (ex1 == e) rk1 = __popcll(b1 & lt);
        if (ex2 == e) rk2 = c1 + __popcll(b2 & lt);
      }
      const int pos1 = ex1 < ex2 ? 0 : 1;
      const int xa = (pos1 ? i2 : i1), xb = (pos1 ? i1 : i2);
      const int pc = gs * 6 + (xa == 0 ? xb - 1 : xa == 1 ? xb + 1 : 5);
      unsigned myc2 = 0u; int rk = 0;
#pragma unroll
      for (int e = 0; e < 24; ++e) { const unsigned long long bb = __ballot(pc == e); if (r32 == e) myc2 = (unsigned)__popcll(bb); if (pc == e) rk = __popcll(bb & lt); }
      unsigned basev = 0u, base2 = 0u;
      if (r32 < 16 && myc) basev = atomicAdd(&cnt[r32 * 64], myc);
      if (r32 < 24 && myc2) base2 = atomicAdd(&pcnt[r32 * 64], myc2);
      const unsigned q1 = (unsigned)__shfl((int)basev, ex1) + (unsigned)rk1, q2 = (unsigned)__shfl((int)basev, ex2) + (unsigned)rk2;
      lists[(size_t)ex1 * NTOK + q1] = t * 2 + pos1; lists[(size_t)ex2 * NTOK + q2] = t * 2 + (1 - pos1);
      cw[t * 2 + pos1] = pg * p1; cw[t * 2 + 1 - pos1] = pg * p2; rstd[t] = rs;
      plist[(size_t)pc * NTOK + (unsigned)__shfl((int)base2, pc) + (unsigned)rk] = t;
    }
    __syncthreads();
  }
}

template <bool FINAL>
__device__ __forceinline__ void phase_combine(const Params& p, int bid, int nblk) {
  char* ws = p.ws; const int tid = threadIdx.x, lane = tid & 63, w = tid >> 6;
  const bf16_t* y = (const bf16_t*)(ws + OFF_G + G_MIX); bf16_t* hb = (bf16_t*)(ws + OFF_G + G_HB); float* rstd = (float*)(ws + OFF_RSTD);
  constexpr int TB = FINAL ? 4 : 8;
  f32x4 gn[4];
#pragma unroll
  for (int i = 0; i < 2; ++i) { const int c = i * 512 + lane * 8; gn[2 * i] = FINAL ? *(const f32x4*)(p.final_norm + c) : (f32x4){1.f, 1.f, 1.f, 1.f}; gn[2 * i + 1] = FINAL ? *(const f32x4*)(p.final_norm + c + 4) : (f32x4){1.f, 1.f, 1.f, 1.f}; }
  const int stride = nblk * 8;
  for (int t0 = bid * 8 + w; t0 < NTOK; t0 += stride * TB) {
    u32x4 ra[TB][2], rd[TB][2];
#pragma unroll
    for (int j = 0; j < TB; ++j) { const int tx = t0 + j * stride, t = tx < NTOK ? tx : t0;
#pragma unroll
      for (int i = 0; i < 2; ++i) { const int c = i * 512 + lane * 8; ra[j][i] = *(const u32x4*)(hb + (size_t)t * DM + c); rd[j][i] = *(const u32x4*)(y + (size_t)t * DM + c); } }
#pragma unroll
    for (int j = 0; j < TB; ++j) { const int t = t0 + j * stride;
      if (t < NTOK) {
        float v[16]; float ss = 0.f;
#pragma unroll
        for (int i = 0; i < 2; ++i) { const u32x4 a = ra[j][i], d = rd[j][i];
          v[8 * i] = bflo(a.x) + bflo(d.x); v[8 * i + 1] = bfhi(a.x) + bfhi(d.x); v[8 * i + 2] = bflo(a.y) + bflo(d.y); v[8 * i + 3] = bfhi(a.y) + bfhi(d.y);
          v[8 * i + 4] = bflo(a.z) + bflo(d.z); v[8 * i + 5] = bfhi(a.z) + bfhi(d.z); v[8 * i + 6] = bflo(a.w) + bflo(d.w); v[8 * i + 7] = bfhi(a.w) + bfhi(d.w); }
#pragma unroll
        for (int k = 0; k < 16; ++k) ss += v[k] * v[k];
        ss = wave_sum(ss);
        const float rs = rsqrtf(ss * (1.f / DM) + EPS);
#pragma unroll
        for (int i = 0; i < 2; ++i) { const int c = i * 512 + lane * 8;
          if (FINAL) {
            const f32x4 g0 = gn[2 * i], g1 = gn[2 * i + 1];
            *(f32x4*)(p.out + (size_t)t * DM + c) = (f32x4){v[8 * i] * rs * g0[0], v[8 * i + 1] * rs * g0[1], v[8 * i + 2] * rs * g0[2], v[8 * i + 3] * rs * g0[3]};
            *(f32x4*)(p.out + (size_t)t * DM + c + 4) = (f32x4){v[8 * i + 4] * rs * g1[0], v[8 * i + 5] * rs * g1[1], v[8 * i + 6] * rs * g1[2], v[8 * i + 7] * rs * g1[3]};
          } else {
            u32x4 o; o.x = cvt_pk_bf16(v[8 * i], v[8 * i + 1]); o.y = cvt_pk_bf16(v[8 * i + 2], v[8 * i + 3]); o.z = cvt_pk_bf16(v[8 * i + 4], v[8 * i + 5]); o.w = cvt_pk_bf16(v[8 * i + 6], v[8 * i + 7]);
            *(u32x4*)(hb + (size_t)t * DM + c) = o;
          }
        }
        if (!FINAL && lane == 0) rstd[t] = rs;
      }
    }
  }
}

namespace mem {
typedef short s16x4 __attribute__((ext_vector_type(4)));
constexpr int TILEB = 8192, LDS_K = 0, LDS_V = 4 * TILEB, LDS_WS = 8 * TILEB, LDS_OST = LDS_WS + 8 * 256;
__device__ __forceinline__ s16x4 vtr(LAS const char* p) { return __builtin_bit_cast(s16x4, __builtin_amdgcn_ds_read_tr16_b64_v4i16((LAS s16x4*)p)); }
__device__ __forceinline__ void prologue(bf16_t* P, const bf16_t* mkv, int b, int hd, int qb, LAS char* lds, bf16x8 (&qr)[4]) {
  const int tid = threadIdx.x, lane = tid & 63, r32 = lane & 31, hi = lane >> 5; const int wid = __builtin_amdgcn_readfirstlane(tid >> 6);
  const bf16_t* Kh = mkv + (size_t)b * 256 * 512 + hd * 64; const bf16_t* Vh = Kh + 256;
  const bf16_t* Qw = P + ((size_t)b * SEQ + qb * 256 + wid * 32) * LDP + PC_MQ + hd * 64;
  const bf16_t* ksrc = Kh + (size_t)lane * 512 + wid * 8;
  const bf16_t* vsrc = Vh + (size_t)(16 * (wid & 3) + (lane >> 2)) * 512 + (wid >> 2) * 32 + (lane & 3) * 8;
#pragma unroll
  for (int t = 0; t < 4; ++t) {
    __builtin_amdgcn_global_load_lds((const unsigned*)(ksrc + (size_t)t * 64 * 512), (LAS unsigned*)(lds + LDS_K + t * TILEB + wid * 1024), 16, 0, 0);
    __builtin_amdgcn_global_load_lds((const unsigned*)(vsrc + (size_t)t * 64 * 512), (LAS unsigned*)(lds + LDS_V + t * TILEB + wid * 1024), 16, 0, 0);
  }
#pragma unroll
  for (int d0 = 0; d0 < 4; ++d0) qr[d0] = *(const bf16x8*)(Qw + (size_t)r32 * LDP + d0 * 16 + hi * 8);
}
__device__ __forceinline__ void unit(bf16_t* P, const bf16_t* mkv, int b, int hd, int qb, LAS char* lds, bf16x8 (&qr)[4], bool has_next, int nb, int nhd, int nqb) {
  const int tid = threadIdx.x, lane = tid & 63, r32 = lane & 31, hi = lane >> 5; const int wid = __builtin_amdgcn_readfirstlane(tid >> 6);
  bf16_t* Qw = P + ((size_t)b * SEQ + qb * 256 + wid * 32) * LDP + PC_MQ + hd * 64;
  asm volatile("s_waitcnt vmcnt(0) lgkmcnt(0)\n\ts_barrier" ::: "memory");
  LAS const char* kp0 = lds + LDS_K + hi * 1024 + r32 * 16;
  LAS const char* vp0 = lds + LDS_V + ((lane >> 4) & 1) * 32 + (lane & 3) * 8 + (4 * hi + ((lane & 15) >> 2)) * 64;
  float mx = -INFINITY;
#pragma unroll
  for (int t = 0; t < 4; ++t) {
    f32x16 p0 = f32x16{}, p1 = f32x16{};
#pragma unroll
    for (int d0 = 0; d0 < 4; ++d0) {
      const bf16x8 k0 = *(LAS const bf16x8*)(kp0 + t * TILEB + d0 * 2048), k1 = *(LAS const bf16x8*)(kp0 + t * TILEB + d0 * 2048 + 512);
      p0 = __builtin_amdgcn_mfma_f32_32x32x16_bf16(k0, qr[d0], p0, 0, 0, 0); p1 = __builtin_amdgcn_mfma_f32_32x32x16_bf16(k1, qr[d0], p1, 0, 0, 0);
    }
#pragma unroll
    for (int r = 0; r < 16; ++r) mx = fmaxf(mx, fmaxf(p0[r], p1[r]));
  }
  { auto sw = __builtin_amdgcn_permlane32_swap(__float_as_uint(mx), __float_as_uint(mx), false, false); mx = fmaxf(__uint_as_float(sw[0]), __uint_as_float(sw[1])); }
  f32x16 o[2]; o[0] = f32x16{}; o[1] = f32x16{};
  float lsum = 0.f;
#pragma unroll
  for (int t = 0; t < 4; ++t) {
    f32x16 p0 = f32x16{}, p1 = f32x16{};
#pragma unroll
    for (int d0 = 0; d0 < 4; ++d0) {
      const bf16x8 k0 = *(LAS const bf16x8*)(kp0 + t * TILEB + d0 * 2048), k1 = *(LAS const bf16x8*)(kp0 + t * TILEB + d0 * 2048 + 512);
      p0 = __builtin_amdgcn_mfma_f32_32x32x16_bf16(k0, qr[d0], p0, 0, 0, 0); p1 = __builtin_amdgcn_mfma_f32_32x32x16_bf16(k1, qr[d0], p1, 0, 0, 0);
    }
    float a[32];
#pragma unroll
    for (int r = 0; r < 16; ++r) { a[r] = __builtin_amdgcn_exp2f(p0[r] - mx); a[16 + r] = __builtin_amdgcn_exp2f(p1[r] - mx); lsum += a[r] + a[16 + r]; }
    u32x4 pw[4];
#pragma unroll
    for (int ks = 0; ks < 4; ++ks) { pw[ks].x = cvt_pk_bf16(a[8 * ks], a[8 * ks + 1]); pw[ks].y = cvt_pk_bf16(a[8 * ks + 2], a[8 * ks + 3]); pw[ks].z = cvt_pk_bf16(a[8 * ks + 4], a[8 * ks + 5]); pw[ks].w = cvt_pk_bf16(a[8 * ks + 6], a[8 * ks + 7]); }
    LAS const char* vp = vp0 + t * TILEB;
#pragma unroll
    for (int d0 = 0; d0 < 2; ++d0)
#pragma unroll
      for (int ks = 0; ks < 4; ++ks) {
        const s16x4 lo = vtr(vp + d0 * 4096 + ks * 1024), hh = vtr(vp + d0 * 4096 + ks * 1024 + 512);
        const bf16x8 vf = (bf16x8){lo[0], lo[1], lo[2], lo[3], hh[0], hh[1], hh[2], hh[3]};
        o[d0] = __builtin_amdgcn_mfma_f32_32x32x16_bf16(__builtin_bit_cast(bf16x8, pw[ks]), vf, o[d0], 0, 0, 0);
      }
  }
  { auto sw = __builtin_amdgcn_permlane32_swap(__float_as_uint(lsum), __float_as_uint(lsum), false, false); lsum = __uint_as_float(sw[0]) + __uint_as_float(sw[1]); }
  asm volatile("s_waitcnt lgkmcnt(0)\n\ts_barrier" ::: "memory");
  bf16x8 qn[4];
  if (has_next) prologue(P, mkv, nb, nhd, nqb, lds, qn);
  LAS float* wsf = (LAS float*)(lds + LDS_WS) + wid * 64;
  if (hi == 0) wsf[r32] = __builtin_amdgcn_rcpf(lsum);
  asm volatile("s_waitcnt lgkmcnt(0)" ::: "memory");
  LAS bf16_t* stg = (LAS bf16_t*)(lds + LDS_OST) + wid * 2048;
#pragma unroll
  for (int r = 0; r < 16; ++r) { const int orow = (r & 3) + 8 * (r >> 2) + 4 * hi; const float il = wsf[orow];
#pragma unroll
    for (int d0 = 0; d0 < 2; ++d0) stg[orow * 64 + d0 * 32 + r32] = f2bf(o[d0][r] * il); }
  asm volatile("s_waitcnt lgkmcnt(0)" ::: "memory");
#pragma unroll
  for (int i = 0; i < 4; ++i) { const int row = i * 8 + (lane >> 3), ch = lane & 7; const u32x4 v = *(LAS const u32x4*)(stg + row * 64 + ch * 8); *(u32x4*)(Qw + (size_t)row * LDP + ch * 8) = v; }
  if (has_next) {
#pragma unroll
    for (int d0 = 0; d0 < 4; ++d0) qr[d0] = qn[d0];
  } else asm volatile("s_waitcnt vmcnt(0) lgkmcnt(0)\n\ts_barrier" ::: "memory");
}
__device__ __forceinline__ void unit1(bf16_t* P, const bf16_t* mkv, int b, int hd, int qb, LAS char* lds) {
  bf16x8 qr[4]; prologue(P, mkv, b, hd, qb, lds, qr); unit(P, mkv, b, hd, qb, lds, qr, false, 0, 0, 0);
}
}
__device__ __forceinline__ void phase_memattn(const Params& p, LAS char* lds, int bid, int nblk, int layer) {
  char* ws = p.ws; bf16_t* P = (bf16_t*)(ws + OFF_P);
  const bf16_t* mkv = (const bf16_t*)(ws + OFF_MEMKV) + (size_t)layer * 2048 * 512;
  int u = bid;
  if (u < NBATCH * 4 * 16) {
    bf16x8 qr[4]; mem::prologue(P, mkv, (u >> 4) >> 2, (u >> 4) & 3, u & 15, lds, qr);
    for (int guard = 0; guard < 64; ++guard) { const int bh = u >> 4, qb = u & 15, nu = u + nblk; const bool has_next = nu < NBATCH * 4 * 16;
      mem::unit(P, mkv, bh >> 2, bh & 3, qb, lds, qr, has_next, (nu >> 4) >> 2, (nu >> 4) & 3, nu & 15);
      if (!has_next) break; u = nu; }
  }
}

namespace sb {
typedef short s16x4 __attribute__((ext_vector_type(4)));
constexpr int SLOTB = 8192, NSLOT = 4, LDS_K = 0, LDS_V = NSLOT * SLOTB, LDS_OST = 2 * NSLOT * SLOTB, LDS_FLAG = LDS_OST + 8 * 4096, LDS_Q = LDS_FLAG + 256, LDS_BYTES_SB = LDS_Q + 8 * 4096;
__device__ __forceinline__ s16x4 vtr(LAS const char* p) { return __builtin_bit_cast(s16x4, __builtin_amdgcn_ds_read_tr16_b64_v4i16((LAS s16x4*)p)); }

#define SB_DMA(t, slot) do { __builtin_amdgcn_global_load_lds((const unsigned*)(ksrc + (size_t)(t) * 64 * LDP), (LAS unsigned*)(kdst + (slot)), 16, 0, 0); \
                             __builtin_amdgcn_global_load_lds((const unsigned*)(vsrc + (size_t)(t) * 64 * LDP), (LAS unsigned*)(vdst + (slot)), 16, 0, 0); } while (0)
__device__ __forceinline__ void prologue(const bf16_t* P, int b, int h, int qb, LAS char* lds) {
  const int tid = threadIdx.x, lane = tid & 63, r32 = lane & 31, hi = lane >> 5; const int wid = __builtin_amdgcn_readfirstlane(tid >> 6);
  const size_t rowbase = (size_t)b * SEQ; const int q0 = qb * 256;
  const bf16_t* Kh = P + rowbase * LDP + PC_K + h * 64; const bf16_t* Vh = P + rowbase * LDP + PC_V + h * 64;
  const bf16_t* Qw = P + (rowbase + q0 + wid * 32) * LDP + PC_Q + h * 64;
  const bf16_t* ksrc = Kh + (size_t)lane * LDP + wid * 8;
  const bf16_t* vsrc = Vh + (size_t)(16 * (wid & 3) + (lane >> 2)) * LDP + (wid >> 2) * 32 + (lane & 3) * 8;
  LAS char* kdst = lds + LDS_K + wid * 1024; LAS char* vdst = lds + LDS_V + wid * 1024;
  const int NT = 4 * qb + 4;
#pragma unroll
  for (int d0 = 0; d0 < 4; ++d0) __builtin_amdgcn_global_load_lds((const unsigned*)(Qw + (size_t)r32 * LDP + d0 * 16 + hi * 8), (LAS unsigned*)(lds + LDS_Q + wid * 4096 + d0 * 1024), 16, 0, 0);
  SB_DMA(NT - 1, 0); SB_DMA(NT - 2, SLOTB); SB_DMA(NT - 3, 2 * SLOTB);
}
__device__ __forceinline__ void unit(const bf16_t* P, bf16_t* O, int ldo, int b, int h, int qb, LAS char* lds, bool has_next, int nb, int nh, int nqb) {
  const int tid = threadIdx.x, lane = tid & 63, r32 = lane & 31, hi = lane >> 5; const int wid = __builtin_amdgcn_readfirstlane(tid >> 6);
  const size_t rowbase = (size_t)b * SEQ; const int q0 = qb * 256;
  const bf16_t* Kh = P + rowbase * LDP + PC_K + h * 64; const bf16_t* Vh = P + rowbase * LDP + PC_V + h * 64;
  const bf16_t* ksrc = Kh + (size_t)lane * LDP + wid * 8;
  const bf16_t* vsrc = Vh + (size_t)(16 * (wid & 3) + (lane >> 2)) * LDP + (wid >> 2) * 32 + (lane & 3) * 8;
  LAS char* kdst = lds + LDS_K + wid * 1024; LAS char* vdst = lds + LDS_V + wid * 1024;
  const int NT = 4 * qb + 4;
  bf16x8 qr[4];
  asm volatile("s_waitcnt vmcnt(6)" ::: "memory");
#pragma unroll
  for (int d0 = 0; d0 < 4; ++d0) qr[d0] = *(LAS const bf16x8*)(lds + LDS_Q + wid * 4096 + d0 * 1024 + lane * 16);
  f32x16 o[2]; o[0] = f32x16{}; o[1] = f32x16{};
  float c = 1.f;
  const int qrel = wid * 32 + r32;
  LAS const char* kp0 = lds + LDS_K + hi * 1024 + r32 * 16;
  LAS const char* vp0 = lds + LDS_V + ((lane >> 4) & 1) * 32 + (lane & 3) * 8 + (4 * hi + ((lane & 15) >> 2)) * 64;
  int slot = 0; bool wave_alive = true;
  LAS unsigned* fl = (LAS unsigned*)(lds + LDS_FLAG);
  for (int i = 0; i < NT; ++i) {
    const int t = NT - 1 - i;
    const int nslot = (slot == (NSLOT - 1) * SLOTB) ? 0 : slot + SLOTB;
    if (t > 1) { asm volatile("s_waitcnt vmcnt(4) lgkmcnt(0)\n\ts_barrier" ::: "memory"); }
    else if (t == 1) { asm volatile("s_waitcnt vmcnt(2) lgkmcnt(0)\n\ts_barrier" ::: "memory"); }
    else { asm volatile("s_waitcnt vmcnt(0) lgkmcnt(0)\n\ts_barrier" ::: "memory"); }
    if (t > 2) { const int pslot = (slot == 0) ? (NSLOT - 1) * SLOTB : slot - SLOTB; SB_DMA(t - 3, pslot); }
    if (i > 0) { const u32x4 f0 = *(LAS const u32x4*)(fl + ((i - 1) & 1) * 8), f1 = *(LAS const u32x4*)(fl + ((i - 1) & 1) * 8 + 4);
      if (__builtin_amdgcn_readfirstlane((int)(f0.x | f0.y | f0.z | f0.w | f1.x | f1.y | f1.z | f1.w)) == 0) break; }
    const int jb = t - (NT - 4);
    if (!(jb >= 0 && 64 * jb > 32 * wid + 30) && wave_alive) {
      f32x16 p0 = f32x16{}, p1 = f32x16{};
#pragma unroll
      for (int d0 = 0; d0 < 4; ++d0) {
        const bf16x8 k0 = *(LAS const bf16x8*)(kp0 + slot + d0 * 2048), k1 = *(LAS const bf16x8*)(kp0 + slot + d0 * 2048 + 512);
        p0 = __builtin_amdgcn_mfma_f32_32x32x16_bf16(k0, qr[d0], p0, 0, 0, 0);
        p1 = __builtin_amdgcn_mfma_f32_32x32x16_bf16(k1, qr[d0], p1, 0, 0, 0);
      }
      if (jb >= 0) {
        const int kb = 64 * jb + 4 * hi;
#pragma unroll
        for (int r = 0; r < 16; ++r) { const int kv = kb + (r & 3) + 8 * (r >> 2); if (kv >= qrel) p0[r] = -INFINITY; if (kv + 32 >= qrel) p1[r] = -INFINITY; }
      }
      float rr[32], be[32];
#pragma unroll
      for (int r = 0; r < 16; ++r) {
        const float e0 = __builtin_amdgcn_exp2f(p0[r]), e1 = __builtin_amdgcn_exp2f(p1[r]);
        rr[r] = __builtin_amdgcn_rcpf(1.f + e0); rr[16 + r] = __builtin_amdgcn_rcpf(1.f + e1);
        be[r] = 1.f - rr[r]; be[16 + r] = 1.f - rr[16 + r];
      }
      float OS[9]; OS[8] = 1.f;
#pragma unroll
      for (int G = 7; G >= 0; --G) { const float gp = (rr[4 * G] * rr[4 * G + 1]) * (rr[4 * G + 2] * rr[4 * G + 3]); OS[G] = OS[G + 1] * gp; }
      float cE[8];
#pragma unroll
      for (int G = 0; G < 8; ++G) {
        const float X = hi ? OS[G] : OS[G + 1], Y = OS[G + 1];
        auto sw = __builtin_amdgcn_permlane32_swap(__float_as_uint(X), __float_as_uint(Y), false, false);
        cE[G] = c * (__uint_as_float(sw[0]) * __uint_as_float(sw[1]));
      }
      { auto sw = __builtin_amdgcn_permlane32_swap(__float_as_uint(OS[0]), __float_as_uint(OS[0]), false, false); c *= __uint_as_float(sw[0]) * __uint_as_float(sw[1]); }
      float a[32];
#pragma unroll
      for (int G = 0; G < 8; ++G) {
        const float t3 = cE[G], t2 = t3 * rr[4 * G + 3], t1 = t2 * rr[4 * G + 2], t0 = t1 * rr[4 * G + 1];
        a[4 * G + 3] = be[4 * G + 3] * t3; a[4 * G + 2] = be[4 * G + 2] * t2; a[4 * G + 1] = be[4 * G + 1] * t1; a[4 * G] = be[4 * G] * t0;
      }
      u32x4 pw[4];
#pragma unroll
      for (int ks = 0; ks < 4; ++ks) { pw[ks].x = cvt_pk_bf16(a[8 * ks], a[8 * ks + 1]); pw[ks].y = cvt_pk_bf16(a[8 * ks + 2], a[8 * ks + 3]); pw[ks].z = cvt_pk_bf16(a[8 * ks + 4], a[8 * ks + 5]); pw[ks].w = cvt_pk_bf16(a[8 * ks + 6], a[8 * ks + 7]); }
      LAS const char* vp = vp0 + slot;
#pragma unroll
      for (int d0 = 0; d0 < 2; ++d0)
#pragma unroll
        for (int ks = 0; ks < 4; ++ks) {
          const s16x4 lo = vtr(vp + d0 * 4096 + ks * 1024), hh = vtr(vp + d0 * 4096 + ks * 1024 + 512);
          const bf16x8 vf = (bf16x8){lo[0], lo[1], lo[2], lo[3], hh[0], hh[1], hh[2], hh[3]};
          o[d0] = __builtin_amdgcn_mfma_f32_32x32x16_bf16(__builtin_bit_cast(bf16x8, pw[ks]), vf, o[d0], 0, 0, 0);
        }
    }
    wave_alive = __any(c != 0.f);
    if (lane == 0) fl[(i & 1) * 8 + wid] = wave_alive ? 1u : 0u;
    slot = nslot;
  }
  asm volatile("s_waitcnt lgkmcnt(0)\n\ts_barrier" ::: "memory");
  if (has_next) prologue(P, nb, nh, nqb, lds);
  bf16_t* Ow = O + (rowbase + q0 + wid * 32) * ldo + h * 64;
  LAS bf16_t* stg = (LAS bf16_t*)(lds + LDS_OST) + wid * 2048;
#pragma unroll
  for (int r = 0; r < 16; ++r) { const int orow = (r & 3) + 8 * (r >> 2) + 4 * hi;
#pragma unroll
    for (int d0 = 0; d0 < 2; ++d0) stg[orow * 64 + d0 * 32 + r32] = f2bf(o[d0][r]); }
  asm volatile("s_waitcnt lgkmcnt(0)" ::: "memory");
#pragma unroll
  for (int i = 0; i < 4; ++i) { const int row = i * 8 + (lane >> 3), ch = lane & 7; const u32x4 v = *(LAS const u32x4*)(stg + row * 64 + ch * 8); *(u32x4*)(Ow + (size_t)row * ldo + ch * 8) = v; }
  if (!has_next) asm volatile("s_waitcnt vmcnt(0) lgkmcnt(0)\n\ts_barrier" ::: "memory");
}
#undef SB_DMA
}
__device__ __forceinline__ void phase_sb_attn(const Params& p, LAS char* lds, int bid, int nblk, bool dummy = false) {
  char* ws = p.ws;
  bf16_t* P = (bf16_t*)(ws + OFF_P); bf16_t* Od = dummy ? (bf16_t*)(ws + OFF_G + G_MIX) : P; const int ldo = dummy ? DM : LDP;
  const int vcu = (nblk % 8 == 0) ? (bid % 8) * (nblk / 8) + bid / 8 : bid;
  int pi = vcu, half = 0;
  if (pi < 96 * 8) {
    { const int bh = pi >> 3, s_ = pi & 7; sb::prologue(P, bh / 12, bh % 12, 15 - s_, lds); }
    for (int guard = 0; guard < 64; ++guard) {
      const int bh = pi >> 3, s_ = pi & 7, b = bh / 12, h = bh % 12, qb = half ? s_ : 15 - s_;
      const int npi = half ? pi + nblk : pi, nhalf = half ^ 1; const bool has_next = npi < 96 * 8;
      const int nbh = npi >> 3, ns_ = npi & 7;
      sb::unit(P, Od, ldo, b, h, qb, lds, has_next, nbh / 12, nbh % 12, nhalf ? ns_ : 15 - ns_);
      if (!has_next) break;
      pi = npi; half = nhalf;
    }
  }
}

namespace gdn {
constexpr int RA_W = 0, RA_QG = 16384, RA_KT = 32768, RA_ATT = 49152, REC_A = 55296, REC_U = 16384, REC = REC_A + REC_U;
constexpr int HALF_LDS = 78848;
constexpr int GA_TM = 57344, GA_YM = GA_TM + 64 * 68 * 4, GA_RB = RA_QG;
constexpr float QSCALE = 0.08838834764831845f;
__device__ __forceinline__ int crow(int r, int hi) { return (r & 3) + 8 * (r >> 2) + 4 * hi; }
}
__device__ __forceinline__ void phase_gdn_prep(const Params& p, LAS char* lds, int ubase, int nunits, unsigned* q, int& t, int& nxt) {
  using namespace gdn;
  char* ws = p.ws; const bf16_t* P = (const bf16_t*)(ws + OFF_P); char* G = ws + OFF_G; float* EGL = (float*)(ws + OFF_EGL);
  LAS int* shq = (LAS int*)(lds + LDS_BYTES - 64);
  const __amdgpu_buffer_rsrc_t gr_ = __builtin_amdgcn_make_buffer_rsrc((void*)G, 0, (int)((size_t)216 << 20), 0x00020000);
  unsigned* gflag = (unsigned*)(ws + OFF_CTRL) + CTRL_GFLAG;
  for (;;) {
    if (2 * t >= nunits) break;
    int tl = threadIdx.x; asm volatile("" : "+v"(tl));
    const int tid = tl, hb = tid >> 8, ht = tid & 255, lane = tid & 63, r32 = lane & 31, hi = lane >> 5;
    const int hw = __builtin_amdgcn_readfirstlane(ht >> 6);
    LAS char* L = lds + hb * HALF_LDS;
    LAS float* sBeta = (LAS float*)(L + REC_A); LAS float* sGc = sBeta + 64; LAS float* sEgc = sGc + 64; LAS float* sRnK = sEgc + 64; LAS float* sRnQ = sRnK + 64;
    LAS char* sQ = L; LAS char* sK = L + 17408;
    LAS float* Amat = (LAS float*)(L + RA_W);
    const int u0 = 2 * t + hb; const bool valid = u0 < nunits; const int uq = ubase + (valid ? u0 : 0);
    const int bh = uq % 48, n = uq / 48, u = bh * 64 + n, b = bh / 6, h = bh % 6; const size_t row0 = (size_t)b * SEQ + (size_t)n * 64;
    const unsigned reco = (unsigned)u * (unsigned)REC;
    __syncthreads();
    if (hw == 0) {
      const bf16_t* pr = P + (row0 + lane) * LDP + PC_BA;
      const float braw = bf2f(pr[h]), araw = bf2f(pr[6 + h]);
      const float beta = sigmoidf_(braw), g = -__expf(p.a_log[h]) * softplusf_(araw + p.a_dt_bias[h]);
      float s = g;
#pragma unroll
      for (int o = 1; o < 64; o <<= 1) { const float t = __shfl_up(s, o); if (lane >= o) s += t; }
      sBeta[lane] = beta; sGc[lane] = s; sEgc[lane] = __expf(s);
    }
    {
      u32x4 rv[13];
#pragma unroll
      for (int k = 0; k < 13; ++k) { const int i = ht + k * 256, ic = i < 67 * 48 ? i : 67 * 48 - 1, rr = ic / 48, cc = ic % 48, part = cc >> 4, c8 = (cc & 15) * 8;
        const int rsrc = (n > 0 || rr >= 3) ? rr - 3 : 0;
        rv[k] = *(const u32x4*)(P + (row0 + rsrc) * LDP + (part == 0 ? PC_Q : part == 1 ? PC_K : PC_V) + h * 128 + c8); }
#pragma unroll
      for (int k = 0; k < 13; ++k) { const int i = ht + k * 256, rr = i / 48, cc = i % 48;
        if (i < 67 * 48) *(LAS u32x4*)(L + rr * 768 + cc * 16) = (n > 0 || rr >= 3) ? rv[k] : (u32x4){0u, 0u, 0u, 0u}; }
    }
    __syncthreads();
    float x[64], xq[64];
    {
      const int c = ht & 127; const bool isk = ht >= 128;
      {
        const int ch = (isk ? 768 : 1536) + h * 128 + c;
        const float w0 = p.a_conv[ch], w1 = p.a_conv[2304 + ch], w2 = p.a_conv[2 * 2304 + ch], w3 = p.a_conv[3 * 2304 + ch];
        LAS const char* src = L + (isk ? 256 : 512) + c * 2;
        float r0 = bf2f(*(LAS const bf16_t*)(src)), r1 = bf2f(*(LAS const bf16_t*)(src + 768)), r2 = bf2f(*(LAS const bf16_t*)(src + 2 * 768));
#pragma unroll
        for (int i = 0; i < 64; ++i) { const float r3 = bf2f(*(LAS const bf16_t*)(src + (i + 3) * 768)); x[i] = siluf_(w0 * r0 + w1 * r1 + w2 * r2 + w3 * r3); r0 = r1; r1 = r2; r2 = r3; }
      }
      if (!isk) {
        const int ch = h * 128 + c;
        const float w0 = p.a_conv[ch], w1 = p.a_conv[2304 + ch], w2 = p.a_conv[2 * 2304 + ch], w3 = p.a_conv[3 * 2304 + ch];
        LAS const char* src = L + c * 2;
        float r0 = bf2f(*(LAS const bf16_t*)(src)), r1 = bf2f(*(LAS const bf16_t*)(src + 768)), r2 = bf2f(*(LAS const bf16_t*)(src + 2 * 768));
#pragma unroll
        for (int i = 0; i < 64; ++i) { const float r3 = bf2f(*(LAS const bf16_t*)(src + (i + 3) * 768)); xq[i] = siluf_(w0 * r0 + w1 * r1 + w2 * r2 + w3 * r3); r0 = r1; r1 = r2; r2 = r3; }
      } else {
#pragma unroll
        for (int i = 0; i < 64; ++i) xq[i] = x[i];
      }
    }
    __syncthreads();
    if (ht < 128) {
#pragma unroll
      for (int i = 0; i < 64; ++i) *(LAS bf16_t*)(sQ + i * 272 + ht * 2) = f2bf(xq[i]);
    } else {
#pragma unroll
      for (int i = 0; i < 64; ++i) *(LAS bf16_t*)(sK + i * 272 + (ht - 128) * 2) = f2bf(x[i]);
    }
    __syncthreads();
    const int it = hw >> 1, jt = hw & 1;
    f32x16 akk = f32x16{}, aqk = f32x16{};
    if (hw != 1) {
#pragma unroll
      for (int ks = 0; ks < 8; ++ks) {
        const bf16x8 ak = *(LAS const bf16x8*)(sK + (32 * it + r32) * 272 + ks * 32 + hi * 16), aq = *(LAS const bf16x8*)(sQ + (32 * it + r32) * 272 + ks * 32 + hi * 16);
        const bf16x8 bk = *(LAS const bf16x8*)(sK + (32 * jt + r32) * 272 + ks * 32 + hi * 16);
        akk = __builtin_amdgcn_mfma_f32_32x32x16_bf16(ak, bk, akk, 0, 0, 0); aqk = __builtin_amdgcn_mfma_f32_32x32x16_bf16(aq, bk, aqk, 0, 0, 0);
      }
    } else {
#pragma unroll
      for (int ks = 0; ks < 8; ++ks) {
        const bf16x8 a0 = *(LAS const bf16x8*)(sQ + r32 * 272 + ks * 32 + hi * 16), a1 = *(LAS const bf16x8*)(sQ + (32 + r32) * 272 + ks * 32 + hi * 16);
        akk = __builtin_amdgcn_mfma_f32_32x32x16_bf16(a0, a0, akk, 0, 0, 0); aqk = __builtin_amdgcn_mfma_f32_32x32x16_bf16(a1, a1, aqk, 0, 0, 0);
      }
    }
    {
      float d0 = 0.f, d1 = 0.f;
#pragma unroll
      for (int r = 0; r < 16; ++r) if (crow(r, hi) == r32) { d0 = akk[r]; d1 = aqk[r]; }
      const bool has = ((r32 >> 2) & 1) == hi;
      if (has && hw == 0) sRnK[r32] = rsqrtf(d0 + EPS);
      if (has && hw == 3) sRnK[32 + r32] = rsqrtf(d0 + EPS);
      if (has && hw == 1) { sRnQ[r32] = rsqrtf(d0 + EPS) * QSCALE; sRnQ[32 + r32] = rsqrtf(d1 + EPS) * QSCALE; }
    }
    __syncthreads();
    if (hw != 1) {
      const int j = 32 * jt + r32; const float rnkj = sRnK[j], gcj = sGc[j];
      const int ksj = 2 * jt + (r32 >> 4), jo = r32 & 15, hip = (jo >> 2) & 1, jp = (jo & 3) + 4 * (jo >> 3);
      LAS char* attf = L + RA_ATT + (it ? 2 + ksj : ksj) * 1024 + hip * 512 + jp * 2;
#pragma unroll
      for (int r = 0; r < 16; ++r) {
        const int il = crow(r, hi), i = 32 * it + il;
        const float dec = __expf(fminf(sGc[i] - gcj, 0.f));
        const float aval = (i > j) ? sBeta[i] * sRnK[i] * rnkj * akk[r] * dec : 0.f;
        const float tval = (i >= j) ? sRnQ[i] * rnkj * aqk[r] * dec : 0.f;
        Amat[i * 64 + j] = aval;
        *(LAS bf16_t*)(attf + il * 16) = f2bf(tval);
        if ((r & 3) == 3) asm volatile("" ::: "memory");
      }
    }
    __syncthreads();
    LAS float* Tm = (LAS float*)(L + GA_TM); LAS float* Ym = (LAS float*)(L + GA_YM); LAS char* RB = L + GA_RB;
    {
      LAS char* rc = RB + ht * 128;
#pragma unroll
      for (int q = 0; q < 8; ++q) { float v[8];
#pragma unroll
        for (int e = 0; e < 8; ++e) { const int i = 8 * q + e; v[e] = x[i] * (ht < 128 ? sBeta[i] : sBeta[i] * sEgc[i] * sRnK[i]); }
        u32x4 w; w.x = cvt_pk_bf16(v[0], v[1]); w.y = cvt_pk_bf16(v[2], v[3]); w.z = cvt_pk_bf16(v[4], v[5]); w.w = cvt_pk_bf16(v[6], v[7]);
        *(LAS u32x4*)(rc + ((q ^ (ht & 7)) * 16)) = w; asm volatile("" ::: "memory"); }
    }
    if (hw == 0) {
      const int blk = hi, c = r32;
      LAS const float* Ab = Amat + (32 * blk) * 64 + 32 * blk;
      float t[32];
#pragma unroll
      for (int i = 0; i < 32; ++i) t[i] = (i == c) ? 1.f : 0.f;
#pragma unroll
      for (int i = 1; i < 32; ++i) {
        float a0 = 0.f, a1 = 0.f, a2 = 0.f, a3 = 0.f;
#pragma unroll
        for (int m4 = 0; m4 < (i + 3) / 4; ++m4) { const f32x4 a = *(LAS const f32x4*)(Ab + i * 64 + m4 * 4); a0 += a[0] * t[4 * m4]; a1 += a[1] * t[4 * m4 + 1]; a2 += a[2] * t[4 * m4 + 2]; a3 += a[3] * t[4 * m4 + 3]; }
        t[i] -= (a0 + a1) + (a2 + a3);
        if ((i & 3) == 3) asm volatile("" ::: "memory");
      }
#pragma unroll
      for (int k = 0; k < 32; ++k) Tm[(32 * blk + k) * 68 + 32 * blk + c] = t[k];
      asm volatile("s_waitcnt lgkmcnt(0)" ::: "memory");
      f32x16 acc = f32x16{};
      {
#pragma unroll
        for (int q = 0; q < 8; ++q) { const f32x4 a = *(LAS const f32x4*)(Amat + (32 + r32) * 64 + q * 4);
          const float av0 = hi ? a[1] : a[0], av1 = hi ? a[3] : a[2]; const float bv0 = Tm[(4 * q + hi) * 68 + r32], bv1 = Tm[(4 * q + 2 + hi) * 68 + r32];
          acc = __builtin_amdgcn_mfma_f32_32x32x2f32(av0, bv0, acc, 0, 0, 0); acc = __builtin_amdgcn_mfma_f32_32x32x2f32(av1, bv1, acc, 0, 0, 0);
          if (q & 1) asm volatile("" ::: "memory"); }
      }
#pragma unroll
      for (int r = 0; r < 16; ++r) Ym[crow(r, hi) * 32 + r32] = acc[r];
      asm volatile("s_waitcnt lgkmcnt(0)" ::: "memory");
      acc = f32x16{};
      {
#pragma unroll
        for (int q = 0; q < 8; ++q) { const f32x4 a = *(LAS const f32x4*)(Tm + (32 + r32) * 68 + 32 + q * 4);
          const float av0 = hi ? a[1] : a[0], av1 = hi ? a[3] : a[2]; const float bv0 = Ym[(4 * q + hi) * 32 + r32], bv1 = Ym[(4 * q + 2 + hi) * 32 + r32];
          acc = __builtin_amdgcn_mfma_f32_32x32x2f32(av0, bv0, acc, 0, 0, 0); acc = __builtin_amdgcn_mfma_f32_32x32x2f32(av1, bv1, acc, 0, 0, 0);
          if (q & 1) asm volatile("" ::: "memory"); }
      }
#pragma unroll
      for (int r = 0; r < 16; ++r) Tm[(32 + crow(r, hi)) * 68 + r32] = -acc[r];
    }
    __syncthreads();
    {
      f32x16 xa[2][2];
#pragma unroll
      for (int mt = 0; mt < 2; ++mt)
#pragma unroll
        for (int nl = 0; nl < 2; ++nl) xa[mt][nl] = f32x16{};
#pragma unroll
      for (int ks = 0; ks < 4; ++ks) {
        bf16x8 bfr[2];
#pragma unroll
        for (int nl = 0; nl < 2; ++nl) { const int col = 64 * hw + 32 * nl + r32; bfr[nl] = *(LAS const bf16x8*)(RB + col * 128 + (((2 * ks + hi) ^ (col & 7)) * 16)); }
#pragma unroll
        for (int mt = 0; mt < 2; ++mt) {
          if (mt == 0 && ks >= 2) continue;
          LAS const float* tp = Tm + (32 * mt + r32) * 68 + 16 * ks + 8 * hi;
          const f32x4 t0 = *(LAS const f32x4*)tp, t1 = *(LAS const f32x4*)(tp + 4);
          u32x4 w; w.x = cvt_pk_bf16(t0[0], t0[1]); w.y = cvt_pk_bf16(t0[2], t0[3]); w.z = cvt_pk_bf16(t1[0], t1[1]); w.w = cvt_pk_bf16(t1[2], t1[3]);
          const bf16x8 af = __builtin_bit_cast(bf16x8, w);
#pragma unroll
          for (int nl = 0; nl < 2; ++nl) xa[mt][nl] = __builtin_amdgcn_mfma_f32_32x32x16_bf16(af, bfr[nl], xa[mt][nl], 0, 0, 0);
        }
      }
      if (hw < 2) {
        if (valid) {
#pragma unroll
          for (int nl = 0; nl < 2; ++nl) { const unsigned ud = reco + (unsigned)(REC_A + (64 * hw + 32 * nl + r32) * 128 + hi * 32);
#pragma unroll
            for (int mt = 0; mt < 2; ++mt)
#pragma unroll
              for (int q = 0; q < 2; ++q) { u32x4 w; w.x = cvt_pk_bf16(xa[mt][nl][8 * q], xa[mt][nl][8 * q + 1]); w.y = cvt_pk_bf16(xa[mt][nl][8 * q + 2], xa[mt][nl][8 * q + 3]);
                w.z = cvt_pk_bf16(xa[mt][nl][8 * q + 4], xa[mt][nl][8 * q + 5]); w.w = cvt_pk_bf16(xa[mt][nl][8 * q + 6], xa[mt][nl][8 * q + 7]); __builtin_amdgcn_raw_buffer_store_b128(w, gr_, ud + mt * 64 + q * 16, 0, 16); } }
        }
      } else {
#pragma unroll
        for (int nl = 0; nl < 2; ++nl) { const int cp = 64 * (hw - 2) + 32 * nl + r32, co = cp & 15, hip = (co >> 2) & 1, jp = (co & 3) + 4 * (co >> 3);
          LAS char* wf = L + RA_W + (cp >> 4) * 1024 + hip * 512 + jp * 2;
#pragma unroll
          for (int mt = 0; mt < 2; ++mt)
#pragma unroll
            for (int r = 0; r < 16; ++r) *(LAS bf16_t*)(wf + mt * 8192 + crow(r, hi) * 16) = f2bf(-xa[mt][nl][r]); }
      }
    }
    __syncthreads();
    if (ht < 128) {
      const int c = ht;
      const int co = c & 15, hip = (co >> 2) & 1, jp = (co & 3) + 4 * (co >> 3);
      LAS char* qgf = L + RA_QG + (c >> 4) * 1024 + hip * 512 + jp * 2;
#pragma unroll
      for (int i = 0; i < 64; ++i) { *(LAS bf16_t*)(qgf + (i >> 5) * 8192 + (i & 31) * 16) = f2bf(xq[i] * sRnQ[i] * sEgc[i]); if ((i & 7) == 7) asm volatile("" ::: "memory"); }
    } else {
      const int c = ht - 128;
      const float gl = sGc[63];
      LAS char* ktf = L + RA_KT + (c >> 5) * 4096 + (c & 31) * 16;
#pragma unroll
      for (int ks = 0; ks < 4; ++ks)
#pragma unroll
        for (int hp = 0; hp < 2; ++hp) {
          float v[8];
#pragma unroll
          for (int jq = 0; jq < 8; ++jq) { const int i = 16 * ks + (jq & 3) + 8 * (jq >> 2) + 4 * hp; v[jq] = xq[i] * sRnK[i] * __expf(gl - sGc[i]); }
          u32x4 w; w.x = cvt_pk_bf16(v[0], v[1]); w.y = cvt_pk_bf16(v[2], v[3]); w.z = cvt_pk_bf16(v[4], v[5]); w.w = cvt_pk_bf16(v[6], v[7]);
          *(LAS u32x4*)(ktf + ks * 1024 + hp * 512) = w;
          asm volatile("" ::: "memory");
        }
    }
    if (ht == 0 && valid) __hip_atomic_store(EGL + u * 32, __expf(sGc[63]), __ATOMIC_RELAXED, __HIP_MEMORY_SCOPE_AGENT);
    __syncthreads();
    if (valid) for (int o = ht * 16; o < REC_A; o += 4096) __builtin_amdgcn_raw_buffer_store_b128(*(LAS const u32x4*)(L + o), gr_, reco + (unsigned)o, 0, 16);
    asm volatile("s_waitcnt vmcnt(0)" ::: "memory");
    if (valid && lane == 0) (void)xb_add(gflag + u, 1u);
    if (!q) break;
    __syncthreads(); if (threadIdx.x == 0) shq[0] = nxt; __syncthreads(); t = __builtin_amdgcn_readfirstlane(shq[0]); if (threadIdx.x == 0) nxt = (int)xb_add(q, 1u);
  }
}

__device__ __forceinline__ void phase_gdn_scan(const Params& p, LAS char* lds, int bid) {
  constexpr int c0 = 0, cend = 64;
  using namespace gdn;
  char* ws = p.ws; bf16_t* P = (bf16_t*)(ws + OFF_P); const char* G = ws + OFF_G; const float* EGL = (const float*)(ws + OFF_EGL);
  const int tid = threadIdx.x, lane = tid & 63, r32 = lane & 31, hi = lane >> 5; const int wid = __builtin_amdgcn_readfirstlane(tid >> 6);
  constexpr int RBUF = 57344;
  LAS char* OX = lds + 2 * RBUF;
  {
    const int u = bid; const int b = u / 6, h = u % 6; const size_t rowb = (size_t)b * SEQ; const char* recb = G + (size_t)u * 64 * REC;
    __syncthreads();
    unsigned* ctl = (unsigned*)(ws + OFF_CTRL);
    if (tid < 4) { unsigned sp = 0u;
      while (xb_ld(ctl + CTRL_GFLAG + u * 64 + tid) < 4u) { __builtin_amdgcn_s_sleep(2); if ((++sp & 255u) == 0u) { if (xb_ld(&ctl[XB_TMO])) break; if (sp > XB_SPIN_CAP) { atomicAdd(&ctl[XB_TMO], 1u); break; } } }
      __builtin_amdgcn_fence(__ATOMIC_ACQUIRE, "agent"); asm volatile("s_waitcnt vmcnt(0)" ::: "memory"); }
    __syncthreads();
    if (wid >= 4) {
      const int j = wid - 4, row = 16 * j + (lane >> 2), cg = (lane & 3) * 32;
      const char* recl = recb + j * 1024 + lane * 16;
      u32x4 R0[14], R1[14];
#define GH_LOAD(RS, r_) do { const int rr_ = (r_) < cend - 1 ? (r_) : cend - 1; const char* rp_ = recl + (size_t)rr_ * REC; _Pragma("unroll") for (int i_ = 0; i_ < 14; ++i_) RS[i_] = *(const u32x4*)(rp_ + i_ * 4096); } while (0)
#define GH_WRITE(RS, r_) do { LAS char* dp_ = lds + ((r_) & 1) * RBUF + j * 1024 + lane * 16; _Pragma("unroll") for (int i_ = 0; i_ < 14; ++i_) *(LAS u32x4*)(dp_ + i_ * 4096) = RS[i_]; } while (0)
      LAS float* gnl = (LAS float*)(lds + 2 * RBUF + 32768);
      if (j == 0) { gnl[lane] = p.a_out_gain[lane]; gnl[64 + lane] = p.a_out_gain[64 + lane]; }
      LAS const float* gnp = gnl + cg;
      const bf16_t* gp0 = P + (rowb + row) * LDP + PC_GATE + h * 128 + cg;
      bf16_t* dp0 = P + (rowb + row) * LDP + PC_Q + h * 128 + cg;
      u32x4 gr[4];
#pragma unroll
      for (int q = 0; q < 4; ++q) gr[q] = *(const u32x4*)(gp0 + (size_t)c0 * 64 * LDP + q * 8);
      asm volatile("" ::: "memory");
      GH_LOAD(R0, c0); GH_WRITE(R0, c0); GH_LOAD(R1, c0 + 1); GH_LOAD(R0, c0 + 2);
#define GH_STEP(c_, RS) do { const int c = (c_); \
        asm volatile("s_waitcnt lgkmcnt(0)\n\ts_barrier" ::: "memory"); \
        GH_WRITE(RS, c + 1); GH_LOAD(RS, c + 3);        \
        if (c >= c0 + 1 && c <= cend) { const int cc = c - 1; \
          LAS const char* op = OX + (cc & 1) * 16384 + row * 256 + cg * 2; \
          float ss = 0.f; \
          _Pragma("unroll") for (int q = 0; q < 4; ++q) { const u32x4 r = *(LAS const u32x4*)(op + q * 16); \
            const float o0 = bflo(r.x), o1 = bfhi(r.x), o2 = bflo(r.y), o3 = bfhi(r.y), o4 = bflo(r.z), o5 = bfhi(r.z), o6 = bflo(r.w), o7 = bfhi(r.w); \
            ss += (o0 * o0 + o1 * o1) + (o2 * o2 + o3 * o3) + (o4 * o4 + o5 * o5) + (o6 * o6 + o7 * o7); } \
          ss += __shfl_xor(ss, 1); ss += __shfl_xor(ss, 2); \
          const float sc = rsqrtf(ss * (1.f / 128.f) + EPS); \
          bf16_t* dp = dp0 + (size_t)cc * 64 * LDP; \
          _Pragma("unroll") for (int q = 0; q < 4; ++q) { u32x4 w; const u32x4 gg = gr[q]; const u32x4 r = *(LAS const u32x4*)(op + q * 16);        \
            const f32x4 g0 = *(LAS const f32x4*)(gnp + 8 * q), g1 = *(LAS const f32x4*)(gnp + 8 * q + 4); \
            w.x = cvt_pk_bf16(bflo(r.x) * sc * g0[0] * siluf_(bflo(gg.x)), bfhi(r.x) * sc * g0[1] * siluf_(bfhi(gg.x))); w.y = cvt_pk_bf16(bflo(r.y) * sc * g0[2] * siluf_(bflo(gg.y)), bfhi(r.y) * sc * g0[3] * siluf_(bfhi(gg.y))); \
            w.z = cvt_pk_bf16(bflo(r.z) * sc * g1[0] * siluf_(bflo(gg.z)), bfhi(r.z) * sc * g1[1] * siluf_(bfhi(gg.z))); w.w = cvt_pk_bf16(bflo(r.w) * sc * g1[2] * siluf_(bflo(gg.w)), bfhi(r.w) * sc * g1[3] * siluf_(bfhi(gg.w))); \
            *(u32x4*)(dp + q * 8) = w; } \
          { const int cn_ = c < cend - 1 ? c : cend - 1; _Pragma("unroll") for (int q = 0; q < 4; ++q) gr[q] = *(const u32x4*)(gp0 + (size_t)cn_ * 64 * LDP + q * 8); } \
        } \
      } while (0)
      for (int c2 = c0; c2 <= cend; c2 += 2) { GH_STEP(c2, R1); GH_STEP(c2 + 1, R0); }
#undef GH_STEP
#undef GH_LOAD
#undef GH_WRITE
    } else {
      const int vs = wid;
      f32x16 S[4];
#pragma unroll
      for (int k = 0; k < 4; ++k)
#pragma unroll
        for (int r = 0; r < 16; ++r) S[k][r] = 0.f;
      const char* ub = recb + REC_A + (vs * 32 + r32) * 128 + hi * 32;
      u32x4 un[4];
#pragma unroll
      for (int q = 0; q < 4; ++q) un[q] = *(const u32x4*)(ub + (size_t)c0 * REC + (q >> 1) * 64 + (q & 1) * 16);
      const float* egp = EGL + (size_t)u * 64 * 32;
      float egn = egp[0];
      unsigned* gfl = ctl + CTRL_GFLAG + u * 64;
      for (int c = c0; c <= cend + 1; ++c) {
        asm volatile("s_waitcnt lgkmcnt(0)\n\ts_barrier" ::: "memory");
        if (c < cend) {
          unsigned fl = 4u;
          if (vs == 0) fl = xb_ld(gfl + (c + 4 < cend ? c + 4 : cend - 1));
          LAS const char* R = lds + (c & 1) * RBUF + lane * 16;
          const float egl = egn;
          u32x4 uc[4];
#pragma unroll
          for (int q = 0; q < 4; ++q) uc[q] = un[q];
          { const int cu = c + 1 < cend ? c + 1 : cend - 1;
#pragma unroll
            for (int q = 0; q < 4; ++q) un[q] = *(const u32x4*)(ub + (size_t)cu * REC + (q >> 1) * 64 + (q & 1) * 16);
            egn = egp[cu * 32]; }
          bf16x8 Sb[8];
#pragma unroll
          for (int ks = 0; ks < 8; ++ks) { const int kt = ks >> 1, o = (ks & 1) * 8; u32x4 w;
            w.x = cvt_pk_bf16(S[kt][o], S[kt][o + 1]); w.y = cvt_pk_bf16(S[kt][o + 2], S[kt][o + 3]); w.z = cvt_pk_bf16(S[kt][o + 4], S[kt][o + 5]); w.w = cvt_pk_bf16(S[kt][o + 6], S[kt][o + 7]);
            Sb[ks] = __builtin_bit_cast(bf16x8, w); }
#define GB_LD(dst, off0, off1) do { _Pragma("unroll") for (int q_ = 0; q_ < 4; ++q_) { dst[q_] = *(LAS const bf16x8*)(R + (off0) + q_ * 1024); dst[4 + q_] = *(LAS const bf16x8*)(R + (off1) + q_ * 1024); } } while (0)
#define GB_SCHED __builtin_amdgcn_sched_barrier(0)
          bf16x8 fa[8];
          GB_LD(fa, RA_W, RA_W + 8192);
          f32x16 vn[2];
#pragma unroll
          for (int t2 = 0; t2 < 2; ++t2)
#pragma unroll
            for (int q = 0; q < 2; ++q) { const u32x4 r = uc[2 * t2 + q];
              vn[t2][8 * q] = bflo(r.x); vn[t2][8 * q + 1] = bfhi(r.x); vn[t2][8 * q + 2] = bflo(r.y); vn[t2][8 * q + 3] = bfhi(r.y); vn[t2][8 * q + 4] = bflo(r.z); vn[t2][8 * q + 5] = bfhi(r.z); vn[t2][8 * q + 6] = bflo(r.w); vn[t2][8 * q + 7] = bfhi(r.w); }
          GB_SCHED;
#pragma unroll
          for (int ks = 0; ks < 4; ++ks) { vn[0] = __builtin_amdgcn_mfma_f32_32x32x16_bf16(fa[ks], Sb[ks], vn[0], 0, 0, 0); vn[1] = __builtin_amdgcn_mfma_f32_32x32x16_bf16(fa[4 + ks], Sb[ks], vn[1], 0, 0, 0); }
          GB_SCHED; GB_LD(fa, RA_W + 4096, RA_W + 8192 + 4096); GB_SCHED;
#pragma unroll
          for (int ks = 0; ks < 4; ++ks) { vn[0] = __builtin_amdgcn_mfma_f32_32x32x16_bf16(fa[ks], Sb[4 + ks], vn[0], 0, 0, 0); vn[1] = __builtin_amdgcn_mfma_f32_32x32x16_bf16(fa[4 + ks], Sb[4 + ks], vn[1], 0, 0, 0); }
          GB_SCHED; GB_LD(fa, RA_KT, RA_KT + 4096); GB_SCHED;
          bf16x8 vb[4];
#pragma unroll
          for (int ks = 0; ks < 4; ++ks) { const int t2 = ks >> 1, o = (ks & 1) * 8; u32x4 w;
            w.x = cvt_pk_bf16(vn[t2][o], vn[t2][o + 1]); w.y = cvt_pk_bf16(vn[t2][o + 2], vn[t2][o + 3]); w.z = cvt_pk_bf16(vn[t2][o + 4], vn[t2][o + 5]); w.w = cvt_pk_bf16(vn[t2][o + 6], vn[t2][o + 7]);
            vb[ks] = __builtin_bit_cast(bf16x8, w); }
          f32x16 oo[2]; oo[0] = f32x16{}; oo[1] = f32x16{};
          S[0] = S[0] * egl; S[1] = S[1] * egl;
#pragma unroll
          for (int ks = 0; ks < 4; ++ks) { S[0] = __builtin_amdgcn_mfma_f32_32x32x16_bf16(fa[ks], vb[ks], S[0], 0, 0, 0); S[1] = __builtin_amdgcn_mfma_f32_32x32x16_bf16(fa[4 + ks], vb[ks], S[1], 0, 0, 0); }
          GB_SCHED; GB_LD(fa, RA_KT + 8192, RA_KT + 12288); GB_SCHED;
          S[2] = S[2] * egl; S[3] = S[3] * egl;
#pragma unroll
          for (int ks = 0; ks < 4; ++ks) { S[2] = __builtin_amdgcn_mfma_f32_32x32x16_bf16(fa[ks], vb[ks], S[2], 0, 0, 0); S[3] = __builtin_amdgcn_mfma_f32_32x32x16_bf16(fa[4 + ks], vb[ks], S[3], 0, 0, 0); }
          GB_SCHED; GB_LD(fa, RA_QG, RA_QG + 8192); GB_SCHED;
#pragma unroll
          for (int ks = 0; ks < 4; ++ks) { oo[0] = __builtin_amdgcn_mfma_f32_32x32x16_bf16(fa[ks], Sb[ks], oo[0], 0, 0, 0); oo[1] = __builtin_amdgcn_mfma_f32_32x32x16_bf16(fa[4 + ks], Sb[ks], oo[1], 0, 0, 0); }
          GB_SCHED; GB_LD(fa, RA_QG + 4096, RA_QG + 8192 + 4096); GB_SCHED;
#pragma unroll
          for (int ks = 0; ks < 4; ++ks) { oo[0] = __builtin_amdgcn_mfma_f32_32x32x16_bf16(fa[ks], Sb[4 + ks], oo[0], 0, 0, 0); oo[1] = __builtin_amdgcn_mfma_f32_32x32x16_bf16(fa[4 + ks], Sb[4 + ks], oo[1], 0, 0, 0); }
          GB_SCHED;
#pragma unroll
          for (int q = 0; q < 6; ++q) fa[q] = *(LAS const bf16x8*)(R + RA_ATT + q * 1024);
          GB_SCHED;
          oo[0] = __builtin_amdgcn_mfma_f32_32x32x16_bf16(fa[0], vb[0], oo[0], 0, 0, 0); oo[1] = __builtin_amdgcn_mfma_f32_32x32x16_bf16(fa[2], vb[0], oo[1], 0, 0, 0);
          oo[0] = __builtin_amdgcn_mfma_f32_32x32x16_bf16(fa[1], vb[1], oo[0], 0, 0, 0); oo[1] = __builtin_amdgcn_mfma_f32_32x32x16_bf16(fa[3], vb[1], oo[1], 0, 0, 0);
          oo[1] = __builtin_amdgcn_mfma_f32_32x32x16_bf16(fa[4], vb[2], oo[1], 0, 0, 0); oo[1] = __builtin_amdgcn_mfma_f32_32x32x16_bf16(fa[5], vb[3], oo[1], 0, 0, 0);
#undef GB_LD
#undef GB_SCHED
          LAS char* ox = OX + (c & 1) * 16384 + (vs * 32 + r32) * 2;
#pragma unroll
          for (int t2 = 0; t2 < 2; ++t2)
#pragma unroll
            for (int r = 0; r < 16; ++r) *(LAS bf16_t*)(ox + (32 * t2 + crow(r, hi)) * 256) = f2bf(oo[t2][r]);
          if (vs == 0) {
            unsigned sp = 0u;
            while ((unsigned)__builtin_amdgcn_readfirstlane(fl) < 4u) { __builtin_amdgcn_s_sleep(2);
              if ((++sp & 255u) == 0u) { if (xb_ld(&ctl[XB_TMO])) break; if (sp > XB_SPIN_CAP) { atomicAdd(&ctl[XB_TMO], 1u); break; } }
              fl = xb_ld(gfl + (c + 4 < cend ? c + 4 : cend - 1)); }
          }
        }
      }
    }
  }
}


__device__ __forceinline__ void phase_l2_stream(const Params& p, LAS char* lds) {
  char* ws = p.ws; unsigned* ctl = (unsigned*)(ws + OFF_CTRL); const char* G = ws + OFF_G; const bf16_t* P = (const bf16_t*)(ws + OFF_P);
  const int tid = threadIdx.x;
  LAS int* sh = (LAS int*)lds;
  __syncthreads();
  if (tid == 0) {
    const unsigned x = xb_xcc_id();
    int n = 0;
    for (int s_ = 0; s_ < 48; ++s_) { const unsigned v = __hip_atomic_load(&ctl[CTRL_XCC + s_], __ATOMIC_RELAXED, __HIP_MEMORY_SCOPE_AGENT); if (v == x + 1u && n < 8) { sh[8 + n] = s_; ++n; } }
    const unsigned rank = n ? __hip_atomic_fetch_add(&ctl[CTRL_RANK + x * 16], 1u, __ATOMIC_RELAXED, __HIP_MEMORY_SCOPE_AGENT) : 0u;
    sh[0] = n ? sh[8 + (int)(rank % (unsigned)n)] : -1;
    sh[1] = n ? (int)(rank / (unsigned)n) : 0;
  }
  __syncthreads();
  const int sbh = sh[0], q = sh[1];
  if (sbh < 0 || q >= 4) return;
  const int b = sbh / 6, h = sbh % 6; const char* recb = G + (size_t)sbh * 64 * gdn::REC; const size_t rowb = (size_t)b * SEQ;
  const unsigned long long t0 = wall_clock64();
  unsigned acc = 0u; int next = 0;
  while (next < 64) {
    const unsigned done = __builtin_amdgcn_readfirstlane(__hip_atomic_load(&ctl[CTRL_PROG + sbh * 16], __ATOMIC_RELAXED, __HIP_MEMORY_SCOPE_AGENT));
    if (wall_clock64() - t0 > 60000ull) break;
    const int lim = (int)done + 5 < 64 ? (int)done + 5 : 64;
    if (next >= lim) { __builtin_amdgcn_s_sleep(16); continue; }
    for (; next < lim; ++next) {
      if (next < (int)done + 1) continue;
      const char* rec = recb + (size_t)next * gdn::REC;
      for (int o = (q * 512 + tid) * 16; o < gdn::REC; o += 4 * 512 * 16) acc ^= (*(const u32x4*)(rec + o)).x;
      if (q == 0) { const int r = tid >> 3, ch = tid & 7; acc ^= (*(const u32x4*)(P + (rowb + (size_t)next * 64 + r) * LDP + PC_GATE + h * 128 + ch * 16)).x; }
    }
  }
  if (acc == 0x9E3779B9u && tid == 1023) ctl[CTRL_RANK + 15 * 16 + 1] = acc;
}

constexpr int NPHASE = 15;
__global__ void __launch_bounds__(NTHR, 2) yoco_fwd(Params p, int lo, int hi) {
  extern __shared__ __attribute__((aligned(16))) char smem_raw[];
  LAS char* lds = (LAS char*)smem_raw;
  const int bid = blockIdx.x, nblk = gridDim.x;
  LAS unsigned* xbw = (LAS unsigned*)(lds + LDS_BYTES - 16);
  if (threadIdx.x == 0) { xbw[0] = 0u; xbw[1] = 0u; xbw[2] = 0u; xbw[3] = 0u; }
  __syncthreads();
  XcdBarrier bar; bar.bar = (unsigned*)(p.ws + OFF_CTRL); bar.x = 0; bar.st = (volatile LAS unsigned*)xbw;
  if (hi - lo > 1) bar = xcd_barrier_post((unsigned*)(p.ws + OFF_CTRL), (volatile LAS unsigned*)xbw);
#ifndef PROBE_DOUBLE
#define PROBE_DOUBLE -1
#endif
#define PH(k) if (lo <= (k) && (k) < hi)
#ifndef PROBE_AMP
#define PROBE_AMP -1
#endif
#ifndef PROBE_BLK
#define PROBE_BLK 0
#endif
#if PROBE_AMP >= 0
  unsigned long long tph = wall_clock64();
#define SEAM_ID(id, k) do { if ((id) == PROBE_AMP && bid == PROBE_BLK && threadIdx.x == 0) { const unsigned long long dt_ = wall_clock64() - tph, t1_ = wall_clock64(); while (wall_clock64() - t1_ < 16ull * dt_) __builtin_amdgcn_s_sleep(8); } \
    if (lo <= (k) && (k) + 1 < hi) xcd_barrier(bar); tph = wall_clock64(); } while (0)
#else
#define SEAM_ID(id, k) do { if (lo <= (k) && (k) + 1 < hi) xcd_barrier(bar); } while (0)
#endif
  PH(0) phase_prep<false>(p, bid, nblk);
#if PROBE_DOUBLE == 0
  PH(0) { __syncthreads(); phase_prep<false>(p, bid, nblk); }
#endif
  SEAM_ID(0, 0);
  PH(1) phase_gemm_inA(p, lds, bid, nblk);
#if PROBE_DOUBLE == 1
  PH(1) phase_gemm_inA(p, lds, bid, nblk);
#endif
  SEAM_ID(1, 1);
  PH(2) { int t = bid, nx = 0; phase_gdn_prep(p, lds, 0, 2 * nblk, nullptr, t, nx); }
  PH(2) { unsigned* ctl = (unsigned*)(p.ws + OFF_CTRL); unsigned* q = ctl + CTRL_QUEUE2; LAS int* shq = (LAS int*)(lds + LDS_BYTES - 64);
          const int nu2 = 3072 - 2 * nblk, NGA = (nu2 + 1) / 2, NT = NGA + NCHUNK0 + NBATCH * 64;
          if (bid < 48) { phase_gdn_scan(p, lds, bid); wait_counter(ctl, CTRL_QUEUE2, (unsigned)NGA); }
          else if (bid >= nblk - 32) phase_gemm_memkv(p, lds, bid - (nblk - 32), 32);
          int t, nx = 0;
          __syncthreads(); if (threadIdx.x == 0) { shq[0] = (int)xb_add(q, 1u); nx = (int)xb_add(q, 1u); } __syncthreads(); t = __builtin_amdgcn_readfirstlane(shq[0]);
          if (bid >= 48) phase_gdn_prep(p, lds, 2 * nblk, nu2, q, t, nx);
          bool waited = false;
          for (int guard = 0; guard < 4096; ++guard) {
            if (t >= NT) break;
            if (t >= NGA) { const int c = t - NGA;
              if (c >= NBATCH * 64) prep_late0_chunk(p, c - NBATCH * 64);
              else { if (!waited) { wait_counter(ctl, CTRL_MEMKV, 32u); waited = true; }
                     const int u = c, bh = u >> 4; mem::unit1((bf16_t*)(p.ws + OFF_P), (const bf16_t*)(p.ws + OFF_MEMKV), bh >> 2, bh & 3, u & 15, lds); } }
            __syncthreads(); if (threadIdx.x == 0) shq[0] = nx; __syncthreads(); t = __builtin_amdgcn_readfirstlane(shq[0]); if (threadIdx.x == 0) nx = (int)xb_add(q, 1u);
          } }
  SEAM_ID(3, 2);
  PH(3) phase_gemm_out(p, lds, bid, nblk, 0);
#if PROBE_DOUBLE == 3
  PH(3) phase_gemm_out(p, lds, bid, nblk, 0);
#endif
  PH(4) phase_norm_route(p, lds, bid, nblk, 0);
  SEAM_ID(5, 4);
  PH(5) phase_moe1(p, lds, bid, nblk, 0);
#if PROBE_DOUBLE == 5
  PH(5) phase_moe1(p, lds, bid, nblk, 0);
#endif
  PH(6) { phase_moe2(p, lds, bid, nblk, 0); phase_prep_late1_queue(p, lds); }
#if PROBE_DOUBLE == 6
  PH(6) phase_moe2(p, lds, bid, nblk, 0);
#endif
  SEAM_ID(7, 6);
  PH(7) phase_combine<false>(p, bid, nblk);
  SEAM_ID(8, 7);
  PH(8) phase_gemm_inB(p, lds, bid, nblk);
#if PROBE_DOUBLE == 8
  PH(8) phase_gemm_inB(p, lds, bid, nblk);
#endif
  SEAM_ID(9, 8);
#if PROBE_DOUBLE == 9
  PH(9) { phase_sb_attn(p, lds, bid, nblk, true); }
#endif
  PH(9) { phase_sb_attn(p, lds, bid, nblk); phase_memattn(p, lds, bid, nblk, 1); }
#if PROBE_DOUBLE == 91
  PH(9) { phase_memattn(p, lds, bid, nblk, 1); }
#endif
  SEAM_ID(10, 9);
  PH(10) phase_gemm_out(p, lds, bid, nblk, 1);
  PH(11) phase_norm_route(p, lds, bid, nblk, 1);
  SEAM_ID(12, 11);
  PH(12) phase_moe1(p, lds, bid, nblk, 1);
  PH(13) phase_moe2(p, lds, bid, nblk, 1);
  SEAM_ID(14, 13);
  PH(14) phase_combine<true>(p, bid, nblk);
#if PROBE_AMP == 15
  if (bid == PROBE_BLK && threadIdx.x == 0) { const unsigned long long dt_ = wall_clock64() - tph, t1_ = wall_clock64(); while (wall_clock64() - t1_ < 16ull * dt_) __builtin_amdgcn_s_sleep(8); }
#endif
#undef PH
#undef SEAM_ID
}

#ifndef N_LAUNCH_SPLIT
#define N_LAUNCH_SPLIT 0
#endif

extern "C" void kernel_launch(void* const* d_in, const int* in_sizes, int n_in, void* d_out, int out_size, void* d_ws, size_t ws_size, hipStream_t stream) {
  (void)in_sizes; (void)n_in; (void)out_size;
  if (ws_size < WS_NEED) return;
  static int grid = 0;
  if (!grid) {
    if (hipFuncSetAttribute((const void*)yoco_fwd, hipFuncAttributeMaxDynamicSharedMemorySize, LDS_BYTES) != hipSuccess) { grid = -1; return; }
    int dev = 0, cus = 0; hipGetDevice(&dev); hipDeviceGetAttribute(&cus, hipDeviceAttributeMultiprocessorCount, dev);
    int per_cu = 0; hipOccupancyMaxActiveBlocksPerMultiprocessor(&per_cu, (const void*)yoco_fwd, NTHR, LDS_BYTES);
    grid = (per_cu >= 1) ? cus : -1;
  }
  if (grid <= 0) return;
  Params p{};
  const float** pf = (const float**)&p;
  for (int i = 0; i < 25; ++i) pf[i] = (const float*)d_in[i];
  p.out = (float*)d_out; p.ws = (char*)d_ws;
  hipMemsetAsync(d_ws, 0, CTRL_BYTES, stream);
#if N_LAUNCH_SPLIT
  for (int k = 0; k < NPHASE; ++k) hipLaunchKernelGGL(yoco_fwd, dim3(grid), dim3(NTHR), LDS_BYTES, stream, p, k, k + 1);
#else
  hipLaunchKernelGGL(yoco_fwd, dim3(grid), dim3(NTHR), LDS_BYTES, stream, p, 0, NPHASE);
#endif
}
```
